# Optimizing an MI355X kernel written in HIP

```python
import jax
import jax.numpy as jnp
from jax import lax
import numpy as np

D_MODEL = 1024
BATCH = 1
SEQ = 16384
DEPTH = 2
DEC_BATCH = 32
DEC_SEQ = 16
PAST_LEN = 4096

CHUNK = 64
N_HEADS = 8
QK_NOPE = 128
QK_ROPE = 64
V_DIM = 128
Q_LORA = 384
KV_LORA = 512
ATTN_WIDTH = N_HEADS * V_DIM
GM_CHUNK = 128
GM_WIDTH = 1024
GM_GROUPS = 8
GM_GROUP_DIM = GM_WIDTH // GM_GROUPS
D_FF = 2816
PLE_DIM = 256
ROPE_THETA = 10000.0
Q_BLOCK = 128
EPS = 1e-6
SCALE = (QK_NOPE + QK_ROPE) ** -0.5
SPLITS = [Q_LORA,
          Q_LORA + KV_LORA,
          Q_LORA + KV_LORA + QK_ROPE,
          Q_LORA + KV_LORA + QK_ROPE + GM_WIDTH,
          Q_LORA + KV_LORA + QK_ROPE + 2 * GM_WIDTH,
          Q_LORA + KV_LORA + QK_ROPE + 2 * GM_WIDTH + D_MODEL]
D_IN = Q_LORA + KV_LORA + QK_ROPE + 2 * GM_WIDTH + 2 * D_MODEL

kernel_name = 'hybrid_mla_gmlp_streaming_step'


def rmsnorm(x, g):
    xf = x.astype(jnp.float32)
    y = xf * lax.rsqrt(jnp.mean(xf * xf, axis=-1, keepdims=True) + EPS)
    return (y * g.astype(jnp.float32)).astype(x.dtype)


def rope(x, pos):
    half = QK_ROPE // 2
    inv = ROPE_THETA ** (-jnp.arange(half, dtype=jnp.float32) / half)
    ang = pos.astype(jnp.float32)[:, None] * inv[None, :]
    cos = jnp.cos(ang)[None, :, None, :].astype(x.dtype)
    sin = jnp.sin(ang)[None, :, None, :].astype(x.dtype)
    x1, x2 = x[..., :half], x[..., half:]
    return jnp.concatenate([x1 * cos - x2 * sin, x1 * sin + x2 * cos], axis=-1)


def swiglu(x, w_gate, w_up, w_down):
    return (jax.nn.silu(x @ w_gate) * (x @ w_up)) @ w_down


def prompt_attention(q_nope, q_rope, k_nope, k_rope, v):
    B, S = q_nope.shape[:2]
    nb = S // Q_BLOCK
    qn = q_nope.reshape(B, nb, Q_BLOCK, N_HEADS, QK_NOPE).transpose(1, 0, 2, 3, 4)
    qr = q_rope.reshape(B, nb, Q_BLOCK, N_HEADS, QK_ROPE).transpose(1, 0, 2, 3, 4)
    key_chunk = jnp.arange(S) // CHUNK
    neg = jnp.finfo(jnp.float32).min

    def block(args):
        qn_b, qr_b, start = args
        s = (jnp.einsum('bqhd,bkhd->bhqk', qn_b, k_nope)
             + jnp.einsum('bqhr,bkr->bhqk', qr_b, k_rope)).astype(jnp.float32) * SCALE
        q_chunk = (start + jnp.arange(Q_BLOCK)) // CHUNK
        mask = key_chunk[None, :] <= q_chunk[:, None]
        s = jnp.where(mask[None, None], s, neg)
        p = jax.nn.softmax(s, axis=-1).astype(v.dtype)
        return jnp.einsum('bhqk,bkhd->bqhd', p, v)

    out = lax.map(block, (qn, qr, jnp.arange(nb, dtype=jnp.int32) * Q_BLOCK))
    return out.transpose(1, 0, 2, 3, 4).reshape(B, S, ATTN_WIDTH)


def sample_attention(q_nope, q_rope, k_nope, k_rope, v):
    B, Q = q_nope.shape[:2]
    s = (jnp.einsum('bqhd,bkhd->bhqk', q_nope, k_nope)
         + jnp.einsum('bqhr,bkr->bhqk', q_rope, k_rope)).astype(jnp.float32) * SCALE
    p = jax.nn.softmax(s, axis=-1).astype(v.dtype)
    return jnp.einsum('bhqk,bkhd->bqhd', p, v).reshape(B, Q, ATTN_WIDTH)


def spatial_gating(u, v, w_s, b_s):
    B, S, _ = v.shape
    L = GM_CHUNK if S >= GM_CHUNK else S
    nc = S // L
    tri = jnp.tril(jnp.ones((L, L), dtype=bool))
    w = jnp.where(tri[None], w_s[:, :L, :L], jnp.zeros((), w_s.dtype))
    vc = v.reshape(B, nc, L, GM_GROUPS, GM_GROUP_DIM)
    mixed = jnp.einsum('gts,bcsgd->bctgd', w, vc) + b_s[:, :L].T[None, None, :, :, None]
    return u * mixed.reshape(B, S, GM_WIDTH)


def run_layer(h, p_l, pos, past_c, past_kr, wl):
    (f1_norm, f1_wg, f1_wu, f1_wd, mix_norm, w_in, q_a_norm, w_uq, q_nope_norm,
     q_rope_norm, kv_a_norm, k_rope_norm, w_uk, w_uv, k_nope_norm, gm_v_norm,
     gm_w_s, gm_b_s, w_o, f2_norm, f2_wg, f2_wu, f2_wd, ple_norm, ple_w_gate,
     ple_w_proj) = wl
    B, S, _ = h.shape
    h = h + 0.5 * swiglu(rmsnorm(h, f1_norm), f1_wg, f1_wu, f1_wd)
    n = rmsnorm(h, mix_norm)
    z = n @ w_in
    q_lat, kv_lat, kr_raw, u, v, g_a, g_b = jnp.split(z, SPLITS, axis=-1)
    q = (rmsnorm(q_lat, q_a_norm) @ w_uq).reshape(B, S, N_HEADS, QK_NOPE + QK_ROPE)
    q_nope = rmsnorm(q[..., :QK_NOPE], q_nope_norm)
    q_rope = rope(rmsnorm(q[..., QK_NOPE:], q_rope_norm), pos)
    c = rmsnorm(kv_lat, kv_a_norm)
    kr = rope(rmsnorm(kr_raw, k_rope_norm)[:, :, None, :], pos)[:, :, 0, :]
    if past_c is None:
        c_all, kr_all = c, kr
    else:
        c_all = jnp.concatenate([past_c, c], axis=1)
        kr_all = jnp.concatenate([past_kr, kr], axis=1)
    k_nope = rmsnorm(jnp.einsum('bsc,chd->bshd', c_all, w_uk), k_nope_norm)
    v_a = jnp.einsum('bsc,chd->bshd', c_all, w_uv)
    if past_c is None:
        o_a = prompt_attention(q_nope, q_rope, k_nope, kr_all, v_a)
    else:
        o_a = sample_attention(q_nope, q_rope, k_nope, kr_all, v_a)
    v_n = rmsnorm(v, gm_v_norm)
    o_b = spatial_gating(u, v_n, gm_w_s, gm_b_s)
    mixed = jax.nn.sigmoid(g_a) * o_a + jax.nn.sigmoid(g_b) * o_b
    h = h + mixed @ w_o
    h = h + 0.5 * swiglu(rmsnorm(h, f2_norm), f2_wg, f2_wu, f2_wd)
    h = h + jax.nn.sigmoid(rmsnorm(h, ple_norm) @ ple_w_gate) * (p_l @ ple_w_proj)
    return h, c, kr, v_n


def setup_inputs(seed: int = 0) -> dict:
    key = jax.random.key(seed)
    ks = iter(jax.random.split(key, 40))

    def nrm(shape, scale=1.0):
        return jax.random.normal(next(ks), shape, jnp.float32) * scale

    def gain(n):
        return 1.0 + 0.05 * nrm((DEPTH, n))

    def lin(fan_in, *shape):
        return nrm((DEPTH, fan_in) + tuple(shape), fan_in ** -0.5)

    return {
        'x_prompt': nrm((BATCH, SEQ, D_MODEL)),
        'x_sample': nrm((DEC_BATCH, DEC_SEQ, D_MODEL)),
        'cache_kv_latent': nrm((DEPTH, DEC_BATCH, PAST_LEN, KV_LORA)),
        'cache_k_rope': nrm((DEPTH, DEC_BATCH, PAST_LEN, QK_ROPE)),
        'p_prompt': nrm((DEPTH, BATCH, SEQ, PLE_DIM)),
        'p_sample': nrm((DEPTH, DEC_BATCH, DEC_SEQ, PLE_DIM)),
        'ffn1_norm': gain(D_MODEL),
        'ffn1_w_gate': lin(D_MODEL, D_FF),
        'ffn1_w_up': lin(D_MODEL, D_FF),
        'ffn1_w_down': lin(D_FF, D_MODEL),
        'mix_norm': gain(D_MODEL),
        'w_in': lin(D_MODEL, D_IN),
        'q_a_norm': gain(Q_LORA),
        'w_uq': lin(Q_LORA, N_HEADS * (QK_NOPE + QK_ROPE)),
        'q_nope_norm': gain(QK_NOPE),
        'q_rope_norm': gain(QK_ROPE),
        'kv_a_norm': gain(KV_LORA),
        'k_rope_norm': gain(QK_ROPE),
        'w_uk': lin(KV_LORA, N_HEADS, QK_NOPE),
        'w_uv': lin(KV_LORA, N_HEADS, V_DIM),
        'k_nope_norm': gain(QK_NOPE),
        'gm_v_norm': gain(GM_WIDTH),
        'gm_w_s': nrm((DEPTH, GM_GROUPS, GM_CHUNK, GM_CHUNK), GM_CHUNK ** -0.5),
        'gm_b_s': 1.0 + 0.1 * nrm((DEPTH, GM_GROUPS, GM_CHUNK)),
        'w_o': lin(D_MODEL, D_MODEL),
        'ffn2_norm': gain(D_MODEL),
        'ffn2_w_gate': lin(D_MODEL, D_FF),
        'ffn2_w_up': lin(D_MODEL, D_FF),
        'ffn2_w_down': lin(D_FF, D_MODEL),
        'ple_norm': gain(D_MODEL),
        'ple_w_gate': lin(D_MODEL, D_MODEL),
        'ple_w_proj': lin(PLE_DIM, D_MODEL),
    }


def reference(x_prompt, x_sample, cache_kv_latent, cache_k_rope, p_prompt, p_sample,
              ffn1_norm, ffn1_w_gate, ffn1_w_up, ffn1_w_down, mix_norm, w_in,
              q_a_norm, w_uq, q_nope_norm, q_rope_norm, kv_a_norm, k_rope_norm,
              w_uk, w_uv, k_nope_norm, gm_v_norm, gm_w_s, gm_b_s, w_o,
              ffn2_norm, ffn2_w_gate, ffn2_w_up, ffn2_w_down,
              ple_norm, ple_w_gate, ple_w_proj):
    stacked = (ffn1_norm, ffn1_w_gate, ffn1_w_up, ffn1_w_down, mix_norm, w_in,
               q_a_norm, w_uq, q_nope_norm, q_rope_norm, kv_a_norm, k_rope_norm,
               w_uk, w_uv, k_nope_norm, gm_v_norm, gm_w_s, gm_b_s, w_o,
               ffn2_norm, ffn2_w_gate, ffn2_w_up, ffn2_w_down,
               ple_norm, ple_w_gate, ple_w_proj)
    seq_p = x_prompt.shape[1]
    past = cache_kv_latent.shape[2]
    dec = x_sample.shape[1]
    pos_p = jnp.arange(seq_p, dtype=jnp.int32)
    pos_s = past + jnp.arange(dec, dtype=jnp.int32)
    hp, hs = x_prompt, x_sample
    pc, pkr, sc, skr, sv = [], [], [], [], []
    for l in range(DEPTH):
        wl = tuple(w[l] for w in stacked)
        hp, c_p, kr_p, _ = run_layer(hp, p_prompt[l], pos_p, None, None, wl)
        hs, c_s, kr_s, v_s = run_layer(hs, p_sample[l], pos_s,
                                       cache_kv_latent[l], cache_k_rope[l], wl)
        pc.append(c_p)
        pkr.append(kr_p)
        sc.append(c_s)
        skr.append(kr_s)
        sv.append(v_s)
    prompt_kv_latent = jnp.stack(pc)
    prompt_k_rope = jnp.stack(pkr)
    sample_kv_latent = jnp.stack(sc)
    sample_k_rope = jnp.stack(skr)
    sample_gm_v = jnp.stack(sv)
    return (hp, hs, prompt_kv_latent, prompt_k_rope, sample_kv_latent, sample_k_rope, sample_gm_v)
```

```cpp
#include <hip/hip_runtime.h>
#include <hip/hip_cooperative_groups.h>
#include <cstdio>
namespace cg = cooperative_groups;

#define DI __device__ __forceinline__
typedef unsigned short u16;
typedef __attribute__((ext_vector_type(8))) short bf16x8;
typedef __attribute__((ext_vector_type(16))) float f32x16;
typedef __attribute__((ext_vector_type(2))) __bf16 bf2_t;
typedef __attribute__((ext_vector_type(2))) float f2_t;

#define M_P 16384
#define M_S 512
#define M_ALL 16896
#define DM 1024
#define DFF 2816
#define DIN 5056
#define LDZ 5120
#define ZQ 0
#define ZKV 384
#define ZKR 896
#define ZU 960
#define ZV 1984
#define ZGA 3008
#define ZGB 4032
#define LKS 4160
#define LKV 4112
#define PAST 4096
#define EPSF 1e-6f
#define QSCALE (0.07216878364870322f * 1.4426950408889634f)

#define NJOBS 26
struct TJob { const float* src; u16* dst; int K, N, kind, tstart; };

struct Params {
  const float *x_prompt, *x_sample, *cache_c, *cache_kr, *p_prompt, *p_sample;
  const float *f1n, *mixn, *qan, *qnn, *qrn, *kvan, *krn, *knn, *gvn, *gws, *gbs, *f2n, *plen;
  float* out;
  u16 *Wgu1, *Wd1, *Win, *Wuq, *Wkv, *Wo, *Wgu2, *Wd2, *Wpg, *Wpe;
  u16 *NB, *ACT, *Z, *QN, *C, *KRp, *KRs, *Q, *Knp, *VTp, *Kns, *VTs, *OA, *MIX, *PP;
  float *rsv, *rope;
  unsigned* ctr;
  TJob jobs[NJOBS];
  int ntile_prep; int pad0;
};

DI int get_tid() { int t = threadIdx.x; asm volatile("" : "+v"(t)); return t; }
DI int get_bid() { int t = blockIdx.x; asm volatile("" : "+s"(t)); return t; }
DI unsigned pk2(float a, float b) { f2_t v = {a, b}; bf2_t r = __builtin_convertvector(v, bf2_t); return __builtin_bit_cast(unsigned, r); }
DI float bflo(unsigned v) { return __uint_as_float(v << 16); }
DI float bfhi(unsigned v) { return __uint_as_float(v & 0xffff0000u); }
DI float bf1(u16 v) { return __uint_as_float(((unsigned)v) << 16); }
DI u16 f2bf(float a) { return (u16)(pk2(a, 0.f) & 0xffffu); }
DI float wave_sum(float v) {
#pragma unroll
  for (int o = 32; o > 0; o >>= 1) v += __shfl_xor(v, o);
  return v;
}
DI float sigm(float x) { return 1.f / (1.f + __expf(-x)); }
DI uint4 pack8(float4 x, float4 y) { return make_uint4(pk2(x.x, x.y), pk2(x.z, x.w), pk2(y.x, y.y), pk2(y.z, y.w)); }
#define MFMA(a, b, c) __builtin_amdgcn_mfma_f32_32x32x16_bf16((a), (b), (c), 0, 0, 0)

#define SMEM_BYTES 73728

DI int job_dst_row(int kind, int n) {
  if (kind == 0) return n;
  if (kind == 1) return 64 * (n >> 5) + (n & 31);
  if (kind == 2) return 64 * (n >> 5) + 32 + (n & 31);
  if (kind == 3) { int h = n / 192, c = n - h * 192; return c < 128 ? h * 128 + c : 1024 + h * 64 + (c - 128); }
  return 1024 + n;
}

DI void prep_phase(const Params& p, char* smem) {
  const int tid = get_tid();
  u16* Ts = (u16*)smem;
  for (int t = get_bid(); t < p.ntile_prep; t += gridDim.x) {
    int j = 0;
#pragma unroll 1
    for (int q = 1; q < NJOBS; ++q) if (t >= p.jobs[q].tstart) j = q;
    const float* src = p.jobs[j].src; u16* dst = p.jobs[j].dst;
    const int K = p.jobs[j].K, N = p.jobs[j].N, kind = p.jobs[j].kind;
    const int lt = t - p.jobs[j].tstart;
    const int ntn = N >> 6;
    const int tk = lt / ntn, tn = lt - tk * ntn;
    const int k0 = tk * 64, n0 = tn * 64;
    __syncthreads();
#pragma unroll
    for (int i = 0; i < 4; ++i) {
      const int k = (tid >> 4) + 16 * i, nc = (tid & 15) * 4;
      float4 v = *(const float4*)(src + (long)(k0 + k) * N + n0 + nc);
      Ts[(nc + 0) * 66 + k] = f2bf(v.x); Ts[(nc + 1) * 66 + k] = f2bf(v.y);
      Ts[(nc + 2) * 66 + k] = f2bf(v.z); Ts[(nc + 3) * 66 + k] = f2bf(v.w);
    }
    __syncthreads();
    {
      const int n = tid >> 2, kc = (tid & 3) * 16;
      const unsigned* s32 = (const unsigned*)(Ts + n * 66 + kc);
      uint4 a = make_uint4(s32[0], s32[1], s32[2], s32[3]);
      uint4 b = make_uint4(s32[4], s32[5], s32[6], s32[7]);
      u16* d = dst + (long)job_dst_row(kind, n0 + n) * K + k0 + kc;
      *(uint4*)d = a; *(uint4*)(d + 8) = b;
    }
  }
  const long gtid = (long)get_bid() * 256 + tid, gstride = (long)gridDim.x * 256;
  for (long e = gtid; e < 2L * 64 * 1024 / 8; e += gstride) {
    const int l = (int)(e / (64 * 1024 / 8)); const long r = e - (long)l * (64 * 1024 / 8);
    *(uint4*)(p.Win + (long)l * LDZ * 1024 + (long)DIN * 1024 + r * 8) = make_uint4(0, 0, 0, 0);
  }
  for (long e = gtid; e < 16384L * 32; e += gstride) {
    const int pos = (int)(e >> 5), i = (int)(e & 31);
    const float inv = powf(10000.0f, -(float)i / 32.0f);
    const float angf = (float)pos * inv;
    const double x = (double)angf;
    const double kq = rint(x * 0.63661977236758134308);
    const double y = (x - kq * 1.5707963267341256e+00) - kq * 6.0771005065061922e-11;
    const double y2 = y * y;
    const double s = y * (1.0 + y2 * (-1.0 / 6 + y2 * (1.0 / 120 + y2 * (-1.0 / 5040 + y2 * (1.0 / 362880 + y2 * (-1.0 / 39916800))))));
    const double c = 1.0 + y2 * (-0.5 + y2 * (1.0 / 24 + y2 * (-1.0 / 720 + y2 * (1.0 / 40320 + y2 * (-1.0 / 3628800 + y2 * (1.0 / 479001600))))));
    const int q = ((int)kq) & 3;
    double cc, ss;
    if (q == 0) { cc = c; ss = s; } else if (q == 1) { cc = -s; ss = c; } else if (q == 2) { cc = -c; ss = -s; } else { cc = s; ss = -c; }
    *(float2*)(p.rope + e * 2) = make_float2((float)cc, (float)ss);
  }
  for (long e = gtid; e < (long)M_ALL * 1024 / 4; e += gstride) {
    const long pe = (long)M_P * 1024 / 4;
    float4 v = e < pe ? ((const float4*)p.x_prompt)[e] : ((const float4*)p.x_sample)[e - pe];
    ((float4*)p.out)[e] = v;
  }
  if (get_bid() == 0 && tid < 16) p.ctr[tid] = 0u;
}

DI void norm_phase(const float* __restrict__ h, const float* __restrict__ g, u16* __restrict__ out) {
  const int tid = get_tid(); const int lane = tid & 63, w = tid >> 6;
  for (int row = get_bid() * 4 + w; row < M_ALL; row += gridDim.x * 4) {
    const float4* hr = (const float4*)(h + (long)row * 1024);
    float4 v[4]; float ss = 0.f;
#pragma unroll
    for (int i = 0; i < 4; ++i) { v[i] = hr[lane + 64 * i]; ss += v[i].x * v[i].x + v[i].y * v[i].y + v[i].z * v[i].z + v[i].w * v[i].w; }
    ss = wave_sum(ss);
    const float rs = rsqrtf(ss * (1.f / 1024.f) + EPSF);
#pragma unroll
    for (int i = 0; i < 4; ++i) {
      const float4 gg = ((const float4*)g)[lane + 64 * i];
      uint2 o = make_uint2(pk2(v[i].x * rs * gg.x, v[i].y * rs * gg.y), pk2(v[i].z * rs * gg.z, v[i].w * rs * gg.w));
      ((uint2*)(out + (long)row * 1024))[lane + 64 * i] = o;
    }
  }
}

template <bool AF32, bool SWAP>
DI void gemm_core(const void* __restrict__ Ap, long lda, const u16* __restrict__ Bp, long ldb, int K,
                  f32x16 (&acc)[2][2], char* smem) {
  const int tid = get_tid(), lane = tid & 63, w = tid >> 6, wm = w >> 1, wn = w & 1, r = lane & 31, hh = lane >> 5;
  u16* As = (u16*)smem;
  u16* Bs = As + 2 * 128 * 72;
  const int lrow = tid >> 3, lkc = (tid & 7) * 8;
  uint4 ra0, ra1, ra2, ra3, rb0, rb1, rb2, rb3;
#pragma unroll
  for (int mi = 0; mi < 2; ++mi)
#pragma unroll
    for (int ni = 0; ni < 2; ++ni)
#pragma unroll
      for (int i = 0; i < 16; ++i) acc[mi][ni][i] = 0.f;
#define GL_A(dst, i) { const int row_ = lrow + 32 * (i); \
    if (AF32) { const float* a_ = (const float*)Ap + (long)row_ * lda + k0_ + lkc; dst = pack8(*(const float4*)a_, *(const float4*)(a_ + 4)); } \
    else { dst = *(const uint4*)((const u16*)Ap + (long)row_ * lda + k0_ + lkc); } }
#define GL_B(dst, i) { const int row_ = lrow + 32 * (i); dst = *(const uint4*)(Bp + (long)row_ * ldb + k0_ + lkc); }
#define GLOAD(k0) { const int k0_ = (k0); GL_A(ra0, 0) GL_A(ra1, 1) GL_A(ra2, 2) GL_A(ra3, 3) GL_B(rb0, 0) GL_B(rb1, 1) GL_B(rb2, 2) GL_B(rb3, 3) }
#define SST(arr, src, i, buf) *(uint4*)(arr + ((buf) * 128 + lrow + 32 * (i)) * 72 + lkc) = src;
#define SSTORE(buf) { SST(As, ra0, 0, buf) SST(As, ra1, 1, buf) SST(As, ra2, 2, buf) SST(As, ra3, 3, buf) SST(Bs, rb0, 0, buf) SST(Bs, rb1, 1, buf) SST(Bs, rb2, 2, buf) SST(Bs, rb3, 3, buf) }
  const int nk = K >> 6;
  __syncthreads();
  GLOAD(0);
  SSTORE(0);
  __syncthreads();
#pragma unroll 1
  for (int kt = 0; kt < nk; ++kt) {
    const int buf = kt & 1;
    if (kt + 1 < nk) GLOAD((kt + 1) << 6);
    const u16* Ab = As + (buf * 128 + 64 * wm + r) * 72 + 8 * hh;
    const u16* Bb = Bs + (buf * 128 + 64 * wn + r) * 72 + 8 * hh;
#pragma unroll
    for (int ks = 0; ks < 4; ++ks) {
      bf16x8 a0 = *(const bf16x8*)(Ab + 16 * ks);
      bf16x8 a1 = *(const bf16x8*)(Ab + 32 * 72 + 16 * ks);
      bf16x8 b0 = *(const bf16x8*)(Bb + 16 * ks);
      bf16x8 b1 = *(const bf16x8*)(Bb + 32 * 72 + 16 * ks);
      if (SWAP) {
        acc[0][0] = MFMA(b0, a0, acc[0][0]); acc[0][1] = MFMA(b1, a0, acc[0][1]);
        acc[1][0] = MFMA(b0, a1, acc[1][0]); acc[1][1] = MFMA(b1, a1, acc[1][1]);
      } else {
        acc[0][0] = MFMA(a0, b0, acc[0][0]); acc[0][1] = MFMA(a0, b1, acc[0][1]);
        acc[1][0] = MFMA(a1, b0, acc[1][0]); acc[1][1] = MFMA(a1, b1, acc[1][1]);
      }
    }
    if (kt + 1 < nk) SSTORE(buf ^ 1);
    __syncthreads();
  }
#undef GL_A
#undef GL_B
#undef GLOAD
#undef SST
#undef SSTORE
}

DI int tok_pos(int m) { return m < M_P ? m : PAST + ((m - M_P) & 15); }

template <class RowPtr>
DI void nope_epilogue(f32x16 (&acc)[2][2], const float* __restrict__ gain, float scale, char* smem, RowPtr rowptr) {
  const int tid = get_tid(), lane = tid & 63, w = tid >> 6, wm = w >> 1, wn = w & 1, r = lane & 31, hh = lane >> 5;
  float* red = (float*)smem;
  float ss[2];
#pragma unroll
  for (int mi = 0; mi < 2; ++mi) {
    float s = 0.f;
#pragma unroll
    for (int ni = 0; ni < 2; ++ni)
#pragma unroll
      for (int i = 0; i < 16; ++i) s += acc[mi][ni][i] * acc[mi][ni][i];
    s += __shfl_xor(s, 32);
    ss[mi] = s;
    if (hh == 0) red[wn * 128 + 64 * wm + 32 * mi + r] = s;
  }
  __syncthreads();
#pragma unroll
  for (int mi = 0; mi < 2; ++mi) {
    const int m = 64 * wm + 32 * mi + r;
    const float tot = ss[mi] + red[(wn ^ 1) * 128 + m];
    const float rs = rsqrtf(tot * (1.f / 128.f) + EPSF) * scale;
    u16* op = rowptr(m);
#pragma unroll
    for (int ni = 0; ni < 2; ++ni)
#pragma unroll
      for (int i4 = 0; i4 < 4; ++i4) {
        const int c = 64 * wn + 32 * ni + 8 * i4 + 4 * hh;
        const float4 g = *(const float4*)(gain + c);
        uint2 o = make_uint2(pk2(acc[mi][ni][4 * i4 + 0] * rs * g.x, acc[mi][ni][4 * i4 + 1] * rs * g.y),
                             pk2(acc[mi][ni][4 * i4 + 2] * rs * g.z, acc[mi][ni][4 * i4 + 3] * rs * g.w));
        *(uint2*)(op + c) = o;
      }
  }
}

template <class KeyPtr>
DI void vt_epilogue(f32x16 (&acc)[2][2], long dstride, KeyPtr keyptr) {
  const int tid = get_tid(), lane = tid & 63, w = tid >> 6, wm = w >> 1, wn = w & 1, r = lane & 31, hh = lane >> 5;
#pragma unroll
  for (int mi = 0; mi < 2; ++mi)
#pragma unroll
    for (int i4 = 0; i4 < 4; ++i4) {
      const int mloc = 64 * wm + 32 * mi + 8 * i4 + 4 * hh;
      u16* base = keyptr(mloc);
#pragma unroll
      for (int ni = 0; ni < 2; ++ni) {
        const int d = 64 * wn + 32 * ni + r;
        uint2 o = make_uint2(pk2(acc[mi][ni][4 * i4 + 0], acc[mi][ni][4 * i4 + 1]), pk2(acc[mi][ni][4 * i4 + 2], acc[mi][ni][4 * i4 + 3]));
        *(uint2*)(base + (long)d * dstride) = o;
      }
    }
}
DI int perm_pos(int key) {
  const int g4 = (key >> 2) & 3;
  const int pg = (g4 == 1) ? 2 : ((g4 == 2) ? 1 : g4);
  return (key & ~15) + 4 * pg;
}

DI void ffn_up_phase(const Params& p, const u16* W, char* smem) {
  const int tid = get_tid(), lane = tid & 63, w = tid >> 6, wm = w >> 1, wn = w & 1, r = lane & 31, hh = lane >> 5;
  const int NT = (2 * DFF) / 128;
  for (int t = get_bid(); t < 132 * NT; t += gridDim.x) {
    const int tm = t / NT, tn = t - tm * NT;
    f32x16 acc[2][2];
    gemm_core<false, true>(p.NB + (long)tm * 128 * 1024, 1024, W + (long)tn * 128 * 1024, 1024, 1024, acc, smem);
#pragma unroll
    for (int mi = 0; mi < 2; ++mi) {
      const long m = (long)tm * 128 + 64 * wm + 32 * mi + r;
#pragma unroll
      for (int i4 = 0; i4 < 4; ++i4) {
        const int c = 64 * tn + 32 * wn + 8 * i4 + 4 * hh;
        float a[4];
#pragma unroll
        for (int j = 0; j < 4; ++j) { const float g = acc[mi][0][4 * i4 + j], u = acc[mi][1][4 * i4 + j]; a[j] = g * sigm(g) * u; }
        *(uint2*)(p.ACT + m * DFF + c) = make_uint2(pk2(a[0], a[1]), pk2(a[2], a[3]));
      }
    }
  }
}

DI void resid_gemm_phase(const Params& p, const u16* A, int K, const u16* W, float alpha, char* smem) {
  const int tid = get_tid(), lane = tid & 63, w = tid >> 6, wm = w >> 1, wn = w & 1, r = lane & 31, hh = lane >> 5;
  for (int t = get_bid(); t < 132 * 8; t += gridDim.x) {
    const int tm = t >> 3, tn = t & 7;
    f32x16 acc[2][2];
    gemm_core<false, true>(A + (long)tm * 128 * K, K, W + (long)tn * 128 * K, K, K, acc, smem);
#pragma unroll
    for (int mi = 0; mi < 2; ++mi) {
      const long m = (long)tm * 128 + 64 * wm + 32 * mi + r;
#pragma unroll
      for (int ni = 0; ni < 2; ++ni)
#pragma unroll
        for (int i4 = 0; i4 < 4; ++i4) {
          const int n = tn * 128 + 64 * wn + 32 * ni + 8 * i4 + 4 * hh;
          float4* hp = (float4*)(p.out + m * 1024 + n);
          float4 v = *hp;
          v.x += alpha * acc[mi][ni][4 * i4 + 0]; v.y += alpha * acc[mi][ni][4 * i4 + 1];
          v.z += alpha * acc[mi][ni][4 * i4 + 2]; v.w += alpha * acc[mi][ni][4 * i4 + 3];
          *hp = v;
        }
    }
  }
}

DI void ple_phase(const Params& p, const u16* W, char* smem) {
  const int tid = get_tid(), lane = tid & 63, w = tid >> 6, wm = w >> 1, wn = w & 1, r = lane & 31, hh = lane >> 5;
  for (int t = get_bid(); t < 132 * 8; t += gridDim.x) {
    const int tm = t >> 3, tn = t & 7;
    f32x16 acc[2][2];
    gemm_core<false, true>(p.NB + (long)tm * 128 * 1024, 1024, W + (long)tn * 128 * 1024, 1024, 1024, acc, smem);
#pragma unroll
    for (int mi = 0; mi < 2; ++mi) {
      const long m = (long)tm * 128 + 64 * wm + 32 * mi + r;
#pragma unroll
      for (int ni = 0; ni < 2; ++ni)
#pragma unroll
        for (int i4 = 0; i4 < 4; ++i4) {
          const int n = tn * 128 + 64 * wn + 32 * ni + 8 * i4 + 4 * hh;
          float4* hp = (float4*)(p.out + m * 1024 + n);
          const uint2 pp = *(const uint2*)(p.PP + m * 1024 + n);
          float4 v = *hp;
          v.x += sigm(acc[mi][ni][4 * i4 + 0]) * bflo(pp.x); v.y += sigm(acc[mi][ni][4 * i4 + 1]) * bfhi(pp.x);
          v.z += sigm(acc[mi][ni][4 * i4 + 2]) * bflo(pp.y); v.w += sigm(acc[mi][ni][4 * i4 + 3]) * bfhi(pp.y);
          *hp = v;
        }
    }
  }
}

DI void win_phase(const Params& p, const u16* W, char* smem) {
  const int tid = get_tid(), lane = tid & 63, w = tid >> 6, wm = w >> 1, wn = w & 1, r = lane & 31, hh = lane >> 5;
  const int NT = LDZ / 128;
  for (int t = get_bid(); t < 132 * NT; t += gridDim.x) {
    const int tm = t / NT, tn = t - tm * NT;
    f32x16 acc[2][2];
    gemm_core<false, true>(p.NB + (long)tm * 128 * 1024, 1024, W + (long)tn * 128 * 1024, 1024, 1024, acc, smem);
#pragma unroll
    for (int mi = 0; mi < 2; ++mi) {
      const long m = (long)tm * 128 + 64 * wm + 32 * mi + r;
#pragma unroll
      for (int ni = 0; ni < 2; ++ni)
#pragma unroll
        for (int i4 = 0; i4 < 4; ++i4) {
          const int n = tn * 128 + 64 * wn + 32 * ni + 8 * i4 + 4 * hh;
          *(uint2*)(p.Z + m * LDZ + n) = make_uint2(pk2(acc[mi][ni][4 * i4 + 0], acc[mi][ni][4 * i4 + 1]), pk2(acc[mi][ni][4 * i4 + 2], acc[mi][ni][4 * i4 + 3]));
        }
    }
  }
}

DI void rowpost_phase(const Params& p, int l) {
  const int tid = get_tid(); const int lane = tid & 63, w = tid >> 6;
  const float* qan = p.qan + l * 384; const float* kvan = p.kvan + l * 512; const float* krn = p.krn + l * 64; const float* gvn = p.gvn + l * 1024;
  float* o_pkv = p.out + 17301504L + (long)l * M_P * 512;
  float* o_pkr = p.out + 34078720L + (long)l * M_P * 64;
  float* o_skv = p.out + 36175872L + (long)l * M_S * 512;
  float* o_skr = p.out + 36700160L + (long)l * M_S * 64;
  float* o_sgv = p.out + 36765696L + (long)l * M_S * 1024;
  for (int row = get_bid() * 4 + w; row < M_ALL; row += gridDim.x * 4) {
    const u16* zr = p.Z + (long)row * LDZ;
    const bool is_s = row >= M_P; const int rs_ = row - M_P;
    {
      unsigned v[3]; float ss = 0.f;
#pragma unroll
      for (int i = 0; i < 3; ++i) { v[i] = *(const unsigned*)(zr + ZQ + 2 * lane + 128 * i); const float a = bflo(v[i]), b = bfhi(v[i]); ss += a * a + b * b; }
      ss = wave_sum(ss);
      const float rs = rsqrtf(ss * (1.f / 384.f) + EPSF);
#pragma unroll
      for (int i = 0; i < 3; ++i) {
        const int c = 2 * lane + 128 * i; const float2 g = *(const float2*)(qan + c);
        *(unsigned*)(p.QN + (long)row * 384 + c) = pk2(bflo(v[i]) * rs * g.x, bfhi(v[i]) * rs * g.y);
      }
    }
    {
      const uint4 v = *(const uint4*)(zr + ZKV + 8 * lane);
      float x[8] = {bflo(v.x), bfhi(v.x), bflo(v.y), bfhi(v.y), bflo(v.z), bfhi(v.z), bflo(v.w), bfhi(v.w)};
      float ss = 0.f;
#pragma unroll
      for (int i = 0; i < 8; ++i) ss += x[i] * x[i];
      ss = wave_sum(ss);
      const float rs = rsqrtf(ss * (1.f / 512.f) + EPSF);
      const float4 g0 = *(const float4*)(kvan + 8 * lane), g1 = *(const float4*)(kvan + 8 * lane + 4);
      float4 y0 = make_float4(x[0] * rs * g0.x, x[1] * rs * g0.y, x[2] * rs * g0.z, x[3] * rs * g0.w);
      float4 y1 = make_float4(x[4] * rs * g1.x, x[5] * rs * g1.y, x[6] * rs * g1.z, x[7] * rs * g1.w);
      float* od = is_s ? (o_skv + (long)rs_ * 512) : (o_pkv + (long)row * 512);
      *(float4*)(od + 8 * lane) = y0; *(float4*)(od + 8 * lane + 4) = y1;
      *(uint4*)(p.C + (long)row * 512 + 8 * lane) = pack8(y0, y1);
    }
    {
      const float x = bf1(zr[ZKR + lane]);
      const float ss = wave_sum(x * x);
      const float rs = rsqrtf(ss * (1.f / 64.f) + EPSF);
      const float y = x * rs * krn[lane];
      const float other = __shfl_xor(y, 32);
      const int pos = tok_pos(row);
      const float2 cs = *(const float2*)(p.rope + ((long)pos * 32 + (lane & 31)) * 2);
      const float o = lane < 32 ? (y * cs.x - other * cs.y) : (other * cs.y + y * cs.x);
      if (is_s) {
        o_skr[(long)rs_ * 64 + lane] = o;
        p.KRs[((long)(rs_ >> 4) * LKS + PAST + (rs_ & 15)) * 64 + lane] = f2bf(o);
      } else {
        o_pkr[(long)row * 64 + lane] = o;
        p.KRp[(long)row * 64 + lane] = f2bf(o);
      }
    }
    {
      uint4 v[2]; float ss = 0.f;
#pragma unroll
      for (int i = 0; i < 2; ++i) {
        v[i] = *(const uint4*)(zr + ZV + 8 * lane + 512 * i);
        const float x[8] = {bflo(v[i].x), bfhi(v[i].x), bflo(v[i].y), bfhi(v[i].y), bflo(v[i].z), bfhi(v[i].z), bflo(v[i].w), bfhi(v[i].w)};
#pragma unroll
        for (int j = 0; j < 8; ++j) ss += x[j] * x[j];
      }
      ss = wave_sum(ss);
      const float rs = rsqrtf(ss * (1.f / 1024.f) + EPSF);
      if (lane == 0) p.rsv[row] = rs;
      if (is_s) {
#pragma unroll
        for (int i = 0; i < 2; ++i) {
          const int c = 8 * lane + 512 * i;
          const float x[8] = {bflo(v[i].x), bfhi(v[i].x), bflo(v[i].y), bfhi(v[i].y), bflo(v[i].z), bfhi(v[i].z), bflo(v[i].w), bfhi(v[i].w)};
          const float4 g0 = *(const float4*)(gvn + c), g1 = *(const float4*)(gvn + c + 4);
          *(float4*)(o_sgv + (long)rs_ * 1024 + c) = make_float4(x[0] * rs * g0.x, x[1] * rs * g0.y, x[2] * rs * g0.z, x[3] * rs * g0.w);
          *(float4*)(o_sgv + (long)rs_ * 1024 + c + 4) = make_float4(x[4] * rs * g1.x, x[5] * rs * g1.y, x[6] * rs * g1.z, x[7] * rs * g1.w);
        }
      }
    }
  }
  const float* ckr = p.cache_kr + (long)l * 32 * PAST * 64;
  const long gtid = (long)get_bid() * 256 + tid, gstride = (long)gridDim.x * 256;
  for (long e = gtid; e < 32L * PAST * 64 / 8; e += gstride) {
    const long el = e * 8; const int b = (int)(el / (PAST * 64)); const long rem = el - (long)b * PAST * 64;
    const float4 a = *(const float4*)(ckr + el), c = *(const float4*)(ckr + el + 4);
    *(uint4*)(p.KRs + (long)b * LKS * 64 + rem) = pack8(a, c);
  }
}

template <bool AF32>
DI void kv_tile(const Params& p, int l, const void* A, int mode, int m0, int tn, char* smem) {
  const u16* W = p.Wkv + (long)l * 2048 * 512 + (long)tn * 128 * 512;
  if (tn < 8) {
    f32x16 acc[2][2];
    gemm_core<AF32, true>(A, 512, W, 512, 512, acc, smem);
    const int h = tn;
    nope_epilogue(acc, p.knn + l * 128, 1.0f, smem, [&](int mloc) -> u16* {
      const int m = m0 + mloc;
      if (mode == 0) return p.Knp + ((long)m * 8 + h) * 128;
      long key;
      if (mode == 1) key = (long)(m >> 12) * LKS + (m & 4095); else key = (long)(m >> 4) * LKS + PAST + (m & 15);
      return p.Kns + (key * 8 + h) * 128;
    });
  } else {
    f32x16 acc[2][2];
    gemm_core<AF32, false>(A, 512, W, 512, 512, acc, smem);
    const int h = tn - 8;
    const long dstride = (mode == 0) ? (long)M_P : (long)LKS;
    vt_epilogue(acc, dstride, [&](int mloc) -> u16* {
      const int m = m0 + mloc;
      if (mode == 0) return p.VTp + (long)h * 128 * M_P + perm_pos(m);
      int b, key;
      if (mode == 1) { b = m >> 12; key = m & 4095; } else { b = m >> 4; key = PAST + (m & 15); }
      return p.VTs + ((long)b * 8 + h) * 128 * LKS + perm_pos(key);
    });
  }
}

DI void multi_phase(const Params& p, int l, char* smem) {
  const int tid = get_tid(), lane = tid & 63, w = tid >> 6, wm = w >> 1, wn = w & 1, r = lane & 31, hh = lane >> 5;
  const int NQ = 132 * 12, NPKV = 128 * 16, NSKV = 4 * 16, NCKV = 1024 * 16, NPP = 132 * 8;
  const int total = NQ + NPKV + NSKV + NCKV + NPP;
  for (int t = get_bid(); t < total; t += gridDim.x) {
    int u = t;
    if (u < NCKV) {
      const int tm = u >> 4, tn = u & 15;
      kv_tile<true>(p, l, p.cache_c + ((long)l * 32 * PAST + (long)tm * 128) * 512, 1, tm * 128, tn, smem);
      continue;
    }
    u -= NCKV;
    if (u < NPKV) {
      const int tm = u >> 4, tn = u & 15;
      kv_tile<false>(p, l, p.C + (long)tm * 128 * 512, 0, tm * 128, tn, smem);
      continue;
    }
    u -= NPKV;
    if (u < NSKV) {
      const int tm = u >> 4, tn = u & 15;
      kv_tile<false>(p, l, p.C + ((long)M_P + tm * 128) * 512, 2, tm * 128, tn, smem);
      continue;
    }
    u -= NSKV;
    if (u < NQ) {
      const int tm = u / 12, tn = u - tm * 12;
      f32x16 acc[2][2];
      gemm_core<false, true>(p.QN + (long)tm * 128 * 384, 384, p.Wuq + (long)l * 1536 * 384 + (long)tn * 128 * 384, 384, 384, acc, smem);
      if (tn < 8) {
        nope_epilogue(acc, p.qnn + l * 128, QSCALE, smem, [&](int mloc) -> u16* { return p.Q + ((long)(tm * 128 + mloc) * 8 + tn) * 192; });
      } else {
        const int head = 2 * (tn - 8) + wn;
        const float* g = p.qrn + l * 64;
#pragma unroll
        for (int mi = 0; mi < 2; ++mi) {
          float s = 0.f;
#pragma unroll
          for (int ni = 0; ni < 2; ++ni)
#pragma unroll
            for (int i = 0; i < 16; ++i) s += acc[mi][ni][i] * acc[mi][ni][i];
          s += __shfl_xor(s, 32);
          const float rs = rsqrtf(s * (1.f / 64.f) + EPSF);
          const int m = tm * 128 + 64 * wm + 32 * mi + r;
          const int pos = tok_pos(m);
          u16* qp = p.Q + ((long)m * 8 + head) * 192 + 128;
#pragma unroll
          for (int i4 = 0; i4 < 4; ++i4) {
            const int cc = 8 * i4 + 4 * hh;
            const float4 g1 = *(const float4*)(g + cc), g2 = *(const float4*)(g + 32 + cc);
            const float4 t0 = *(const float4*)(p.rope + ((long)pos * 32 + cc) * 2);
            const float4 t1 = *(const float4*)(p.rope + ((long)pos * 32 + cc) * 2 + 4);
            const float cs[4] = {t0.x, t0.z, t1.x, t1.z}, sn[4] = {t0.y, t0.w, t1.y, t1.w};
            const float gg1[4] = {g1.x, g1.y, g1.z, g1.w}, gg2[4] = {g2.x, g2.y, g2.z, g2.w};
            float o1[4], o2[4];
#pragma unroll
            for (int j = 0; j < 4; ++j) {
              const float y1 = acc[mi][0][4 * i4 + j] * rs * gg1[j], y2 = acc[mi][1][4 * i4 + j] * rs * gg2[j];
              o1[j] = (y1 * cs[j] - y2 * sn[j]) * QSCALE; o2[j] = (y1 * sn[j] + y2 * cs[j]) * QSCALE;
            }
            *(uint2*)(qp + cc) = make_uint2(pk2(o1[0], o1[1]), pk2(o1[2], o1[3]));
            *(uint2*)(qp + 32 + cc) = make_uint2(pk2(o2[0], o2[1]), pk2(o2[2], o2[3]));
          }
        }
      }
      continue;
    }
    u -= NQ;
    {
      const int tm = u >> 3, tn = u & 7;
      const float* A = tm < 128 ? (p.p_prompt + ((long)l * M_P + (long)tm * 128) * 256) : (p.p_sample + ((long)l * M_S + (long)(tm - 128) * 128) * 256);
      f32x16 acc[2][2];
      gemm_core<true, true>(A, 256, p.Wpe + (long)l * 1024 * 256 + (long)tn * 128 * 256, 256, 256, acc, smem);
#pragma unroll
      for (int mi = 0; mi < 2; ++mi) {
        const long m = (long)tm * 128 + 64 * wm + 32 * mi + r;
#pragma unroll
        for (int ni = 0; ni < 2; ++ni)
#pragma unroll
          for (int i4 = 0; i4 < 4; ++i4) {
            const int n = tn * 128 + 64 * wn + 32 * ni + 8 * i4 + 4 * hh;
            *(uint2*)(p.PP + m * 1024 + n) = make_uint2(pk2(acc[mi][ni][4 * i4 + 0], acc[mi][ni][4 * i4 + 1]), pk2(acc[mi][ni][4 * i4 + 2], acc[mi][ni][4 * i4 + 3]));
          }
      }
    }
  }
}

DI void attn_item(const u16* __restrict__ Qb, int qclamp, const u16* __restrict__ Kn, const u16* __restrict__ KR,
                  const u16* __restrict__ VT, long vt_stride, int ntiles, int ntw, int Lk, u16* __restrict__ Ob, char* smem) {
  const int tid = get_tid(), lane = tid & 63, w = tid >> 6, r = lane & 31, hh = lane >> 5;
  u16* Ks = (u16*)smem;
  u16* Vs = Ks + 64 * 200;
  bf16x8 qf[12];
  {
    const int qr = r < qclamp ? r : qclamp;
    const u16* qp = Qb + (long)(32 * w + qr) * (8 * 192) + 8 * hh;
#pragma unroll
    for (int ks = 0; ks < 12; ++ks) qf[ks] = *(const bf16x8*)(qp + 16 * ks);
  }
  f32x16 oacc[4];
#pragma unroll
  for (int dt = 0; dt < 4; ++dt)
#pragma unroll
    for (int i = 0; i < 16; ++i) oacc[dt][i] = 0.f;
  float mrun = -INFINITY, lrun = 0.f;

  uint4 rk0, rk1, rk2, rk3, rk4, rk5, rv0, rv1, rv2, rv3;
  const int lkey = tid >> 2, lq = tid & 3;
  unsigned koff = (unsigned)(lkey * 1024 + lq * 8) * 2u;
  unsigned kroff = (unsigned)(lkey * 64 + lq * 8) * 2u;
  const unsigned vstep = (unsigned)(32 * vt_stride * 2);
  unsigned voff = (unsigned)((tid >> 3) * vt_stride * 2 + (tid & 7) * 16);
  const char* KnB = (const char*)Kn; const char* KRB = (const char*)KR; const char* VTB = (const char*)VT;
  char* KsW = (char*)Ks + lkey * 400 + lq * 16;
  char* VsW = (char*)Vs + (tid >> 3) * 144 + (tid & 7) * 16;
#define AGLOAD() { \
    rk0 = *(const uint4*)(KnB + (size_t)koff); rk1 = *(const uint4*)(KnB + (size_t)koff + 64); \
    rk2 = *(const uint4*)(KnB + (size_t)koff + 128); rk3 = *(const uint4*)(KnB + (size_t)koff + 192); \
    rk4 = *(const uint4*)(KRB + (size_t)kroff); rk5 = *(const uint4*)(KRB + (size_t)kroff + 64); \
    rv0 = *(const uint4*)(VTB + (size_t)voff); rv1 = *(const uint4*)(VTB + (size_t)(voff + vstep)); \
    rv2 = *(const uint4*)(VTB + (size_t)(voff + 2 * vstep)); rv3 = *(const uint4*)(VTB + (size_t)(voff + 3 * vstep)); \
    koff += 64 * 1024 * 2; kroff += 64 * 64 * 2; voff += 128; }
#define ASTORE() { \
    *(uint4*)(KsW) = rk0; *(uint4*)(KsW + 64) = rk1; *(uint4*)(KsW + 128) = rk2; *(uint4*)(KsW + 192) = rk3; \
    *(uint4*)(KsW + 256) = rk4; *(uint4*)(KsW + 320) = rk5; \
    *(uint4*)(VsW) = rv0; *(uint4*)(VsW + 32 * 144) = rv1; *(uint4*)(VsW + 64 * 144) = rv2; *(uint4*)(VsW + 96 * 144) = rv3; }

  AGLOAD();
#pragma unroll 1
  for (int jt = 0; jt < ntiles; ++jt) {
    __syncthreads();
    ASTORE();
    __syncthreads();
    if (jt >= ntw) { if (jt + 1 < ntiles) AGLOAD(); }
    if (jt < ntw) {
      f32x16 sacc[2];
#pragma unroll
      for (int kt = 0; kt < 2; ++kt)
#pragma unroll
        for (int i = 0; i < 16; ++i) sacc[kt][i] = 0.f;
      const u16* kb = Ks + r * 200 + 8 * hh;
#pragma unroll
      for (int ks = 0; ks < 12; ++ks) {
        bf16x8 k0 = *(const bf16x8*)(kb + 16 * ks);
        bf16x8 k1 = *(const bf16x8*)(kb + 32 * 200 + 16 * ks);
        sacc[0] = MFMA(k0, qf[ks], sacc[0]);
        sacc[1] = MFMA(k1, qf[ks], sacc[1]);
        if ((ks & 3) == 3) __builtin_amdgcn_sched_barrier(0);
      }
      if ((jt + 1) * 64 > Lk) {
#pragma unroll
        for (int kt = 0; kt < 2; ++kt)
#pragma unroll
          for (int i = 0; i < 16; ++i) {
            const int key = jt * 64 + 32 * kt + (i & 3) + 8 * (i >> 2) + 4 * hh;
            if (key >= Lk) sacc[kt][i] = -INFINITY;
          }
      }
      float tmax = -INFINITY;
#pragma unroll
      for (int kt = 0; kt < 2; ++kt)
#pragma unroll
        for (int i = 0; i < 16; ++i) tmax = fmaxf(tmax, sacc[kt][i]);
      tmax = fmaxf(tmax, __shfl_xor(tmax, 32));
      const float mnew = fmaxf(mrun, tmax);
      const float alpha = __builtin_amdgcn_exp2f(mrun - mnew);
      mrun = mnew;
      float psum = 0.f;
#pragma unroll
      for (int kt = 0; kt < 2; ++kt)
#pragma unroll
        for (int i = 0; i < 16; ++i) { const float pv = __builtin_amdgcn_exp2f(sacc[kt][i] - mnew); sacc[kt][i] = pv; psum += pv; }
      lrun = lrun * alpha + psum;
#pragma unroll
      for (int dt = 0; dt < 4; ++dt)
#pragma unroll
        for (int i = 0; i < 16; ++i) oacc[dt][i] *= alpha;
      bf16x8 pf[2][2];
#pragma unroll
      for (int kt = 0; kt < 2; ++kt)
#pragma unroll
        for (int s = 0; s < 2; ++s) {
          uint4 pp = make_uint4(pk2(sacc[kt][8 * s + 0], sacc[kt][8 * s + 1]), pk2(sacc[kt][8 * s + 2], sacc[kt][8 * s + 3]),
                                pk2(sacc[kt][8 * s + 4], sacc[kt][8 * s + 5]), pk2(sacc[kt][8 * s + 6], sacc[kt][8 * s + 7]));
          pf[kt][s] = __builtin_bit_cast(bf16x8, pp);
        }
      if (jt + 1 < ntiles) AGLOAD();
      const u16* vb = Vs + r * 72 + 8 * hh;
#pragma unroll
      for (int dt = 0; dt < 4; ++dt)
#pragma unroll
        for (int kt = 0; kt < 2; ++kt)
#pragma unroll
          for (int s = 0; s < 2; ++s) {
            bf16x8 vf = *(const bf16x8*)(vb + 32 * dt * 72 + 32 * kt + 16 * s);
            oacc[dt] = MFMA(vf, pf[kt][s], oacc[dt]);
            if (kt == 1 && s == 1) __builtin_amdgcn_sched_barrier(0);
          }
    }
  }
  if (ntw > 0 && r <= qclamp) {
    const float ltot = lrun + __shfl_xor(lrun, 32);
    const float inv = 1.f / ltot;
    u16* op = Ob + (long)(32 * w + r) * 1024;
#pragma unroll
    for (int dt = 0; dt < 4; ++dt)
#pragma unroll
      for (int i4 = 0; i4 < 4; ++i4) {
        const int d = 32 * dt + 8 * i4 + 4 * hh;
        *(uint2*)(op + d) = make_uint2(pk2(oacc[dt][4 * i4 + 0] * inv, oacc[dt][4 * i4 + 1] * inv), pk2(oacc[dt][4 * i4 + 2] * inv, oacc[dt][4 * i4 + 3] * inv));
      }
  } else if (ntw > 0) {
    (void)__shfl_xor(lrun, 32);
  }
}

DI void attn_phase(const Params& p, int l, char* smem, int* s_item) {
  const int tid = get_tid(), w = tid >> 6;
  const int NITEM = 256 + 1024;
  for (;;) {
    __syncthreads();
    if (tid == 0) *s_item = (int)atomicAdd(p.ctr + l, 1u);
    __syncthreads();
    const int item = *s_item;
    if (item >= NITEM) break;
    if (item < 256) {
      const int b = item >> 3, h = item & 7;
      const u16* Qb = p.Q + ((long)(M_P + 16 * b) * 8 + h) * 192;
      const u16* Kn = p.Kns + ((long)b * LKS * 8 + h) * 128;
      const u16* KR = p.KRs + (long)b * LKS * 64;
      const u16* VT = p.VTs + ((long)b * 8 + h) * 128 * LKS;
      u16* Ob = p.OA + (long)(M_P + 16 * b) * 1024 + h * 128;
      attn_item(Qb, 15, Kn, KR, VT, LKS, 65, w == 0 ? 65 : 0, LKV, Ob, smem);
    } else {
      const int idx = item - 256;
      const int qb = 127 - (idx >> 3), h = idx & 7;
      const u16* Qb = p.Q + ((long)(128 * qb) * 8 + h) * 192;
      const u16* Kn = p.Knp + (long)h * 128;
      const u16* KR = p.KRp;
      const u16* VT = p.VTp + (long)h * 128 * M_P;
      u16* Ob = p.OA + (long)(128 * qb) * 1024 + h * 128;
      const int ntiles = 2 * qb + 2;
      attn_item(Qb, 31, Kn, KR, VT, M_P, ntiles, w < 2 ? ntiles - 1 : ntiles, 1 << 30, Ob, smem);
    }
  }
}

DI void gmlp_phase(const Params& p, int l, char* smem) {
  const int tid = get_tid(), lane = tid & 63, w = tid >> 6, wm = w >> 1, wn = w & 1, r = lane & 31, hh = lane >> 5;
  const float* gvn = p.gvn + l * 1024;
  const float* gws = p.gws + (long)l * 8 * 128 * 128;
  const float* gbs = p.gbs + (long)l * 8 * 128;
  u16* Xs = (u16*)smem;
  u16* Ws = Xs + 128 * 136;
  const int NP = 128 * 8, NS = 32 * 4;
  for (int t = get_bid(); t < NP + NS; t += gridDim.x) {
    if (t < NP) {
      const int ci = t >> 3, g = t & 7;
      const int t0 = ci * 128, c0 = g * 128;
      __syncthreads();
#pragma unroll
      for (int i = 0; i < 8; ++i) {
        const int c = tid + 256 * i; const int s = c >> 4, dc = (c & 15) * 8;
        const uint4 v = *(const uint4*)(p.Z + (long)(t0 + s) * LDZ + ZV + c0 + dc);
        const float rs = p.rsv[t0 + s];
        const float4 g0 = *(const float4*)(gvn + c0 + dc), g1 = *(const float4*)(gvn + c0 + dc + 4);
        Xs[(dc + 0) * 136 + s] = f2bf(bflo(v.x) * rs * g0.x); Xs[(dc + 1) * 136 + s] = f2bf(bfhi(v.x) * rs * g0.y);
        Xs[(dc + 2) * 136 + s] = f2bf(bflo(v.y) * rs * g0.z); Xs[(dc + 3) * 136 + s] = f2bf(bfhi(v.y) * rs * g0.w);
        Xs[(dc + 4) * 136 + s] = f2bf(bflo(v.z) * rs * g1.x); Xs[(dc + 5) * 136 + s] = f2bf(bfhi(v.z) * rs * g1.y);
        Xs[(dc + 6) * 136 + s] = f2bf(bflo(v.w) * rs * g1.z); Xs[(dc + 7) * 136 + s] = f2bf(bfhi(v.w) * rs * g1.w);
        const int tt = c >> 4, sc = (c & 15) * 8;
        const float* wp = gws + ((long)g * 128 + tt) * 128 + sc;
        float4 a = *(const float4*)wp, b = *(const float4*)(wp + 4);
        a.x = (sc + 0 <= tt) ? a.x : 0.f; a.y = (sc + 1 <= tt) ? a.y : 0.f; a.z = (sc + 2 <= tt) ? a.z : 0.f; a.w = (sc + 3 <= tt) ? a.w : 0.f;
        b.x = (sc + 4 <= tt) ? b.x : 0.f; b.y = (sc + 5 <= tt) ? b.y : 0.f; b.z = (sc + 6 <= tt) ? b.z : 0.f; b.w = (sc + 7 <= tt) ? b.w : 0.f;
        *(uint4*)(Ws + tt * 136 + sc) = pack8(a, b);
      }
      __syncthreads();
      f32x16 acc[2][2];
#pragma unroll
      for (int mi = 0; mi < 2; ++mi)
#pragma unroll
        for (int ni = 0; ni < 2; ++ni)
#pragma unroll
          for (int i = 0; i < 16; ++i) acc[mi][ni][i] = 0.f;
      const u16* Ab = Ws + (64 * wm + r) * 136 + 8 * hh;
      const u16* Bb = Xs + (64 * wn + r) * 136 + 8 * hh;
#pragma unroll
      for (int ks = 0; ks < 8; ++ks) {
        bf16x8 a0 = *(const bf16x8*)(Ab + 16 * ks), a1 = *(const bf16x8*)(Ab + 32 * 136 + 16 * ks);
        bf16x8 b0 = *(const bf16x8*)(Bb + 16 * ks), b1 = *(const bf16x8*)(Bb + 32 * 136 + 16 * ks);
        acc[0][0] = MFMA(b0, a0, acc[0][0]); acc[0][1] = MFMA(b1, a0, acc[0][1]);
        acc[1][0] = MFMA(b0, a1, acc[1][0]); acc[1][1] = MFMA(b1, a1, acc[1][1]);
      }
#pragma unroll
      for (int mi = 0; mi < 2; ++mi) {
        const int tl = 64 * wm + 32 * mi + r;
        const long row = t0 + tl;
        const float bias = gbs[g * 128 + tl];
        const u16* zr = p.Z + row * LDZ;
#pragma unroll
        for (int ni = 0; ni < 2; ++ni)
#pragma unroll
          for (int i4 = 0; i4 < 4; ++i4) {
            const int col = c0 + 64 * wn + 32 * ni + 8 * i4 + 4 * hh;
            const uint2 uu = *(const uint2*)(zr + ZU + col), ga = *(const uint2*)(zr + ZGA + col), gb = *(const uint2*)(zr + ZGB + col);
            const uint2 oa = *(const uint2*)(p.OA + row * 1024 + col);
            const float o0 = sigm(bflo(ga.x)) * bflo(oa.x) + sigm(bflo(gb.x)) * bflo(uu.x) * (acc[mi][ni][4 * i4 + 0] + bias);
            const float o1 = sigm(bfhi(ga.x)) * bfhi(oa.x) + sigm(bfhi(gb.x)) * bfhi(uu.x) * (acc[mi][ni][4 * i4 + 1] + bias);
            const float o2 = sigm(bflo(ga.y)) * bflo(oa.y) + sigm(bflo(gb.y)) * bflo(uu.y) * (acc[mi][ni][4 * i4 + 2] + bias);
            const float o3 = sigm(bfhi(ga.y)) * bfhi(oa.y) + sigm(bfhi(gb.y)) * bfhi(uu.y) * (acc[mi][ni][4 * i4 + 3] + bias);
            *(uint2*)(p.MIX + row * 1024 + col) = make_uint2(pk2(o0, o1), pk2(o2, o3));
          }
      }
    } else {
      const int u = t - NP; const int b = u >> 2, col = (u & 3) * 256 + tid; const int g = col >> 7;
      const long row0 = M_P + 16 * b;
      const float gv = gvn[col];
      float vn[16];
#pragma unroll
      for (int s = 0; s < 16; ++s) vn[s] = bf1(p.Z[(row0 + s) * LDZ + ZV + col]) * p.rsv[row0 + s] * gv;
#pragma unroll
      for (int tt = 0; tt < 16; ++tt) {
        float mx = gbs[g * 128 + tt];
#pragma unroll
        for (int s = 0; s <= tt; ++s) mx += gws[((long)g * 128 + tt) * 128 + s] * vn[s];
        const u16* zr = p.Z + (row0 + tt) * LDZ;
        const float uu = bf1(zr[ZU + col]), ga = bf1(zr[ZGA + col]), gb = bf1(zr[ZGB + col]);
        const float oa = bf1(p.OA[(row0 + tt) * 1024 + col]);
        p.MIX[(row0 + tt) * 1024 + col] = f2bf(sigm(ga) * oa + sigm(gb) * uu * mx);
      }
    }
  }
}

__global__ void __launch_bounds__(256, 2) mega_fwd(Params p) {
  __shared__ __attribute__((aligned(16))) char smem[SMEM_BYTES];
  __shared__ int s_item;
  cg::grid_group grid = cg::this_grid();

  prep_phase(p, smem);
  grid.sync();
#pragma unroll 1
  for (int l = 0; l < 2; ++l) {
    norm_phase(p.out, p.f1n + l * 1024, p.NB);
    grid.sync();
    ffn_up_phase(p, p.Wgu1 + (long)l * 2 * DFF * 1024, smem);
    grid.sync();
    resid_gemm_phase(p, p.ACT, DFF, p.Wd1 + (long)l * 1024 * DFF, 0.5f, smem);
    grid.sync();
    norm_phase(p.out, p.mixn + l * 1024, p.NB);
    grid.sync();
    win_phase(p, p.Win + (long)l * LDZ * 1024, smem);
    grid.sync();
    rowpost_phase(p, l);
    grid.sync();
    multi_phase(p, l, smem);
    grid.sync();
    attn_phase(p, l, smem, &s_item);
    grid.sync();
    gmlp_phase(p, l, smem);
    grid.sync();
    resid_gemm_phase(p, p.MIX, 1024, p.Wo + (long)l * 1024 * 1024, 1.0f, smem);
    grid.sync();
    norm_phase(p.out, p.f2n + l * 1024, p.NB);
    grid.sync();
    ffn_up_phase(p, p.Wgu2 + (long)l * 2 * DFF * 1024, smem);
    grid.sync();
    resid_gemm_phase(p, p.ACT, DFF, p.Wd2 + (long)l * 1024 * DFF, 0.5f, smem);
    grid.sync();
    norm_phase(p.out, p.plen + l * 1024, p.NB);
    grid.sync();
    ple_phase(p, p.Wpg + (long)l * 1024 * 1024, smem);
    grid.sync();
  }
}

extern "C" void kernel_launch(void* const* d_in, const int* in_sizes, int n_in, void* d_out, int out_size, void* d_ws,
                              size_t ws_size, hipStream_t stream) {
  (void)in_sizes; (void)n_in; (void)out_size; (void)ws_size;
  Params p{};
  auto F = [&](int i) { return (const float*)d_in[i]; };
  p.x_prompt = F(0); p.x_sample = F(1); p.cache_c = F(2); p.cache_kr = F(3); p.p_prompt = F(4); p.p_sample = F(5);
  p.f1n = F(6); p.mixn = F(10); p.qan = F(12); p.qnn = F(14); p.qrn = F(15); p.kvan = F(16); p.krn = F(17);
  p.knn = F(20); p.gvn = F(21); p.gws = F(22); p.gbs = F(23); p.f2n = F(25); p.plen = F(29);
  p.out = (float*)d_out;
  char* ws = (char*)d_ws; size_t off = 0;
  auto alloc = [&](size_t bytes) { char* r = ws + off; off += (bytes + 255) & ~(size_t)255; return r; };
  p.Wgu1 = (u16*)alloc(2UL * 2 * DFF * 1024 * 2);
  p.Wd1 = (u16*)alloc(2UL * 1024 * DFF * 2);
  p.Win = (u16*)alloc(2UL * LDZ * 1024 * 2);
  p.Wuq = (u16*)alloc(2UL * 1536 * 384 * 2);
  p.Wkv = (u16*)alloc(2UL * 2048 * 512 * 2);
  p.Wo = (u16*)alloc(2UL * 1024 * 1024 * 2);
  p.Wgu2 = (u16*)alloc(2UL * 2 * DFF * 1024 * 2);
  p.Wd2 = (u16*)alloc(2UL * 1024 * DFF * 2);
  p.Wpg = (u16*)alloc(2UL * 1024 * 1024 * 2);
  p.Wpe = (u16*)alloc(2UL * 1024 * 256 * 2);
  p.NB = (u16*)alloc((size_t)M_ALL * 1024 * 2);
  p.ACT = (u16*)alloc((size_t)M_ALL * DFF * 2);
  p.Z = (u16*)alloc((size_t)M_ALL * LDZ * 2);
  p.QN = (u16*)alloc((size_t)M_ALL * 384 * 2);
  p.C = (u16*)alloc((size_t)M_ALL * 512 * 2);
  p.KRp = (u16*)alloc((size_t)M_P * 64 * 2);
  p.KRs = (u16*)alloc((size_t)32 * LKS * 64 * 2);
  p.Q = (u16*)alloc((size_t)M_ALL * 8 * 192 * 2);
  p.Knp = (u16*)alloc((size_t)M_P * 1024 * 2);
  p.VTp = (u16*)alloc((size_t)M_P * 1024 * 2);
  p.Kns = (u16*)alloc((size_t)32 * LKS * 1024 * 2);
  p.VTs = (u16*)alloc((size_t)32 * LKS * 1024 * 2);
  p.OA = (u16*)alloc((size_t)M_ALL * 1024 * 2);
  p.MIX = (u16*)alloc((size_t)M_ALL * 1024 * 2);
  p.PP = (u16*)alloc((size_t)M_ALL * 1024 * 2);
  p.rsv = (float*)alloc((size_t)M_ALL * 4);
  p.rope = (float*)alloc((size_t)16384 * 32 * 2 * 4);
  p.ctr = (unsigned*)alloc(256);

  int nj = 0, ts = 0;
  auto job = [&](const float* src, u16* dst, int K, int N, int kind) {
    p.jobs[nj].src = src; p.jobs[nj].dst = dst; p.jobs[nj].K = K; p.jobs[nj].N = N; p.jobs[nj].kind = kind; p.jobs[nj].tstart = ts;
    ts += (K / 64) * (N / 64); ++nj;
  };
  for (int l = 0; l < 2; ++l) {
    job(F(7) + (size_t)l * 1024 * DFF, p.Wgu1 + (size_t)l * 2 * DFF * 1024, 1024, DFF, 1);
    job(F(8) + (size_t)l * 1024 * DFF, p.Wgu1 + (size_t)l * 2 * DFF * 1024, 1024, DFF, 2);
    job(F(9) + (size_t)l * DFF * 1024, p.Wd1 + (size_t)l * 1024 * DFF, DFF, 1024, 0);
    job(F(11) + (size_t)l * 1024 * DIN, p.Win + (size_t)l * LDZ * 1024, 1024, DIN, 0);
    job(F(13) + (size_t)l * 384 * 1536, p.Wuq + (size_t)l * 1536 * 384, 384, 1536, 3);
    job(F(18) + (size_t)l * 512 * 1024, p.Wkv + (size_t)l * 2048 * 512, 512, 1024, 0);
    job(F(19) + (size_t)l * 512 * 1024, p.Wkv + (size_t)l * 2048 * 512, 512, 1024, 4);
    job(F(24) + (size_t)l * 1024 * 1024, p.Wo + (size_t)l * 1024 * 1024, 1024, 1024, 0);
    job(F(26) + (size_t)l * 1024 * DFF, p.Wgu2 + (size_t)l * 2 * DFF * 1024, 1024, DFF, 1);
    job(F(27) + (size_t)l * 1024 * DFF, p.Wgu2 + (size_t)l * 2 * DFF * 1024, 1024, DFF, 2);
    job(F(28) + (size_t)l * DFF * 1024, p.Wd2 + (size_t)l * 1024 * DFF, DFF, 1024, 0);
    job(F(30) + (size_t)l * 1024 * 1024, p.Wpg + (size_t)l * 1024 * 1024, 1024, 1024, 0);
    job(F(31) + (size_t)l * 256 * 1024, p.Wpe + (size_t)l * 1024 * 256, 256, 1024, 0);
  }
  p.ntile_prep = ts;

  static int grid_blocks = 0;
  if (!grid_blocks) {
    int dev = 0, cus = 0, per_cu = 0;
    hipGetDevice(&dev);
    hipDeviceGetAttribute(&cus, hipDeviceAttributeMultiprocessorCount, dev);
    hipOccupancyMaxActiveBlocksPerMultiprocessor(&per_cu, (const void*)mega_fwd, 256, 0);
    if (per_cu > 2) per_cu = 2;
    if (per_cu < 1) per_cu = 1;
    grid_blocks = cus * per_cu;
  }
  void* args[] = {&p};
  hipError_t e = hipLaunchCooperativeKernel((const void*)mega_fwd, dim3(grid_blocks), dim3(256), args, 0, stream);
  if (e != hipSuccess) fprintf(stderr, "cooperative launch failed: %s (grid %d)\n", hipGetErrorString(e), grid_blocks);
}
```

```cpp
#include <hip/hip_runtime.h>
#include <hip/hip_cooperative_groups.h>
#include <cstdio>
namespace cg = cooperative_groups;

#define DI __device__ __forceinline__
typedef unsigned short u16;
typedef __attribute__((ext_vector_type(8))) short bf16x8;
typedef __attribute__((ext_vector_type(16))) float f32x16;
typedef __attribute__((ext_vector_type(2))) __bf16 bf2_t;
typedef __attribute__((ext_vector_type(2))) float f2_t;

#define M_P 16384
#define M_S 512
#define M_ALL 16896
#define DM 1024
#define DFF 2816
#define DIN 5056
#define LDZ 5120
#define ZQ 0
#define ZKV 384
#define ZKR 896
#define ZU 960
#define ZV 1984
#define ZGA 3008
#define ZGB 4032
#define LKS 4160
#define LKV 4112
#define PAST 4096
#define EPSF 1e-6f
#define QSCALE (0.07216878364870322f * 1.4426950408889634f)

#define NJOBS 26
struct TJob { const float* src; u16* dst; int K, N, kind, tstart; };

struct Params {
  const float *x_prompt, *x_sample, *cache_c, *cache_kr, *p_prompt, *p_sample;
  const float *f1n, *mixn, *qan, *qnn, *qrn, *kvan, *krn, *knn, *gvn, *gws, *gbs, *f2n, *plen;
  float* out;
  u16 *Wgu1, *Wd1, *Win, *Wuq, *Wkv, *Wo, *Wgu2, *Wd2, *Wpg, *Wpe;
  u16 *NB, *ACT, *Z, *QN, *C, *KRp, *KRs, *Q, *Knp, *VTp, *Kns, *VTs, *OA, *MIX, *PP;
  float *rsv, *rope;
  unsigned* ctr;
  unsigned* bar;
  TJob jobs[NJOBS];
  int ntile_prep; int pad0;
};

DI int get_tid() { int t = threadIdx.x; asm volatile("" : "+v"(t)); return t; }
DI int get_bid() { int t = blockIdx.x; asm volatile("" : "+s"(t)); return t; }
DI unsigned pk2(float a, float b) { f2_t v = {a, b}; bf2_t r = __builtin_convertvector(v, bf2_t); return __builtin_bit_cast(unsigned, r); }
DI float bflo(unsigned v) { return __uint_as_float(v << 16); }
DI float bfhi(unsigned v) { return __uint_as_float(v & 0xffff0000u); }
DI float bf1(u16 v) { return __uint_as_float(((unsigned)v) << 16); }
DI u16 f2bf(float a) { return (u16)(pk2(a, 0.f) & 0xffffu); }
DI float wave_sum(float v) {
#pragma unroll
  for (int o = 32; o > 0; o >>= 1) v += __shfl_xor(v, o);
  return v;
}
DI float sigm(float x) { return 1.f / (1.f + __expf(-x)); }
DI uint4 pack8(float4 x, float4 y) { return make_uint4(pk2(x.x, x.y), pk2(x.z, x.w), pk2(y.x, y.y), pk2(y.z, y.w)); }
#define MFMA(a, b, c) __builtin_amdgcn_mfma_f32_32x32x16_bf16((a), (b), (c), 0, 0, 0)

#define SMEM_BYTES 73728

DI int job_dst_row(int kind, int n) {
  if (kind == 0) return n;
  if (kind == 1) return 64 * (n >> 5) + (n & 31);
  if (kind == 2) return 64 * (n >> 5) + 32 + (n & 31);
  if (kind == 3) { int h = n / 192, c = n - h * 192; return c < 128 ? h * 128 + c : 1024 + h * 64 + (c - 128); }
  return 1024 + n;
}

DI void prep_phase(const Params& p, char* smem) {
  const int tid = get_tid();
  u16* Ts = (u16*)smem;
  for (int t = get_bid(); t < p.ntile_prep; t += gridDim.x) {
    int j = 0;
#pragma unroll 1
    for (int q = 1; q < NJOBS; ++q) if (t >= p.jobs[q].tstart) j = q;
    const float* src = p.jobs[j].src; u16* dst = p.jobs[j].dst;
    const int K = p.jobs[j].K, N = p.jobs[j].N, kind = p.jobs[j].kind;
    const int lt = t - p.jobs[j].tstart;
    const int ntn = N >> 6;
    const int tk = lt / ntn, tn = lt - tk * ntn;
    const int k0 = tk * 64, n0 = tn * 64;
    __syncthreads();
#pragma unroll
    for (int i = 0; i < 4; ++i) {
      const int k = (tid >> 4) + 16 * i, nc = (tid & 15) * 4;
      float4 v = *(const float4*)(src + (long)(k0 + k) * N + n0 + nc);
      Ts[(nc + 0) * 66 + k] = f2bf(v.x); Ts[(nc + 1) * 66 + k] = f2bf(v.y);
      Ts[(nc + 2) * 66 + k] = f2bf(v.z); Ts[(nc + 3) * 66 + k] = f2bf(v.w);
    }
    __syncthreads();
    {
      const int n = tid >> 2, kc = (tid & 3) * 16;
      const unsigned* s32 = (const unsigned*)(Ts + n * 66 + kc);
      uint4 a = make_uint4(s32[0], s32[1], s32[2], s32[3]);
      uint4 b = make_uint4(s32[4], s32[5], s32[6], s32[7]);
      u16* d = dst + (long)job_dst_row(kind, n0 + n) * K + k0 + kc;
      *(uint4*)d = a; *(uint4*)(d + 8) = b;
    }
  }
  const long gtid = (long)get_bid() * 256 + tid, gstride = (long)gridDim.x * 256;
  for (long e = gtid; e < 2L * 64 * 1024 / 8; e += gstride) {
    const int l = (int)(e / (64 * 1024 / 8)); const long r = e - (long)l * (64 * 1024 / 8);
    *(uint4*)(p.Win + (long)l * LDZ * 1024 + (long)DIN * 1024 + r * 8) = make_uint4(0, 0, 0, 0);
  }
  for (long e = gtid; e < 16384L * 32; e += gstride) {
    const int pos = (int)(e >> 5), i = (int)(e & 31);
    const float inv = powf(10000.0f, -(float)i / 32.0f);
    const float angf = (float)pos * inv;
    const double x = (double)angf;
    const double kq = rint(x * 0.63661977236758134308);
    const double y = (x - kq * 1.5707963267341256e+00) - kq * 6.0771005065061922e-11;
    const double y2 = y * y;
    const double s = y * (1.0 + y2 * (-1.0 / 6 + y2 * (1.0 / 120 + y2 * (-1.0 / 5040 + y2 * (1.0 / 362880 + y2 * (-1.0 / 39916800))))));
    const double c = 1.0 + y2 * (-0.5 + y2 * (1.0 / 24 + y2 * (-1.0 / 720 + y2 * (1.0 / 40320 + y2 * (-1.0 / 3628800 + y2 * (1.0 / 479001600))))));
    const int q = ((int)kq) & 3;
    double cc, ss;
    if (q == 0) { cc = c; ss = s; } else if (q == 1) { cc = -s; ss = c; } else if (q == 2) { cc = -c; ss = -s; } else { cc = s; ss = -c; }
    *(float2*)(p.rope + e * 2) = make_float2((float)cc, (float)ss);
  }
  for (long e = gtid; e < (long)M_ALL * 1024 / 4; e += gstride) {
    const long pe = (long)M_P * 1024 / 4;
    float4 v = e < pe ? ((const float4*)p.x_prompt)[e] : ((const float4*)p.x_sample)[e - pe];
    ((float4*)p.out)[e] = v;
  }
  if (get_bid() == 0 && tid < 16) p.ctr[tid] = 0u;
}

DI void norm_phase(const float* __restrict__ h, const float* __restrict__ g, u16* __restrict__ out) {
  const int tid = get_tid(); const int lane = tid & 63, w = tid >> 6;
  for (int row = get_bid() * 4 + w; row < M_ALL; row += gridDim.x * 4) {
    const float4* hr = (const float4*)(h + (long)row * 1024);
    float4 v[4]; float ss = 0.f;
#pragma unroll
    for (int i = 0; i < 4; ++i) { v[i] = hr[lane + 64 * i]; ss += v[i].x * v[i].x + v[i].y * v[i].y + v[i].z * v[i].z + v[i].w * v[i].w; }
    ss = wave_sum(ss);
    const float rs = rsqrtf(ss * (1.f / 1024.f) + EPSF);
#pragma unroll
    for (int i = 0; i < 4; ++i) {
      const float4 gg = ((const float4*)g)[lane + 64 * i];
      uint2 o = make_uint2(pk2(v[i].x * rs * gg.x, v[i].y * rs * gg.y), pk2(v[i].z * rs * gg.z, v[i].w * rs * gg.w));
      ((uint2*)(out + (long)row * 1024))[lane + 64 * i] = o;
    }
  }
}

template <bool AF32, bool SWAP>
DI void gemm_core(const void* __restrict__ Ap, long lda, const u16* __restrict__ Bp, long ldb, int K,
                  f32x16 (&acc)[2][2], char* smem) {
  const int tid = get_tid(), lane = tid & 63, w = tid >> 6, wm = w >> 1, wn = w & 1, r = lane & 31, hh = lane >> 5;
  u16* As = (u16*)smem;
  u16* Bs = As + 2 * 128 * 72;
  const int lrow = tid >> 3, lkc = (tid & 7) * 8;
  uint4 ra0, ra1, ra2, ra3, rb0, rb1, rb2, rb3;
#pragma unroll
  for (int mi = 0; mi < 2; ++mi)
#pragma unroll
    for (int ni = 0; ni < 2; ++ni)
#pragma unroll
      for (int i = 0; i < 16; ++i) acc[mi][ni][i] = 0.f;
#define GL_A(dst, i) { const int row_ = lrow + 32 * (i); \
    if (AF32) { const float* a_ = (const float*)Ap + (long)row_ * lda + k0_ + lkc; dst = pack8(*(const float4*)a_, *(const float4*)(a_ + 4)); } \
    else { dst = *(const uint4*)((const u16*)Ap + (long)row_ * lda + k0_ + lkc); } }
#define GL_B(dst, i) { const int row_ = lrow + 32 * (i); dst = *(const uint4*)(Bp + (long)row_ * ldb + k0_ + lkc); }
#define GLOAD(k0) { const int k0_ = (k0); GL_A(ra0, 0) GL_A(ra1, 1) GL_A(ra2, 2) GL_A(ra3, 3) GL_B(rb0, 0) GL_B(rb1, 1) GL_B(rb2, 2) GL_B(rb3, 3) }
#define SST(arr, src, i, buf) *(uint4*)(arr + ((buf) * 128 + lrow + 32 * (i)) * 72 + lkc) = src;
#define SSTORE(buf) { SST(As, ra0, 0, buf) SST(As, ra1, 1, buf) SST(As, ra2, 2, buf) SST(As, ra3, 3, buf) SST(Bs, rb0, 0, buf) SST(Bs, rb1, 1, buf) SST(Bs, rb2, 2, buf) SST(Bs, rb3, 3, buf) }
  const int nk = K >> 6;
  __syncthreads();
  GLOAD(0);
  SSTORE(0);
  __syncthreads();
#pragma unroll 1
  for (int kt = 0; kt < nk; ++kt) {
    const int buf = kt & 1;
    if (kt + 1 < nk) GLOAD((kt + 1) << 6);
    const u16* Ab = As + (buf * 128 + 64 * wm + r) * 72 + 8 * hh;
    const u16* Bb = Bs + (buf * 128 + 64 * wn + r) * 72 + 8 * hh;
#pragma unroll
    for (int ks = 0; ks < 4; ++ks) {
      bf16x8 a0 = *(const bf16x8*)(Ab + 16 * ks);
      bf16x8 a1 = *(const bf16x8*)(Ab + 32 * 72 + 16 * ks);
      bf16x8 b0 = *(const bf16x8*)(Bb + 16 * ks);
      bf16x8 b1 = *(const bf16x8*)(Bb + 32 * 72 + 16 * ks);
      if (SWAP) {
        acc[0][0] = MFMA(b0, a0, acc[0][0]); acc[0][1] = MFMA(b1, a0, acc[0][1]);
        acc[1][0] = MFMA(b0, a1, acc[1][0]); acc[1][1] = MFMA(b1, a1, acc[1][1]);
      } else {
        acc[0][0] = MFMA(a0, b0, acc[0][0]); acc[0][1] = MFMA(a0, b1, acc[0][1]);
        acc[1][0] = MFMA(a1, b0, acc[1][0]); acc[1][1] = MFMA(a1, b1, acc[1][1]);
      }
    }
    if (kt + 1 < nk) SSTORE(buf ^ 1);
    __syncthreads();
  }
#undef GL_A
#undef GL_B
#undef GLOAD
#undef SST
#undef SSTORE
}

DI int tok_pos(int m) { return m < M_P ? m : PAST + ((m - M_P) & 15); }

template <class RowPtr>
DI void nope_epilogue(f32x16 (&acc)[2][2], const float* __restrict__ gain, float scale, char* smem, RowPtr rowptr) {
  const int tid = get_tid(), lane = tid & 63, w = tid >> 6, wm = w >> 1, wn = w & 1, r = lane & 31, hh = lane >> 5;
  float* red = (float*)smem;
  float ss[2];
#pragma unroll
  for (int mi = 0; mi < 2; ++mi) {
    float s = 0.f;
#pragma unroll
    for (int ni = 0; ni < 2; ++ni)
#pragma unroll
      for (int i = 0; i < 16; ++i) s += acc[mi][ni][i] * acc[mi][ni][i];
    s += __shfl_xor(s, 32);
    ss[mi] = s;
    if (hh == 0) red[wn * 128 + 64 * wm + 32 * mi + r] = s;
  }
  __syncthreads();
#pragma unroll
  for (int mi = 0; mi < 2; ++mi) {
    const int m = 64 * wm + 32 * mi + r;
    const float tot = ss[mi] + red[(wn ^ 1) * 128 + m];
    const float rs = rsqrtf(tot * (1.f / 128.f) + EPSF) * scale;
    u16* op = rowptr(m);
#pragma unroll
    for (int ni = 0; ni < 2; ++ni)
#pragma unroll
      for (int i4 = 0; i4 < 4; ++i4) {
        const int c = 64 * wn + 32 * ni + 8 * i4 + 4 * hh;
        const float4 g = *(const float4*)(gain + c);
        uint2 o = make_uint2(pk2(acc[mi][ni][4 * i4 + 0] * rs * g.x, acc[mi][ni][4 * i4 + 1] * rs * g.y),
                             pk2(acc[mi][ni][4 * i4 + 2] * rs * g.z, acc[mi][ni][4 * i4 + 3] * rs * g.w));
        *(uint2*)(op + c) = o;
      }
  }
}

template <class KeyPtr>
DI void vt_epilogue(f32x16 (&acc)[2][2], long dstride, KeyPtr keyptr) {
  const int tid = get_tid(), lane = tid & 63, w = tid >> 6, wm = w >> 1, wn = w & 1, r = lane & 31, hh = lane >> 5;
#pragma unroll
  for (int mi = 0; mi < 2; ++mi)
#pragma unroll
    for (int i4 = 0; i4 < 4; ++i4) {
      const int mloc = 64 * wm + 32 * mi + 8 * i4 + 4 * hh;
      u16* base = keyptr(mloc);
#pragma unroll
      for (int ni = 0; ni < 2; ++ni) {
        const int d = 64 * wn + 32 * ni + r;
        uint2 o = make_uint2(pk2(acc[mi][ni][4 * i4 + 0], acc[mi][ni][4 * i4 + 1]), pk2(acc[mi][ni][4 * i4 + 2], acc[mi][ni][4 * i4 + 3]));
        *(uint2*)(base + (long)d * dstride) = o;
      }
    }
}
DI int perm_pos(int key) {
  const int g4 = (key >> 2) & 3;
  const int pg = (g4 == 1) ? 2 : ((g4 == 2) ? 1 : g4);
  return (key & ~15) + 4 * pg;
}

DI void ffn_up_phase(const Params& p, const u16* W, char* smem) {
  const int tid = get_tid(), lane = tid & 63, w = tid >> 6, wm = w >> 1, wn = w & 1, r = lane & 31, hh = lane >> 5;
  const int NT = (2 * DFF) / 128;
  for (int t = get_bid(); t < 132 * NT; t += gridDim.x) {
    const int tm = t / NT, tn = t - tm * NT;
    f32x16 acc[2][2];
    gemm_core<false, true>(p.NB + (long)tm * 128 * 1024, 1024, W + (long)tn * 128 * 1024, 1024, 1024, acc, smem);
#pragma unroll
    for (int mi = 0; mi < 2; ++mi) {
      const long m = (long)tm * 128 + 64 * wm + 32 * mi + r;
#pragma unroll
      for (int i4 = 0; i4 < 4; ++i4) {
        const int c = 64 * tn + 32 * wn + 8 * i4 + 4 * hh;
        float a[4];
#pragma unroll
        for (int j = 0; j < 4; ++j) { const float g = acc[mi][0][4 * i4 + j], u = acc[mi][1][4 * i4 + j]; a[j] = g * sigm(g) * u; }
        *(uint2*)(p.ACT + m * DFF + c) = make_uint2(pk2(a[0], a[1]), pk2(a[2], a[3]));
      }
    }
  }
}

DI void resid_gemm_phase(const Params& p, const u16* A, int K, const u16* W, float alpha, char* smem) {
  const int tid = get_tid(), lane = tid & 63, w = tid >> 6, wm = w >> 1, wn = w & 1, r = lane & 31, hh = lane >> 5;
  for (int t = get_bid(); t < 132 * 8; t += gridDim.x) {
    const int tm = t >> 3, tn = t & 7;
    f32x16 acc[2][2];
    gemm_core<false, true>(A + (long)tm * 128 * K, K, W + (long)tn * 128 * K, K, K, acc, smem);
#pragma unroll
    for (int mi = 0; mi < 2; ++mi) {
      const long m = (long)tm * 128 + 64 * wm + 32 * mi + r;
#pragma unroll
      for (int ni = 0; ni < 2; ++ni)
#pragma unroll
        for (int i4 = 0; i4 < 4; ++i4) {
          const int n = tn * 128 + 64 * wn + 32 * ni + 8 * i4 + 4 * hh;
          float4* hp = (float4*)(p.out + m * 1024 + n);
          float4 v = *hp;
          v.x += alpha * acc[mi][ni][4 * i4 + 0]; v.y += alpha * acc[mi][ni][4 * i4 + 1];
          v.z += alpha * acc[mi][ni][4 * i4 + 2]; v.w += alpha * acc[mi][ni][4 * i4 + 3];
          *hp = v;
        }
    }
  }
}

DI void ple_phase(const Params& p, const u16* W, char* smem) {
  const int tid = get_tid(), lane = tid & 63, w = tid >> 6, wm = w >> 1, wn = w & 1, r = lane & 31, hh = lane >> 5;
  for (int t = get_bid(); t < 132 * 8; t += gridDim.x) {
    const int tm = t >> 3, tn = t & 7;
    f32x16 acc[2][2];
    gemm_core<false, true>(p.NB + (long)tm * 128 * 1024, 1024, W + (long)tn * 128 * 1024, 1024, 1024, acc, smem);
#pragma unroll
    for (int mi = 0; mi < 2; ++mi) {
      const long m = (long)tm * 128 + 64 * wm + 32 * mi + r;
#pragma unroll
      for (int ni = 0; ni < 2; ++ni)
#pragma unroll
        for (int i4 = 0; i4 < 4; ++i4) {
          const int n = tn * 128 + 64 * wn + 32 * ni + 8 * i4 + 4 * hh;
          float4* hp = (float4*)(p.out + m * 1024 + n);
          const uint2 pp = *(const uint2*)(p.PP + m * 1024 + n);
          float4 v = *hp;
          v.x += sigm(acc[mi][ni][4 * i4 + 0]) * bflo(pp.x); v.y += sigm(acc[mi][ni][4 * i4 + 1]) * bfhi(pp.x);
          v.z += sigm(acc[mi][ni][4 * i4 + 2]) * bflo(pp.y); v.w += sigm(acc[mi][ni][4 * i4 + 3]) * bfhi(pp.y);
          *hp = v;
        }
    }
  }
}

DI void win_phase(const Params& p, const u16* W, char* smem) {
  const int tid = get_tid(), lane = tid & 63, w = tid >> 6, wm = w >> 1, wn = w & 1, r = lane & 31, hh = lane >> 5;
  const int NT = LDZ / 128;
  for (int t = get_bid(); t < 132 * NT; t += gridDim.x) {
    const int tm = t / NT, tn = t - tm * NT;
    f32x16 acc[2][2];
    gemm_core<false, true>(p.NB + (long)tm * 128 * 1024, 1024, W + (long)tn * 128 * 1024, 1024, 1024, acc, smem);
#pragma unroll
    for (int mi = 0; mi < 2; ++mi) {
      const long m = (long)tm * 128 + 64 * wm + 32 * mi + r;
#pragma unroll
      for (int ni = 0; ni < 2; ++ni)
#pragma unroll
        for (int i4 = 0; i4 < 4; ++i4) {
          const int n = tn * 128 + 64 * wn + 32 * ni + 8 * i4 + 4 * hh;
          *(uint2*)(p.Z + m * LDZ + n) = make_uint2(pk2(acc[mi][ni][4 * i4 + 0], acc[mi][ni][4 * i4 + 1]), pk2(acc[mi][ni][4 * i4 + 2], acc[mi][ni][4 * i4 + 3]));
        }
    }
  }
}

DI void rowpost_phase(const Params& p, int l) {
  const int tid = get_tid(); const int lane = tid & 63, w = tid >> 6;
  const float* qan = p.qan + l * 384; const float* kvan = p.kvan + l * 512; const float* krn = p.krn + l * 64; const float* gvn = p.gvn + l * 1024;
  float* o_pkv = p.out + 17301504L + (long)l * M_P * 512;
  float* o_pkr = p.out + 34078720L + (long)l * M_P * 64;
  float* o_skv = p.out + 36175872L + (long)l * M_S * 512;
  float* o_skr = p.out + 36700160L + (long)l * M_S * 64;
  float* o_sgv = p.out + 36765696L + (long)l * M_S * 1024;
  for (int row = get_bid() * 4 + w; row < M_ALL; row += gridDim.x * 4) {
    const u16* zr = p.Z + (long)row * LDZ;
    const bool is_s = row >= M_P; const int rs_ = row - M_P;
    {
      unsigned v[3]; float ss = 0.f;
#pragma unroll
      for (int i = 0; i < 3; ++i) { v[i] = *(const unsigned*)(zr + ZQ + 2 * lane + 128 * i); const float a = bflo(v[i]), b = bfhi(v[i]); ss += a * a + b * b; }
      ss = wave_sum(ss);
      const float rs = rsqrtf(ss * (1.f / 384.f) + EPSF);
#pragma unroll
      for (int i = 0; i < 3; ++i) {
        const int c = 2 * lane + 128 * i; const float2 g = *(const float2*)(qan + c);
        *(unsigned*)(p.QN + (long)row * 384 + c) = pk2(bflo(v[i]) * rs * g.x, bfhi(v[i]) * rs * g.y);
      }
    }
    {
      const uint4 v = *(const uint4*)(zr + ZKV + 8 * lane);
      float x[8] = {bflo(v.x), bfhi(v.x), bflo(v.y), bfhi(v.y), bflo(v.z), bfhi(v.z), bflo(v.w), bfhi(v.w)};
      float ss = 0.f;
#pragma unroll
      for (int i = 0; i < 8; ++i) ss += x[i] * x[i];
      ss = wave_sum(ss);
      const float rs = rsqrtf(ss * (1.f / 512.f) + EPSF);
      const float4 g0 = *(const float4*)(kvan + 8 * lane), g1 = *(const float4*)(kvan + 8 * lane + 4);
      float4 y0 = make_float4(x[0] * rs * g0.x, x[1] * rs * g0.y, x[2] * rs * g0.z, x[3] * rs * g0.w);
      float4 y1 = make_float4(x[4] * rs * g1.x, x[5] * rs * g1.y, x[6] * rs * g1.z, x[7] * rs * g1.w);
      float* od = is_s ? (o_skv + (long)rs_ * 512) : (o_pkv + (long)row * 512);
      *(float4*)(od + 8 * lane) = y0; *(float4*)(od + 8 * lane + 4) = y1;
      *(uint4*)(p.C + (long)row * 512 + 8 * lane) = pack8(y0, y1);
    }
    {
      const float x = bf1(zr[ZKR + lane]);
      const float ss = wave_sum(x * x);
      const float rs = rsqrtf(ss * (1.f / 64.f) + EPSF);
      const float y = x * rs * krn[lane];
      const float other = __shfl_xor(y, 32);
      const int pos = tok_pos(row);
      const float2 cs = *(const float2*)(p.rope + ((long)pos * 32 + (lane & 31)) * 2);
      const float o = lane < 32 ? (y * cs.x - other * cs.y) : (other * cs.y + y * cs.x);
      if (is_s) {
        o_skr[(long)rs_ * 64 + lane] = o;
        p.KRs[((long)(rs_ >> 4) * LKS + PAST + (rs_ & 15)) * 64 + lane] = f2bf(o);
      } else {
        o_pkr[(long)row * 64 + lane] = o;
        p.KRp[(long)row * 64 + lane] = f2bf(o);
      }
    }
    {
      uint4 v[2]; float ss = 0.f;
#pragma unroll
      for (int i = 0; i < 2; ++i) {
        v[i] = *(const uint4*)(zr + ZV + 8 * lane + 512 * i);
        const float x[8] = {bflo(v[i].x), bfhi(v[i].x), bflo(v[i].y), bfhi(v[i].y), bflo(v[i].z), bfhi(v[i].z), bflo(v[i].w), bfhi(v[i].w)};
#pragma unroll
        for (int j = 0; j < 8; ++j) ss += x[j] * x[j];
      }
      ss = wave_sum(ss);
      const float rs = rsqrtf(ss * (1.f / 1024.f) + EPSF);
      if (lane == 0) p.rsv[row] = rs;
      if (is_s) {
#pragma unroll
        for (int i = 0; i < 2; ++i) {
          const int c = 8 * lane + 512 * i;
          const float x[8] = {bflo(v[i].x), bfhi(v[i].x), bflo(v[i].y), bfhi(v[i].y), bflo(v[i].z), bfhi(v[i].z), bflo(v[i].w), bfhi(v[i].w)};
          const float4 g0 = *(const float4*)(gvn + c), g1 = *(const float4*)(gvn + c + 4);
          *(float4*)(o_sgv + (long)rs_ * 1024 + c) = make_float4(x[0] * rs * g0.x, x[1] * rs * g0.y, x[2] * rs * g0.z, x[3] * rs * g0.w);
          *(float4*)(o_sgv + (long)rs_ * 1024 + c + 4) = make_float4(x[4] * rs * g1.x, x[5] * rs * g1.y, x[6] * rs * g1.z, x[7] * rs * g1.w);
        }
      }
    }
  }
  const float* ckr = p.cache_kr + (long)l * 32 * PAST * 64;
  const long gtid = (long)get_bid() * 256 + tid, gstride = (long)gridDim.x * 256;
  for (long e = gtid; e < 32L * PAST * 64 / 8; e += gstride) {
    const long el = e * 8; const int b = (int)(el / (PAST * 64)); const long rem = el - (long)b * PAST * 64;
    const float4 a = *(const float4*)(ckr + el), c = *(const float4*)(ckr + el + 4);
    *(uint4*)(p.KRs + (long)b * LKS * 64 + rem) = pack8(a, c);
  }
}

template <bool AF32>
DI void kv_tile(const Params& p, int l, const void* A, int mode, int m0, int tn, char* smem) {
  const u16* W = p.Wkv + (long)l * 2048 * 512 + (long)tn * 128 * 512;
  if (tn < 8) {
    f32x16 acc[2][2];
    gemm_core<AF32, true>(A, 512, W, 512, 512, acc, smem);
    const int h = tn;
    nope_epilogue(acc, p.knn + l * 128, 1.0f, smem, [&](int mloc) -> u16* {
      const int m = m0 + mloc;
      if (mode == 0) return p.Knp + ((long)m * 8 + h) * 128;
      long key;
      if (mode == 1) key = (long)(m >> 12) * LKS + (m & 4095); else key = (long)(m >> 4) * LKS + PAST + (m & 15);
      return p.Kns + (key * 8 + h) * 128;
    });
  } else {
    f32x16 acc[2][2];
    gemm_core<AF32, false>(A, 512, W, 512, 512, acc, smem);
    const int h = tn - 8;
    const long dstride = (mode == 0) ? (long)M_P : (long)LKS;
    vt_epilogue(acc, dstride, [&](int mloc) -> u16* {
      const int m = m0 + mloc;
      if (mode == 0) return p.VTp + (long)h * 128 * M_P + perm_pos(m);
      int b, key;
      if (mode == 1) { b = m >> 12; key = m & 4095; } else { b = m >> 4; key = PAST + (m & 15); }
      return p.VTs + ((long)b * 8 + h) * 128 * LKS + perm_pos(key);
    });
  }
}

DI void multi_phase(const Params& p, int l, char* smem) {
  const int tid = get_tid(), lane = tid & 63, w = tid >> 6, wm = w >> 1, wn = w & 1, r = lane & 31, hh = lane >> 5;
  const int NQ = 132 * 12, NPKV = 128 * 16, NSKV = 4 * 16, NCKV = 1024 * 16, NPP = 132 * 8;
  const int total = NQ + NPKV + NSKV + NCKV + NPP;
  for (int t = get_bid(); t < total; t += gridDim.x) {
    int u = t;
    if (u < NCKV) {
      const int tm = u >> 4, tn = u & 15;
      kv_tile<true>(p, l, p.cache_c + ((long)l * 32 * PAST + (long)tm * 128) * 512, 1, tm * 128, tn, smem);
      continue;
    }
    u -= NCKV;
    if (u < NPKV) {
      const int tm = u >> 4, tn = u & 15;
      kv_tile<false>(p, l, p.C + (long)tm * 128 * 512, 0, tm * 128, tn, smem);
      continue;
    }
    u -= NPKV;
    if (u < NSKV) {
      const int tm = u >> 4, tn = u & 15;
      kv_tile<false>(p, l, p.C + ((long)M_P + tm * 128) * 512, 2, tm * 128, tn, smem);
      continue;
    }
    u -= NSKV;
    if (u < NQ) {
      const int tm = u / 12, tn = u - tm * 12;
      f32x16 acc[2][2];
      gemm_core<false, true>(p.QN + (long)tm * 128 * 384, 384, p.Wuq + (long)l * 1536 * 384 + (long)tn * 128 * 384, 384, 384, acc, smem);
      if (tn < 8) {
        nope_epilogue(acc, p.qnn + l * 128, QSCALE, smem, [&](int mloc) -> u16* { return p.Q + ((long)(tm * 128 + mloc) * 8 + tn) * 192; });
      } else {
        const int head = 2 * (tn - 8) + wn;
        const float* g = p.qrn + l * 64;
#pragma unroll
        for (int mi = 0; mi < 2; ++mi) {
          float s = 0.f;
#pragma unroll
          for (int ni = 0; ni < 2; ++ni)
#pragma unroll
            for (int i = 0; i < 16; ++i) s += acc[mi][ni][i] * acc[mi][ni][i];
          s += __shfl_xor(s, 32);
          const float rs = rsqrtf(s * (1.f / 64.f) + EPSF);
          const int m = tm * 128 + 64 * wm + 32 * mi + r;
          const int pos = tok_pos(m);
          u16* qp = p.Q + ((long)m * 8 + head) * 192 + 128;
#pragma unroll
          for (int i4 = 0; i4 < 4; ++i4) {
            const int cc = 8 * i4 + 4 * hh;
            const float4 g1 = *(const float4*)(g + cc), g2 = *(const float4*)(g + 32 + cc);
            const float4 t0 = *(const float4*)(p.rope + ((long)pos * 32 + cc) * 2);
            const float4 t1 = *(const float4*)(p.rope + ((long)pos * 32 + cc) * 2 + 4);
            const float cs[4] = {t0.x, t0.z, t1.x, t1.z}, sn[4] = {t0.y, t0.w, t1.y, t1.w};
            const float gg1[4] = {g1.x, g1.y, g1.z, g1.w}, gg2[4] = {g2.x, g2.y, g2.z, g2.w};
            float o1[4], o2[4];
#pragma unroll
            for (int j = 0; j < 4; ++j) {
              const float y1 = acc[mi][0][4 * i4 + j] * rs * gg1[j], y2 = acc[mi][1][4 * i4 + j] * rs * gg2[j];
              o1[j] = (y1 * cs[j] - y2 * sn[j]) * QSCALE; o2[j] = (y1 * sn[j] + y2 * cs[j]) * QSCALE;
            }
            *(uint2*)(qp + cc) = make_uint2(pk2(o1[0], o1[1]), pk2(o1[2], o1[3]));
            *(uint2*)(qp + 32 + cc) = make_uint2(pk2(o2[0], o2[1]), pk2(o2[2], o2[3]));
          }
        }
      }
      continue;
    }
    u -= NQ;
    {
      const int tm = u >> 3, tn = u & 7;
      const float* A = tm < 128 ? (p.p_prompt + ((long)l * M_P + (long)tm * 128) * 256) : (p.p_sample + ((long)l * M_S + (long)(tm - 128) * 128) * 256);
      f32x16 acc[2][2];
      gemm_core<true, true>(A, 256, p.Wpe + (long)l * 1024 * 256 + (long)tn * 128 * 256, 256, 256, acc, smem);
#pragma unroll
      for (int mi = 0; mi < 2; ++mi) {
        const long m = (long)tm * 128 + 64 * wm + 32 * mi + r;
#pragma unroll
        for (int ni = 0; ni < 2; ++ni)
#pragma unroll
          for (int i4 = 0; i4 < 4; ++i4) {
            const int n = tn * 128 + 64 * wn + 32 * ni + 8 * i4 + 4 * hh;
            *(uint2*)(p.PP + m * 1024 + n) = make_uint2(pk2(acc[mi][ni][4 * i4 + 0], acc[mi][ni][4 * i4 + 1]), pk2(acc[mi][ni][4 * i4 + 2], acc[mi][ni][4 * i4 + 3]));
          }
      }
    }
  }
}

DI void attn_item(const u16* __restrict__ Qb, int qclamp, const u16* __restrict__ Kn, const u16* __restrict__ KR,
                  const u16* __restrict__ VT, long vt_stride, int ntiles, int ntw, int Lk, u16* __restrict__ Ob, char* smem) {
  const int tid = get_tid(), lane = tid & 63, w = tid >> 6, r = lane & 31, hh = lane >> 5;
  u16* Ks = (u16*)smem;
  u16* Vs = Ks + 64 * 200;
  bf16x8 qf[12];
  {
    const int qr = r < qclamp ? r : qclamp;
    const u16* qp = Qb + (long)(32 * w + qr) * (8 * 192) + 8 * hh;
#pragma unroll
    for (int ks = 0; ks < 12; ++ks) qf[ks] = *(const bf16x8*)(qp + 16 * ks);
  }
  f32x16 oacc[4];
#pragma unroll
  for (int dt = 0; dt < 4; ++dt)
#pragma unroll
    for (int i = 0; i < 16; ++i) oacc[dt][i] = 0.f;
  float mrun = -INFINITY, lrun = 0.f;

  uint4 rk0, rk1, rk2, rk3, rk4, rk5, rv0, rv1, rv2, rv3;
  const int lkey = tid >> 2, lq = tid & 3;
  unsigned koff = (unsigned)(lkey * 1024 + lq * 8) * 2u;
  unsigned kroff = (unsigned)(lkey * 64 + lq * 8) * 2u;
  const unsigned vstep = (unsigned)(32 * vt_stride * 2);
  unsigned voff = (unsigned)((tid >> 3) * vt_stride * 2 + (tid & 7) * 16);
  const char* KnB = (const char*)Kn; const char* KRB = (const char*)KR; const char* VTB = (const char*)VT;
  char* KsW = (char*)Ks + lkey * 400 + lq * 16;
  char* VsW = (char*)Vs + (tid >> 3) * 144 + (tid & 7) * 16;
#define AGLOAD() { \
    rk0 = *(const uint4*)(KnB + (size_t)koff); rk1 = *(const uint4*)(KnB + (size_t)koff + 64); \
    rk2 = *(const uint4*)(KnB + (size_t)koff + 128); rk3 = *(const uint4*)(KnB + (size_t)koff + 192); \
    rk4 = *(const uint4*)(KRB + (size_t)kroff); rk5 = *(const uint4*)(KRB + (size_t)kroff + 64); \
    rv0 = *(const uint4*)(VTB + (size_t)voff); rv1 = *(const uint4*)(VTB + (size_t)(voff + vstep)); \
    rv2 = *(const uint4*)(VTB + (size_t)(voff + 2 * vstep)); rv3 = *(const uint4*)(VTB + (size_t)(voff + 3 * vstep)); \
    koff += 64 * 1024 * 2; kroff += 64 * 64 * 2; voff += 128; }
#define ASTORE() { \
    *(uint4*)(KsW) = rk0; *(uint4*)(KsW + 64) = rk1; *(uint4*)(KsW + 128) = rk2; *(uint4*)(KsW + 192) = rk3; \
    *(uint4*)(KsW + 256) = rk4; *(uint4*)(KsW + 320) = rk5; \
    *(uint4*)(VsW) = rv0; *(uint4*)(VsW + 32 * 144) = rv1; *(uint4*)(VsW + 64 * 144) = rv2; *(uint4*)(VsW + 96 * 144) = rv3; }

  AGLOAD();
#pragma unroll 1
  for (int jt = 0; jt < ntiles; ++jt) {
    __syncthreads();
    ASTORE();
    __syncthreads();
    if (jt >= ntw) { if (jt + 1 < ntiles) AGLOAD(); }
    if (jt < ntw) {
      f32x16 sacc[2];
#pragma unroll
      for (int kt = 0; kt < 2; ++kt)
#pragma unroll
        for (int i = 0; i < 16; ++i) sacc[kt][i] = 0.f;
      const u16* kb = Ks + r * 200 + 8 * hh;
#pragma unroll
      for (int ks = 0; ks < 12; ++ks) {
        bf16x8 k0 = *(const bf16x8*)(kb + 16 * ks);
        bf16x8 k1 = *(const bf16x8*)(kb + 32 * 200 + 16 * ks);
        sacc[0] = MFMA(k0, qf[ks], sacc[0]);
        sacc[1] = MFMA(k1, qf[ks], sacc[1]);
        if ((ks & 3) == 3) __builtin_amdgcn_sched_barrier(0);
      }
      if ((jt + 1) * 64 > Lk) {
#pragma unroll
        for (int kt = 0; kt < 2; ++kt)
#pragma unroll
          for (int i = 0; i < 16; ++i) {
            const int key = jt * 64 + 32 * kt + (i & 3) + 8 * (i >> 2) + 4 * hh;
            if (key >= Lk) sacc[kt][i] = -INFINITY;
          }
      }
      float tmax = -INFINITY;
#pragma unroll
      for (int kt = 0; kt < 2; ++kt)
#pragma unroll
        for (int i = 0; i < 16; ++i) tmax = fmaxf(tmax, sacc[kt][i]);
      tmax = fmaxf(tmax, __shfl_xor(tmax, 32));
      const float mnew = fmaxf(mrun, tmax);
      const float alpha = __builtin_amdgcn_exp2f(mrun - mnew);
      mrun = mnew;
      float psum = 0.f;
#pragma unroll
      for (int kt = 0; kt < 2; ++kt)
#pragma unroll
        for (int i = 0; i < 16; ++i) { const float pv = __builtin_amdgcn_exp2f(sacc[kt][i] - mnew); sacc[kt][i] = pv; psum += pv; }
      lrun = lrun * alpha + psum;
#pragma unroll
      for (int dt = 0; dt < 4; ++dt)
#pragma unroll
        for (int i = 0; i < 16; ++i) oacc[dt][i] *= alpha;
      bf16x8 pf[2][2];
#pragma unroll
      for (int kt = 0; kt < 2; ++kt)
#pragma unroll
        for (int s = 0; s < 2; ++s) {
          uint4 pp = make_uint4(pk2(sacc[kt][8 * s + 0], sacc[kt][8 * s + 1]), pk2(sacc[kt][8 * s + 2], sacc[kt][8 * s + 3]),
                                pk2(sacc[kt][8 * s + 4], sacc[kt][8 * s + 5]), pk2(sacc[kt][8 * s + 6], sacc[kt][8 * s + 7]));
          pf[kt][s] = __builtin_bit_cast(bf16x8, pp);
        }
      if (jt + 1 < ntiles) AGLOAD();
      const u16* vb = Vs + r * 72 + 8 * hh;
#pragma unroll
      for (int dt = 0; dt < 4; ++dt)
#pragma unroll
        for (int kt = 0; kt < 2; ++kt)
#pragma unroll
          for (int s = 0; s < 2; ++s) {
            bf16x8 vf = *(const bf16x8*)(vb + 32 * dt * 72 + 32 * kt + 16 * s);
            oacc[dt] = MFMA(vf, pf[kt][s], oacc[dt]);
            if (kt == 1 && s == 1) __builtin_amdgcn_sched_barrier(0);
          }
    }
  }
  if (ntw > 0 && r <= qclamp) {
    const float ltot = lrun + __shfl_xor(lrun, 32);
    const float inv = 1.f / ltot;
    u16* op = Ob + (long)(32 * w + r) * 1024;
#pragma unroll
    for (int dt = 0; dt < 4; ++dt)
#pragma unroll
      for (int i4 = 0; i4 < 4; ++i4) {
        const int d = 32 * dt + 8 * i4 + 4 * hh;
        *(uint2*)(op + d) = make_uint2(pk2(oacc[dt][4 * i4 + 0] * inv, oacc[dt][4 * i4 + 1] * inv), pk2(oacc[dt][4 * i4 + 2] * inv, oacc[dt][4 * i4 + 3] * inv));
      }
  } else if (ntw > 0) {
    (void)__shfl_xor(lrun, 32);
  }
}

DI void attn_phase(const Params& p, int l, char* smem, int* s_item) {
  const int tid = get_tid(), w = tid >> 6;
  const int NITEM = 256 + 1024;
  for (;;) {
    __syncthreads();
    if (tid == 0) *s_item = (int)atomicAdd(p.ctr + l, 1u);
    __syncthreads();
    const int item = *s_item;
    if (item >= NITEM) break;
    if (item < 256) {
      const int b = item >> 3, h = item & 7;
      const u16* Qb = p.Q + ((long)(M_P + 16 * b) * 8 + h) * 192;
      const u16* Kn = p.Kns + ((long)b * LKS * 8 + h) * 128;
      const u16* KR = p.KRs + (long)b * LKS * 64;
      const u16* VT = p.VTs + ((long)b * 8 + h) * 128 * LKS;
      u16* Ob = p.OA + (long)(M_P + 16 * b) * 1024 + h * 128;
      attn_item(Qb, 15, Kn, KR, VT, LKS, 65, w == 0 ? 65 : 0, LKV, Ob, smem);
    } else {
      const int idx = item - 256;
      const int qb = 127 - (idx >> 3), h = idx & 7;
      const u16* Qb = p.Q + ((long)(128 * qb) * 8 + h) * 192;
      const u16* Kn = p.Knp + (long)h * 128;
      const u16* KR = p.KRp;
      const u16* VT = p.VTp + (long)h * 128 * M_P;
      u16* Ob = p.OA + (long)(128 * qb) * 1024 + h * 128;
      const int ntiles = 2 * qb + 2;
      attn_item(Qb, 31, Kn, KR, VT, M_P, ntiles, w < 2 ? ntiles - 1 : ntiles, 1 << 30, Ob, smem);
    }
  }
}

DI void gmlp_phase(const Params& p, int l, char* smem) {
  const int tid = get_tid(), lane = tid & 63, w = tid >> 6, wm = w >> 1, wn = w & 1, r = lane & 31, hh = lane >> 5;
  const float* gvn = p.gvn + l * 1024;
  const float* gws = p.gws + (long)l * 8 * 128 * 128;
  const float* gbs = p.gbs + (long)l * 8 * 128;
  u16* Xs = (u16*)smem;
  u16* Ws = Xs + 128 * 136;
  const int NP = 128 * 8, NS = 32 * 4;
  for (int t = get_bid(); t < NP + NS; t += gridDim.x) {
    if (t < NP) {
      const int ci = t >> 3, g = t & 7;
      const int t0 = ci * 128, c0 = g * 128;
      __syncthreads();
#pragma unroll
      for (int i = 0; i < 8; ++i) {
        const int c = tid + 256 * i; const int s = c >> 4, dc = (c & 15) * 8;
        const uint4 v = *(const uint4*)(p.Z + (long)(t0 + s) * LDZ + ZV + c0 + dc);
        const float rs = p.rsv[t0 + s];
        const float4 g0 = *(const float4*)(gvn + c0 + dc), g1 = *(const float4*)(gvn + c0 + dc + 4);
        Xs[(dc + 0) * 136 + s] = f2bf(bflo(v.x) * rs * g0.x); Xs[(dc + 1) * 136 + s] = f2bf(bfhi(v.x) * rs * g0.y);
        Xs[(dc + 2) * 136 + s] = f2bf(bflo(v.y) * rs * g0.z); Xs[(dc + 3) * 136 + s] = f2bf(bfhi(v.y) * rs * g0.w);
        Xs[(dc + 4) * 136 + s] = f2bf(bflo(v.z) * rs * g1.x); Xs[(dc + 5) * 136 + s] = f2bf(bfhi(v.z) * rs * g1.y);
        Xs[(dc + 6) * 136 + s] = f2bf(bflo(v.w) * rs * g1.z); Xs[(dc + 7) * 136 + s] = f2bf(bfhi(v.w) * rs * g1.w);
        const int tt = c >> 4, sc = (c & 15) * 8;
        const float* wp = gws + ((long)g * 128 + tt) * 128 + sc;
        float4 a = *(const float4*)wp, b = *(const float4*)(wp + 4);
        a.x = (sc + 0 <= tt) ? a.x : 0.f; a.y = (sc + 1 <= tt) ? a.y : 0.f; a.z = (sc + 2 <= tt) ? a.z : 0.f; a.w = (sc + 3 <= tt) ? a.w : 0.f;
        b.x = (sc + 4 <= tt) ? b.x : 0.f; b.y = (sc + 5 <= tt) ? b.y : 0.f; b.z = (sc + 6 <= tt) ? b.z : 0.f; b.w = (sc + 7 <= tt) ? b.w : 0.f;
        *(uint4*)(Ws + tt * 136 + sc) = pack8(a, b);
      }
      __syncthreads();
      f32x16 acc[2][2];
#pragma unroll
      for (int mi = 0; mi < 2; ++mi)
#pragma unroll
        for (int ni = 0; ni < 2; ++ni)
#pragma unroll
          for (int i = 0; i < 16; ++i) acc[mi][ni][i] = 0.f;
      const u16* Ab = Ws + (64 * wm + r) * 136 + 8 * hh;
      const u16* Bb = Xs + (64 * wn + r) * 136 + 8 * hh;
#pragma unroll
      for (int ks = 0; ks < 8; ++ks) {
        bf16x8 a0 = *(const bf16x8*)(Ab + 16 * ks), a1 = *(const bf16x8*)(Ab + 32 * 136 + 16 * ks);
        bf16x8 b0 = *(const bf16x8*)(Bb + 16 * ks), b1 = *(const bf16x8*)(Bb + 32 * 136 + 16 * ks);
        acc[0][0] = MFMA(b0, a0, acc[0][0]); acc[0][1] = MFMA(b1, a0, acc[0][1]);
        acc[1][0] = MFMA(b0, a1, acc[1][0]); acc[1][1] = MFMA(b1, a1, acc[1][1]);
      }
#pragma unroll
      for (int mi = 0; mi < 2; ++mi) {
        const int tl = 64 * wm + 32 * mi + r;
        const long row = t0 + tl;
        const float bias = gbs[g * 128 + tl];
        const u16* zr = p.Z + row * LDZ;
#pragma unroll
        for (int ni = 0; ni < 2; ++ni)
#pragma unroll
          for (int i4 = 0; i4 < 4; ++i4) {
            const int col = c0 + 64 * wn + 32 * ni + 8 * i4 + 4 * hh;
            const uint2 uu = *(const uint2*)(zr + ZU + col), ga = *(const uint2*)(zr + ZGA + col), gb = *(const uint2*)(zr + ZGB + col);
            const uint2 oa = *(const uint2*)(p.OA + row * 1024 + col);
            const float o0 = sigm(bflo(ga.x)) * bflo(oa.x) + sigm(bflo(gb.x)) * bflo(uu.x) * (acc[mi][ni][4 * i4 + 0] + bias);
            const float o1 = sigm(bfhi(ga.x)) * bfhi(oa.x) + sigm(bfhi(gb.x)) * bfhi(uu.x) * (acc[mi][ni][4 * i4 + 1] + bias);
            const float o2 = sigm(bflo(ga.y)) * bflo(oa.y) + sigm(bflo(gb.y)) * bflo(uu.y) * (acc[mi][ni][4 * i4 + 2] + bias);
            const float o3 = sigm(bfhi(ga.y)) * bfhi(oa.y) + sigm(bfhi(gb.y)) * bfhi(uu.y) * (acc[mi][ni][4 * i4 + 3] + bias);
            *(uint2*)(p.MIX + row * 1024 + col) = make_uint2(pk2(o0, o1), pk2(o2, o3));
          }
      }
    } else {
      const int u = t - NP; const int b = u >> 2, col = (u & 3) * 256 + tid; const int g = col >> 7;
      const long row0 = M_P + 16 * b;
      const float gv = gvn[col];
      float vn[16];
#pragma unroll
      for (int s = 0; s < 16; ++s) vn[s] = bf1(p.Z[(row0 + s) * LDZ + ZV + col]) * p.rsv[row0 + s] * gv;
#pragma unroll
      for (int tt = 0; tt < 16; ++tt) {
        float mx = gbs[g * 128 + tt];
#pragma unroll
        for (int s = 0; s <= tt; ++s) mx += gws[((long)g * 128 + tt) * 128 + s] * vn[s];
        const u16* zr = p.Z + (row0 + tt) * LDZ;
        const float uu = bf1(zr[ZU + col]), ga = bf1(zr[ZGA + col]), gb = bf1(zr[ZGB + col]);
        const float oa = bf1(p.OA[(row0 + tt) * 1024 + col]);
        p.MIX[(row0 + tt) * 1024 + col] = f2bf(sigm(ga) * oa + sigm(gb) * uu * mx);
      }
    }
  }
}

#define XB_TMO      128
#define XB_XCNT(j)  (256  + 64 * (j))
#define XB_XSUB(j)  (1280 + 64 * (j))
#define XB_XGEN(j)  (2304 + 64 * (j))
#define XB_TOP      3328
#define XB_TOPGEN   3392
#define XCD_BAR_WORDS 3456
#define XB_SPIN_CAP (1u << 22)
#define LAS __attribute__((address_space(3)))
DI unsigned xb_ld(unsigned* p) { return __hip_atomic_load(p, __ATOMIC_RELAXED, __HIP_MEMORY_SCOPE_AGENT); }
DI unsigned xb_add(unsigned* p, unsigned v) { return __hip_atomic_fetch_add(p, v, __ATOMIC_RELAXED, __HIP_MEMORY_SCOPE_AGENT); }
DI unsigned xb_xcc_id() { return (unsigned)__builtin_amdgcn_s_getreg((3 << 11) | 20) & 0xFu; }
#define XB_SPIN(cond, bar) do { unsigned _sp = 0; while (cond) { __builtin_amdgcn_s_sleep(1); \
    if ((++_sp & 255u) == 0u) { if (xb_ld(&(bar)[XB_TMO])) break; if (_sp > XB_SPIN_CAP) { atomicAdd(&(bar)[XB_TMO], 1u); break; } } } } while (0)
struct XcdBarrier { unsigned* bar; unsigned x; volatile LAS unsigned* st; };
DI XcdBarrier xcd_barrier_post(unsigned* bar, volatile LAS unsigned* st) {
  XcdBarrier b; b.bar = bar; b.x = xb_xcc_id(); b.st = st;
  if (threadIdx.x == 0) (void)xb_add(&bar[XB_XCNT(b.x)], 1u);
  return b;
}
DI void xcd_barrier_complete(unsigned* bar, unsigned x, unsigned& nloc, unsigned& nx) {
  const unsigned G = gridDim.x * gridDim.y * gridDim.z;
  unsigned sum, cnt, mine, sp = 0u;
  for (;;) {
    sum = 0u; cnt = 0u; mine = 0u;
#pragma unroll
    for (unsigned j = 0; j < 16; ++j) { const unsigned c = xb_ld(&bar[XB_XCNT(j)]); sum += c; cnt += (c > 0u) ? 1u : 0u; mine = (j == x) ? c : mine; }
    if (sum == G) break;
    __builtin_amdgcn_s_sleep(1);
    if ((++sp & 255u) == 0u) { if (xb_ld(&bar[XB_TMO])) break; if (sp > XB_SPIN_CAP) { atomicAdd(&bar[XB_TMO], 1u); break; } }
  }
  nloc = mine > 0u ? mine : 1u; nx = cnt > 0u ? cnt : 1u;
}
DI void xcd_barrier(const XcdBarrier& b) {
  asm volatile("s_waitcnt vmcnt(0)" ::: "memory");
  __syncthreads();
  if (threadIdx.x == 0) {
    unsigned* bar = b.bar;
    __builtin_amdgcn_s_waitcnt(0);
    unsigned nloc = b.st[0], nx = b.st[1];
    if (nloc == 0u) { xcd_barrier_complete(bar, b.x, nloc, nx); b.st[0] = nloc; b.st[1] = nx; }
    const unsigned old = xb_add(&bar[XB_XSUB(b.x)], 1u);
    const unsigned gen = old / nloc;
    if (old + 1u == (gen + 1u) * nloc) {
      __builtin_amdgcn_fence(__ATOMIC_RELEASE, "agent");
      asm volatile("s_waitcnt vmcnt(0)" ::: "memory");
      const unsigned og = xb_add(&bar[XB_TOP], 1u);
      const unsigned tg = og / nx;
      if (og + 1u == (tg + 1u) * nx) xb_add(&bar[XB_TOPGEN], 1u);
      else XB_SPIN(xb_ld(&bar[XB_TOPGEN]) == tg, bar);
      __builtin_amdgcn_fence(__ATOMIC_ACQUIRE, "agent");
      xb_add(&bar[XB_XGEN(b.x)], 1u);
      asm volatile("s_waitcnt vmcnt(0)" ::: "memory");
    } else {
      XB_SPIN(xb_ld(&bar[XB_XGEN(b.x)]) == gen, bar);
      __builtin_amdgcn_fence(__ATOMIC_ACQUIRE, "agent");
      asm volatile("s_waitcnt vmcnt(0)" ::: "memory");
    }
  }
  __syncthreads();
}

__global__ void __launch_bounds__(256, 2) mega_fwd(Params p) {
  __shared__ __attribute__((aligned(16))) char smem[SMEM_BYTES];
  __shared__ int s_item;
  __shared__ uint4 xb_words;
  cg::grid_group grid = cg::this_grid();
  if (threadIdx.x == 0) xb_words = make_uint4(0u, 0u, 0u, 0u);
  __syncthreads();
  XcdBarrier xb = xcd_barrier_post(p.bar, (volatile LAS unsigned*)&xb_words);

  prep_phase(p, smem);
  grid.sync();
#pragma unroll 1
  for (int l = 0; l < 2; ++l) {
    norm_phase(p.out, p.f1n + l * 1024, p.NB);
    xcd_barrier(xb);
    ffn_up_phase(p, p.Wgu1 + (long)l * 2 * DFF * 1024, smem);
    xcd_barrier(xb);
    resid_gemm_phase(p, p.ACT, DFF, p.Wd1 + (long)l * 1024 * DFF, 0.5f, smem);
    xcd_barrier(xb);
    norm_phase(p.out, p.mixn + l * 1024, p.NB);
    xcd_barrier(xb);
    win_phase(p, p.Win + (long)l * LDZ * 1024, smem);
    xcd_barrier(xb);
    rowpost_phase(p, l);
    xcd_barrier(xb);
    multi_phase(p, l, smem);
    xcd_barrier(xb);
    attn_phase(p, l, smem, &s_item);
    xcd_barrier(xb);
    gmlp_phase(p, l, smem);
    xcd_barrier(xb);
    resid_gemm_phase(p, p.MIX, 1024, p.Wo + (long)l * 1024 * 1024, 1.0f, smem);
    xcd_barrier(xb);
    norm_phase(p.out, p.f2n + l * 1024, p.NB);
    xcd_barrier(xb);
    ffn_up_phase(p, p.Wgu2 + (long)l * 2 * DFF * 1024, smem);
    xcd_barrier(xb);
    resid_gemm_phase(p, p.ACT, DFF, p.Wd2 + (long)l * 1024 * DFF, 0.5f, smem);
    xcd_barrier(xb);
    norm_phase(p.out, p.plen + l * 1024, p.NB);
    xcd_barrier(xb);
    ple_phase(p, p.Wpg + (long)l * 1024 * 1024, smem);
    xcd_barrier(xb);
  }
}

extern "C" void kernel_launch(void* const* d_in, const int* in_sizes, int n_in, void* d_out, int out_size, void* d_ws,
                              size_t ws_size, hipStream_t stream) {
  (void)in_sizes; (void)n_in; (void)out_size; (void)ws_size;
  Params p{};
  auto F = [&](int i) { return (const float*)d_in[i]; };
  p.x_prompt = F(0); p.x_sample = F(1); p.cache_c = F(2); p.cache_kr = F(3); p.p_prompt = F(4); p.p_sample = F(5);
  p.f1n = F(6); p.mixn = F(10); p.qan = F(12); p.qnn = F(14); p.qrn = F(15); p.kvan = F(16); p.krn = F(17);
  p.knn = F(20); p.gvn = F(21); p.gws = F(22); p.gbs = F(23); p.f2n = F(25); p.plen = F(29);
  p.out = (float*)d_out;
  char* ws = (char*)d_ws; size_t off = 0;
  auto alloc = [&](size_t bytes) { char* r = ws + off; off += (bytes + 255) & ~(size_t)255; return r; };
  p.Wgu1 = (u16*)alloc(2UL * 2 * DFF * 1024 * 2);
  p.Wd1 = (u16*)alloc(2UL * 1024 * DFF * 2);
  p.Win = (u16*)alloc(2UL * LDZ * 1024 * 2);
  p.Wuq = (u16*)alloc(2UL * 1536 * 384 * 2);
  p.Wkv = (u16*)alloc(2UL * 2048 * 512 * 2);
  p.Wo = (u16*)alloc(2UL * 1024 * 1024 * 2);
  p.Wgu2 = (u16*)alloc(2UL * 2 * DFF * 1024 * 2);
  p.Wd2 = (u16*)alloc(2UL * 1024 * DFF * 2);
  p.Wpg = (u16*)alloc(2UL * 1024 * 1024 * 2);
  p.Wpe = (u16*)alloc(2UL * 1024 * 256 * 2);
  p.NB = (u16*)alloc((size_t)M_ALL * 1024 * 2);
  p.ACT = (u16*)alloc((size_t)M_ALL * DFF * 2);
  p.Z = (u16*)alloc((size_t)M_ALL * LDZ * 2);
  p.QN = (u16*)alloc((size_t)M_ALL * 384 * 2);
  p.C = (u16*)alloc((size_t)M_ALL * 512 * 2);
  p.KRp = (u16*)alloc((size_t)M_P * 64 * 2);
  p.KRs = (u16*)alloc((size_t)32 * LKS * 64 * 2);
  p.Q = (u16*)alloc((size_t)M_ALL * 8 * 192 * 2);
  p.Knp = (u16*)alloc((size_t)M_P * 1024 * 2);
  p.VTp = (u16*)alloc((size_t)M_P * 1024 * 2);
  p.Kns = (u16*)alloc((size_t)32 * LKS * 1024 * 2);
  p.VTs = (u16*)alloc((size_t)32 * LKS * 1024 * 2);
  p.OA = (u16*)alloc((size_t)M_ALL * 1024 * 2);
  p.MIX = (u16*)alloc((size_t)M_ALL * 1024 * 2);
  p.PP = (u16*)alloc((size_t)M_ALL * 1024 * 2);
  p.rsv = (float*)alloc((size_t)M_ALL * 4);
  p.rope = (float*)alloc((size_t)16384 * 32 * 2 * 4);
  p.ctr = (unsigned*)alloc(256);
  p.bar = (unsigned*)alloc(XCD_BAR_WORDS * 4);

  int nj = 0, ts = 0;
  auto job = [&](const float* src, u16* dst, int K, int N, int kind) {
    p.jobs[nj].src = src; p.jobs[nj].dst = dst; p.jobs[nj].K = K; p.jobs[nj].N = N; p.jobs[nj].kind = kind; p.jobs[nj].tstart = ts;
    ts += (K / 64) * (N / 64); ++nj;
  };
  for (int l = 0; l < 2; ++l) {
    job(F(7) + (size_t)l * 1024 * DFF, p.Wgu1 + (size_t)l * 2 * DFF * 1024, 1024, DFF, 1);
    job(F(8) + (size_t)l * 1024 * DFF, p.Wgu1 + (size_t)l * 2 * DFF * 1024, 1024, DFF, 2);
    job(F(9) + (size_t)l * DFF * 1024, p.Wd1 + (size_t)l * 1024 * DFF, DFF, 1024, 0);
    job(F(11) + (size_t)l * 1024 * DIN, p.Win + (size_t)l * LDZ * 1024, 1024, DIN, 0);
    job(F(13) + (size_t)l * 384 * 1536, p.Wuq + (size_t)l * 1536 * 384, 384, 1536, 3);
    job(F(18) + (size_t)l * 512 * 1024, p.Wkv + (size_t)l * 2048 * 512, 512, 1024, 0);
    job(F(19) + (size_t)l * 512 * 1024, p.Wkv + (size_t)l * 2048 * 512, 512, 1024, 4);
    job(F(24) + (size_t)l * 1024 * 1024, p.Wo + (size_t)l * 1024 * 1024, 1024, 1024, 0);
    job(F(26) + (size_t)l * 1024 * DFF, p.Wgu2 + (size_t)l * 2 * DFF * 1024, 1024, DFF, 1);
    job(F(27) + (size_t)l * 1024 * DFF, p.Wgu2 + (size_t)l * 2 * DFF * 1024, 1024, DFF, 2);
    job(F(28) + (size_t)l * DFF * 1024, p.Wd2 + (size_t)l * 1024 * DFF, DFF, 1024, 0);
    job(F(30) + (size_t)l * 1024 * 1024, p.Wpg + (size_t)l * 1024 * 1024, 1024, 1024, 0);
    job(F(31) + (size_t)l * 256 * 1024, p.Wpe + (size_t)l * 1024 * 256, 256, 1024, 0);
  }
  p.ntile_prep = ts;

  static int grid_blocks = 0;
  if (!grid_blocks) {
    int dev = 0, cus = 0, per_cu = 0;
    hipGetDevice(&dev);
    hipDeviceGetAttribute(&cus, hipDeviceAttributeMultiprocessorCount, dev);
    hipOccupancyMaxActiveBlocksPerMultiprocessor(&per_cu, (const void*)mega_fwd, 256, 0);
    if (per_cu > 2) per_cu = 2;
    if (per_cu < 1) per_cu = 1;
    grid_blocks = cus * per_cu;
  }
  (void)hipMemsetAsync(p.bar, 0, XCD_BAR_WORDS * 4, stream);
  void* args[] = {&p};
  hipError_t e = hipLaunchCooperativeKernel((const void*)mega_fwd, dim3(grid_blocks), dim3(256), args, 0, stream);
  if (e != hipSuccess) fprintf(stderr, "cooperative launch failed: %s (grid %d)\n", hipGetErrorString(e), grid_blocks);
}
```

```cpp
#include <hip/hip_runtime.h>
#include <hip/hip_cooperative_groups.h>
#include <cstdio>
namespace cg = cooperative_groups;

#define DI __device__ __forceinline__
typedef unsigned short u16;
typedef __attribute__((ext_vector_type(8))) short bf16x8;
typedef __attribute__((ext_vector_type(16))) float f32x16;
typedef __attribute__((ext_vector_type(2))) __bf16 bf2_t;
typedef __attribute__((ext_vector_type(2))) float f2_t;

#define M_P 16384
#define M_S 512
#define M_ALL 16896
#define DM 1024
#define DFF 2816
#define DIN 5056
#define LDZ 5120
#define ZQ 0
#define ZKV 384
#define ZKR 896
#define ZU 960
#define ZV 1984
#define ZGA 3008
#define ZGB 4032
#define LKS 4160
#define LKV 4112
#define PAST 4096
#define EPSF 1e-6f
#define QSCALE (0.07216878364870322f * 1.4426950408889634f)

#define NJOBS 26
struct TJob { const float* src; u16* dst; int K, N, kind, tstart; };

struct Params {
  const float *x_prompt, *x_sample, *cache_c, *cache_kr, *p_prompt, *p_sample;
  const float *f1n, *mixn, *qan, *qnn, *qrn, *kvan, *krn, *knn, *gvn, *gws, *gbs, *f2n, *plen;
  float* out;
  u16 *Wgu1, *Wd1, *Win, *Wuq, *Wkv, *Wo, *Wgu2, *Wd2, *Wpg, *Wpe;
  u16 *CB, *PB;
  u16 *NB, *ACT, *Z, *QN, *C, *KRp, *KRs, *Q, *Knp, *VTp, *Kns, *VTs, *OA, *MIX, *PP;
  float *rsv, *rope;
  unsigned* ctr;
  unsigned* bar;
  TJob jobs[NJOBS];
  int ntile_prep; int pad0;
};

DI int get_tid() { int t = threadIdx.x; asm volatile("" : "+v"(t)); return t; }
DI int get_bid() { int t = blockIdx.x; asm volatile("" : "+s"(t)); return t; }
DI unsigned pk2(float a, float b) { f2_t v = {a, b}; bf2_t r = __builtin_convertvector(v, bf2_t); return __builtin_bit_cast(unsigned, r); }
DI float bflo(unsigned v) { return __uint_as_float(v << 16); }
DI float bfhi(unsigned v) { return __uint_as_float(v & 0xffff0000u); }
DI float bf1(u16 v) { return __uint_as_float(((unsigned)v) << 16); }
DI u16 f2bf(float a) { return (u16)(pk2(a, 0.f) & 0xffffu); }
DI float wave_sum(float v) {
#pragma unroll
  for (int o = 32; o > 0; o >>= 1) v += __shfl_xor(v, o);
  return v;
}
DI float sigm(float x) { return 1.f / (1.f + __expf(-x)); }
DI uint4 pack8(float4 x, float4 y) { return make_uint4(pk2(x.x, x.y), pk2(x.z, x.w), pk2(y.x, y.y), pk2(y.z, y.w)); }
#define MFMA(a, b, c) __builtin_amdgcn_mfma_f32_32x32x16_bf16((a), (b), (c), 0, 0, 0)

#define SMEM_BYTES (73728 + 1024)

DI int job_dst_row(int kind, int n) {
  if (kind == 0) return n;
  if (kind == 1) return 64 * (n >> 5) + (n & 31);
  if (kind == 2) return 64 * (n >> 5) + 32 + (n & 31);
  if (kind == 3) { int h = n / 192, c = n - h * 192; return c < 128 ? h * 128 + c : 1024 + h * 64 + (c - 128); }
  return 1024 + n;
}

DI void prep_phase(const Params& p, char* smem) {
  const int tid = get_tid();
  u16* Ts = (u16*)smem;
  for (int t = get_bid(); t < p.ntile_prep; t += gridDim.x) {
    int j = 0;
#pragma unroll 1
    for (int q = 1; q < NJOBS; ++q) if (t >= p.jobs[q].tstart) j = q;
    const float* src = p.jobs[j].src; u16* dst = p.jobs[j].dst;
    const int K = p.jobs[j].K, N = p.jobs[j].N, kind = p.jobs[j].kind;
    const int lt = t - p.jobs[j].tstart;
    const int ntn = N >> 6;
    const int tk = lt / ntn, tn = lt - tk * ntn;
    const int k0 = tk * 64, n0 = tn * 64;
    __syncthreads();
#pragma unroll
    for (int i = 0; i < 4; ++i) {
      const int k = (tid >> 4) + 16 * i, nc = (tid & 15) * 4;
      float4 v = *(const float4*)(src + (long)(k0 + k) * N + n0 + nc);
      Ts[(nc + 0) * 66 + k] = f2bf(v.x); Ts[(nc + 1) * 66 + k] = f2bf(v.y);
      Ts[(nc + 2) * 66 + k] = f2bf(v.z); Ts[(nc + 3) * 66 + k] = f2bf(v.w);
    }
    __syncthreads();
    {
      const int n = tid >> 2, kc = (tid & 3) * 16;
      const unsigned* s32 = (const unsigned*)(Ts + n * 66 + kc);
      uint4 a = make_uint4(s32[0], s32[1], s32[2], s32[3]);
      uint4 b = make_uint4(s32[4], s32[5], s32[6], s32[7]);
      u16* d = dst + (long)job_dst_row(kind, n0 + n) * K + k0 + kc;
      *(uint4*)d = a; *(uint4*)(d + 8) = b;
    }
  }
  const long gtid = (long)get_bid() * 256 + tid, gstride = (long)gridDim.x * 256;
  for (long e = gtid; e < 2L * 64 * 1024 / 8; e += gstride) {
    const int l = (int)(e / (64 * 1024 / 8)); const long r = e - (long)l * (64 * 1024 / 8);
    *(uint4*)(p.Win + (long)l * LDZ * 1024 + (long)DIN * 1024 + r * 8) = make_uint4(0, 0, 0, 0);
  }
  for (long e = gtid; e < 16384L * 32; e += gstride) {
    const int pos = (int)(e >> 5), i = (int)(e & 31);
    const float inv = powf(10000.0f, -(float)i / 32.0f);
    const float angf = (float)pos * inv;
    const double x = (double)angf;
    const double kq = rint(x * 0.63661977236758134308);
    const double y = (x - kq * 1.5707963267341256e+00) - kq * 6.0771005065061922e-11;
    const double y2 = y * y;
    const double s = y * (1.0 + y2 * (-1.0 / 6 + y2 * (1.0 / 120 + y2 * (-1.0 / 5040 + y2 * (1.0 / 362880 + y2 * (-1.0 / 39916800))))));
    const double c = 1.0 + y2 * (-0.5 + y2 * (1.0 / 24 + y2 * (-1.0 / 720 + y2 * (1.0 / 40320 + y2 * (-1.0 / 3628800 + y2 * (1.0 / 479001600))))));
    const int q = ((int)kq) & 3;
    double cc, ss;
    if (q == 0) { cc = c; ss = s; } else if (q == 1) { cc = -s; ss = c; } else if (q == 2) { cc = -c; ss = -s; } else { cc = s; ss = -c; }
    *(float2*)(p.rope + e * 2) = make_float2((float)cc, (float)ss);
  }
  for (long e = gtid; e < (long)M_ALL * 1024 / 4; e += gstride) {
    const long pe = (long)M_P * 1024 / 4;
    float4 v = e < pe ? ((const float4*)p.x_prompt)[e] : ((const float4*)p.x_sample)[e - pe];
    ((float4*)p.out)[e] = v;
  }
  if (get_bid() == 0 && tid < 16) p.ctr[tid] = 0u;
}

DI void norm_phase(const float* __restrict__ h, const float* __restrict__ g, u16* __restrict__ out) {
  const int tid = get_tid(); const int lane = tid & 63, w = tid >> 6;
  for (int row = get_bid() * 4 + w; row < M_ALL; row += gridDim.x * 4) {
    const float4* hr = (const float4*)(h + (long)row * 1024);
    float4 v[4]; float ss = 0.f;
#pragma unroll
    for (int i = 0; i < 4; ++i) { v[i] = hr[lane + 64 * i]; ss += v[i].x * v[i].x + v[i].y * v[i].y + v[i].z * v[i].z + v[i].w * v[i].w; }
    ss = wave_sum(ss);
    const float rs = rsqrtf(ss * (1.f / 1024.f) + EPSF);
#pragma unroll
    for (int i = 0; i < 4; ++i) {
      const float4 gg = ((const float4*)g)[lane + 64 * i];
      uint2 o = make_uint2(pk2(v[i].x * rs * gg.x, v[i].y * rs * gg.y), pk2(v[i].z * rs * gg.z, v[i].w * rs * gg.w));
      ((uint2*)(out + (long)row * 1024))[lane + 64 * i] = o;
    }
  }
}

struct TD { const char* A; const char* B; unsigned sa, sb; int nk; };
#define RED_OFF 73728

template <class Desc, class Epi>
DI void gemm_stream(int total, Desc desc, Epi epi, char* smem) {
  const int tid = get_tid(), lane = tid & 63, w = tid >> 6, wm = w >> 1, wn = w & 1, r = lane & 31, hh = lane >> 5;
  const int G = gridDim.x;
  u16* As = (u16*)smem;
  u16* Bs = As + 2 * 128 * 72;
  const int lrow = tid >> 3, lkc = (tid & 7) * 8;
  int ct = get_bid();
  if (ct >= total) return;
  int lt = ct, lk = 0; bool lvalid = true;
  TD ltd = desc(lt);
  uint4 S0a0, S0a1, S0a2, S0a3, S0b0, S0b1, S0b2, S0b3, S1a0, S1a1, S1a2, S1a3, S1b0, S1b1, S1b2, S1b3;
  bool v0 = false, v1 = false;
#define LD1(dst, base, off) dst = *(const uint4*)((base) + (size_t)(off));
#define GLOADS(S, V) { V = lvalid; if (lvalid) { \
    const unsigned oa_ = lrow * ltd.sa + (unsigned)(lk * 64 + lkc) * 2u, ob_ = lrow * ltd.sb + (unsigned)(lk * 64 + lkc) * 2u; \
    LD1(S##a0, ltd.A, oa_) LD1(S##a1, ltd.A, oa_ + 32u * ltd.sa) LD1(S##a2, ltd.A, oa_ + 64u * ltd.sa) LD1(S##a3, ltd.A, oa_ + 96u * ltd.sa) \
    LD1(S##b0, ltd.B, ob_) LD1(S##b1, ltd.B, ob_ + 32u * ltd.sb) LD1(S##b2, ltd.B, ob_ + 64u * ltd.sb) LD1(S##b3, ltd.B, ob_ + 96u * ltd.sb) \
    if (++lk == ltd.nk) { lk = 0; lt += G; lvalid = lt < total; if (lvalid) ltd = desc(lt); } } }
#define SST1(arr, src, i, buf) *(uint4*)(arr + ((buf) * 128 + lrow + 32 * (i)) * 72 + lkc) = src;
#define SSTORES(S, V, buf) if (V) { SST1(As, S##a0, 0, buf) SST1(As, S##a1, 1, buf) SST1(As, S##a2, 2, buf) SST1(As, S##a3, 3, buf) \
    SST1(Bs, S##b0, 0, buf) SST1(Bs, S##b1, 1, buf) SST1(Bs, S##b2, 2, buf) SST1(Bs, S##b3, 3, buf) }
#define COMPUTE(buf) { \
    const u16* Ab = As + ((buf) * 128 + 64 * wm + r) * 72 + 8 * hh; \
    const u16* Bb = Bs + ((buf) * 128 + 64 * wn + r) * 72 + 8 * hh; \
    _Pragma("unroll") for (int ks = 0; ks < 4; ++ks) { \
      bf16x8 a0 = *(const bf16x8*)(Ab + 16 * ks), a1 = *(const bf16x8*)(Ab + 32 * 72 + 16 * ks); \
      bf16x8 b0 = *(const bf16x8*)(Bb + 16 * ks), b1 = *(const bf16x8*)(Bb + 32 * 72 + 16 * ks); \
      acc[0][0] = MFMA(b0, a0, acc[0][0]); acc[0][1] = MFMA(b1, a0, acc[0][1]); \
      acc[1][0] = MFMA(b0, a1, acc[1][0]); acc[1][1] = MFMA(b1, a1, acc[1][1]); } }

  GLOADS(S0, v0)
  GLOADS(S1, v1)
  SSTORES(S0, v0, 0)
  __syncthreads();
#pragma unroll 1
  for (; ct < total; ct += G) {
    const int nk2 = desc(ct).nk >> 1;
    f32x16 acc[2][2];
#pragma unroll
    for (int mi = 0; mi < 2; ++mi)
#pragma unroll
      for (int ni = 0; ni < 2; ++ni)
#pragma unroll
        for (int i = 0; i < 16; ++i) acc[mi][ni][i] = 0.f;
#pragma unroll 1
    for (int k2 = 0; k2 < nk2; ++k2) {
      GLOADS(S0, v0)
      COMPUTE(0)
      SSTORES(S1, v1, 1)
      __syncthreads();
      GLOADS(S1, v1)
      COMPUTE(1)
      SSTORES(S0, v0, 0)
      __syncthreads();
    }
    epi(ct, acc);
  }
#undef LD1
#undef GLOADS
#undef SST1
#undef SSTORES
#undef COMPUTE
}

DI int tok_pos(int m) { return m < M_P ? m : PAST + ((m - M_P) & 15); }
DI int perm_pos(int key) {
  const int g4 = (key >> 2) & 3;
  const int pg = (g4 == 1) ? 2 : ((g4 == 2) ? 1 : g4);
  return (key & ~15) + 4 * pg;
}

template <class RowPtr>
DI void nope_epilogue(f32x16 (&acc)[2][2], const float* __restrict__ gain, float scale, char* smem, RowPtr rowptr) {
  const int tid = threadIdx.x, lane = tid & 63, w = tid >> 6, wm = w >> 1, wn = w & 1, r = lane & 31, hh = lane >> 5;
  float* red = (float*)(smem + RED_OFF);
  float ss[2];
#pragma unroll
  for (int mi = 0; mi < 2; ++mi) {
    float s = 0.f;
#pragma unroll
    for (int ni = 0; ni < 2; ++ni)
#pragma unroll
      for (int i = 0; i < 16; ++i) s += acc[mi][ni][i] * acc[mi][ni][i];
    s += __shfl_xor(s, 32);
    ss[mi] = s;
    if (hh == 0) red[wn * 128 + 64 * wm + 32 * mi + r] = s;
  }
  __syncthreads();
#pragma unroll
  for (int mi = 0; mi < 2; ++mi) {
    const int m = 64 * wm + 32 * mi + r;
    const float tot = ss[mi] + red[(wn ^ 1) * 128 + m];
    const float rs = rsqrtf(tot * (1.f / 128.f) + EPSF) * scale;
    u16* op = rowptr(m);
#pragma unroll
    for (int ni = 0; ni < 2; ++ni)
#pragma unroll
      for (int i4 = 0; i4 < 4; ++i4) {
        const int c = 64 * wn + 32 * ni + 8 * i4 + 4 * hh;
        const float4 g = *(const float4*)(gain + c);
        uint2 o = make_uint2(pk2(acc[mi][ni][4 * i4 + 0] * rs * g.x, acc[mi][ni][4 * i4 + 1] * rs * g.y),
                             pk2(acc[mi][ni][4 * i4 + 2] * rs * g.z, acc[mi][ni][4 * i4 + 3] * rs * g.w));
        *(uint2*)(op + c) = o;
      }
  }
}

#define LANE_COORDS const int tid = get_tid(), lane = tid & 63, w = tid >> 6, wm = w >> 1, wn = w & 1, r = lane & 31, hh = lane >> 5; (void)wm; (void)wn; (void)r; (void)hh;

DI void ffn_up_phase(const Params& p, const u16* W, char* smem) {
  LANE_COORDS
  const int NT = (2 * DFF) / 128;
  gemm_stream(132 * NT,
    [&](int t) { const int tm = t / NT, tn = t - tm * NT; TD d; d.A = (const char*)(p.NB + (long)tm * 128 * 1024); d.B = (const char*)(W + (long)tn * 128 * 1024); d.sa = 2048; d.sb = 2048; d.nk = 16; return d; },
    [&](int t, f32x16 (&acc)[2][2]) {
      const int tm = t / NT, tn = t - tm * NT;
#pragma unroll
      for (int mi = 0; mi < 2; ++mi) {
        const long m = (long)tm * 128 + 64 * wm + 32 * mi + r;
#pragma unroll
        for (int i4 = 0; i4 < 4; ++i4) {
          const int c = 64 * tn + 32 * wn + 8 * i4 + 4 * hh;
          float a[4];
#pragma unroll
          for (int j = 0; j < 4; ++j) { const float g = acc[mi][0][4 * i4 + j], u = acc[mi][1][4 * i4 + j]; a[j] = g * sigm(g) * u; }
          *(uint2*)(p.ACT + m * DFF + c) = make_uint2(pk2(a[0], a[1]), pk2(a[2], a[3]));
        }
      }
    }, smem);
}

DI void resid_gemm_phase(const Params& p, const u16* A, int K, const u16* W, float alpha, char* smem) {
  LANE_COORDS
  gemm_stream(132 * 8,
    [&](int t) { const int tm = t >> 3, tn = t & 7; TD d; d.A = (const char*)(A + (long)tm * 128 * K); d.B = (const char*)(W + (long)tn * 128 * K); d.sa = 2 * K; d.sb = 2 * K; d.nk = K >> 6; return d; },
    [&](int t, f32x16 (&acc)[2][2]) {
      const int tm = t >> 3, tn = t & 7;
#pragma unroll
      for (int mi = 0; mi < 2; ++mi) {
        const long m = (long)tm * 128 + 64 * wm + 32 * mi + r;
#pragma unroll
        for (int ni = 0; ni < 2; ++ni)
#pragma unroll
          for (int i4 = 0; i4 < 4; ++i4) {
            const int n = tn * 128 + 64 * wn + 32 * ni + 8 * i4 + 4 * hh;
            float4* hp = (float4*)(p.out + m * 1024 + n);
            float4 v = *hp;
            v.x += alpha * acc[mi][ni][4 * i4 + 0]; v.y += alpha * acc[mi][ni][4 * i4 + 1];
            v.z += alpha * acc[mi][ni][4 * i4 + 2]; v.w += alpha * acc[mi][ni][4 * i4 + 3];
            *hp = v;
          }
      }
    }, smem);
}

DI void ple_phase(const Params& p, const u16* W, char* smem) {
  LANE_COORDS
  gemm_stream(132 * 8,
    [&](int t) { const int tm = t >> 3, tn = t & 7; TD d; d.A = (const char*)(p.NB + (long)tm * 128 * 1024); d.B = (const char*)(W + (long)tn * 128 * 1024); d.sa = 2048; d.sb = 2048; d.nk = 16; return d; },
    [&](int t, f32x16 (&acc)[2][2]) {
      const int tm = t >> 3, tn = t & 7;
#pragma unroll
      for (int mi = 0; mi < 2; ++mi) {
        const long m = (long)tm * 128 + 64 * wm + 32 * mi + r;
#pragma unroll
        for (int ni = 0; ni < 2; ++ni)
#pragma unroll
          for (int i4 = 0; i4 < 4; ++i4) {
            const int n = tn * 128 + 64 * wn + 32 * ni + 8 * i4 + 4 * hh;
            float4* hp = (float4*)(p.out + m * 1024 + n);
            const uint2 pp = *(const uint2*)(p.PP + m * 1024 + n);
            float4 v = *hp;
            v.x += sigm(acc[mi][ni][4 * i4 + 0]) * bflo(pp.x); v.y += sigm(acc[mi][ni][4 * i4 + 1]) * bfhi(pp.x);
            v.z += sigm(acc[mi][ni][4 * i4 + 2]) * bflo(pp.y); v.w += sigm(acc[mi][ni][4 * i4 + 3]) * bfhi(pp.y);
            *hp = v;
          }
      }
    }, smem);
}

DI void win_phase(const Params& p, const u16* W, char* smem) {
  LANE_COORDS
  const int NT = LDZ / 128;
  gemm_stream(132 * NT,
    [&](int t) { const int tm = t / NT, tn = t - tm * NT; TD d; d.A = (const char*)(p.NB + (long)tm * 128 * 1024); d.B = (const char*)(W + (long)tn * 128 * 1024); d.sa = 2048; d.sb = 2048; d.nk = 16; return d; },
    [&](int t, f32x16 (&acc)[2][2]) {
      const int tm = t / NT, tn = t - tm * NT;
#pragma unroll
      for (int mi = 0; mi < 2; ++mi) {
        const long m = (long)tm * 128 + 64 * wm + 32 * mi + r;
#pragma unroll
        for (int ni = 0; ni < 2; ++ni)
#pragma unroll
          for (int i4 = 0; i4 < 4; ++i4) {
            const int n = tn * 128 + 64 * wn + 32 * ni + 8 * i4 + 4 * hh;
            *(uint2*)(p.Z + m * LDZ + n) = make_uint2(pk2(acc[mi][ni][4 * i4 + 0], acc[mi][ni][4 * i4 + 1]), pk2(acc[mi][ni][4 * i4 + 2], acc[mi][ni][4 * i4 + 3]));
          }
      }
    }, smem);
}

DI void rowpost_phase(const Params& p, int l) {
  const int tid = get_tid(); const int lane = tid & 63, w = tid >> 6;
  const float* qan = p.qan + l * 384; const float* kvan = p.kvan + l * 512; const float* krn = p.krn + l * 64; const float* gvn = p.gvn + l * 1024;
  float* o_pkv = p.out + 17301504L + (long)l * M_P * 512;
  float* o_pkr = p.out + 34078720L + (long)l * M_P * 64;
  float* o_skv = p.out + 36175872L + (long)l * M_S * 512;
  float* o_skr = p.out + 36700160L + (long)l * M_S * 64;
  float* o_sgv = p.out + 36765696L + (long)l * M_S * 1024;
  for (int row = get_bid() * 4 + w; row < M_ALL; row += gridDim.x * 4) {
    const u16* zr = p.Z + (long)row * LDZ;
    const bool is_s = row >= M_P; const int rs_ = row - M_P;
    {
      unsigned v[3]; float ss = 0.f;
#pragma unroll
      for (int i = 0; i < 3; ++i) { v[i] = *(const unsigned*)(zr + ZQ + 2 * lane + 128 * i); const float a = bflo(v[i]), b = bfhi(v[i]); ss += a * a + b * b; }
      ss = wave_sum(ss);
      const float rs = rsqrtf(ss * (1.f / 384.f) + EPSF);
#pragma unroll
      for (int i = 0; i < 3; ++i) {
        const int c = 2 * lane + 128 * i; const float2 g = *(const float2*)(qan + c);
        *(unsigned*)(p.QN + (long)row * 384 + c) = pk2(bflo(v[i]) * rs * g.x, bfhi(v[i]) * rs * g.y);
      }
    }
    {
      const uint4 v = *(const uint4*)(zr + ZKV + 8 * lane);
      float x[8] = {bflo(v.x), bfhi(v.x), bflo(v.y), bfhi(v.y), bflo(v.z), bfhi(v.z), bflo(v.w), bfhi(v.w)};
      float ss = 0.f;
#pragma unroll
      for (int i = 0; i < 8; ++i) ss += x[i] * x[i];
      ss = wave_sum(ss);
      const float rs = rsqrtf(ss * (1.f / 512.f) + EPSF);
      const float4 g0 = *(const float4*)(kvan + 8 * lane), g1 = *(const float4*)(kvan + 8 * lane + 4);
      float4 y0 = make_float4(x[0] * rs * g0.x, x[1] * rs * g0.y, x[2] * rs * g0.z, x[3] * rs * g0.w);
      float4 y1 = make_float4(x[4] * rs * g1.x, x[5] * rs * g1.y, x[6] * rs * g1.z, x[7] * rs * g1.w);
      float* od = is_s ? (o_skv + (long)rs_ * 512) : (o_pkv + (long)row * 512);
      *(float4*)(od + 8 * lane) = y0; *(float4*)(od + 8 * lane + 4) = y1;
      *(uint4*)(p.C + (long)row * 512 + 8 * lane) = pack8(y0, y1);
    }
    {
      const float x = bf1(zr[ZKR + lane]);
      const float ss = wave_sum(x * x);
      const float rs = rsqrtf(ss * (1.f / 64.f) + EPSF);
      const float y = x * rs * krn[lane];
      const float other = __shfl_xor(y, 32);
      const int pos = tok_pos(row);
      const float2 cs = *(const float2*)(p.rope + ((long)pos * 32 + (lane & 31)) * 2);
      const float o = lane < 32 ? (y * cs.x - other * cs.y) : (other * cs.y + y * cs.x);
      if (is_s) {
        o_skr[(long)rs_ * 64 + lane] = o;
        p.KRs[((long)(rs_ >> 4) * LKS + PAST + (rs_ & 15)) * 64 + lane] = f2bf(o);
      } else {
        o_pkr[(long)row * 64 + lane] = o;
        p.KRp[(long)row * 64 + lane] = f2bf(o);
      }
    }
    {
      uint4 v[2]; float ss = 0.f;
#pragma unroll
      for (int i = 0; i < 2; ++i) {
        v[i] = *(const uint4*)(zr + ZV + 8 * lane + 512 * i);
        const float x[8] = {bflo(v[i].x), bfhi(v[i].x), bflo(v[i].y), bfhi(v[i].y), bflo(v[i].z), bfhi(v[i].z), bflo(v[i].w), bfhi(v[i].w)};
#pragma unroll
        for (int j = 0; j < 8; ++j) ss += x[j] * x[j];
      }
      ss = wave_sum(ss);
      const float rs = rsqrtf(ss * (1.f / 1024.f) + EPSF);
      if (lane == 0) p.rsv[row] = rs;
      if (is_s) {
#pragma unroll
        for (int i = 0; i < 2; ++i) {
          const int c = 8 * lane + 512 * i;
          const float x[8] = {bflo(v[i].x), bfhi(v[i].x), bflo(v[i].y), bfhi(v[i].y), bflo(v[i].z), bfhi(v[i].z), bflo(v[i].w), bfhi(v[i].w)};
          const float4 g0 = *(const float4*)(gvn + c), g1 = *(const float4*)(gvn + c + 4);
          *(float4*)(o_sgv + (long)rs_ * 1024 + c) = make_float4(x[0] * rs * g0.x, x[1] * rs * g0.y, x[2] * rs * g0.z, x[3] * rs * g0.w);
          *(float4*)(o_sgv + (long)rs_ * 1024 + c + 4) = make_float4(x[4] * rs * g1.x, x[5] * rs * g1.y, x[6] * rs * g1.z, x[7] * rs * g1.w);
        }
      }
    }
  }
  {
    const float* cc = p.cache_c + (long)l * 32 * PAST * 512;
    const long gt = (long)get_bid() * 256 + tid, gs = (long)gridDim.x * 256;
    for (long e = gt; e < 32L * PAST * 512 / 8; e += gs) {
      const float4 a = *(const float4*)(cc + e * 8), c = *(const float4*)(cc + e * 8 + 4);
      *(uint4*)(p.CB + e * 8) = pack8(a, c);
    }
    const float* pp = p.p_prompt + (long)l * M_P * 256; const float* ps = p.p_sample + (long)l * M_S * 256;
    for (long e = gt; e < (long)M_ALL * 256 / 8; e += gs) {
      const long pe = (long)M_P * 256 / 8;
      const float* src = e < pe ? (pp + e * 8) : (ps + (e - pe) * 8);
      *(uint4*)(p.PB + e * 8) = pack8(*(const float4*)src, *(const float4*)(src + 4));
    }
  }
  const float* ckr = p.cache_kr + (long)l * 32 * PAST * 64;
  const long gtid = (long)get_bid() * 256 + tid, gstride = (long)gridDim.x * 256;
  for (long e = gtid; e < 32L * PAST * 64 / 8; e += gstride) {
    const long el = e * 8; const int b = (int)(el / (PAST * 64)); const long rem = el - (long)b * PAST * 64;
    const float4 a = *(const float4*)(ckr + el), c = *(const float4*)(ckr + el + 4);
    *(uint4*)(p.KRs + (long)b * LKS * 64 + rem) = pack8(a, c);
  }
}

#define NCKV (1024 * 16)
#define NPKV (128 * 16)
#define NSKV (4 * 16)
#define NQT (132 * 12)
#define NPPT (132 * 8)
DI void multi_phase(const Params& p, int l, char* smem) {
  LANE_COORDS
  const u16* Wkv = p.Wkv + (long)l * 2048 * 512;
  const u16* Wuq = p.Wuq + (long)l * 1536 * 384;
  const u16* Wpe = p.Wpe + (long)l * 1024 * 256;
  const int total = NCKV + NPKV + NSKV + NQT + NPPT;
  gemm_stream(total,
    [&](int t) {
      TD d;
      if (t < NCKV + NPKV + NSKV) {
        const u16* tok; int u = t;
        if (u < NCKV) tok = p.CB + (long)(u >> 4) * 128 * 512;
        else if ((u -= NCKV) < NPKV) tok = p.C + (long)(u >> 4) * 128 * 512;
        else { u -= NPKV; tok = p.C + ((long)M_P + (u >> 4) * 128) * 512; }
        const int tn = u & 15;
        const u16* wgt = Wkv + (long)tn * 128 * 512;
        d.A = (const char*)(tn < 8 ? tok : wgt); d.B = (const char*)(tn < 8 ? wgt : tok); d.sa = 1024; d.sb = 1024; d.nk = 8;
      } else {
        int u = t - (NCKV + NPKV + NSKV);
        if (u < NQT) { const int tm = u / 12, tn = u - tm * 12; d.A = (const char*)(p.QN + (long)tm * 128 * 384); d.B = (const char*)(Wuq + (long)tn * 128 * 384); d.sa = 768; d.sb = 768; d.nk = 6; }
        else { u -= NQT; const int tm = u >> 3, tn = u & 7; d.A = (const char*)(p.PB + (long)tm * 128 * 256); d.B = (const char*)(Wpe + (long)tn * 128 * 256); d.sa = 512; d.sb = 512; d.nk = 4; }
      }
      return d;
    },
    [&](int t, f32x16 (&acc)[2][2]) {
      if (t < NCKV + NPKV + NSKV) {
        int mode, u = t;
        if (u < NCKV) mode = 1; else if ((u -= NCKV) < NPKV) mode = 0; else { u -= NPKV; mode = 2; }
        const int m0 = (u >> 4) * 128, tn = u & 15;
        if (tn < 8) {
          const int h = tn;
          nope_epilogue(acc, p.knn + l * 128, 1.0f, smem, [&](int mloc) -> u16* {
            const int m = m0 + mloc;
            if (mode == 0) return p.Knp + ((long)m * 8 + h) * 128;
            long key;
            if (mode == 1) key = (long)(m >> 12) * LKS + (m & 4095); else key = (long)(m >> 4) * LKS + PAST + (m & 15);
            return p.Kns + (key * 8 + h) * 128;
          });
        } else {
          const int h = tn - 8;
          const long dstride = (mode == 0) ? (long)M_P : (long)LKS;
#pragma unroll
          for (int ni = 0; ni < 2; ++ni)
#pragma unroll
            for (int i4 = 0; i4 < 4; ++i4) {
              const int m = m0 + 64 * wn + 32 * ni + 8 * i4 + 4 * hh;
              u16* base;
              if (mode == 0) base = p.VTp + (long)h * 128 * M_P + perm_pos(m);
              else {
                int b, key;
                if (mode == 1) { b = m >> 12; key = m & 4095; } else { b = m >> 4; key = PAST + (m & 15); }
                base = p.VTs + ((long)b * 8 + h) * 128 * LKS + perm_pos(key);
              }
#pragma unroll
              for (int mi = 0; mi < 2; ++mi) {
                const int dd = 64 * wm + 32 * mi + r;
                *(uint2*)(base + (long)dd * dstride) = make_uint2(pk2(acc[mi][ni][4 * i4 + 0], acc[mi][ni][4 * i4 + 1]), pk2(acc[mi][ni][4 * i4 + 2], acc[mi][ni][4 * i4 + 3]));
              }
            }
        }
        return;
      }
      int u = t - (NCKV + NPKV + NSKV);
      if (u < NQT) {
        const int tm = u / 12, tn = u - tm * 12;
        if (tn < 8) {
          nope_epilogue(acc, p.qnn + l * 128, QSCALE, smem, [&](int mloc) -> u16* { return p.Q + ((long)(tm * 128 + mloc) * 8 + tn) * 192; });
        } else {
          const int head = 2 * (tn - 8) + wn;
          const float* g = p.qrn + l * 64;
#pragma unroll
          for (int mi = 0; mi < 2; ++mi) {
            float s = 0.f;
#pragma unroll
            for (int ni = 0; ni < 2; ++ni)
#pragma unroll
              for (int i = 0; i < 16; ++i) s += acc[mi][ni][i] * acc[mi][ni][i];
            s += __shfl_xor(s, 32);
            const float rs = rsqrtf(s * (1.f / 64.f) + EPSF);
            const int m = tm * 128 + 64 * wm + 32 * mi + r;
            const int pos = tok_pos(m);
            u16* qp = p.Q + ((long)m * 8 + head) * 192 + 128;
#pragma unroll
            for (int i4 = 0; i4 < 4; ++i4) {
              const int cc = 8 * i4 + 4 * hh;
              const float4 g1 = *(const float4*)(g + cc), g2 = *(const float4*)(g + 32 + cc);
              const float4 t0 = *(const float4*)(p.rope + ((long)pos * 32 + cc) * 2);
              const float4 t1 = *(const float4*)(p.rope + ((long)pos * 32 + cc) * 2 + 4);
              const float cs[4] = {t0.x, t0.z, t1.x, t1.z}, sn[4] = {t0.y, t0.w, t1.y, t1.w};
              const float gg1[4] = {g1.x, g1.y, g1.z, g1.w}, gg2[4] = {g2.x, g2.y, g2.z, g2.w};
              float o1[4], o2[4];
#pragma unroll
              for (int j = 0; j < 4; ++j) {
                const float y1 = acc[mi][0][4 * i4 + j] * rs * gg1[j], y2 = acc[mi][1][4 * i4 + j] * rs * gg2[j];
                o1[j] = (y1 * cs[j] - y2 * sn[j]) * QSCALE; o2[j] = (y1 * sn[j] + y2 * cs[j]) * QSCALE;
              }
              *(uint2*)(qp + cc) = make_uint2(pk2(o1[0], o1[1]), pk2(o1[2], o1[3]));
              *(uint2*)(qp + 32 + cc) = make_uint2(pk2(o2[0], o2[1]), pk2(o2[2], o2[3]));
            }
          }
        }
        return;
      }
      u -= NQT;
      {
        const int tm = u >> 3, tn = u & 7;
#pragma unroll
        for (int mi = 0; mi < 2; ++mi) {
          const long m = (long)tm * 128 + 64 * wm + 32 * mi + r;
#pragma unroll
          for (int ni = 0; ni < 2; ++ni)
#pragma unroll
            for (int i4 = 0; i4 < 4; ++i4) {
              const int n = tn * 128 + 64 * wn + 32 * ni + 8 * i4 + 4 * hh;
              *(uint2*)(p.PP + m * 1024 + n) = make_uint2(pk2(acc[mi][ni][4 * i4 + 0], acc[mi][ni][4 * i4 + 1]), pk2(acc[mi][ni][4 * i4 + 2], acc[mi][ni][4 * i4 + 3]));
            }
        }
      }
    }, smem);
}

DI void attn_item(const u16* __restrict__ Qb, int qclamp, const u16* __restrict__ Kn, const u16* __restrict__ KR,
                  const u16* __restrict__ VT, long vt_stride, int ntiles, int ntw, int Lk, u16* __restrict__ Ob, char* smem) {
  const int tid = get_tid(), lane = tid & 63, w = tid >> 6, r = lane & 31, hh = lane >> 5;
  u16* Ks = (u16*)smem;
  u16* Vs = Ks + 64 * 200;
  bf16x8 qf[12];
  {
    const int qr = r < qclamp ? r : qclamp;
    const u16* qp = Qb + (long)(32 * w + qr) * (8 * 192) + 8 * hh;
#pragma unroll
    for (int ks = 0; ks < 12; ++ks) qf[ks] = *(const bf16x8*)(qp + 16 * ks);
  }
  f32x16 oacc[4];
#pragma unroll
  for (int dt = 0; dt < 4; ++dt)
#pragma unroll
    for (int i = 0; i < 16; ++i) oacc[dt][i] = 0.f;
  float mrun = -INFINITY, lrun = 0.f;

  uint4 rk0, rk1, rk2, rk3, rk4, rk5, rv0, rv1, rv2, rv3;
  const int lkey = tid >> 2, lq = tid & 3;
  unsigned koff = (unsigned)(lkey * 1024 + lq * 8) * 2u;
  unsigned kroff = (unsigned)(lkey * 64 + lq * 8) * 2u;
  const unsigned vstep = (unsigned)(32 * vt_stride * 2);
  unsigned voff = (unsigned)((tid >> 3) * vt_stride * 2 + (tid & 7) * 16);
  const char* KnB = (const char*)Kn; const char* KRB = (const char*)KR; const char* VTB = (const char*)VT;
  char* KsW = (char*)Ks + lkey * 400 + lq * 16;
  char* VsW = (char*)Vs + (tid >> 3) * 144 + (tid & 7) * 16;
#define AGLOAD() { \
    rk0 = *(const uint4*)(KnB + (size_t)koff); rk1 = *(const uint4*)(KnB + (size_t)koff + 64); \
    rk2 = *(const uint4*)(KnB + (size_t)koff + 128); rk3 = *(const uint4*)(KnB + (size_t)koff + 192); \
    rk4 = *(const uint4*)(KRB + (size_t)kroff); rk5 = *(const uint4*)(KRB + (size_t)kroff + 64); \
    rv0 = *(const uint4*)(VTB + (size_t)voff); rv1 = *(const uint4*)(VTB + (size_t)(voff + vstep)); \
    rv2 = *(const uint4*)(VTB + (size_t)(voff + 2 * vstep)); rv3 = *(const uint4*)(VTB + (size_t)(voff + 3 * vstep)); \
    koff += 64 * 1024 * 2; kroff += 64 * 64 * 2; voff += 128; }
#define ASTORE() { \
    *(uint4*)(KsW) = rk0; *(uint4*)(KsW + 64) = rk1; *(uint4*)(KsW + 128) = rk2; *(uint4*)(KsW + 192) = rk3; \
    *(uint4*)(KsW + 256) = rk4; *(uint4*)(KsW + 320) = rk5; \
    *(uint4*)(VsW) = rv0; *(uint4*)(VsW + 32 * 144) = rv1; *(uint4*)(VsW + 64 * 144) = rv2; *(uint4*)(VsW + 96 * 144) = rv3; }

  AGLOAD();
#pragma unroll 1
  for (int jt = 0; jt < ntiles; ++jt) {
    __syncthreads();
    ASTORE();
    __syncthreads();
    if (jt >= ntw) { if (jt + 1 < ntiles) AGLOAD(); }
    if (jt < ntw) {
      f32x16 sacc[2];
#pragma unroll
      for (int kt = 0; kt < 2; ++kt)
#pragma unroll
        for (int i = 0; i < 16; ++i) sacc[kt][i] = 0.f;
      const u16* kb = Ks + r * 200 + 8 * hh;
#pragma unroll
      for (int ks = 0; ks < 12; ++ks) {
        bf16x8 k0 = *(const bf16x8*)(kb + 16 * ks);
        bf16x8 k1 = *(const bf16x8*)(kb + 32 * 200 + 16 * ks);
        sacc[0] = MFMA(k0, qf[ks], sacc[0]);
        sacc[1] = MFMA(k1, qf[ks], sacc[1]);
        if ((ks & 3) == 3) __builtin_amdgcn_sched_barrier(0);
      }
      if ((jt + 1) * 64 > Lk) {
#pragma unroll
        for (int kt = 0; kt < 2; ++kt)
#pragma unroll
          for (int i = 0; i < 16; ++i) {
            const int key = jt * 64 + 32 * kt + (i & 3) + 8 * (i >> 2) + 4 * hh;
            if (key >= Lk) sacc[kt][i] = -INFINITY;
          }
      }
      float tmax = -INFINITY;
#pragma unroll
      for (int kt = 0; kt < 2; ++kt)
#pragma unroll
        for (int i = 0; i < 16; ++i) tmax = fmaxf(tmax, sacc[kt][i]);
      tmax = fmaxf(tmax, __shfl_xor(tmax, 32));
      const float mnew = fmaxf(mrun, tmax);
      const float alpha = __builtin_amdgcn_exp2f(mrun - mnew);
      mrun = mnew;
      float psum = 0.f;
#pragma unroll
      for (int kt = 0; kt < 2; ++kt)
#pragma unroll
        for (int i = 0; i < 16; ++i) { const float pv = __builtin_amdgcn_exp2f(sacc[kt][i] - mnew); sacc[kt][i] = pv; psum += pv; }
      lrun = lrun * alpha + psum;
#pragma unroll
      for (int dt = 0; dt < 4; ++dt)
#pragma unroll
        for (int i = 0; i < 16; ++i) oacc[dt][i] *= alpha;
      bf16x8 pf[2][2];
#pragma unroll
      for (int kt = 0; kt < 2; ++kt)
#pragma unroll
        for (int s = 0; s < 2; ++s) {
          uint4 pp = make_uint4(pk2(sacc[kt][8 * s + 0], sacc[kt][8 * s + 1]), pk2(sacc[kt][8 * s + 2], sacc[kt][8 * s + 3]),
                                pk2(sacc[kt][8 * s + 4], sacc[kt][8 * s + 5]), pk2(sacc[kt][8 * s + 6], sacc[kt][8 * s + 7]));
          pf[kt][s] = __builtin_bit_cast(bf16x8, pp);
        }
      if (jt + 1 < ntiles) AGLOAD();
      const u16* vb = Vs + r * 72 + 8 * hh;
#pragma unroll
      for (int dt = 0; dt < 4; ++dt)
#pragma unroll
        for (int kt = 0; kt < 2; ++kt)
#pragma unroll
          for (int s = 0; s < 2; ++s) {
            bf16x8 vf = *(const bf16x8*)(vb + 32 * dt * 72 + 32 * kt + 16 * s);
            oacc[dt] = MFMA(vf, pf[kt][s], oacc[dt]);
            if (kt == 1 && s == 1) __builtin_amdgcn_sched_barrier(0);
          }
    }
  }
  if (ntw > 0 && r <= qclamp) {
    const float ltot = lrun + __shfl_xor(lrun, 32);
    const float inv = 1.f / ltot;
    u16* op = Ob + (long)(32 * w + r) * 1024;
#pragma unroll
    for (int dt = 0; dt < 4; ++dt)
#pragma unroll
      for (int i4 = 0; i4 < 4; ++i4) {
        const int d = 32 * dt + 8 * i4 + 4 * hh;
        *(uint2*)(op + d) = make_uint2(pk2(oacc[dt][4 * i4 + 0] * inv, oacc[dt][4 * i4 + 1] * inv), pk2(oacc[dt][4 * i4 + 2] * inv, oacc[dt][4 * i4 + 3] * inv));
      }
  } else if (ntw > 0) {
    (void)__shfl_xor(lrun, 32);
  }
}

DI void attn_phase(const Params& p, int l, char* smem, int* s_item, int cidx) {
  const int tid = get_tid(), w = tid >> 6;
  const int NITEM = 256 + 1024;
  for (;;) {
    __syncthreads();
    if (tid == 0) *s_item = (int)atomicAdd(p.ctr + cidx, 1u);
    __syncthreads();
    const int item = *s_item;
    if (item >= NITEM) break;
    if (item < 256) {
      const int b = item >> 3, h = item & 7;
      const u16* Qb = p.Q + ((long)(M_P + 16 * b) * 8 + h) * 192;
      const u16* Kn = p.Kns + ((long)b * LKS * 8 + h) * 128;
      const u16* KR = p.KRs + (long)b * LKS * 64;
      const u16* VT = p.VTs + ((long)b * 8 + h) * 128 * LKS;
      u16* Ob = p.OA + (long)(M_P + 16 * b) * 1024 + h * 128;
      attn_item(Qb, 15, Kn, KR, VT, LKS, 65, w == 0 ? 65 : 0, LKV, Ob, smem);
    } else {
      const int idx = item - 256;
      const int qb = 127 - (idx >> 3), h = idx & 7;
      const u16* Qb = p.Q + ((long)(128 * qb) * 8 + h) * 192;
      const u16* Kn = p.Knp + (long)h * 128;
      const u16* KR = p.KRp;
      const u16* VT = p.VTp + (long)h * 128 * M_P;
      u16* Ob = p.OA + (long)(128 * qb) * 1024 + h * 128;
      const int ntiles = 2 * qb + 2;
      attn_item(Qb, 31, Kn, KR, VT, M_P, ntiles, w < 2 ? ntiles - 1 : ntiles, 1 << 30, Ob, smem);
    }
  }
}

DI void gmlp_phase(const Params& p, int l, char* smem) {
  const int tid = get_tid(), lane = tid & 63, w = tid >> 6, wm = w >> 1, wn = w & 1, r = lane & 31, hh = lane >> 5;
  const float* gvn = p.gvn + l * 1024;
  const float* gws = p.gws + (long)l * 8 * 128 * 128;
  const float* gbs = p.gbs + (long)l * 8 * 128;
  u16* Xs = (u16*)smem;
  u16* Ws = Xs + 128 * 136;
  const int NP = 128 * 8, NS = 32 * 4;
  for (int t = get_bid(); t < NP + NS; t += gridDim.x) {
    if (t < NP) {
      const int ci = t >> 3, g = t & 7;
      const int t0 = ci * 128, c0 = g * 128;
      __syncthreads();
#pragma unroll
      for (int i = 0; i < 8; ++i) {
        const int c = tid + 256 * i; const int s = c >> 4, dc = (c & 15) * 8;
        const uint4 v = *(const uint4*)(p.Z + (long)(t0 + s) * LDZ + ZV + c0 + dc);
        const float rs = p.rsv[t0 + s];
        const float4 g0 = *(const float4*)(gvn + c0 + dc), g1 = *(const float4*)(gvn + c0 + dc + 4);
        Xs[(dc + 0) * 136 + s] = f2bf(bflo(v.x) * rs * g0.x); Xs[(dc + 1) * 136 + s] = f2bf(bfhi(v.x) * rs * g0.y);
        Xs[(dc + 2) * 136 + s] = f2bf(bflo(v.y) * rs * g0.z); Xs[(dc + 3) * 136 + s] = f2bf(bfhi(v.y) * rs * g0.w);
        Xs[(dc + 4) * 136 + s] = f2bf(bflo(v.z) * rs * g1.x); Xs[(dc + 5) * 136 + s] = f2bf(bfhi(v.z) * rs * g1.y);
        Xs[(dc + 6) * 136 + s] = f2bf(bflo(v.w) * rs * g1.z); Xs[(dc + 7) * 136 + s] = f2bf(bfhi(v.w) * rs * g1.w);
        const int tt = c >> 4, sc = (c & 15) * 8;
        const float* wp = gws + ((long)g * 128 + tt) * 128 + sc;
        float4 a = *(const float4*)wp, b = *(const float4*)(wp + 4);
        a.x = (sc + 0 <= tt) ? a.x : 0.f; a.y = (sc + 1 <= tt) ? a.y : 0.f; a.z = (sc + 2 <= tt) ? a.z : 0.f; a.w = (sc + 3 <= tt) ? a.w : 0.f;
        b.x = (sc + 4 <= tt) ? b.x : 0.f; b.y = (sc + 5 <= tt) ? b.y : 0.f; b.z = (sc + 6 <= tt) ? b.z : 0.f; b.w = (sc + 7 <= tt) ? b.w : 0.f;
        *(uint4*)(Ws + tt * 136 + sc) = pack8(a, b);
      }
      __syncthreads();
      f32x16 acc[2][2];
#pragma unroll
      for (int mi = 0; mi < 2; ++mi)
#pragma unroll
        for (int ni = 0; ni < 2; ++ni)
#pragma unroll
          for (int i = 0; i < 16; ++i) acc[mi][ni][i] = 0.f;
      const u16* Ab = Ws + (64 * wm + r) * 136 + 8 * hh;
      const u16* Bb = Xs + (64 * wn + r) * 136 + 8 * hh;
#pragma unroll
      for (int ks = 0; ks < 8; ++ks) {
        bf16x8 a0 = *(const bf16x8*)(Ab + 16 * ks), a1 = *(const bf16x8*)(Ab + 32 * 136 + 16 * ks);
        bf16x8 b0 = *(const bf16x8*)(Bb + 16 * ks), b1 = *(const bf16x8*)(Bb + 32 * 136 + 16 * ks);
        acc[0][0] = MFMA(b0, a0, acc[0][0]); acc[0][1] = MFMA(b1, a0, acc[0][1]);
        acc[1][0] = MFMA(b0, a1, acc[1][0]); acc[1][1] = MFMA(b1, a1, acc[1][1]);
      }
#pragma unroll
      for (int mi = 0; mi < 2; ++mi) {
        const int tl = 64 * wm + 32 * mi + r;
        const long row = t0 + tl;
        const float bias = gbs[g * 128 + tl];
        const u16* zr = p.Z + row * LDZ;
#pragma unroll
        for (int ni = 0; ni < 2; ++ni)
#pragma unroll
          for (int i4 = 0; i4 < 4; ++i4) {
            const int col = c0 + 64 * wn + 32 * ni + 8 * i4 + 4 * hh;
            const uint2 uu = *(const uint2*)(zr + ZU + col), ga = *(const uint2*)(zr + ZGA + col), gb = *(const uint2*)(zr + ZGB + col);
            const uint2 oa = *(const uint2*)(p.OA + row * 1024 + col);
            const float o0 = sigm(bflo(ga.x)) * bflo(oa.x) + sigm(bflo(gb.x)) * bflo(uu.x) * (acc[mi][ni][4 * i4 + 0] + bias);
            const float o1 = sigm(bfhi(ga.x)) * bfhi(oa.x) + sigm(bfhi(gb.x)) * bfhi(uu.x) * (acc[mi][ni][4 * i4 + 1] + bias);
            const float o2 = sigm(bflo(ga.y)) * bflo(oa.y) + sigm(bflo(gb.y)) * bflo(uu.y) * (acc[mi][ni][4 * i4 + 2] + bias);
            const float o3 = sigm(bfhi(ga.y)) * bfhi(oa.y) + sigm(bfhi(gb.y)) * bfhi(uu.y) * (acc[mi][ni][4 * i4 + 3] + bias);
            *(uint2*)(p.MIX + row * 1024 + col) = make_uint2(pk2(o0, o1), pk2(o2, o3));
          }
      }
    } else {
      const int u = t - NP; const int b = u >> 2, col = (u & 3) * 256 + tid; const int g = col >> 7;
      const long row0 = M_P + 16 * b;
      const float gv = gvn[col];
      float vn[16];
#pragma unroll
      for (int s = 0; s < 16; ++s) vn[s] = bf1(p.Z[(row0 + s) * LDZ + ZV + col]) * p.rsv[row0 + s] * gv;
#pragma unroll
      for (int tt = 0; tt < 16; ++tt) {
        float mx = gbs[g * 128 + tt];
#pragma unroll
        for (int s = 0; s <= tt; ++s) mx += gws[((long)g * 128 + tt) * 128 + s] * vn[s];
        const u16* zr = p.Z + (row0 + tt) * LDZ;
        const float uu = bf1(zr[ZU + col]), ga = bf1(zr[ZGA + col]), gb = bf1(zr[ZGB + col]);
        const float oa = bf1(p.OA[(row0 + tt) * 1024 + col]);
        p.MIX[(row0 + tt) * 1024 + col] = f2bf(sigm(ga) * oa + sigm(gb) * uu * mx);
      }
    }
  }
}

#define XB_TMO      128
#define XB_XCNT(j)  (256  + 64 * (j))
#define XB_XSUB(j)  (1280 + 64 * (j))
#define XB_XGEN(j)  (2304 + 64 * (j))
#define XB_TOP      3328
#define XB_TOPGEN   3392
#define XCD_BAR_WORDS 3456
#define XB_SPIN_CAP (1u << 22)
#define LAS __attribute__((address_space(3)))
DI unsigned xb_ld(unsigned* p) { return __hip_atomic_load(p, __ATOMIC_RELAXED, __HIP_MEMORY_SCOPE_AGENT); }
DI unsigned xb_add(unsigned* p, unsigned v) { return __hip_atomic_fetch_add(p, v, __ATOMIC_RELAXED, __HIP_MEMORY_SCOPE_AGENT); }
DI unsigned xb_xcc_id() { return (unsigned)__builtin_amdgcn_s_getreg((3 << 11) | 20) & 0xFu; }
#define XB_SPIN(cond, bar) do { unsigned _sp = 0; while (cond) { __builtin_amdgcn_s_sleep(1); \
    if ((++_sp & 255u) == 0u) { if (xb_ld(&(bar)[XB_TMO])) break; if (_sp > XB_SPIN_CAP) { atomicAdd(&(bar)[XB_TMO], 1u); break; } } } } while (0)
struct XcdBarrier { unsigned* bar; unsigned x; volatile LAS unsigned* st; };
DI XcdBarrier xcd_barrier_post(unsigned* bar, volatile LAS unsigned* st) {
  XcdBarrier b; b.bar = bar; b.x = xb_xcc_id(); b.st = st;
  if (threadIdx.x == 0) (void)xb_add(&bar[XB_XCNT(b.x)], 1u);
  return b;
}
DI void xcd_barrier_complete(unsigned* bar, unsigned x, unsigned& nloc, unsigned& nx) {
  const unsigned G = gridDim.x * gridDim.y * gridDim.z;
  unsigned sum, cnt, mine, sp = 0u;
  for (;;) {
    sum = 0u; cnt = 0u; mine = 0u;
#pragma unroll
    for (unsigned j = 0; j < 16; ++j) { const unsigned c = xb_ld(&bar[XB_XCNT(j)]); sum += c; cnt += (c > 0u) ? 1u : 0u; mine = (j == x) ? c : mine; }
    if (sum == G) break;
    __builtin_amdgcn_s_sleep(1);
    if ((++sp & 255u) == 0u) { if (xb_ld(&bar[XB_TMO])) break; if (sp > XB_SPIN_CAP) { atomicAdd(&bar[XB_TMO], 1u); break; } }
  }
  nloc = mine > 0u ? mine : 1u; nx = cnt > 0u ? cnt : 1u;
}
DI void xcd_barrier(const XcdBarrier& b) {
  asm volatile("s_waitcnt vmcnt(0)" ::: "memory");
  __syncthreads();
  if (threadIdx.x == 0) {
    unsigned* bar = b.bar;
    __builtin_amdgcn_s_waitcnt(0);
    unsigned nloc = b.st[0], nx = b.st[1];
    if (nloc == 0u) { xcd_barrier_complete(bar, b.x, nloc, nx); b.st[0] = nloc; b.st[1] = nx; }
    const unsigned old = xb_add(&bar[XB_XSUB(b.x)], 1u);
    const unsigned gen = old / nloc;
    if (old + 1u == (gen + 1u) * nloc) {
      __builtin_amdgcn_fence(__ATOMIC_RELEASE, "agent");
      asm volatile("s_waitcnt vmcnt(0)" ::: "memory");
      const unsigned og = xb_add(&bar[XB_TOP], 1u);
      const unsigned tg = og / nx;
      if (og + 1u == (tg + 1u) * nx) xb_add(&bar[XB_TOPGEN], 1u);
      else XB_SPIN(xb_ld(&bar[XB_TOPGEN]) == tg, bar);
      __builtin_amdgcn_fence(__ATOMIC_ACQUIRE, "agent");
      xb_add(&bar[XB_XGEN(b.x)], 1u);
      asm volatile("s_waitcnt vmcnt(0)" ::: "memory");
    } else {
      XB_SPIN(xb_ld(&bar[XB_XGEN(b.x)]) == gen, bar);
      __builtin_amdgcn_fence(__ATOMIC_ACQUIRE, "agent");
      asm volatile("s_waitcnt vmcnt(0)" ::: "memory");
    }
  }
  __syncthreads();
}

__global__ void __launch_bounds__(256, 2) mega_fwd(Params p) {
  __shared__ __attribute__((aligned(16))) char smem[SMEM_BYTES];
  __shared__ int s_item;
  __shared__ uint4 xb_words;
  cg::grid_group grid = cg::this_grid();
  if (threadIdx.x == 0) xb_words = make_uint4(0u, 0u, 0u, 0u);
  __syncthreads();
  XcdBarrier xb = xcd_barrier_post(p.bar, (volatile LAS unsigned*)&xb_words);

  prep_phase(p, smem);
  grid.sync();
#pragma unroll 1
  for (int l = 0; l < 2; ++l) {
    norm_phase(p.out, p.f1n + l * 1024, p.NB);
    xcd_barrier(xb);
    ffn_up_phase(p, p.Wgu1 + (long)l * 2 * DFF * 1024, smem);
    xcd_barrier(xb);
#ifdef PROBE_FFN
    ffn_up_phase(p, p.Wgu1 + (long)l * 2 * DFF * 1024, smem);
    xcd_barrier(xb);
#endif
    resid_gemm_phase(p, p.ACT, DFF, p.Wd1 + (long)l * 1024 * DFF, 0.5f, smem);
    xcd_barrier(xb);
    norm_phase(p.out, p.mixn + l * 1024, p.NB);
    xcd_barrier(xb);
    win_phase(p, p.Win + (long)l * LDZ * 1024, smem);
    xcd_barrier(xb);
    rowpost_phase(p, l);
    xcd_barrier(xb);
    multi_phase(p, l, smem);
    xcd_barrier(xb);
    attn_phase(p, l, smem, &s_item, l);
    xcd_barrier(xb);
#ifdef PROBE_ATTN
    attn_phase(p, l, smem, &s_item, 2 + l);
    xcd_barrier(xb);
#endif
#ifdef PROBE_MULTI
    multi_phase(p, l, smem);
    xcd_barrier(xb);
#endif
    gmlp_phase(p, l, smem);
    xcd_barrier(xb);
    resid_gemm_phase(p, p.MIX, 1024, p.Wo + (long)l * 1024 * 1024, 1.0f, smem);
    xcd_barrier(xb);
    norm_phase(p.out, p.f2n + l * 1024, p.NB);
    xcd_barrier(xb);
    ffn_up_phase(p, p.Wgu2 + (long)l * 2 * DFF * 1024, smem);
    xcd_barrier(xb);
#ifdef PROBE_FFN
    ffn_up_phase(p, p.Wgu2 + (long)l * 2 * DFF * 1024, smem);
    xcd_barrier(xb);
#endif
    resid_gemm_phase(p, p.ACT, DFF, p.Wd2 + (long)l * 1024 * DFF, 0.5f, smem);
    xcd_barrier(xb);
    norm_phase(p.out, p.plen + l * 1024, p.NB);
    xcd_barrier(xb);
    ple_phase(p, p.Wpg + (long)l * 1024 * 1024, smem);
    xcd_barrier(xb);
  }
}

extern "C" void kernel_launch(void* const* d_in, const int* in_sizes, int n_in, void* d_out, int out_size, void* d_ws,
                              size_t ws_size, hipStream_t stream) {
  (void)in_sizes; (void)n_in; (void)out_size; (void)ws_size;
  Params p{};
  auto F = [&](int i) { return (const float*)d_in[i]; };
  p.x_prompt = F(0); p.x_sample = F(1); p.cache_c = F(2); p.cache_kr = F(3); p.p_prompt = F(4); p.p_sample = F(5);
  p.f1n = F(6); p.mixn = F(10); p.qan = F(12); p.qnn = F(14); p.qrn = F(15); p.kvan = F(16); p.krn = F(17);
  p.knn = F(20); p.gvn = F(21); p.gws = F(22); p.gbs = F(23); p.f2n = F(25); p.plen = F(29);
  p.out = (float*)d_out;
  char* ws = (char*)d_ws; size_t off = 0;
  auto alloc = [&](size_t bytes) { char* r = ws + off; off += (bytes + 255) & ~(size_t)255; return r; };
  p.Wgu1 = (u16*)alloc(2UL * 2 * DFF * 1024 * 2);
  p.Wd1 = (u16*)alloc(2UL * 1024 * DFF * 2);
  p.Win = (u16*)alloc(2UL * LDZ * 1024 * 2);
  p.Wuq = (u16*)alloc(2UL * 1536 * 384 * 2);
  p.Wkv = (u16*)alloc(2UL * 2048 * 512 * 2);
  p.Wo = (u16*)alloc(2UL * 1024 * 1024 * 2);
  p.Wgu2 = (u16*)alloc(2UL * 2 * DFF * 1024 * 2);
  p.Wd2 = (u16*)alloc(2UL * 1024 * DFF * 2);
  p.Wpg = (u16*)alloc(2UL * 1024 * 1024 * 2);
  p.Wpe = (u16*)alloc(2UL * 1024 * 256 * 2);
  p.NB = (u16*)alloc((size_t)M_ALL * 1024 * 2);
  p.ACT = (u16*)alloc((size_t)M_ALL * DFF * 2);
  p.Z = (u16*)alloc((size_t)M_ALL * LDZ * 2);
  p.QN = (u16*)alloc((size_t)M_ALL * 384 * 2);
  p.C = (u16*)alloc((size_t)M_ALL * 512 * 2);
  p.KRp = (u16*)alloc((size_t)M_P * 64 * 2);
  p.KRs = (u16*)alloc((size_t)32 * LKS * 64 * 2);
  p.Q = (u16*)alloc((size_t)M_ALL * 8 * 192 * 2);
  p.Knp = (u16*)alloc((size_t)M_P * 1024 * 2);
  p.VTp = (u16*)alloc((size_t)M_P * 1024 * 2);
  p.Kns = (u16*)alloc((size_t)32 * LKS * 1024 * 2);
  p.VTs = (u16*)alloc((size_t)32 * LKS * 1024 * 2);
  p.OA = (u16*)alloc((size_t)M_ALL * 1024 * 2);
  p.MIX = (u16*)alloc((size_t)M_ALL * 1024 * 2);
  p.PP = (u16*)alloc((size_t)M_ALL * 1024 * 2);
  p.CB = (u16*)alloc((size_t)32 * PAST * 512 * 2);
  p.PB = (u16*)alloc((size_t)M_ALL * 256 * 2);
  p.rsv = (float*)alloc((size_t)M_ALL * 4);
  p.rope = (float*)alloc((size_t)16384 * 32 * 2 * 4);
  p.ctr = (unsigned*)alloc(256);
  p.bar = (unsigned*)alloc(XCD_BAR_WORDS * 4);

  int nj = 0, ts = 0;
  auto job = [&](const float* src, u16* dst, int K, int N, int kind) {
    p.jobs[nj].src = src; p.jobs[nj].dst = dst; p.jobs[nj].K = K; p.jobs[nj].N = N; p.jobs[nj].kind = kind; p.jobs[nj].tstart = ts;
    ts += (K / 64) * (N / 64); ++nj;
  };
  for (int l = 0; l < 2; ++l) {
    job(F(7) + (size_t)l * 1024 * DFF, p.Wgu1 + (size_t)l * 2 * DFF * 1024, 1024, DFF, 1);
    job(F(8) + (size_t)l * 1024 * DFF, p.Wgu1 + (size_t)l * 2 * DFF * 1024, 1024, DFF, 2);
    job(F(9) + (size_t)l * DFF * 1024, p.Wd1 + (size_t)l * 1024 * DFF, DFF, 1024, 0);
    job(F(11) + (size_t)l * 1024 * DIN, p.Win + (size_t)l * LDZ * 1024, 1024, DIN, 0);
    job(F(13) + (size_t)l * 384 * 1536, p.Wuq + (size_t)l * 1536 * 384, 384, 1536, 3);
    job(F(18) + (size_t)l * 512 * 1024, p.Wkv + (size_t)l * 2048 * 512, 512, 1024, 0);
    job(F(19) + (size_t)l * 512 * 1024, p.Wkv + (size_t)l * 2048 * 512, 512, 1024, 4);
    job(F(24) + (size_t)l * 1024 * 1024, p.Wo + (size_t)l * 1024 * 1024, 1024, 1024, 0);
    job(F(26) + (size_t)l * 1024 * DFF, p.Wgu2 + (size_t)l * 2 * DFF * 1024, 1024, DFF, 1);
    job(F(27) + (size_t)l * 1024 * DFF, p.Wgu2 + (size_t)l * 2 * DFF * 1024, 1024, DFF, 2);
    job(F(28) + (size_t)l * DFF * 1024, p.Wd2 + (size_t)l * 1024 * DFF, DFF, 1024, 0);
    job(F(30) + (size_t)l * 1024 * 1024, p.Wpg + (size_t)l * 1024 * 1024, 1024, 1024, 0);
    job(F(31) + (size_t)l * 256 * 1024, p.Wpe + (size_t)l * 1024 * 256, 256, 1024, 0);
  }
  p.ntile_prep = ts;

  static int grid_blocks = 0;
  if (!grid_blocks) {
    int dev = 0, cus = 0, per_cu = 0;
    hipGetDevice(&dev);
    hipDeviceGetAttribute(&cus, hipDeviceAttributeMultiprocessorCount, dev);
    hipOccupancyMaxActiveBlocksPerMultiprocessor(&per_cu, (const void*)mega_fwd, 256, 0);
    if (per_cu > 2) per_cu = 2;
    if (per_cu < 1) per_cu = 1;
    grid_blocks = cus * per_cu;
  }
  (void)hipMemsetAsync(p.bar, 0, XCD_BAR_WORDS * 4, stream);
  void* args[] = {&p};
  hipError_t e = hipLaunchCooperativeKernel((const void*)mega_fwd, dim3(grid_blocks), dim3(256), args, 0, stream);
  if (e != hipSuccess) fprintf(stderr, "cooperative launch failed: %s (grid %d)\n", hipGetErrorString(e), grid_blocks);
}
```

```cpp
#include <hip/hip_runtime.h>
#include <hip/hip_cooperative_groups.h>
#include <cstdio>
namespace cg = cooperative_groups;

#define DI __device__ __forceinline__
typedef unsigned short u16;
typedef __attribute__((ext_vector_type(8))) short bf16x8;
typedef __attribute__((ext_vector_type(16))) float f32x16;
typedef __attribute__((ext_vector_type(2))) __bf16 bf2_t;
typedef __attribute__((ext_vector_type(2))) float f2_t;

#define M_P 16384
#define M_S 512
#define M_ALL 16896
#define DM 1024
#define DFF 2816
#define DIN 5056
#define LDZ 5120
#define ZQ 0
#define ZKV 384
#define ZKR 896
#define ZU 960
#define ZV 1984
#define ZGA 3008
#define ZGB 4032
#define LKS 4160
#define LKV 4112
#define PAST 4096
#define EPSF 1e-6f
#define QSCALE (0.07216878364870322f * 1.4426950408889634f)

#define NJOBS 26
struct TJob { const float* src; u16* dst; int K, N, kind, tstart; };

struct Params {
  const float *x_prompt, *x_sample, *cache_c, *cache_kr, *p_prompt, *p_sample;
  const float *f1n, *mixn, *qan, *qnn, *qrn, *kvan, *krn, *knn, *gvn, *gws, *gbs, *f2n, *plen;
  float* out;
  u16 *Wgu1, *Wd1, *Win, *Wuq, *Wkv, *Wo, *Wgu2, *Wd2, *Wpg, *Wpe;
  u16 *CB, *PB;
  u16 *NB, *ACT, *Z, *QN, *C, *KRp, *KRs, *Q, *Knp, *VTp, *Kns, *VTs, *OA, *MIX, *PP;
  float *rsv, *rope;
  unsigned* ctr;
  unsigned* bar;
  TJob jobs[NJOBS];
  int ntile_prep; int pad0;
};

DI int get_tid() { int t = threadIdx.x; asm volatile("" : "+v"(t)); return t; }
DI int get_bid() { int t = blockIdx.x; asm volatile("" : "+s"(t)); return t; }
DI unsigned pk2(float a, float b) { f2_t v = {a, b}; bf2_t r = __builtin_convertvector(v, bf2_t); return __builtin_bit_cast(unsigned, r); }
DI float bflo(unsigned v) { return __uint_as_float(v << 16); }
DI float bfhi(unsigned v) { return __uint_as_float(v & 0xffff0000u); }
DI float bf1(u16 v) { return __uint_as_float(((unsigned)v) << 16); }
DI u16 f2bf(float a) { return (u16)(pk2(a, 0.f) & 0xffffu); }
DI float wave_sum(float v) {
#pragma unroll
  for (int o = 32; o > 0; o >>= 1) v += __shfl_xor(v, o);
  return v;
}
DI float sigm(float x) { return 1.f / (1.f + __expf(-x)); }
DI uint4 pack8(float4 x, float4 y) { return make_uint4(pk2(x.x, x.y), pk2(x.z, x.w), pk2(y.x, y.y), pk2(y.z, y.w)); }
#define MFMA(a, b, c) __builtin_amdgcn_mfma_f32_32x32x16_bf16((a), (b), (c), 0, 0, 0)

#define HALF_BYTES (73728 + 1024)
#define SMEM_BYTES (2 * HALF_BYTES)

DI int job_dst_row(int kind, int n) {
  if (kind == 0) return n;
  if (kind == 1) return 64 * (n >> 5) + (n & 31);
  if (kind == 2) return 64 * (n >> 5) + 32 + (n & 31);
  if (kind == 3) { int h = n / 192, c = n - h * 192; return c < 128 ? h * 128 + c : 1024 + h * 64 + (c - 128); }
  return 1024 + n;
}

DI void prep_phase(const Params& p, char* smem) {
  const int tid = get_tid();
  {
    const int vt = tid & 255, half = tid >> 8;
    u16* Ts = (u16*)smem + half * (64 * 66);
    const int npair = (p.ntile_prep + 1) >> 1;
    for (int t2 = get_bid(); t2 < npair; t2 += gridDim.x) {
      const int t = 2 * t2 + half;
      const bool valid = t < p.ntile_prep;
      int j = 0;
#pragma unroll 1
      for (int q = 1; q < NJOBS; ++q) if (t >= p.jobs[q].tstart) j = q;
      const float* src = p.jobs[j].src; u16* dst = p.jobs[j].dst;
      const int K = p.jobs[j].K, N = p.jobs[j].N, kind = p.jobs[j].kind;
      const int lt = t - p.jobs[j].tstart;
      const int ntn = N >> 6;
      const int tk = lt / ntn, tn = lt - tk * ntn;
      const int k0 = tk * 64, n0 = tn * 64;
      __syncthreads();
      if (valid) {
#pragma unroll
        for (int i = 0; i < 4; ++i) {
          const int k = (vt >> 4) + 16 * i, nc = (vt & 15) * 4;
          float4 v = *(const float4*)(src + (long)(k0 + k) * N + n0 + nc);
          Ts[(nc + 0) * 66 + k] = f2bf(v.x); Ts[(nc + 1) * 66 + k] = f2bf(v.y);
          Ts[(nc + 2) * 66 + k] = f2bf(v.z); Ts[(nc + 3) * 66 + k] = f2bf(v.w);
        }
      }
      __syncthreads();
      if (valid) {
        const int n = vt >> 2, kc = (vt & 3) * 16;
        const unsigned* s32 = (const unsigned*)(Ts + n * 66 + kc);
        uint4 a = make_uint4(s32[0], s32[1], s32[2], s32[3]);
        uint4 b = make_uint4(s32[4], s32[5], s32[6], s32[7]);
        u16* d = dst + (long)job_dst_row(kind, n0 + n) * K + k0 + kc;
        *(uint4*)d = a; *(uint4*)(d + 8) = b;
      }
    }
  }
  const long gtid = (long)get_bid() * 512 + tid, gstride = (long)gridDim.x * 512;
  for (long e = gtid; e < 2L * 64 * 1024 / 8; e += gstride) {
    const int l = (int)(e / (64 * 1024 / 8)); const long r = e - (long)l * (64 * 1024 / 8);
    *(uint4*)(p.Win + (long)l * LDZ * 1024 + (long)DIN * 1024 + r * 8) = make_uint4(0, 0, 0, 0);
  }
  for (long e = gtid; e < 16384L * 32; e += gstride) {
    const int pos = (int)(e >> 5), i = (int)(e & 31);
    const float inv = powf(10000.0f, -(float)i / 32.0f);
    const float angf = (float)pos * inv;
    const double x = (double)angf;
    const double kq = rint(x * 0.63661977236758134308);
    const double y = (x - kq * 1.5707963267341256e+00) - kq * 6.0771005065061922e-11;
    const double y2 = y * y;
    const double s = y * (1.0 + y2 * (-1.0 / 6 + y2 * (1.0 / 120 + y2 * (-1.0 / 5040 + y2 * (1.0 / 362880 + y2 * (-1.0 / 39916800))))));
    const double c = 1.0 + y2 * (-0.5 + y2 * (1.0 / 24 + y2 * (-1.0 / 720 + y2 * (1.0 / 40320 + y2 * (-1.0 / 3628800 + y2 * (1.0 / 479001600))))));
    const int q = ((int)kq) & 3;
    double cc, ss;
    if (q == 0) { cc = c; ss = s; } else if (q == 1) { cc = -s; ss = c; } else if (q == 2) { cc = -c; ss = -s; } else { cc = s; ss = -c; }
    *(float2*)(p.rope + e * 2) = make_float2((float)cc, (float)ss);
  }
  for (long e = gtid; e < (long)M_ALL * 1024 / 4; e += gstride) {
    const long pe = (long)M_P * 1024 / 4;
    float4 v = e < pe ? ((const float4*)p.x_prompt)[e] : ((const float4*)p.x_sample)[e - pe];
    ((float4*)p.out)[e] = v;
  }
  if (get_bid() == 0 && tid < 16) p.ctr[tid] = 0u;
}

DI void norm_phase(const float* __restrict__ h, const float* __restrict__ g, u16* __restrict__ out) {
  const int tid = get_tid(); const int lane = tid & 63, w = tid >> 6;
  for (int row = get_bid() * 8 + w; row < M_ALL; row += gridDim.x * 8) {
    const float4* hr = (const float4*)(h + (long)row * 1024);
    float4 v[4]; float ss = 0.f;
#pragma unroll
    for (int i = 0; i < 4; ++i) { v[i] = hr[lane + 64 * i]; ss += v[i].x * v[i].x + v[i].y * v[i].y + v[i].z * v[i].z + v[i].w * v[i].w; }
    ss = wave_sum(ss);
    const float rs = rsqrtf(ss * (1.f / 1024.f) + EPSF);
#pragma unroll
    for (int i = 0; i < 4; ++i) {
      const float4 gg = ((const float4*)g)[lane + 64 * i];
      uint2 o = make_uint2(pk2(v[i].x * rs * gg.x, v[i].y * rs * gg.y), pk2(v[i].z * rs * gg.z, v[i].w * rs * gg.w));
      ((uint2*)(out + (long)row * 1024))[lane + 64 * i] = o;
    }
  }
}

struct TD { const char* A; const char* B; unsigned sa, sb; int nk; };
#define RED_OFF 73728

template <class Desc, class Epi>
DI void gemm_stream(int nloc, int nmax, Desc desc, Epi epi, char* smem_all) {
  const int tid = get_tid() & 255, lane = tid & 63, w = tid >> 6, wm = w >> 1, wn = w & 1, r = lane & 31, hh = lane >> 5;
  char* smem = smem_all + (get_tid() >> 8) * HALF_BYTES;
  u16* As = (u16*)smem;
  u16* Bs = As + 2 * 128 * 72;
  const int lrow = tid >> 3, lkc = (tid & 7) * 8;
  int ct = 0;
  if (nmax <= 0) return;
  TD ltd = desc(0);
  uint4 S0a0, S0a1, S0a2, S0a3, S0b0, S0b1, S0b2, S0b3, S1a0, S1a1, S1a2, S1a3, S1b0, S1b1, S1b2, S1b3;
#define LD1(dst, base, off) dst = *(const uint4*)((base) + (size_t)(off));
#define GLOADS(S, kk) { \
    const unsigned oa_ = lrow * ltd.sa + (unsigned)((kk) * 64 + lkc) * 2u, ob_ = lrow * ltd.sb + (unsigned)((kk) * 64 + lkc) * 2u; \
    LD1(S##a0, ltd.A, oa_) LD1(S##a1, ltd.A, oa_ + 32u * ltd.sa) LD1(S##a2, ltd.A, oa_ + 64u * ltd.sa) LD1(S##a3, ltd.A, oa_ + 96u * ltd.sa) \
    LD1(S##b0, ltd.B, ob_) LD1(S##b1, ltd.B, ob_ + 32u * ltd.sb) LD1(S##b2, ltd.B, ob_ + 64u * ltd.sb) LD1(S##b3, ltd.B, ob_ + 96u * ltd.sb) }
#define SST1(arr, src, i, buf) *(uint4*)(arr + ((buf) * 128 + lrow + 32 * (i)) * 72 + lkc) = src;
#define SSTORES(S, buf) { SST1(As, S##a0, 0, buf) SST1(As, S##a1, 1, buf) SST1(As, S##a2, 2, buf) SST1(As, S##a3, 3, buf) \
    SST1(Bs, S##b0, 0, buf) SST1(Bs, S##b1, 1, buf) SST1(Bs, S##b2, 2, buf) SST1(Bs, S##b3, 3, buf) }
#define COMPUTE(buf) { \
    const u16* Ab = As + ((buf) * 128 + 64 * wm + r) * 72 + 8 * hh; \
    const u16* Bb = Bs + ((buf) * 128 + 64 * wn + r) * 72 + 8 * hh; \
    _Pragma("unroll") for (int ks = 0; ks < 4; ++ks) { \
      bf16x8 a0 = *(const bf16x8*)(Ab + 16 * ks), a1 = *(const bf16x8*)(Ab + 32 * 72 + 16 * ks); \
      bf16x8 b0 = *(const bf16x8*)(Bb + 16 * ks), b1 = *(const bf16x8*)(Bb + 32 * 72 + 16 * ks); \
      acc[0][0] = MFMA(b0, a0, acc[0][0]); acc[0][1] = MFMA(b1, a0, acc[0][1]); \
      acc[1][0] = MFMA(b0, a1, acc[1][0]); acc[1][1] = MFMA(b1, a1, acc[1][1]); } }
#define SCHED_STEP() { \
    __builtin_amdgcn_sched_group_barrier(0x020, 8, 0); \
    __builtin_amdgcn_sched_group_barrier(0x100, 4, 0); \
    _Pragma("unroll") for (int q_ = 0; q_ < 4; ++q_) { __builtin_amdgcn_sched_group_barrier(0x008, 1, 0); __builtin_amdgcn_sched_group_barrier(0x100, 1, 0); } \
    _Pragma("unroll") for (int q_ = 0; q_ < 8; ++q_) { __builtin_amdgcn_sched_group_barrier(0x008, 1, 0); __builtin_amdgcn_sched_group_barrier(0x100, 1, 0); __builtin_amdgcn_sched_group_barrier(0x200, 1, 0); } \
    _Pragma("unroll") for (int q_ = 0; q_ < 4; ++q_) { __builtin_amdgcn_sched_group_barrier(0x008, 1, 0); } }

  GLOADS(S0, 0)
  GLOADS(S1, 1)
  SSTORES(S0, 0)
  __syncthreads();
#pragma unroll 1
  for (; ct < nmax; ++ct) {
    const int nk2 = ltd.nk >> 1;
    f32x16 acc[2][2];
#pragma unroll
    for (int mi = 0; mi < 2; ++mi)
#pragma unroll
      for (int ni = 0; ni < 2; ++ni)
#pragma unroll
        for (int i = 0; i < 16; ++i) acc[mi][ni][i] = 0.f;
#pragma unroll 1
    for (int k2 = 0; k2 < nk2; ++k2) {
      int kb = 2 * k2 + 2;
      if (k2 == nk2 - 1) { kb = 0; if (ct + 1 < nloc) ltd = desc(ct + 1); }
      GLOADS(S0, kb)
      COMPUTE(0)
      SSTORES(S1, 1)
      SCHED_STEP()
      __syncthreads();
      GLOADS(S1, kb + 1)
      COMPUTE(1)
      SSTORES(S0, 0)
      SCHED_STEP()
      __syncthreads();
    }
    if (ct < nloc) epi(ct, acc);
  }
#undef LD1
#undef GLOADS
#undef SST1
#undef SSTORES
#undef COMPUTE
#undef SCHED_STEP
}

template <class Desc, class Epi>
DI void gemm_stream8(int nloc, Desc desc, Epi epi, char* smem) {
  const int tid = get_tid(), lane = tid & 63, w = tid >> 6, wm = w >> 1, wn = w & 1, r = lane & 31, hh = lane >> 5;
  u16* As = (u16*)smem;
  u16* Bs = As + 2 * 256 * 72;
  const int lrow = tid >> 3, lkc = (tid & 7) * 8;
  int ct = 0;
  if (nloc <= 0) return;
  TD ltd = desc(0);
  uint4 S0a0, S0a1, S0a2, S0a3, S0b0, S0b1, S0b2, S0b3;
#define LD1(dst, base, off) dst = *(const uint4*)((base) + (size_t)(off));
#define GLOADS(S, kk) { \
    const unsigned oa_ = lrow * ltd.sa + (unsigned)((kk) * 64 + lkc) * 2u, ob_ = lrow * ltd.sb + (unsigned)((kk) * 64 + lkc) * 2u; \
    LD1(S##a0, ltd.A, oa_) LD1(S##a1, ltd.A, oa_ + 64u * ltd.sa) LD1(S##a2, ltd.A, oa_ + 128u * ltd.sa) LD1(S##a3, ltd.A, oa_ + 192u * ltd.sa) \
    LD1(S##b0, ltd.B, ob_) LD1(S##b1, ltd.B, ob_ + 64u * ltd.sb) LD1(S##b2, ltd.B, ob_ + 128u * ltd.sb) LD1(S##b3, ltd.B, ob_ + 192u * ltd.sb) }
#define SST1(arr, src, i, buf) *(uint4*)(arr + ((buf) * 256 + lrow + 64 * (i)) * 72 + lkc) = src;
#define SSTORES(S, buf) { SST1(As, S##a0, 0, buf) SST1(As, S##a1, 1, buf) SST1(As, S##a2, 2, buf) SST1(As, S##a3, 3, buf) \
    SST1(Bs, S##b0, 0, buf) SST1(Bs, S##b1, 1, buf) SST1(Bs, S##b2, 2, buf) SST1(Bs, S##b3, 3, buf) }
#define COMPUTE(buf) { \
    const u16* Ab = As + ((buf) * 256 + 64 * wm + r) * 72 + 8 * hh; \
    const u16* Bb = Bs + ((buf) * 256 + 128 * wn + r) * 72 + 8 * hh; \
    _Pragma("unroll") for (int ks = 0; ks < 4; ++ks) { \
      bf16x8 a0 = *(const bf16x8*)(Ab + 16 * ks), a1 = *(const bf16x8*)(Ab + 32 * 72 + 16 * ks); \
      bf16x8 b0 = *(const bf16x8*)(Bb + 16 * ks), b1 = *(const bf16x8*)(Bb + 32 * 72 + 16 * ks); \
      bf16x8 b2 = *(const bf16x8*)(Bb + 64 * 72 + 16 * ks), b3 = *(const bf16x8*)(Bb + 96 * 72 + 16 * ks); \
      acc[0][0] = MFMA(b0, a0, acc[0][0]); acc[0][1] = MFMA(b1, a0, acc[0][1]); acc[0][2] = MFMA(b2, a0, acc[0][2]); acc[0][3] = MFMA(b3, a0, acc[0][3]); \
      acc[1][0] = MFMA(b0, a1, acc[1][0]); acc[1][1] = MFMA(b1, a1, acc[1][1]); acc[1][2] = MFMA(b2, a1, acc[1][2]); acc[1][3] = MFMA(b3, a1, acc[1][3]); } }
#define SCHED_STEP() { \
    __builtin_amdgcn_sched_group_barrier(0x020, 8, 0); \
    __builtin_amdgcn_sched_group_barrier(0x100, 6, 0); \
    _Pragma("unroll") for (int q_ = 0; q_ < 18; ++q_) { __builtin_amdgcn_sched_group_barrier(0x008, 1, 0); __builtin_amdgcn_sched_group_barrier(0x100, 1, 0); } \
    _Pragma("unroll") for (int q_ = 0; q_ < 8; ++q_) { __builtin_amdgcn_sched_group_barrier(0x008, 1, 0); __builtin_amdgcn_sched_group_barrier(0x200, 1, 0); } \
    _Pragma("unroll") for (int q_ = 0; q_ < 6; ++q_) { __builtin_amdgcn_sched_group_barrier(0x008, 1, 0); } }

  GLOADS(S0, 0)
  SSTORES(S0, 0)
  __syncthreads();
#pragma unroll 1
  for (; ct < nloc; ++ct) {
    const int nk2 = ltd.nk >> 1;
    f32x16 acc[2][4];
#pragma unroll
    for (int mi = 0; mi < 2; ++mi)
#pragma unroll
      for (int ni = 0; ni < 4; ++ni)
#pragma unroll
        for (int i = 0; i < 16; ++i) acc[mi][ni][i] = 0.f;
#pragma unroll 1
    for (int k2 = 0; k2 < nk2; ++k2) {
      GLOADS(S0, 2 * k2 + 1)
      COMPUTE(0)
      SSTORES(S0, 1)
      __syncthreads();
      int kb = 2 * k2 + 2;
      if (k2 == nk2 - 1) { kb = 0; if (ct + 1 < nloc) ltd = desc(ct + 1); }
      GLOADS(S0, kb)
      COMPUTE(1)
      SSTORES(S0, 0)
      __syncthreads();
    }
    epi(ct, acc);
  }
#undef LD1
#undef GLOADS
#undef SST1
#undef SSTORES
#undef COMPUTE
#undef SCHED_STEP
}

template <class RowPtr>
DI void nope_epilogue8(f32x16 (&acc)[2][4], const float* __restrict__ gain, float scale, RowPtr rowptr) {
  const int tid = get_tid(), lane = tid & 63, w = tid >> 6, wm = w >> 1, r = lane & 31, hh = lane >> 5;
#pragma unroll
  for (int mi = 0; mi < 2; ++mi) {
    float s = 0.f;
#pragma unroll
    for (int ni = 0; ni < 4; ++ni)
#pragma unroll
      for (int i = 0; i < 16; ++i) s += acc[mi][ni][i] * acc[mi][ni][i];
    s += __shfl_xor(s, 32);
    const float rs = rsqrtf(s * (1.f / 128.f) + EPSF) * scale;
    u16* op = rowptr(64 * wm + 32 * mi + r);
#pragma unroll
    for (int ni = 0; ni < 4; ++ni)
#pragma unroll
      for (int i4 = 0; i4 < 4; ++i4) {
        const int c = 32 * ni + 8 * i4 + 4 * hh;
        const float4 g = *(const float4*)(gain + c);
        *(uint2*)(op + c) = make_uint2(pk2(acc[mi][ni][4 * i4 + 0] * rs * g.x, acc[mi][ni][4 * i4 + 1] * rs * g.y),
                                       pk2(acc[mi][ni][4 * i4 + 2] * rs * g.z, acc[mi][ni][4 * i4 + 3] * rs * g.w));
      }
  }
}

DI int tok_pos(int m) { return m < M_P ? m : PAST + ((m - M_P) & 15); }
DI int perm_pos(int key) {
  const int g4 = (key >> 2) & 3;
  const int pg = (g4 == 1) ? 2 : ((g4 == 2) ? 1 : g4);
  return (key & ~15) + 4 * pg;
}

template <class RowPtr>
DI void nope_epilogue(f32x16 (&acc)[2][2], const float* __restrict__ gain, float scale, char* smem, RowPtr rowptr) {
  const int tid = get_tid() & 255, lane = tid & 63, w = tid >> 6, wm = w >> 1, wn = w & 1, r = lane & 31, hh = lane >> 5;
  float* red = (float*)(smem + RED_OFF);
  float ss[2];
#pragma unroll
  for (int mi = 0; mi < 2; ++mi) {
    float s = 0.f;
#pragma unroll
    for (int ni = 0; ni < 2; ++ni)
#pragma unroll
      for (int i = 0; i < 16; ++i) s += acc[mi][ni][i] * acc[mi][ni][i];
    s += __shfl_xor(s, 32);
    ss[mi] = s;
    if (hh == 0) red[wn * 128 + 64 * wm + 32 * mi + r] = s;
  }
  __syncthreads();
#pragma unroll
  for (int mi = 0; mi < 2; ++mi) {
    const int m = 64 * wm + 32 * mi + r;
    const float tot = ss[mi] + red[(wn ^ 1) * 128 + m];
    const float rs = rsqrtf(tot * (1.f / 128.f) + EPSF) * scale;
    u16* op = rowptr(m);
#pragma unroll
    for (int ni = 0; ni < 2; ++ni)
#pragma unroll
      for (int i4 = 0; i4 < 4; ++i4) {
        const int c = 64 * wn + 32 * ni + 8 * i4 + 4 * hh;
        const float4 g = *(const float4*)(gain + c);
        uint2 o = make_uint2(pk2(acc[mi][ni][4 * i4 + 0] * rs * g.x, acc[mi][ni][4 * i4 + 1] * rs * g.y),
                             pk2(acc[mi][ni][4 * i4 + 2] * rs * g.z, acc[mi][ni][4 * i4 + 3] * rs * g.w));
        *(uint2*)(op + c) = o;
      }
  }
}

DI int nloc_plain(int total) { const int b = get_bid(), G = gridDim.x; return b < total ? (total - b + G - 1) / G : 0; }
#define LANE_COORDS8 const int tid = get_tid(), lane = tid & 63, w = tid >> 6, wm = w >> 1, wn = w & 1, r = lane & 31, hh = lane >> 5; (void)wm; (void)wn; (void)r; (void)hh;

DI void ffn_up_phase(const Params& p, const u16* W, char* smem) {
  LANE_COORDS8
  const int NT = (2 * DFF) / 256;
  const int bid0 = get_bid(), G = gridDim.x;
  gemm_stream8(nloc_plain(66 * NT),
    [&](int k) { const int t = bid0 + k * G; const int tm = t / NT, tn = t - tm * NT; TD d; d.A = (const char*)(p.NB + (long)tm * 256 * 1024); d.B = (const char*)(W + (long)tn * 256 * 1024); d.sa = 2048; d.sb = 2048; d.nk = 16; return d; },
    [&](int k, f32x16 (&acc)[2][4]) {
      const int t = bid0 + k * G; const int tm = t / NT, tn = t - tm * NT;
#pragma unroll
      for (int mi = 0; mi < 2; ++mi) {
        const long m = (long)tm * 256 + 64 * wm + 32 * mi + r;
#pragma unroll
        for (int g2 = 0; g2 < 2; ++g2)
#pragma unroll
          for (int i4 = 0; i4 < 4; ++i4) {
            const int c = 128 * tn + 64 * wn + 32 * g2 + 8 * i4 + 4 * hh;
            float a[4];
#pragma unroll
            for (int j = 0; j < 4; ++j) { const float g = acc[mi][2 * g2][4 * i4 + j], u = acc[mi][2 * g2 + 1][4 * i4 + j]; a[j] = g * sigm(g) * u; }
            *(uint2*)(p.ACT + m * DFF + c) = make_uint2(pk2(a[0], a[1]), pk2(a[2], a[3]));
          }
      }
    }, smem);
}

DI void win_phase(const Params& p, const u16* W, char* smem) {
  LANE_COORDS8
  const int NT = LDZ / 256;
  const int bid0 = get_bid(), G = gridDim.x;
  gemm_stream8(nloc_plain(66 * NT),
    [&](int k) { const int t = bid0 + k * G; const int tm = t / NT, tn = t - tm * NT; TD d; d.A = (const char*)(p.NB + (long)tm * 256 * 1024); d.B = (const char*)(W + (long)tn * 256 * 1024); d.sa = 2048; d.sb = 2048; d.nk = 16; return d; },
    [&](int k, f32x16 (&acc)[2][4]) {
      const int t = bid0 + k * G; const int tm = t / NT, tn = t - tm * NT;
#pragma unroll
      for (int mi = 0; mi < 2; ++mi) {
        const long m = (long)tm * 256 + 64 * wm + 32 * mi + r;
#pragma unroll
        for (int ni = 0; ni < 4; ++ni)
#pragma unroll
          for (int i4 = 0; i4 < 4; ++i4) {
            const int n = tn * 256 + 128 * wn + 32 * ni + 8 * i4 + 4 * hh;
            *(uint2*)(p.Z + m * LDZ + n) = make_uint2(pk2(acc[mi][ni][4 * i4 + 0], acc[mi][ni][4 * i4 + 1]), pk2(acc[mi][ni][4 * i4 + 2], acc[mi][ni][4 * i4 + 3]));
          }
      }
    }, smem);
}

#define LANE_COORDS4 const int tid = get_tid() & 255, lane = tid & 63, w = tid >> 6, wm = w >> 1, wn = w & 1, r = lane & 31, hh = lane >> 5; (void)wm; (void)wn; (void)r; (void)hh; \
  const int vb = 2 * get_bid() + (get_tid() >> 8), VG = 2 * gridDim.x; \
  const int nl_mine = vb < 132 * 8 ? (132 * 8 - vb + VG - 1) / VG : 0; const int nl_max = (2 * get_bid()) < 132 * 8 ? (132 * 8 - 2 * get_bid() + VG - 1) / VG : 0;

DI void resid_gemm_phase(const Params& p, const u16* A, int K, const u16* W, float alpha, char* smem) {
  LANE_COORDS4
  gemm_stream(nl_mine, nl_max,
    [&](int k) { const int t = vb + k * VG; const int tm = t >> 3, tn = t & 7; TD d; d.A = (const char*)(A + (long)tm * 128 * K); d.B = (const char*)(W + (long)tn * 128 * K); d.sa = 2 * K; d.sb = 2 * K; d.nk = K >> 6; return d; },
    [&](int k, f32x16 (&acc)[2][2]) {
      const int t = vb + k * VG; const int tm = t >> 3, tn = t & 7;
#pragma unroll
      for (int mi = 0; mi < 2; ++mi) {
        const long m = (long)tm * 128 + 64 * wm + 32 * mi + r;
#pragma unroll
        for (int ni = 0; ni < 2; ++ni)
#pragma unroll
          for (int i4 = 0; i4 < 4; ++i4) {
            const int n = tn * 128 + 64 * wn + 32 * ni + 8 * i4 + 4 * hh;
            float4* hp = (float4*)(p.out + m * 1024 + n);
            float4 v = *hp;
            v.x += alpha * acc[mi][ni][4 * i4 + 0]; v.y += alpha * acc[mi][ni][4 * i4 + 1];
            v.z += alpha * acc[mi][ni][4 * i4 + 2]; v.w += alpha * acc[mi][ni][4 * i4 + 3];
            *hp = v;
          }
      }
    }, smem);
}

DI void ple_phase(const Params& p, const u16* W, char* smem) {
  LANE_COORDS4
  gemm_stream(nl_mine, nl_max,
    [&](int k) { const int t = vb + k * VG; const int tm = t >> 3, tn = t & 7; TD d; d.A = (const char*)(p.NB + (long)tm * 128 * 1024); d.B = (const char*)(W + (long)tn * 128 * 1024); d.sa = 2048; d.sb = 2048; d.nk = 16; return d; },
    [&](int k, f32x16 (&acc)[2][2]) {
      const int t = vb + k * VG; const int tm = t >> 3, tn = t & 7;
#pragma unroll
      for (int mi = 0; mi < 2; ++mi) {
        const long m = (long)tm * 128 + 64 * wm + 32 * mi + r;
#pragma unroll
        for (int ni = 0; ni < 2; ++ni)
#pragma unroll
          for (int i4 = 0; i4 < 4; ++i4) {
            const int n = tn * 128 + 64 * wn + 32 * ni + 8 * i4 + 4 * hh;
            float4* hp = (float4*)(p.out + m * 1024 + n);
            const uint2 pp = *(const uint2*)(p.PP + m * 1024 + n);
            float4 v = *hp;
            v.x += sigm(acc[mi][ni][4 * i4 + 0]) * bflo(pp.x); v.y += sigm(acc[mi][ni][4 * i4 + 1]) * bfhi(pp.x);
            v.z += sigm(acc[mi][ni][4 * i4 + 2]) * bflo(pp.y); v.w += sigm(acc[mi][ni][4 * i4 + 3]) * bfhi(pp.y);
            *hp = v;
          }
      }
    }, smem);
}

DI void rowpost_phase(const Params& p, int l) {
  const int tid = get_tid(); const int lane = tid & 63, w = tid >> 6;
  const float* qan = p.qan + l * 384; const float* kvan = p.kvan + l * 512; const float* krn = p.krn + l * 64; const float* gvn = p.gvn + l * 1024;
  float* o_pkv = p.out + 17301504L + (long)l * M_P * 512;
  float* o_pkr = p.out + 34078720L + (long)l * M_P * 64;
  float* o_skv = p.out + 36175872L + (long)l * M_S * 512;
  float* o_skr = p.out + 36700160L + (long)l * M_S * 64;
  float* o_sgv = p.out + 36765696L + (long)l * M_S * 1024;
  for (int row = get_bid() * 8 + w; row < M_ALL; row += gridDim.x * 8) {
    const u16* zr = p.Z + (long)row * LDZ;
    const bool is_s = row >= M_P; const int rs_ = row - M_P;
    {
      unsigned v[3]; float ss = 0.f;
#pragma unroll
      for (int i = 0; i < 3; ++i) { v[i] = *(const unsigned*)(zr + ZQ + 2 * lane + 128 * i); const float a = bflo(v[i]), b = bfhi(v[i]); ss += a * a + b * b; }
      ss = wave_sum(ss);
      const float rs = rsqrtf(ss * (1.f / 384.f) + EPSF);
#pragma unroll
      for (int i = 0; i < 3; ++i) {
        const int c = 2 * lane + 128 * i; const float2 g = *(const float2*)(qan + c);
        *(unsigned*)(p.QN + (long)row * 384 + c) = pk2(bflo(v[i]) * rs * g.x, bfhi(v[i]) * rs * g.y);
      }
    }
    {
      const uint4 v = *(const uint4*)(zr + ZKV + 8 * lane);
      float x[8] = {bflo(v.x), bfhi(v.x), bflo(v.y), bfhi(v.y), bflo(v.z), bfhi(v.z), bflo(v.w), bfhi(v.w)};
      float ss = 0.f;
#pragma unroll
      for (int i = 0; i < 8; ++i) ss += x[i] * x[i];
      ss = wave_sum(ss);
      const float rs = rsqrtf(ss * (1.f / 512.f) + EPSF);
      const float4 g0 = *(const float4*)(kvan + 8 * lane), g1 = *(const float4*)(kvan + 8 * lane + 4);
      float4 y0 = make_float4(x[0] * rs * g0.x, x[1] * rs * g0.y, x[2] * rs * g0.z, x[3] * rs * g0.w);
      float4 y1 = make_float4(x[4] * rs * g1.x, x[5] * rs * g1.y, x[6] * rs * g1.z, x[7] * rs * g1.w);
      float* od = is_s ? (o_skv + (long)rs_ * 512) : (o_pkv + (long)row * 512);
      *(float4*)(od + 8 * lane) = y0; *(float4*)(od + 8 * lane + 4) = y1;
      *(uint4*)(p.C + (long)row * 512 + 8 * lane) = pack8(y0, y1);
    }
    {
      const float x = bf1(zr[ZKR + lane]);
      const float ss = wave_sum(x * x);
      const float rs = rsqrtf(ss * (1.f / 64.f) + EPSF);
      const float y = x * rs * krn[lane];
      const float other = __shfl_xor(y, 32);
      const int pos = tok_pos(row);
      const float2 cs = *(const float2*)(p.rope + ((long)pos * 32 + (lane & 31)) * 2);
      const float o = lane < 32 ? (y * cs.x - other * cs.y) : (other * cs.y + y * cs.x);
      if (is_s) {
        o_skr[(long)rs_ * 64 + lane] = o;
        p.KRs[((long)(rs_ >> 4) * LKS + PAST + (rs_ & 15)) * 64 + lane] = f2bf(o);
      } else {
        o_pkr[(long)row * 64 + lane] = o;
        p.KRp[(long)row * 64 + lane] = f2bf(o);
      }
    }
    {
      uint4 v[2]; float ss = 0.f;
#pragma unroll
      for (int i = 0; i < 2; ++i) {
        v[i] = *(const uint4*)(zr + ZV + 8 * lane + 512 * i);
        const float x[8] = {bflo(v[i].x), bfhi(v[i].x), bflo(v[i].y), bfhi(v[i].y), bflo(v[i].z), bfhi(v[i].z), bflo(v[i].w), bfhi(v[i].w)};
#pragma unroll
        for (int j = 0; j < 8; ++j) ss += x[j] * x[j];
      }
      ss = wave_sum(ss);
      const float rs = rsqrtf(ss * (1.f / 1024.f) + EPSF);
      if (lane == 0) p.rsv[row] = rs;
      if (is_s) {
#pragma unroll
        for (int i = 0; i < 2; ++i) {
          const int c = 8 * lane + 512 * i;
          const float x[8] = {bflo(v[i].x), bfhi(v[i].x), bflo(v[i].y), bfhi(v[i].y), bflo(v[i].z), bfhi(v[i].z), bflo(v[i].w), bfhi(v[i].w)};
          const float4 g0 = *(const float4*)(gvn + c), g1 = *(const float4*)(gvn + c + 4);
          *(float4*)(o_sgv + (long)rs_ * 1024 + c) = make_float4(x[0] * rs * g0.x, x[1] * rs * g0.y, x[2] * rs * g0.z, x[3] * rs * g0.w);
          *(float4*)(o_sgv + (long)rs_ * 1024 + c + 4) = make_float4(x[4] * rs * g1.x, x[5] * rs * g1.y, x[6] * rs * g1.z, x[7] * rs * g1.w);
        }
      }
    }
  }
  {
    const float* cc = p.cache_c + (long)l * 32 * PAST * 512;
    const long gt = (long)get_bid() * 512 + tid, gs = (long)gridDim.x * 512;
    for (long e = gt; e < 32L * PAST * 512 / 8; e += gs) {
      const float4 a = *(const float4*)(cc + e * 8), c = *(const float4*)(cc + e * 8 + 4);
      *(uint4*)(p.CB + e * 8) = pack8(a, c);
    }
    const float* pp = p.p_prompt + (long)l * M_P * 256; const float* ps = p.p_sample + (long)l * M_S * 256;
    for (long e = gt; e < (long)M_ALL * 256 / 8; e += gs) {
      const long pe = (long)M_P * 256 / 8;
      const float* src = e < pe ? (pp + e * 8) : (ps + (e - pe) * 8);
      *(uint4*)(p.PB + e * 8) = pack8(*(const float4*)src, *(const float4*)(src + 4));
    }
  }
  const float* ckr = p.cache_kr + (long)l * 32 * PAST * 64;
  const long gtid = (long)get_bid() * 512 + tid, gstride = (long)gridDim.x * 512;
  for (long e = gtid; e < 32L * PAST * 64 / 8; e += gstride) {
    const long el = e * 8; const int b = (int)(el / (PAST * 64)); const long rem = el - (long)b * PAST * 64;
    const float4 a = *(const float4*)(ckr + el), c = *(const float4*)(ckr + el + 4);
    *(uint4*)(p.KRs + (long)b * LKS * 64 + rem) = pack8(a, c);
  }
}

#define NCKV (512 * 8)
#define NPKV (64 * 8)
#define NSKV (2 * 8)
#define NQT (66 * 6)
#define NPPT (66 * 4)
DI void multi_phase(const Params& p, int l, char* smem) {
  LANE_COORDS8
  const u16* Wkv = p.Wkv + (long)l * 2048 * 512;
  const u16* Wuq = p.Wuq + (long)l * 1536 * 384;
  const u16* Wpe = p.Wpe + (long)l * 1024 * 256;
  const int total = NCKV + NPKV + NSKV + NQT + NPPT;
  const int bid0 = get_bid(), G = gridDim.x;
  gemm_stream8(nloc_plain(total),
    [&](int k) {
      const int t = bid0 + k * G;
      TD d;
      if (t < NCKV + NPKV + NSKV) {
        const u16* tok; int u = t;
        if (u < NCKV) tok = p.CB + (long)(u >> 3) * 256 * 512;
        else if ((u -= NCKV) < NPKV) tok = p.C + (long)(u >> 3) * 256 * 512;
        else { u -= NPKV; tok = p.C + ((long)M_P + (u >> 3) * 256) * 512; }
        const int tn = u & 7;
        const u16* wgt = Wkv + (long)tn * 256 * 512;
        d.A = (const char*)(tn < 4 ? tok : wgt); d.B = (const char*)(tn < 4 ? wgt : tok); d.sa = 1024; d.sb = 1024; d.nk = 8;
      } else {
        int u = t - (NCKV + NPKV + NSKV);
        if (u < NQT) { const int tm = u / 6, tn = u - tm * 6; d.A = (const char*)(p.QN + (long)tm * 256 * 384); d.B = (const char*)(Wuq + (long)tn * 256 * 384); d.sa = 768; d.sb = 768; d.nk = 6; }
        else { u -= NQT; const int tm = u >> 2, tn = u & 3; d.A = (const char*)(p.PB + (long)tm * 256 * 256); d.B = (const char*)(Wpe + (long)tn * 256 * 256); d.sa = 512; d.sb = 512; d.nk = 4; }
      }
      return d;
    },
    [&](int k, f32x16 (&acc)[2][4]) {
      const int t = bid0 + k * G;
      if (t < NCKV + NPKV + NSKV) {
        int mode, u = t;
        if (u < NCKV) mode = 1; else if ((u -= NCKV) < NPKV) mode = 0; else { u -= NPKV; mode = 2; }
        const int m0 = (u >> 3) * 256, tn = u & 7;
        if (tn < 4) {
          const int h = 2 * tn + wn;
          nope_epilogue8(acc, p.knn + l * 128, 1.0f, [&](int mloc) -> u16* {
            const int m = m0 + mloc;
            if (mode == 0) return p.Knp + ((long)m * 8 + h) * 128;
            long key;
            if (mode == 1) key = (long)(m >> 12) * LKS + (m & 4095); else key = (long)(m >> 4) * LKS + PAST + (m & 15);
            return p.Kns + (key * 8 + h) * 128;
          });
        } else {
          const int h = 2 * (tn - 4) + (wm >> 1);
          const long dstride = (mode == 0) ? (long)M_P : (long)LKS;
#pragma unroll
          for (int ni = 0; ni < 4; ++ni)
#pragma unroll
            for (int i4 = 0; i4 < 4; ++i4) {
              const int m = m0 + 128 * wn + 32 * ni + 8 * i4 + 4 * hh;
              u16* base;
              if (mode == 0) base = p.VTp + (long)h * 128 * M_P + perm_pos(m);
              else {
                int b, key;
                if (mode == 1) { b = m >> 12; key = m & 4095; } else { b = m >> 4; key = PAST + (m & 15); }
                base = p.VTs + ((long)b * 8 + h) * 128 * LKS + perm_pos(key);
              }
#pragma unroll
              for (int mi = 0; mi < 2; ++mi) {
                const int dd = 64 * (wm & 1) + 32 * mi + r;
                *(uint2*)(base + (long)dd * dstride) = make_uint2(pk2(acc[mi][ni][4 * i4 + 0], acc[mi][ni][4 * i4 + 1]), pk2(acc[mi][ni][4 * i4 + 2], acc[mi][ni][4 * i4 + 3]));
              }
            }
        }
        return;
      }
      int u = t - (NCKV + NPKV + NSKV);
      if (u < NQT) {
        const int tm = u / 6, tn = u - tm * 6;
        if (tn < 4) {
          const int h = 2 * tn + wn;
          nope_epilogue8(acc, p.qnn + l * 128, QSCALE, [&](int mloc) -> u16* { return p.Q + ((long)(tm * 256 + mloc) * 8 + h) * 192; });
        } else {
          const float* g = p.qrn + l * 64;
#pragma unroll
          for (int mi = 0; mi < 2; ++mi) {
            const int m = tm * 256 + 64 * wm + 32 * mi + r;
            const int pos = tok_pos(m);
#pragma unroll
            for (int g2 = 0; g2 < 2; ++g2) {
              const int head = 4 * (tn - 4) + 2 * wn + g2;
              float s = 0.f;
#pragma unroll
              for (int i = 0; i < 16; ++i) s += acc[mi][2 * g2][i] * acc[mi][2 * g2][i] + acc[mi][2 * g2 + 1][i] * acc[mi][2 * g2 + 1][i];
              s += __shfl_xor(s, 32);
              const float rs = rsqrtf(s * (1.f / 64.f) + EPSF);
              u16* qp = p.Q + ((long)m * 8 + head) * 192 + 128;
#pragma unroll
              for (int i4 = 0; i4 < 4; ++i4) {
                const int cc = 8 * i4 + 4 * hh;
                const float4 g1 = *(const float4*)(g + cc), g2v = *(const float4*)(g + 32 + cc);
                const float4 t0 = *(const float4*)(p.rope + ((long)pos * 32 + cc) * 2);
                const float4 t1 = *(const float4*)(p.rope + ((long)pos * 32 + cc) * 2 + 4);
                const float cs[4] = {t0.x, t0.z, t1.x, t1.z}, sn[4] = {t0.y, t0.w, t1.y, t1.w};
                const float gg1[4] = {g1.x, g1.y, g1.z, g1.w}, gg2[4] = {g2v.x, g2v.y, g2v.z, g2v.w};
                float o1[4], o2[4];
#pragma unroll
                for (int j = 0; j < 4; ++j) {
                  const float y1 = acc[mi][2 * g2][4 * i4 + j] * rs * gg1[j], y2 = acc[mi][2 * g2 + 1][4 * i4 + j] * rs * gg2[j];
                  o1[j] = (y1 * cs[j] - y2 * sn[j]) * QSCALE; o2[j] = (y1 * sn[j] + y2 * cs[j]) * QSCALE;
                }
                *(uint2*)(qp + cc) = make_uint2(pk2(o1[0], o1[1]), pk2(o1[2], o1[3]));
                *(uint2*)(qp + 32 + cc) = make_uint2(pk2(o2[0], o2[1]), pk2(o2[2], o2[3]));
              }
            }
          }
        }
        return;
      }
      u -= NQT;
      {
        const int tm = u >> 2, tn = u & 3;
#pragma unroll
        for (int mi = 0; mi < 2; ++mi) {
          const long m = (long)tm * 256 + 64 * wm + 32 * mi + r;
#pragma unroll
          for (int ni = 0; ni < 4; ++ni)
#pragma unroll
            for (int i4 = 0; i4 < 4; ++i4) {
              const int n = tn * 256 + 128 * wn + 32 * ni + 8 * i4 + 4 * hh;
              *(uint2*)(p.PP + m * 1024 + n) = make_uint2(pk2(acc[mi][ni][4 * i4 + 0], acc[mi][ni][4 * i4 + 1]), pk2(acc[mi][ni][4 * i4 + 2], acc[mi][ni][4 * i4 + 3]));
            }
        }
      }
    }, smem);
}

DI void attn_item(const u16* __restrict__ Qb, int qclamp, const u16* __restrict__ Kn, const u16* __restrict__ KR,
                  const u16* __restrict__ VT, long vt_stride, int ntiles, int ntw, int Lk, u16* __restrict__ Ob, char* smem) {
  const int tid = get_tid(), lane = tid & 63, w = tid >> 6, r = lane & 31, hh = lane >> 5;
  u16* Ks = (u16*)smem;
  u16* Vs = Ks + 64 * 200;
  bf16x8 qf[12];
  {
    const int qr = r < qclamp ? r : qclamp;
    const u16* qp = Qb + (long)(32 * w + qr) * (8 * 192) + 8 * hh;
#pragma unroll
    for (int ks = 0; ks < 12; ++ks) qf[ks] = *(const bf16x8*)(qp + 16 * ks);
  }
  f32x16 oacc[4];
#pragma unroll
  for (int dt = 0; dt < 4; ++dt)
#pragma unroll
    for (int i = 0; i < 16; ++i) oacc[dt][i] = 0.f;
  float mrun = -INFINITY, lrun = 0.f;

  uint4 rk0, rk1, rk2, rv0, rv1;
  const int lkey = tid >> 3, lq = tid & 7;
  unsigned koff = (unsigned)(lkey * 1024 + lq * 8) * 2u;
  unsigned kroff = (unsigned)(lkey * 64 + lq * 8) * 2u;
  const unsigned vstep = (unsigned)(64 * vt_stride * 2);
  unsigned voff = (unsigned)(lkey * vt_stride * 2 + lq * 16);
  const char* KnB = (const char*)Kn; const char* KRB = (const char*)KR; const char* VTB = (const char*)VT;
  char* KsW = (char*)Ks + lkey * 400 + lq * 16;
  char* VsW = (char*)Vs + lkey * 144 + lq * 16;
#define AGLOAD() { \
    rk0 = *(const uint4*)(KnB + (size_t)koff); rk1 = *(const uint4*)(KnB + (size_t)koff + 128); \
    rk2 = *(const uint4*)(KRB + (size_t)kroff); \
    rv0 = *(const uint4*)(VTB + (size_t)voff); rv1 = *(const uint4*)(VTB + (size_t)(voff + vstep)); \
    koff += 64 * 1024 * 2; kroff += 64 * 64 * 2; voff += 128; }
#define ASTORE() { \
    *(uint4*)(KsW) = rk0; *(uint4*)(KsW + 128) = rk1; *(uint4*)(KsW + 256) = rk2; \
    *(uint4*)(VsW) = rv0; *(uint4*)(VsW + 64 * 144) = rv1; }

  AGLOAD();
#pragma unroll 1
  for (int jt = 0; jt < ntiles; ++jt) {
    __syncthreads();
    ASTORE();
    __syncthreads();
    if (jt >= ntw) { if (jt + 1 < ntiles) AGLOAD(); }
    if (jt < ntw) {
      f32x16 sacc[2];
#pragma unroll
      for (int kt = 0; kt < 2; ++kt)
#pragma unroll
        for (int i = 0; i < 16; ++i) sacc[kt][i] = 0.f;
      const u16* kb = Ks + r * 200 + 8 * hh;
#pragma unroll
      for (int ks = 0; ks < 12; ++ks) {
        bf16x8 k0 = *(const bf16x8*)(kb + 16 * ks);
        bf16x8 k1 = *(const bf16x8*)(kb + 32 * 200 + 16 * ks);
        sacc[0] = MFMA(k0, qf[ks], sacc[0]);
        sacc[1] = MFMA(k1, qf[ks], sacc[1]);
        if ((ks & 3) == 3) __builtin_amdgcn_sched_barrier(0);
      }
      if ((jt + 1) * 64 > Lk) {
#pragma unroll
        for (int kt = 0; kt < 2; ++kt)
#pragma unroll
          for (int i = 0; i < 16; ++i) {
            const int key = jt * 64 + 32 * kt + (i & 3) + 8 * (i >> 2) + 4 * hh;
            if (key >= Lk) sacc[kt][i] = -INFINITY;
          }
      }
      float tmax = -INFINITY;
#pragma unroll
      for (int kt = 0; kt < 2; ++kt)
#pragma unroll
        for (int i = 0; i < 16; ++i) tmax = fmaxf(tmax, sacc[kt][i]);
      tmax = fmaxf(tmax, __shfl_xor(tmax, 32));
      const float mnew = fmaxf(mrun, tmax);
      const float alpha = __builtin_amdgcn_exp2f(mrun - mnew);
      mrun = mnew;
      float psum = 0.f;
#pragma unroll
      for (int kt = 0; kt < 2; ++kt)
#pragma unroll
        for (int i = 0; i < 16; ++i) { const float pv = __builtin_amdgcn_exp2f(sacc[kt][i] - mnew); sacc[kt][i] = pv; psum += pv; }
      lrun = lrun * alpha + psum;
#pragma unroll
      for (int dt = 0; dt < 4; ++dt)
#pragma unroll
        for (int i = 0; i < 16; ++i) oacc[dt][i] *= alpha;
      bf16x8 pf[2][2];
#pragma unroll
      for (int kt = 0; kt < 2; ++kt)
#pragma unroll
        for (int s = 0; s < 2; ++s) {
          uint4 pp = make_uint4(pk2(sacc[kt][8 * s + 0], sacc[kt][8 * s + 1]), pk2(sacc[kt][8 * s + 2], sacc[kt][8 * s + 3]),
                                pk2(sacc[kt][8 * s + 4], sacc[kt][8 * s + 5]), pk2(sacc[kt][8 * s + 6], sacc[kt][8 * s + 7]));
          pf[kt][s] = __builtin_bit_cast(bf16x8, pp);
        }
      if (jt + 1 < ntiles) AGLOAD();
      const u16* vb = Vs + r * 72 + 8 * hh;
#pragma unroll
      for (int dt = 0; dt < 4; ++dt)
#pragma unroll
        for (int kt = 0; kt < 2; ++kt)
#pragma unroll
          for (int s = 0; s < 2; ++s) {
            bf16x8 vf = *(const bf16x8*)(vb + 32 * dt * 72 + 32 * kt + 16 * s);
            oacc[dt] = MFMA(vf, pf[kt][s], oacc[dt]);
            if (kt == 1 && s == 1) __builtin_amdgcn_sched_barrier(0);
          }
    }
  }
  if (ntw > 0 && r <= qclamp) {
    const float ltot = lrun + __shfl_xor(lrun, 32);
    const float inv = 1.f / ltot;
    u16* op = Ob + (long)(32 * w + r) * 1024;
#pragma unroll
    for (int dt = 0; dt < 4; ++dt)
#pragma unroll
      for (int i4 = 0; i4 < 4; ++i4) {
        const int d = 32 * dt + 8 * i4 + 4 * hh;
        *(uint2*)(op + d) = make_uint2(pk2(oacc[dt][4 * i4 + 0] * inv, oacc[dt][4 * i4 + 1] * inv), pk2(oacc[dt][4 * i4 + 2] * inv, oacc[dt][4 * i4 + 3] * inv));
      }
  } else if (ntw > 0) {
    (void)__shfl_xor(lrun, 32);
  }
}

DI void attn_phase(const Params& p, int l, char* smem, int* s_item, int cidx) {
  const int tid = get_tid(), w = tid >> 6;
  const int NITEM = 256 + 512;
  for (;;) {
    __syncthreads();
    if (tid == 0) *s_item = (int)atomicAdd(p.ctr + cidx, 1u);
    __syncthreads();
    const int item = *s_item;
    if (item >= NITEM) break;
    if (item < 256) {
      const int b = item >> 3, h = item & 7;
      const u16* Qb = p.Q + ((long)(M_P + 16 * b) * 8 + h) * 192;
      const u16* Kn = p.Kns + ((long)b * LKS * 8 + h) * 128;
      const u16* KR = p.KRs + (long)b * LKS * 64;
      const u16* VT = p.VTs + ((long)b * 8 + h) * 128 * LKS;
      u16* Ob = p.OA + (long)(M_P + 16 * b) * 1024 + h * 128;
      attn_item(Qb, 15, Kn, KR, VT, LKS, 65, w == 0 ? 65 : 0, LKV, Ob, smem);
    } else {
      const int idx = item - 256;
      const int qb = 63 - (idx >> 3), h = idx & 7;
      const u16* Qb = p.Q + ((long)(256 * qb) * 8 + h) * 192;
      const u16* Kn = p.Knp + (long)h * 128;
      const u16* KR = p.KRp;
      const u16* VT = p.VTp + (long)h * 128 * M_P;
      u16* Ob = p.OA + (long)(256 * qb) * 1024 + h * 128;
      const int ntiles = 4 * qb + 4;
      attn_item(Qb, 31, Kn, KR, VT, M_P, ntiles, 4 * qb + (w >> 1) + 1, 1 << 30, Ob, smem);
    }
  }
}

DI void gmlp_phase(const Params& p, int l, char* smem_all) {
  const int half = get_tid() >> 8; char* smem = smem_all + half * HALF_BYTES;
  const int tid = get_tid() & 255, lane = tid & 63, w = tid >> 6, wm = w >> 1, wn = w & 1, r = lane & 31, hh = lane >> 5;
  const float* gvn = p.gvn + l * 1024;
  const float* gws = p.gws + (long)l * 8 * 128 * 128;
  const float* gbs = p.gbs + (long)l * 8 * 128;
  u16* Xs = (u16*)smem;
  u16* Ws = Xs + 128 * 136;
  const int NP = 128 * 8, NS = 32 * 4;
  for (int t2 = get_bid(); t2 < (NP + NS + 1) / 2; t2 += gridDim.x) {
    const int t = 2 * t2 + half;
    const bool valid = t < NP + NS;
    const bool isp = valid && t < NP;
    {
      const int ci = t >> 3, g = t & 7;
      const int t0 = ci * 128, c0 = g * 128;
      __syncthreads();
      if (isp) {
#pragma unroll
      for (int i = 0; i < 8; ++i) {
        const int c = tid + 256 * i; const int s = c >> 4, dc = (c & 15) * 8;
        const uint4 v = *(const uint4*)(p.Z + (long)(t0 + s) * LDZ + ZV + c0 + dc);
        const float rs = p.rsv[t0 + s];
        const float4 g0 = *(const float4*)(gvn + c0 + dc), g1 = *(const float4*)(gvn + c0 + dc + 4);
        Xs[(dc + 0) * 136 + s] = f2bf(bflo(v.x) * rs * g0.x); Xs[(dc + 1) * 136 + s] = f2bf(bfhi(v.x) * rs * g0.y);
        Xs[(dc + 2) * 136 + s] = f2bf(bflo(v.y) * rs * g0.z); Xs[(dc + 3) * 136 + s] = f2bf(bfhi(v.y) * rs * g0.w);
        Xs[(dc + 4) * 136 + s] = f2bf(bflo(v.z) * rs * g1.x); Xs[(dc + 5) * 136 + s] = f2bf(bfhi(v.z) * rs * g1.y);
        Xs[(dc + 6) * 136 + s] = f2bf(bflo(v.w) * rs * g1.z); Xs[(dc + 7) * 136 + s] = f2bf(bfhi(v.w) * rs * g1.w);
        const int tt = c >> 4, sc = (c & 15) * 8;
        const float* wp = gws + ((long)g * 128 + tt) * 128 + sc;
        float4 a = *(const float4*)wp, b = *(const float4*)(wp + 4);
        a.x = (sc + 0 <= tt) ? a.x : 0.f; a.y = (sc + 1 <= tt) ? a.y : 0.f; a.z = (sc + 2 <= tt) ? a.z : 0.f; a.w = (sc + 3 <= tt) ? a.w : 0.f;
        b.x = (sc + 4 <= tt) ? b.x : 0.f; b.y = (sc + 5 <= tt) ? b.y : 0.f; b.z = (sc + 6 <= tt) ? b.z : 0.f; b.w = (sc + 7 <= tt) ? b.w : 0.f;
        *(uint4*)(Ws + tt * 136 + sc) = pack8(a, b);
      }
      }
      __syncthreads();
      if (isp) {
      f32x16 acc[2][2];
#pragma unroll
      for (int mi = 0; mi < 2; ++mi)
#pragma unroll
        for (int ni = 0; ni < 2; ++ni)
#pragma unroll
          for (int i = 0; i < 16; ++i) acc[mi][ni][i] = 0.f;
      const u16* Ab = Ws + (64 * wm + r) * 136 + 8 * hh;
      const u16* Bb = Xs + (64 * wn + r) * 136 + 8 * hh;
#pragma unroll
      for (int ks = 0; ks < 8; ++ks) {
        bf16x8 a0 = *(const bf16x8*)(Ab + 16 * ks), a1 = *(const bf16x8*)(Ab + 32 * 136 + 16 * ks);
        bf16x8 b0 = *(const bf16x8*)(Bb + 16 * ks), b1 = *(const bf16x8*)(Bb + 32 * 136 + 16 * ks);
        acc[0][0] = MFMA(b0, a0, acc[0][0]); acc[0][1] = MFMA(b1, a0, acc[0][1]);
        acc[1][0] = MFMA(b0, a1, acc[1][0]); acc[1][1] = MFMA(b1, a1, acc[1][1]);
      }
#pragma unroll
      for (int mi = 0; mi < 2; ++mi) {
        const int tl = 64 * wm + 32 * mi + r;
        const long row = t0 + tl;
        const float bias = gbs[g * 128 + tl];
        const u16* zr = p.Z + row * LDZ;
#pragma unroll
        for (int ni = 0; ni < 2; ++ni)
#pragma unroll
          for (int i4 = 0; i4 < 4; ++i4) {
            const int col = c0 + 64 * wn + 32 * ni + 8 * i4 + 4 * hh;
            const uint2 uu = *(const uint2*)(zr + ZU + col), ga = *(const uint2*)(zr + ZGA + col), gb = *(const uint2*)(zr + ZGB + col);
            const uint2 oa = *(const uint2*)(p.OA + row * 1024 + col);
            const float o0 = sigm(bflo(ga.x)) * bflo(oa.x) + sigm(bflo(gb.x)) * bflo(uu.x) * (acc[mi][ni][4 * i4 + 0] + bias);
            const float o1 = sigm(bfhi(ga.x)) * bfhi(oa.x) + sigm(bfhi(gb.x)) * bfhi(uu.x) * (acc[mi][ni][4 * i4 + 1] + bias);
            const float o2 = sigm(bflo(ga.y)) * bflo(oa.y) + sigm(bflo(gb.y)) * bflo(uu.y) * (acc[mi][ni][4 * i4 + 2] + bias);
            const float o3 = sigm(bfhi(ga.y)) * bfhi(oa.y) + sigm(bfhi(gb.y)) * bfhi(uu.y) * (acc[mi][ni][4 * i4 + 3] + bias);
            *(uint2*)(p.MIX + row * 1024 + col) = make_uint2(pk2(o0, o1), pk2(o2, o3));
          }
      }
      }
    }
    if (valid && !isp) {
      const int u = t - NP; const int b = u >> 2, col = (u & 3) * 256 + tid; const int g = col >> 7;
      const long row0 = M_P + 16 * b;
      const float gv = gvn[col];
      float vn[16];
#pragma unroll
      for (int s = 0; s < 16; ++s) vn[s] = bf1(p.Z[(row0 + s) * LDZ + ZV + col]) * p.rsv[row0 + s] * gv;
#pragma unroll
      for (int tt = 0; tt < 16; ++tt) {
        float mx = gbs[g * 128 + tt];
#pragma unroll
        for (int s = 0; s <= tt; ++s) mx += gws[((long)g * 128 + tt) * 128 + s] * vn[s];
        const u16* zr = p.Z + (row0 + tt) * LDZ;
        const float uu = bf1(zr[ZU + col]), ga = bf1(zr[ZGA + col]), gb = bf1(zr[ZGB + col]);
        const float oa = bf1(p.OA[(row0 + tt) * 1024 + col]);
        p.MIX[(row0 + tt) * 1024 + col] = f2bf(sigm(ga) * oa + sigm(gb) * uu * mx);
      }
    }
  }
}

#define XB_TMO      128
#define XB_XCNT(j)  (256  + 64 * (j))
#define XB_XSUB(j)  (1280 + 64 * (j))
#define XB_XGEN(j)  (2304 + 64 * (j))
#define XB_TOP      3328
#define XB_TOPGEN   3392
#define XCD_BAR_WORDS 3456
#define XB_SPIN_CAP (1u << 22)
#define LAS __attribute__((address_space(3)))
DI unsigned xb_ld(unsigned* p) { return __hip_atomic_load(p, __ATOMIC_RELAXED, __HIP_MEMORY_SCOPE_AGENT); }
DI unsigned xb_add(unsigned* p, unsigned v) { return __hip_atomic_fetch_add(p, v, __ATOMIC_RELAXED, __HIP_MEMORY_SCOPE_AGENT); }
DI unsigned xb_xcc_id() { return (unsigned)__builtin_amdgcn_s_getreg((3 << 11) | 20) & 0xFu; }
#define XB_SPIN(cond, bar) do { unsigned _sp = 0; while (cond) { __builtin_amdgcn_s_sleep(1); \
    if ((++_sp & 255u) == 0u) { if (xb_ld(&(bar)[XB_TMO])) break; if (_sp > XB_SPIN_CAP) { atomicAdd(&(bar)[XB_TMO], 1u); break; } } } } while (0)
struct XcdBarrier { unsigned* bar; unsigned x; volatile LAS unsigned* st; };
DI XcdBarrier xcd_barrier_post(unsigned* bar, volatile LAS unsigned* st) {
  XcdBarrier b; b.bar = bar; b.x = xb_xcc_id(); b.st = st;
  if (threadIdx.x == 0) (void)xb_add(&bar[XB_XCNT(b.x)], 1u);
  return b;
}
DI void xcd_barrier_complete(unsigned* bar, unsigned x, unsigned& nloc, unsigned& nx) {
  const unsigned G = gridDim.x * gridDim.y * gridDim.z;
  unsigned sum, cnt, mine, sp = 0u;
  for (;;) {
    sum = 0u; cnt = 0u; mine = 0u;
#pragma unroll
    for (unsigned j = 0; j < 16; ++j) { const unsigned c = xb_ld(&bar[XB_XCNT(j)]); sum += c; cnt += (c > 0u) ? 1u : 0u; mine = (j == x) ? c : mine; }
    if (sum == G) break;
    __builtin_amdgcn_s_sleep(1);
    if ((++sp & 255u) == 0u) { if (xb_ld(&bar[XB_TMO])) break; if (sp > XB_SPIN_CAP) { atomicAdd(&bar[XB_TMO], 1u); break; } }
  }
  nloc = mine > 0u ? mine : 1u; nx = cnt > 0u ? cnt : 1u;
}
DI void xcd_barrier(const XcdBarrier& b) {
  asm volatile("s_waitcnt vmcnt(0)" ::: "memory");
  __syncthreads();
  if (threadIdx.x == 0) {
    unsigned* bar = b.bar;
    __builtin_amdgcn_s_waitcnt(0);
    unsigned nloc = b.st[0], nx = b.st[1];
    if (nloc == 0u) { xcd_barrier_complete(bar, b.x, nloc, nx); b.st[0] = nloc; b.st[1] = nx; }
    const unsigned old = xb_add(&bar[XB_XSUB(b.x)], 1u);
    const unsigned gen = old / nloc;
    if (old + 1u == (gen + 1u) * nloc) {
      __builtin_amdgcn_fence(__ATOMIC_RELEASE, "agent");
      asm volatile("s_waitcnt vmcnt(0)" ::: "memory");
      const unsigned og = xb_add(&bar[XB_TOP], 1u);
      const unsigned tg = og / nx;
      if (og + 1u == (tg + 1u) * nx) xb_add(&bar[XB_TOPGEN], 1u);
      else XB_SPIN(xb_ld(&bar[XB_TOPGEN]) == tg, bar);
      __builtin_amdgcn_fence(__ATOMIC_ACQUIRE, "agent");
      xb_add(&bar[XB_XGEN(b.x)], 1u);
      asm volatile("s_waitcnt vmcnt(0)" ::: "memory");
    } else {
      XB_SPIN(xb_ld(&bar[XB_XGEN(b.x)]) == gen, bar);
      __builtin_amdgcn_fence(__ATOMIC_ACQUIRE, "agent");
      asm volatile("s_waitcnt vmcnt(0)" ::: "memory");
    }
  }
  __syncthreads();
}

__global__ void __launch_bounds__(512, 2) mega_fwd(Params p) {
  __shared__ __attribute__((aligned(16))) char smem[SMEM_BYTES];
  __shared__ int s_item;
  __shared__ uint4 xb_words;
  cg::grid_group grid = cg::this_grid();
  if (threadIdx.x == 0) xb_words = make_uint4(0u, 0u, 0u, 0u);
  __syncthreads();
  XcdBarrier xb = xcd_barrier_post(p.bar, (volatile LAS unsigned*)&xb_words);

  prep_phase(p, smem);
  grid.sync();
#ifdef PROBE_PREP
  prep_phase(p, smem);
  grid.sync();
#endif
#pragma unroll 1
  for (int l = 0; l < 2; ++l) {
    norm_phase(p.out, p.f1n + l * 1024, p.NB);
    xcd_barrier(xb);
    ffn_up_phase(p, p.Wgu1 + (long)l * 2 * DFF * 1024, smem);
    xcd_barrier(xb);
#ifdef PROBE_FFN
    ffn_up_phase(p, p.Wgu1 + (long)l * 2 * DFF * 1024, smem);
    xcd_barrier(xb);
#endif
    resid_gemm_phase(p, p.ACT, DFF, p.Wd1 + (long)l * 1024 * DFF, 0.5f, smem);
    xcd_barrier(xb);
    norm_phase(p.out, p.mixn + l * 1024, p.NB);
    xcd_barrier(xb);
    win_phase(p, p.Win + (long)l * LDZ * 1024, smem);
    xcd_barrier(xb);
    rowpost_phase(p, l);
    xcd_barrier(xb);
    multi_phase(p, l, smem);
    xcd_barrier(xb);
    attn_phase(p, l, smem, &s_item, l);
    xcd_barrier(xb);
#ifdef PROBE_ATTN
    attn_phase(p, l, smem, &s_item, 2 + l);
    xcd_barrier(xb);
#endif
#ifdef PROBE_MULTI
    multi_phase(p, l, smem);
    xcd_barrier(xb);
#endif
    gmlp_phase(p, l, smem);
    xcd_barrier(xb);
#ifdef PROBE_GMLP
    gmlp_phase(p, l, smem);
    xcd_barrier(xb);
#endif
#ifdef PROBE_ROWPOST
    rowpost_phase(p, l);
    xcd_barrier(xb);
#endif
    resid_gemm_phase(p, p.MIX, 1024, p.Wo + (long)l * 1024 * 1024, 1.0f, smem);
    xcd_barrier(xb);
    norm_phase(p.out, p.f2n + l * 1024, p.NB);
    xcd_barrier(xb);
    ffn_up_phase(p, p.Wgu2 + (long)l * 2 * DFF * 1024, smem);
    xcd_barrier(xb);
#ifdef PROBE_FFN
    ffn_up_phase(p, p.Wgu2 + (long)l * 2 * DFF * 1024, smem);
    xcd_barrier(xb);
#endif
    resid_gemm_phase(p, p.ACT, DFF, p.Wd2 + (long)l * 1024 * DFF, 0.5f, smem);
    xcd_barrier(xb);
    norm_phase(p.out, p.plen + l * 1024, p.NB);
    xcd_barrier(xb);
    ple_phase(p, p.Wpg + (long)l * 1024 * 1024, smem);
    xcd_barrier(xb);
  }
}

extern "C" void kernel_launch(void* const* d_in, const int* in_sizes, int n_in, void* d_out, int out_size, void* d_ws,
                              size_t ws_size, hipStream_t stream) {
  (void)in_sizes; (void)n_in; (void)out_size; (void)ws_size;
  Params p{};
  auto F = [&](int i) { return (const float*)d_in[i]; };
  p.x_prompt = F(0); p.x_sample = F(1); p.cache_c = F(2); p.cache_kr = F(3); p.p_prompt = F(4); p.p_sample = F(5);
  p.f1n = F(6); p.mixn = F(10); p.qan = F(12); p.qnn = F(14); p.qrn = F(15); p.kvan = F(16); p.krn = F(17);
  p.knn = F(20); p.gvn = F(21); p.gws = F(22); p.gbs = F(23); p.f2n = F(25); p.plen = F(29);
  p.out = (float*)d_out;
  char* ws = (char*)d_ws; size_t off = 0;
  auto alloc = [&](size_t bytes) { char* r = ws + off; off += (bytes + 255) & ~(size_t)255; return r; };
  p.Wgu1 = (u16*)alloc(2UL * 2 * DFF * 1024 * 2);
  p.Wd1 = (u16*)alloc(2UL * 1024 * DFF * 2);
  p.Win = (u16*)alloc(2UL * LDZ * 1024 * 2);
  p.Wuq = (u16*)alloc(2UL * 1536 * 384 * 2);
  p.Wkv = (u16*)alloc(2UL * 2048 * 512 * 2);
  p.Wo = (u16*)alloc(2UL * 1024 * 1024 * 2);
  p.Wgu2 = (u16*)alloc(2UL * 2 * DFF * 1024 * 2);
  p.Wd2 = (u16*)alloc(2UL * 1024 * DFF * 2);
  p.Wpg = (u16*)alloc(2UL * 1024 * 1024 * 2);
  p.Wpe = (u16*)alloc(2UL * 1024 * 256 * 2);
  p.NB = (u16*)alloc((size_t)M_ALL * 1024 * 2);
  p.ACT = (u16*)alloc((size_t)M_ALL * DFF * 2);
  p.Z = (u16*)alloc((size_t)M_ALL * LDZ * 2);
  p.QN = (u16*)alloc((size_t)M_ALL * 384 * 2);
  p.C = (u16*)alloc((size_t)M_ALL * 512 * 2);
  p.KRp = (u16*)alloc((size_t)M_P * 64 * 2);
  p.KRs = (u16*)alloc((size_t)32 * LKS * 64 * 2);
  p.Q = (u16*)alloc((size_t)M_ALL * 8 * 192 * 2);
  p.Knp = (u16*)alloc((size_t)M_P * 1024 * 2);
  p.VTp = (u16*)alloc((size_t)M_P * 1024 * 2);
  p.Kns = (u16*)alloc((size_t)32 * LKS * 1024 * 2);
  p.VTs = (u16*)alloc((size_t)32 * LKS * 1024 * 2);
  p.OA = (u16*)alloc((size_t)M_ALL * 1024 * 2);
  p.MIX = (u16*)alloc((size_t)M_ALL * 1024 * 2);
  p.PP = (u16*)alloc((size_t)M_ALL * 1024 * 2);
  p.CB = (u16*)alloc((size_t)32 * PAST * 512 * 2);
  p.PB = (u16*)alloc((size_t)M_ALL * 256 * 2);
  p.rsv = (float*)alloc((size_t)M_ALL * 4);
  p.rope = (float*)alloc((size_t)16384 * 32 * 2 * 4);
  p.ctr = (unsigned*)alloc(256);
  p.bar = (unsigned*)alloc(XCD_BAR_WORDS * 4);

  int nj = 0, ts = 0;
  auto job = [&](const float* src, u16* dst, int K, int N, int kind) {
    p.jobs[nj].src = src; p.jobs[nj].dst = dst; p.jobs[nj].K = K; p.jobs[nj].N = N; p.jobs[nj].kind = kind; p.jobs[nj].tstart = ts;
    ts += (K / 64) * (N / 64); ++nj;
  };
  for (int l = 0; l < 2; ++l) {
    job(F(7) + (size_t)l * 1024 * DFF, p.Wgu1 + (size_t)l * 2 * DFF * 1024, 1024, DFF, 1);
    job(F(8) + (size_t)l * 1024 * DFF, p.Wgu1 + (size_t)l * 2 * DFF * 1024, 1024, DFF, 2);
    job(F(9) + (size_t)l * DFF * 1024, p.Wd1 + (size_t)l * 1024 * DFF, DFF, 1024, 0);
    job(F(11) + (size_t)l * 1024 * DIN, p.Win + (size_t)l * LDZ * 1024, 1024, DIN, 0);
    job(F(13) + (size_t)l * 384 * 1536, p.Wuq + (size_t)l * 1536 * 384, 384, 1536, 3);
    job(F(18) + (size_t)l * 512 * 1024, p.Wkv + (size_t)l * 2048 * 512, 512, 1024, 0);
    job(F(19) + (size_t)l * 512 * 1024, p.Wkv + (size_t)l * 2048 * 512, 512, 1024, 4);
    job(F(24) + (size_t)l * 1024 * 1024, p.Wo + (size_t)l * 1024 * 1024, 1024, 1024, 0);
    job(F(26) + (size_t)l * 1024 * DFF, p.Wgu2 + (size_t)l * 2 * DFF * 1024, 1024, DFF, 1);
    job(F(27) + (size_t)l * 1024 * DFF, p.Wgu2 + (size_t)l * 2 * DFF * 1024, 1024, DFF, 2);
    job(F(28) + (size_t)l * DFF * 1024, p.Wd2 + (size_t)l * 1024 * DFF, DFF, 1024, 0);
    job(F(30) + (size_t)l * 1024 * 1024, p.Wpg + (size_t)l * 1024 * 1024, 1024, 1024, 0);
    job(F(31) + (size_t)l * 256 * 1024, p.Wpe + (size_t)l * 1024 * 256, 256, 1024, 0);
  }
  p.ntile_prep = ts;

  static int grid_blocks = 0;
  if (!grid_blocks) {
    int dev = 0, cus = 0, per_cu = 0;
    hipGetDevice(&dev);
    hipDeviceGetAttribute(&cus, hipDeviceAttributeMultiprocessorCount, dev);
    hipOccupancyMaxActiveBlocksPerMultiprocessor(&per_cu, (const void*)mega_fwd, 512, 0);
    if (per_cu > 1) per_cu = 1;
    if (per_cu < 1) per_cu = 1;
    grid_blocks = cus * per_cu;
  }
  (void)hipMemsetAsync(p.bar, 0, XCD_BAR_WORDS * 4, stream);
  void* args[] = {&p};
  hipError_t e = hipLaunchCooperativeKernel((const void*)mega_fwd, dim3(grid_blocks), dim3(512), args, 0, stream);
  if (e != hipSuccess) fprintf(stderr, "cooperative launch failed: %s (grid %d)\n", hipGetErrorString(e), grid_blocks);
}
```

```cpp
#include <hip/hip_runtime.h>
#include <hip/hip_cooperative_groups.h>
#include <cstdio>
namespace cg = cooperative_groups;

#define DI __device__ __forceinline__
typedef unsigned short u16;
typedef __attribute__((ext_vector_type(8))) short bf16x8;
typedef __attribute__((ext_vector_type(16))) float f32x16;
typedef __attribute__((ext_vector_type(2))) __bf16 bf2_t;
typedef __attribute__((ext_vector_type(2))) float f2_t;

#define M_P 16384
#define M_S 512
#define M_ALL 16896
#define DM 1024
#define DFF 2816
#define DIN 5056
#define LDZ 5120
#define ZQ 0
#define ZKV 384
#define ZKR 896
#define ZU 960
#define ZV 1984
#define ZGA 3008
#define ZGB 4032
#define LKS 4160
#define LKV 4112
#define PAST 4096
#define EPSF 1e-6f
#define QSCALE (0.07216878364870322f * 1.4426950408889634f)

#define NJOBS 26
struct TJob { const float* src; u16* dst; int K, N, kind, tstart; };

struct Params {
  const float *x_prompt, *x_sample, *cache_c, *cache_kr, *p_prompt, *p_sample;
  const float *f1n, *mixn, *qan, *qnn, *qrn, *kvan, *krn, *knn, *gvn, *gws, *gbs, *f2n, *plen;
  float* out;
  u16 *Wgu1, *Wd1, *Win, *Wuq, *Wkv, *Wo, *Wgu2, *Wd2, *Wpg, *Wpe;
  u16 *CB, *PB;
  u16 *NB, *ACT, *Z, *QN, *C, *KRp, *KRs, *Q, *Knp, *VTp, *Kns, *VTs, *OA, *MIX, *PP;
  float *rsv, *rope;
  unsigned* ctr;
  unsigned* bar;
  TJob jobs[NJOBS];
  int ntile_prep; int pad0;
};

DI int get_tid() { int t = threadIdx.x; asm volatile("" : "+v"(t)); return t; }
DI int get_bid() { int t = blockIdx.x; asm volatile("" : "+s"(t)); return t; }
DI unsigned pk2(float a, float b) { f2_t v = {a, b}; bf2_t r = __builtin_convertvector(v, bf2_t); return __builtin_bit_cast(unsigned, r); }
DI float bflo(unsigned v) { return __uint_as_float(v << 16); }
DI float bfhi(unsigned v) { return __uint_as_float(v & 0xffff0000u); }
DI float bf1(u16 v) { return __uint_as_float(((unsigned)v) << 16); }
DI u16 f2bf(float a) { return (u16)(pk2(a, 0.f) & 0xffffu); }
DI float wave_sum(float v) {
#pragma unroll
  for (int o = 32; o > 0; o >>= 1) v += __shfl_xor(v, o);
  return v;
}
DI float sigm(float x) { return 1.f / (1.f + __expf(-x)); }
DI uint4 pack8(float4 x, float4 y) { return make_uint4(pk2(x.x, x.y), pk2(x.z, x.w), pk2(y.x, y.y), pk2(y.z, y.w)); }
#define MFMA(a, b, c) __builtin_amdgcn_mfma_f32_32x32x16_bf16((a), (b), (c), 0, 0, 0)

#define HALF_BYTES (73728 + 1024)
#define SMEM_BYTES (2 * HALF_BYTES)

DI int job_dst_row(int kind, int n) {
  if (kind == 0) return n;
  if (kind == 1) return 64 * (n >> 5) + (n & 31);
  if (kind == 2) return 64 * (n >> 5) + 32 + (n & 31);
  if (kind == 3) { int h = n / 192, c = n - h * 192; return c < 128 ? h * 128 + c : 1024 + h * 64 + (c - 128); }
  return 1024 + n;
}

DI void prep_phase(const Params& p, char* smem) {
  const int tid = get_tid();
  {
    const int vt = tid & 255, half = tid >> 8;
    u16* Ts = (u16*)smem + half * (64 * 66);
    const int npair = (p.ntile_prep + 1) >> 1;
    for (int t2 = get_bid(); t2 < npair; t2 += gridDim.x) {
      const int t = 2 * t2 + half;
      const bool valid = t < p.ntile_prep;
      int j = 0;
#pragma unroll 1
      for (int q = 1; q < NJOBS; ++q) if (t >= p.jobs[q].tstart) j = q;
      const float* src = p.jobs[j].src; u16* dst = p.jobs[j].dst;
      const int K = p.jobs[j].K, N = p.jobs[j].N, kind = p.jobs[j].kind;
      const int lt = t - p.jobs[j].tstart;
      const int ntn = N >> 6;
      const int tk = lt / ntn, tn = lt - tk * ntn;
      const int k0 = tk * 64, n0 = tn * 64;
      __syncthreads();
      if (valid) {
#pragma unroll
        for (int i = 0; i < 4; ++i) {
          const int k = (vt >> 4) + 16 * i, nc = (vt & 15) * 4;
          float4 v = *(const float4*)(src + (long)(k0 + k) * N + n0 + nc);
          Ts[(nc + 0) * 66 + k] = f2bf(v.x); Ts[(nc + 1) * 66 + k] = f2bf(v.y);
          Ts[(nc + 2) * 66 + k] = f2bf(v.z); Ts[(nc + 3) * 66 + k] = f2bf(v.w);
        }
      }
      __syncthreads();
      if (valid) {
        const int n = vt >> 2, kc = (vt & 3) * 16;
        const unsigned* s32 = (const unsigned*)(Ts + n * 66 + kc);
        uint4 a = make_uint4(s32[0], s32[1], s32[2], s32[3]);
        uint4 b = make_uint4(s32[4], s32[5], s32[6], s32[7]);
        u16* d = dst + (long)job_dst_row(kind, n0 + n) * K + k0 + kc;
        *(uint4*)d = a; *(uint4*)(d + 8) = b;
      }
    }
  }
  const long gtid = (long)get_bid() * 512 + tid, gstride = (long)gridDim.x * 512;
  for (long e = gtid; e < 2L * 64 * 1024 / 8; e += gstride) {
    const int l = (int)(e / (64 * 1024 / 8)); const long r = e - (long)l * (64 * 1024 / 8);
    *(uint4*)(p.Win + (long)l * LDZ * 1024 + (long)DIN * 1024 + r * 8) = make_uint4(0, 0, 0, 0);
  }
  for (long e = gtid; e < 16384L * 32; e += gstride) {
    const int pos = (int)(e >> 5), i = (int)(e & 31);
    const float inv = powf(10000.0f, -(float)i / 32.0f);
    const float angf = (float)pos * inv;
    const double x = (double)angf;
    const double kq = rint(x * 0.63661977236758134308);
    const double y = (x - kq * 1.5707963267341256e+00) - kq * 6.0771005065061922e-11;
    const double y2 = y * y;
    const double s = y * (1.0 + y2 * (-1.0 / 6 + y2 * (1.0 / 120 + y2 * (-1.0 / 5040 + y2 * (1.0 / 362880 + y2 * (-1.0 / 39916800))))));
    const double c = 1.0 + y2 * (-0.5 + y2 * (1.0 / 24 + y2 * (-1.0 / 720 + y2 * (1.0 / 40320 + y2 * (-1.0 / 3628800 + y2 * (1.0 / 479001600))))));
    const int q = ((int)kq) & 3;
    double cc, ss;
    if (q == 0) { cc = c; ss = s; } else if (q == 1) { cc = -s; ss = c; } else if (q == 2) { cc = -c; ss = -s; } else { cc = s; ss = -c; }
    *(float2*)(p.rope + e * 2) = make_float2((float)cc, (float)ss);
  }
  for (long e = gtid; e < (long)M_ALL * 1024 / 4; e += gstride) {
    const long pe = (long)M_P * 1024 / 4;
    float4 v = e < pe ? ((const float4*)p.x_prompt)[e] : ((const float4*)p.x_sample)[e - pe];
    ((float4*)p.out)[e] = v;
  }
  if (get_bid() == 0 && tid < 16) p.ctr[tid] = 0u;
}

DI void norm_phase(const float* __restrict__ h, const float* __restrict__ g, u16* __restrict__ out) {
  const int tid = get_tid(); const int lane = tid & 63, w = tid >> 6;
  for (int row = get_bid() * 8 + w; row < M_ALL; row += gridDim.x * 8) {
    const float4* hr = (const float4*)(h + (long)row * 1024);
    float4 v[4]; float ss = 0.f;
#pragma unroll
    for (int i = 0; i < 4; ++i) { v[i] = hr[lane + 64 * i]; ss += v[i].x * v[i].x + v[i].y * v[i].y + v[i].z * v[i].z + v[i].w * v[i].w; }
    ss = wave_sum(ss);
    const float rs = rsqrtf(ss * (1.f / 1024.f) + EPSF);
#pragma unroll
    for (int i = 0; i < 4; ++i) {
      const float4 gg = ((const float4*)g)[lane + 64 * i];
      uint2 o = make_uint2(pk2(v[i].x * rs * gg.x, v[i].y * rs * gg.y), pk2(v[i].z * rs * gg.z, v[i].w * rs * gg.w));
      ((uint2*)(out + (long)row * 1024))[lane + 64 * i] = o;
    }
  }
}

struct TD { const char* A; const char* B; unsigned sa, sb; int nk; int pb; };
#define RED_OFF 73728

template <class Desc, class Epi>
DI void gemm_stream(int nloc, int nmax, Desc desc, Epi epi, char* smem_all) {
  const int tid = get_tid() & 255, lane = tid & 63, w = tid >> 6, wm = w >> 1, wn = w & 1, r = lane & 31, hh = lane >> 5;
  char* smem = smem_all + (get_tid() >> 8) * HALF_BYTES;
  u16* As = (u16*)smem;
  u16* Bs = As + 2 * 128 * 72;
  const int lrow = tid >> 3, lkc = (tid & 7) * 8;
  int ct = 0;
  if (nmax <= 0) return;
  TD ltd = desc(0);
  uint4 S0a0, S0a1, S0a2, S0a3, S0b0, S0b1, S0b2, S0b3, S1a0, S1a1, S1a2, S1a3, S1b0, S1b1, S1b2, S1b3;
#define LD1(dst, base, off) dst = *(const uint4*)((base) + (size_t)(off));
#define GLOADS(S, kk) { \
    const unsigned oa_ = lrow * ltd.sa + (unsigned)((kk) * 64 + lkc) * 2u, ob_ = lrow * ltd.sb + (unsigned)((kk) * 64 + lkc) * 2u; \
    LD1(S##a0, ltd.A, oa_) LD1(S##a1, ltd.A, oa_ + 32u * ltd.sa) LD1(S##a2, ltd.A, oa_ + 64u * ltd.sa) LD1(S##a3, ltd.A, oa_ + 96u * ltd.sa) \
    LD1(S##b0, ltd.B, ob_) LD1(S##b1, ltd.B, ob_ + 32u * ltd.sb) LD1(S##b2, ltd.B, ob_ + 64u * ltd.sb) LD1(S##b3, ltd.B, ob_ + 96u * ltd.sb) }
#define SST1(arr, src, i, buf) *(uint4*)(arr + ((buf) * 128 + lrow + 32 * (i)) * 72 + lkc) = src;
#define SSTORES(S, buf) { SST1(As, S##a0, 0, buf) SST1(As, S##a1, 1, buf) SST1(As, S##a2, 2, buf) SST1(As, S##a3, 3, buf) \
    SST1(Bs, S##b0, 0, buf) SST1(Bs, S##b1, 1, buf) SST1(Bs, S##b2, 2, buf) SST1(Bs, S##b3, 3, buf) }
#define COMPUTE(buf) { \
    const u16* Ab = As + ((buf) * 128 + 64 * wm + r) * 72 + 8 * hh; \
    const u16* Bb = Bs + ((buf) * 128 + 64 * wn + r) * 72 + 8 * hh; \
    _Pragma("unroll") for (int ks = 0; ks < 4; ++ks) { \
      bf16x8 a0 = *(const bf16x8*)(Ab + 16 * ks), a1 = *(const bf16x8*)(Ab + 32 * 72 + 16 * ks); \
      bf16x8 b0 = *(const bf16x8*)(Bb + 16 * ks), b1 = *(const bf16x8*)(Bb + 32 * 72 + 16 * ks); \
      acc[0][0] = MFMA(b0, a0, acc[0][0]); acc[0][1] = MFMA(b1, a0, acc[0][1]); \
      acc[1][0] = MFMA(b0, a1, acc[1][0]); acc[1][1] = MFMA(b1, a1, acc[1][1]); } }
#define SCHED_STEP() { \
    __builtin_amdgcn_sched_group_barrier(0x020, 8, 0); \
    __builtin_amdgcn_sched_group_barrier(0x100, 4, 0); \
    _Pragma("unroll") for (int q_ = 0; q_ < 4; ++q_) { __builtin_amdgcn_sched_group_barrier(0x008, 1, 0); __builtin_amdgcn_sched_group_barrier(0x100, 1, 0); } \
    _Pragma("unroll") for (int q_ = 0; q_ < 8; ++q_) { __builtin_amdgcn_sched_group_barrier(0x008, 1, 0); __builtin_amdgcn_sched_group_barrier(0x100, 1, 0); __builtin_amdgcn_sched_group_barrier(0x200, 1, 0); } \
    _Pragma("unroll") for (int q_ = 0; q_ < 4; ++q_) { __builtin_amdgcn_sched_group_barrier(0x008, 1, 0); } }

  GLOADS(S0, 0)
  GLOADS(S1, 1)
  SSTORES(S0, 0)
  __syncthreads();
#pragma unroll 1
  for (; ct < nmax; ++ct) {
    const int nk2 = ltd.nk >> 1;
    f32x16 acc[2][2];
#pragma unroll
    for (int mi = 0; mi < 2; ++mi)
#pragma unroll
      for (int ni = 0; ni < 2; ++ni)
#pragma unroll
        for (int i = 0; i < 16; ++i) acc[mi][ni][i] = 0.f;
#pragma unroll 1
    for (int k2 = 0; k2 < nk2; ++k2) {
      int kb = 2 * k2 + 2;
      if (k2 == nk2 - 1) { kb = 0; if (ct + 1 < nloc) ltd = desc(ct + 1); }
      GLOADS(S0, kb)
      COMPUTE(0)
      SSTORES(S1, 1)
      SCHED_STEP()
      __syncthreads();
      GLOADS(S1, kb + 1)
      COMPUTE(1)
      SSTORES(S0, 0)
      SCHED_STEP()
      __syncthreads();
    }
    if (ct < nloc) epi(ct, acc);
  }
#undef LD1
#undef GLOADS
#undef SST1
#undef SSTORES
#undef COMPUTE
#undef SCHED_STEP
}

template <class Desc, class Epi>
DI void gemm_stream8(int nloc, Desc desc, Epi epi, char* smem) {
  const int tid = get_tid(), lane = tid & 63, w = tid >> 6, wm = w >> 1, wn = w & 1, r = lane & 31, hh = lane >> 5;
  u16* As = (u16*)smem;
  u16* Bs = As + 2 * 256 * 72;
  const int lrow = tid >> 3, lkc = (tid & 7) * 8;
  const int lrowp = (lrow & ~12) | ((lrow & 4) << 1) | ((lrow & 8) >> 1);
  int ct = 0;
  if (nloc <= 0) return;
  TD ltd = desc(0);
  uint4 S0a0, S0a1, S0a2, S0a3, S0b0, S0b1, S0b2, S0b3;
#define LD1(dst, base, off) dst = *(const uint4*)((base) + (size_t)(off));
#define GLOADS(S, kk) { \
    const unsigned oa_ = lrow * ltd.sa + (unsigned)((kk) * 64 + lkc) * 2u, ob_ = (ltd.pb ? lrowp : lrow) * ltd.sb + (unsigned)((kk) * 64 + lkc) * 2u; \
    LD1(S##a0, ltd.A, oa_) LD1(S##a1, ltd.A, oa_ + 64u * ltd.sa) LD1(S##a2, ltd.A, oa_ + 128u * ltd.sa) LD1(S##a3, ltd.A, oa_ + 192u * ltd.sa) \
    LD1(S##b0, ltd.B, ob_) LD1(S##b1, ltd.B, ob_ + 64u * ltd.sb) LD1(S##b2, ltd.B, ob_ + 128u * ltd.sb) LD1(S##b3, ltd.B, ob_ + 192u * ltd.sb) }
#define SST1(arr, src, i, buf) *(uint4*)(arr + ((buf) * 256 + lrow + 64 * (i)) * 72 + lkc) = src;
#define SSTORES(S, buf) { SST1(As, S##a0, 0, buf) SST1(As, S##a1, 1, buf) SST1(As, S##a2, 2, buf) SST1(As, S##a3, 3, buf) \
    SST1(Bs, S##b0, 0, buf) SST1(Bs, S##b1, 1, buf) SST1(Bs, S##b2, 2, buf) SST1(Bs, S##b3, 3, buf) }
#define COMPUTE(buf) { \
    const u16* Ab = As + ((buf) * 256 + 64 * wm + r) * 72 + 8 * hh; \
    const u16* Bb = Bs + ((buf) * 256 + 128 * wn + r) * 72 + 8 * hh; \
    _Pragma("unroll") for (int ks = 0; ks < 4; ++ks) { \
      bf16x8 a0 = *(const bf16x8*)(Ab + 16 * ks), a1 = *(const bf16x8*)(Ab + 32 * 72 + 16 * ks); \
      bf16x8 b0 = *(const bf16x8*)(Bb + 16 * ks), b1 = *(const bf16x8*)(Bb + 32 * 72 + 16 * ks); \
      bf16x8 b2 = *(const bf16x8*)(Bb + 64 * 72 + 16 * ks), b3 = *(const bf16x8*)(Bb + 96 * 72 + 16 * ks); \
      acc[0][0] = MFMA(b0, a0, acc[0][0]); acc[0][1] = MFMA(b1, a0, acc[0][1]); acc[0][2] = MFMA(b2, a0, acc[0][2]); acc[0][3] = MFMA(b3, a0, acc[0][3]); \
      acc[1][0] = MFMA(b0, a1, acc[1][0]); acc[1][1] = MFMA(b1, a1, acc[1][1]); acc[1][2] = MFMA(b2, a1, acc[1][2]); acc[1][3] = MFMA(b3, a1, acc[1][3]); } }
#define SCHED_STEP() { \
    __builtin_amdgcn_sched_group_barrier(0x020, 8, 0); \
    __builtin_amdgcn_sched_group_barrier(0x100, 6, 0); \
    _Pragma("unroll") for (int q_ = 0; q_ < 18; ++q_) { __builtin_amdgcn_sched_group_barrier(0x008, 1, 0); __builtin_amdgcn_sched_group_barrier(0x100, 1, 0); } \
    _Pragma("unroll") for (int q_ = 0; q_ < 8; ++q_) { __builtin_amdgcn_sched_group_barrier(0x008, 1, 0); __builtin_amdgcn_sched_group_barrier(0x200, 1, 0); } \
    _Pragma("unroll") for (int q_ = 0; q_ < 6; ++q_) { __builtin_amdgcn_sched_group_barrier(0x008, 1, 0); } }

  GLOADS(S0, 0)
  SSTORES(S0, 0)
  __syncthreads();
#pragma unroll 1
  for (; ct < nloc; ++ct) {
    const int nk2 = ltd.nk >> 1;
    f32x16 acc[2][4];
#pragma unroll
    for (int mi = 0; mi < 2; ++mi)
#pragma unroll
      for (int ni = 0; ni < 4; ++ni)
#pragma unroll
        for (int i = 0; i < 16; ++i) acc[mi][ni][i] = 0.f;
#pragma unroll 1
    for (int k2 = 0; k2 < nk2; ++k2) {
      GLOADS(S0, 2 * k2 + 1)
      COMPUTE(0)
      SSTORES(S0, 1)
      __syncthreads();
      int kb = 2 * k2 + 2;
      if (k2 == nk2 - 1) { kb = 0; if (ct + 1 < nloc) ltd = desc(ct + 1); }
      GLOADS(S0, kb)
      COMPUTE(1)
      SSTORES(S0, 0)
      __syncthreads();
    }
    epi(ct, acc);
  }
#undef LD1
#undef GLOADS
#undef SST1
#undef SSTORES
#undef COMPUTE
#undef SCHED_STEP
}

template <class RowPtr>
DI void nope_epilogue8(f32x16 (&acc)[2][4], const float* __restrict__ gain, float scale, RowPtr rowptr) {
  const int tid = get_tid(), lane = tid & 63, w = tid >> 6, wm = w >> 1, r = lane & 31, hh = lane >> 5;
#pragma unroll
  for (int mi = 0; mi < 2; ++mi) {
    float s = 0.f;
#pragma unroll
    for (int ni = 0; ni < 4; ++ni)
#pragma unroll
      for (int i = 0; i < 16; ++i) s += acc[mi][ni][i] * acc[mi][ni][i];
    s += __shfl_xor(s, 32);
    const float rs = rsqrtf(s * (1.f / 128.f) + EPSF) * scale;
    u16* op = rowptr(64 * wm + 32 * mi + r);
#pragma unroll
    for (int ni = 0; ni < 4; ++ni)
#pragma unroll
      for (int g8 = 0; g8 < 2; ++g8) {
        const int c = 32 * ni + 16 * g8 + 8 * hh;
        const float4 ga = *(const float4*)(gain + c), gb = *(const float4*)(gain + c + 4);
        *(uint4*)(op + c) = make_uint4(pk2(acc[mi][ni][8 * g8 + 0] * rs * ga.x, acc[mi][ni][8 * g8 + 1] * rs * ga.y),
                                       pk2(acc[mi][ni][8 * g8 + 2] * rs * ga.z, acc[mi][ni][8 * g8 + 3] * rs * ga.w),
                                       pk2(acc[mi][ni][8 * g8 + 4] * rs * gb.x, acc[mi][ni][8 * g8 + 5] * rs * gb.y),
                                       pk2(acc[mi][ni][8 * g8 + 6] * rs * gb.z, acc[mi][ni][8 * g8 + 7] * rs * gb.w));
      }
  }
}

DI int tok_pos(int m) { return m < M_P ? m : PAST + ((m - M_P) & 15); }
DI int perm_pos(int key) {
  const int g4 = (key >> 2) & 3;
  const int pg = (g4 == 1) ? 2 : ((g4 == 2) ? 1 : g4);
  return (key & ~15) + 4 * pg;
}

template <class RowPtr>
DI void nope_epilogue(f32x16 (&acc)[2][2], const float* __restrict__ gain, float scale, char* smem, RowPtr rowptr) {
  const int tid = get_tid() & 255, lane = tid & 63, w = tid >> 6, wm = w >> 1, wn = w & 1, r = lane & 31, hh = lane >> 5;
  float* red = (float*)(smem + RED_OFF);
  float ss[2];
#pragma unroll
  for (int mi = 0; mi < 2; ++mi) {
    float s = 0.f;
#pragma unroll
    for (int ni = 0; ni < 2; ++ni)
#pragma unroll
      for (int i = 0; i < 16; ++i) s += acc[mi][ni][i] * acc[mi][ni][i];
    s += __shfl_xor(s, 32);
    ss[mi] = s;
    if (hh == 0) red[wn * 128 + 64 * wm + 32 * mi + r] = s;
  }
  __syncthreads();
#pragma unroll
  for (int mi = 0; mi < 2; ++mi) {
    const int m = 64 * wm + 32 * mi + r;
    const float tot = ss[mi] + red[(wn ^ 1) * 128 + m];
    const float rs = rsqrtf(tot * (1.f / 128.f) + EPSF) * scale;
    u16* op = rowptr(m);
#pragma unroll
    for (int ni = 0; ni < 2; ++ni)
#pragma unroll
      for (int i4 = 0; i4 < 4; ++i4) {
        const int c = 64 * wn + 32 * ni + 8 * i4 + 4 * hh;
        const float4 g = *(const float4*)(gain + c);
        uint2 o = make_uint2(pk2(acc[mi][ni][4 * i4 + 0] * rs * g.x, acc[mi][ni][4 * i4 + 1] * rs * g.y),
                             pk2(acc[mi][ni][4 * i4 + 2] * rs * g.z, acc[mi][ni][4 * i4 + 3] * rs * g.w));
        *(uint2*)(op + c) = o;
      }
  }
}

DI int nloc_plain(int total) { const int b = get_bid(), G = gridDim.x; return b < total ? (total - b + G - 1) / G : 0; }
DI void grouped_tile(int L, int nM, int nN, int& tm, int& tn) {
  const int nwg = nM * nN;
  const int q = nwg >> 3, rr = nwg & 7, xcd = L & 7, off = L >> 3;
  const int wgid = (xcd < rr ? xcd * (q + 1) : rr * (q + 1) + (xcd - rr) * q) + off;
  const int nig = 8 * nN, gid = wgid / nig, fm = gid * 8;
  const int gsz = (nM - fm) < 8 ? (nM - fm) : 8;
  const int rem = wgid - gid * nig;
  tm = fm + rem % gsz; tn = rem / gsz;
}
#define LANE_COORDS8 const int tid = get_tid(), lane = tid & 63, w = tid >> 6, wm = w >> 1, wn = w & 1, r = lane & 31, hh = lane >> 5; (void)wm; (void)wn; (void)r; (void)hh;

DI void ffn_up_phase(const Params& p, const u16* W, char* smem) {
  LANE_COORDS8
  const int NT = (2 * DFF) / 256;
  const int bid0 = get_bid(), G = gridDim.x;
  gemm_stream8(nloc_plain(66 * NT),
    [&](int k) { int tm, tn; grouped_tile(bid0 + k * G, 66, NT, tm, tn); TD d; d.A = (const char*)(p.NB + (long)tm * 256 * 1024); d.B = (const char*)(W + (long)tn * 256 * 1024); d.sa = 2048; d.sb = 2048; d.nk = 16; d.pb = 1; return d; },
    [&](int k, f32x16 (&acc)[2][4]) {
      int tm, tn; grouped_tile(bid0 + k * G, 66, NT, tm, tn);
#pragma unroll
      for (int mi = 0; mi < 2; ++mi) {
        const long m = (long)tm * 256 + 64 * wm + 32 * mi + r;
#pragma unroll
        for (int g2 = 0; g2 < 2; ++g2)
#pragma unroll
          for (int g8 = 0; g8 < 2; ++g8) {
            const int c = 128 * tn + 64 * wn + 32 * g2 + 16 * g8 + 8 * hh;
            float a[8];
#pragma unroll
            for (int j = 0; j < 8; ++j) { const float g = acc[mi][2 * g2][8 * g8 + j], u = acc[mi][2 * g2 + 1][8 * g8 + j]; a[j] = g * sigm(g) * u; }
            *(uint4*)(p.ACT + m * DFF + c) = make_uint4(pk2(a[0], a[1]), pk2(a[2], a[3]), pk2(a[4], a[5]), pk2(a[6], a[7]));
          }
      }
    }, smem);
}

DI void win_phase(const Params& p, const u16* W, char* smem) {
  LANE_COORDS8
  const int NT = LDZ / 256;
  const int bid0 = get_bid(), G = gridDim.x;
  gemm_stream8(nloc_plain(66 * NT),
    [&](int k) { int tm, tn; grouped_tile(bid0 + k * G, 66, NT, tm, tn); TD d; d.A = (const char*)(p.NB + (long)tm * 256 * 1024); d.B = (const char*)(W + (long)tn * 256 * 1024); d.sa = 2048; d.sb = 2048; d.nk = 16; d.pb = 1; return d; },
    [&](int k, f32x16 (&acc)[2][4]) {
      int tm, tn; grouped_tile(bid0 + k * G, 66, NT, tm, tn);
#pragma unroll
      for (int mi = 0; mi < 2; ++mi) {
        const long m = (long)tm * 256 + 64 * wm + 32 * mi + r;
#pragma unroll
        for (int ni = 0; ni < 4; ++ni)
#pragma unroll
          for (int g8 = 0; g8 < 2; ++g8) {
            const int n = tn * 256 + 128 * wn + 32 * ni + 16 * g8 + 8 * hh;
            *(uint4*)(p.Z + m * LDZ + n) = make_uint4(pk2(acc[mi][ni][8 * g8 + 0], acc[mi][ni][8 * g8 + 1]), pk2(acc[mi][ni][8 * g8 + 2], acc[mi][ni][8 * g8 + 3]),
                                                      pk2(acc[mi][ni][8 * g8 + 4], acc[mi][ni][8 * g8 + 5]), pk2(acc[mi][ni][8 * g8 + 6], acc[mi][ni][8 * g8 + 7]));
          }
      }
    }, smem);
}

#define LANE_COORDS4 const int tid = get_tid() & 255, lane = tid & 63, w = tid >> 6, wm = w >> 1, wn = w & 1, r = lane & 31, hh = lane >> 5; (void)wm; (void)wn; (void)r; (void)hh; \
  const int vb = 2 * get_bid() + (get_tid() >> 8), VG = 2 * gridDim.x; \
  const int nl_mine = vb < 132 * 8 ? (132 * 8 - vb + VG - 1) / VG : 0; const int nl_max = (2 * get_bid()) < 132 * 8 ? (132 * 8 - 2 * get_bid() + VG - 1) / VG : 0;

DI void resid_gemm_phase(const Params& p, const u16* A, int K, const u16* W, float alpha, char* smem) {
  LANE_COORDS4
  gemm_stream(nl_mine, nl_max,
    [&](int k) { const int t = vb + k * VG; const int tm = t >> 3, tn = t & 7; TD d; d.A = (const char*)(A + (long)tm * 128 * K); d.B = (const char*)(W + (long)tn * 128 * K); d.sa = 2 * K; d.sb = 2 * K; d.nk = K >> 6; d.pb = 0; return d; },
    [&](int k, f32x16 (&acc)[2][2]) {
      const int t = vb + k * VG; const int tm = t >> 3, tn = t & 7;
#pragma unroll
      for (int mi = 0; mi < 2; ++mi) {
        const long m = (long)tm * 128 + 64 * wm + 32 * mi + r;
#pragma unroll
        for (int ni = 0; ni < 2; ++ni)
#pragma unroll
          for (int i4 = 0; i4 < 4; ++i4) {
            const int n = tn * 128 + 64 * wn + 32 * ni + 8 * i4 + 4 * hh;
            float4* hp = (float4*)(p.out + m * 1024 + n);
            float4 v = *hp;
            v.x += alpha * acc[mi][ni][4 * i4 + 0]; v.y += alpha * acc[mi][ni][4 * i4 + 1];
            v.z += alpha * acc[mi][ni][4 * i4 + 2]; v.w += alpha * acc[mi][ni][4 * i4 + 3];
            *hp = v;
          }
      }
    }, smem);
}

DI void ple_phase(const Params& p, const u16* W, char* smem) {
  LANE_COORDS4
  gemm_stream(nl_mine, nl_max,
    [&](int k) { const int t = vb + k * VG; const int tm = t >> 3, tn = t & 7; TD d; d.A = (const char*)(p.NB + (long)tm * 128 * 1024); d.B = (const char*)(W + (long)tn * 128 * 1024); d.sa = 2048; d.sb = 2048; d.nk = 16; d.pb = 1; return d; },
    [&](int k, f32x16 (&acc)[2][2]) {
      const int t = vb + k * VG; const int tm = t >> 3, tn = t & 7;
#pragma unroll
      for (int mi = 0; mi < 2; ++mi) {
        const long m = (long)tm * 128 + 64 * wm + 32 * mi + r;
#pragma unroll
        for (int ni = 0; ni < 2; ++ni)
#pragma unroll
          for (int i4 = 0; i4 < 4; ++i4) {
            const int n = tn * 128 + 64 * wn + 32 * ni + 8 * i4 + 4 * hh;
            float4* hp = (float4*)(p.out + m * 1024 + n);
            const uint2 pp = *(const uint2*)(p.PP + m * 1024 + n);
            float4 v = *hp;
            v.x += sigm(acc[mi][ni][4 * i4 + 0]) * bflo(pp.x); v.y += sigm(acc[mi][ni][4 * i4 + 1]) * bfhi(pp.x);
            v.z += sigm(acc[mi][ni][4 * i4 + 2]) * bflo(pp.y); v.w += sigm(acc[mi][ni][4 * i4 + 3]) * bfhi(pp.y);
            *hp = v;
          }
      }
    }, smem);
}

DI void rowpost_phase(const Params& p, int l) {
  const int tid = get_tid(); const int lane = tid & 63, w = tid >> 6;
  const float* qan = p.qan + l * 384; const float* kvan = p.kvan + l * 512; const float* krn = p.krn + l * 64; const float* gvn = p.gvn + l * 1024;
  float* o_pkv = p.out + 17301504L + (long)l * M_P * 512;
  float* o_pkr = p.out + 34078720L + (long)l * M_P * 64;
  float* o_skv = p.out + 36175872L + (long)l * M_S * 512;
  float* o_skr = p.out + 36700160L + (long)l * M_S * 64;
  float* o_sgv = p.out + 36765696L + (long)l * M_S * 1024;
  for (int row = get_bid() * 8 + w; row < M_ALL; row += gridDim.x * 8) {
    const u16* zr = p.Z + (long)row * LDZ;
    const bool is_s = row >= M_P; const int rs_ = row - M_P;
    {
      unsigned v[3]; float ss = 0.f;
#pragma unroll
      for (int i = 0; i < 3; ++i) { v[i] = *(const unsigned*)(zr + ZQ + 2 * lane + 128 * i); const float a = bflo(v[i]), b = bfhi(v[i]); ss += a * a + b * b; }
      ss = wave_sum(ss);
      const float rs = rsqrtf(ss * (1.f / 384.f) + EPSF);
#pragma unroll
      for (int i = 0; i < 3; ++i) {
        const int c = 2 * lane + 128 * i; const float2 g = *(const float2*)(qan + c);
        *(unsigned*)(p.QN + (long)row * 384 + c) = pk2(bflo(v[i]) * rs * g.x, bfhi(v[i]) * rs * g.y);
      }
    }
    {
      const uint4 v = *(const uint4*)(zr + ZKV + 8 * lane);
      float x[8] = {bflo(v.x), bfhi(v.x), bflo(v.y), bfhi(v.y), bflo(v.z), bfhi(v.z), bflo(v.w), bfhi(v.w)};
      float ss = 0.f;
#pragma unroll
      for (int i = 0; i < 8; ++i) ss += x[i] * x[i];
      ss = wave_sum(ss);
      const float rs = rsqrtf(ss * (1.f / 512.f) + EPSF);
      const float4 g0 = *(const float4*)(kvan + 8 * lane), g1 = *(const float4*)(kvan + 8 * lane + 4);
      float4 y0 = make_float4(x[0] * rs * g0.x, x[1] * rs * g0.y, x[2] * rs * g0.z, x[3] * rs * g0.w);
      float4 y1 = make_float4(x[4] * rs * g1.x, x[5] * rs * g1.y, x[6] * rs * g1.z, x[7] * rs * g1.w);
      float* od = is_s ? (o_skv + (long)rs_ * 512) : (o_pkv + (long)row * 512);
      *(float4*)(od + 8 * lane) = y0; *(float4*)(od + 8 * lane + 4) = y1;
      *(uint4*)(p.C + (long)row * 512 + 8 * lane) = pack8(y0, y1);
    }
    {
      const float x = bf1(zr[ZKR + lane]);
      const float ss = wave_sum(x * x);
      const float rs = rsqrtf(ss * (1.f / 64.f) + EPSF);
      const float y = x * rs * krn[lane];
      const float other = __shfl_xor(y, 32);
      const int pos = tok_pos(row);
      const float2 cs = *(const float2*)(p.rope + ((long)pos * 32 + (lane & 31)) * 2);
      const float o = lane < 32 ? (y * cs.x - other * cs.y) : (other * cs.y + y * cs.x);
      if (is_s) {
        o_skr[(long)rs_ * 64 + lane] = o;
        p.KRs[((long)(rs_ >> 4) * LKS + PAST + (rs_ & 15)) * 64 + lane] = f2bf(o);
      } else {
        o_pkr[(long)row * 64 + lane] = o;
        p.KRp[(long)row * 64 + lane] = f2bf(o);
      }
    }
    {
      uint4 v[2]; float ss = 0.f;
#pragma unroll
      for (int i = 0; i < 2; ++i) {
        v[i] = *(const uint4*)(zr + ZV + 8 * lane + 512 * i);
        const float x[8] = {bflo(v[i].x), bfhi(v[i].x), bflo(v[i].y), bfhi(v[i].y), bflo(v[i].z), bfhi(v[i].z), bflo(v[i].w), bfhi(v[i].w)};
#pragma unroll
        for (int j = 0; j < 8; ++j) ss += x[j] * x[j];
      }
      ss = wave_sum(ss);
      const float rs = rsqrtf(ss * (1.f / 1024.f) + EPSF);
      if (lane == 0) p.rsv[row] = rs;
      if (is_s) {
#pragma unroll
        for (int i = 0; i < 2; ++i) {
          const int c = 8 * lane + 512 * i;
          const float x[8] = {bflo(v[i].x), bfhi(v[i].x), bflo(v[i].y), bfhi(v[i].y), bflo(v[i].z), bfhi(v[i].z), bflo(v[i].w), bfhi(v[i].w)};
          const float4 g0 = *(const float4*)(gvn + c), g1 = *(const float4*)(gvn + c + 4);
          *(float4*)(o_sgv + (long)rs_ * 1024 + c) = make_float4(x[0] * rs * g0.x, x[1] * rs * g0.y, x[2] * rs * g0.z, x[3] * rs * g0.w);
          *(float4*)(o_sgv + (long)rs_ * 1024 + c + 4) = make_float4(x[4] * rs * g1.x, x[5] * rs * g1.y, x[6] * rs * g1.z, x[7] * rs * g1.w);
        }
      }
    }
  }
  {
    const float* cc = p.cache_c + (long)l * 32 * PAST * 512;
    const long gt = (long)get_bid() * 512 + tid, gs = (long)gridDim.x * 512;
    for (long e = gt; e < 32L * PAST * 512 / 8; e += gs) {
      const float4 a = *(const float4*)(cc + e * 8), c = *(const float4*)(cc + e * 8 + 4);
      *(uint4*)(p.CB + e * 8) = pack8(a, c);
    }
    const float* pp = p.p_prompt + (long)l * M_P * 256; const float* ps = p.p_sample + (long)l * M_S * 256;
    for (long e = gt; e < (long)M_ALL * 256 / 8; e += gs) {
      const long pe = (long)M_P * 256 / 8;
      const float* src = e < pe ? (pp + e * 8) : (ps + (e - pe) * 8);
      *(uint4*)(p.PB + e * 8) = pack8(*(const float4*)src, *(const float4*)(src + 4));
    }
  }
  const float* ckr = p.cache_kr + (long)l * 32 * PAST * 64;
  const long gtid = (long)get_bid() * 512 + tid, gstride = (long)gridDim.x * 512;
  for (long e = gtid; e < 32L * PAST * 64 / 8; e += gstride) {
    const long el = e * 8; const int b = (int)(el / (PAST * 64)); const long rem = el - (long)b * PAST * 64;
    const float4 a = *(const float4*)(ckr + el), c = *(const float4*)(ckr + el + 4);
    *(uint4*)(p.KRs + (long)b * LKS * 64 + rem) = pack8(a, c);
  }
}

#define NCKV (512 * 8)
#define NPKV (64 * 8)
#define NSKV (2 * 8)
#define NQT (66 * 6)
#define NPPT (66 * 4)
DI void multi_phase(const Params& p, int l, char* smem) {
  LANE_COORDS8
  const u16* Wkv = p.Wkv + (long)l * 2048 * 512;
  const u16* Wuq = p.Wuq + (long)l * 1536 * 384;
  const u16* Wpe = p.Wpe + (long)l * 1024 * 256;
  const int total = NCKV + NPKV + NSKV + NQT + NPPT;
  const int bid0 = get_bid(), G = gridDim.x;
  gemm_stream8(nloc_plain(total),
    [&](int k) {
      const int t = bid0 + k * G;
      TD d;
      if (t < NCKV + NPKV + NSKV) {
        const u16* tok; int u = t;
        if (u < NCKV) tok = p.CB + (long)(u >> 3) * 256 * 512;
        else if ((u -= NCKV) < NPKV) tok = p.C + (long)(u >> 3) * 256 * 512;
        else { u -= NPKV; tok = p.C + ((long)M_P + (u >> 3) * 256) * 512; }
        const int tn = u & 7;
        const u16* wgt = Wkv + (long)tn * 256 * 512;
        d.A = (const char*)(tn < 4 ? tok : wgt); d.B = (const char*)(tn < 4 ? wgt : tok); d.sa = 1024; d.sb = 1024; d.nk = 8; d.pb = tn < 4 ? 1 : 0;
      } else {
        int u = t - (NCKV + NPKV + NSKV);
        if (u < NQT) { const int tm = u / 6, tn = u - tm * 6; d.A = (const char*)(p.QN + (long)tm * 256 * 384); d.B = (const char*)(Wuq + (long)tn * 256 * 384); d.sa = 768; d.sb = 768; d.nk = 6; d.pb = 1; }
        else { u -= NQT; const int tm = u >> 2, tn = u & 3; d.A = (const char*)(p.PB + (long)tm * 256 * 256); d.B = (const char*)(Wpe + (long)tn * 256 * 256); d.sa = 512; d.sb = 512; d.nk = 4; d.pb = 1; }
      }
      return d;
    },
    [&](int k, f32x16 (&acc)[2][4]) {
      const int t = bid0 + k * G;
      if (t < NCKV + NPKV + NSKV) {
        int mode, u = t;
        if (u < NCKV) mode = 1; else if ((u -= NCKV) < NPKV) mode = 0; else { u -= NPKV; mode = 2; }
        const int m0 = (u >> 3) * 256, tn = u & 7;
        if (tn < 4) {
          const int h = 2 * tn + wn;
          nope_epilogue8(acc, p.knn + l * 128, 1.0f, [&](int mloc) -> u16* {
            const int m = m0 + mloc;
            if (mode == 0) return p.Knp + ((long)m * 8 + h) * 128;
            long key;
            if (mode == 1) key = (long)(m >> 12) * LKS + (m & 4095); else key = (long)(m >> 4) * LKS + PAST + (m & 15);
            return p.Kns + (key * 8 + h) * 128;
          });
        } else {
          const int h = 2 * (tn - 4) + (wm >> 1);
          const long dstride = (mode == 0) ? (long)M_P : (long)LKS;
#pragma unroll
          for (int ni = 0; ni < 4; ++ni)
#pragma unroll
            for (int g8 = 0; g8 < 2; ++g8) {
              const int m = m0 + 128 * wn + 32 * ni + 16 * g8;
              u16* base;
              if (mode == 0) base = p.VTp + (long)h * 128 * M_P + m + 8 * hh;
              else {
                int b, key;
                if (mode == 1) { b = m >> 12; key = m & 4095; } else { b = m >> 4; key = PAST + (m & 15); }
                base = p.VTs + ((long)b * 8 + h) * 128 * LKS + key + 8 * hh;
              }
#pragma unroll
              for (int mi = 0; mi < 2; ++mi) {
                const int dd = 64 * (wm & 1) + 32 * mi + r;
                *(uint4*)(base + (long)dd * dstride) = make_uint4(pk2(acc[mi][ni][8 * g8 + 0], acc[mi][ni][8 * g8 + 1]), pk2(acc[mi][ni][8 * g8 + 2], acc[mi][ni][8 * g8 + 3]),
                                                                  pk2(acc[mi][ni][8 * g8 + 4], acc[mi][ni][8 * g8 + 5]), pk2(acc[mi][ni][8 * g8 + 6], acc[mi][ni][8 * g8 + 7]));
              }
            }
        }
        return;
      }
      int u = t - (NCKV + NPKV + NSKV);
      if (u < NQT) {
        const int tm = u / 6, tn = u - tm * 6;
        if (tn < 4) {
          const int h = 2 * tn + wn;
          nope_epilogue8(acc, p.qnn + l * 128, QSCALE, [&](int mloc) -> u16* { return p.Q + ((long)(tm * 256 + mloc) * 8 + h) * 192; });
        } else {
          const float* g = p.qrn + l * 64;
#pragma unroll
          for (int mi = 0; mi < 2; ++mi) {
            const int m = tm * 256 + 64 * wm + 32 * mi + r;
            const int pos = tok_pos(m);
#pragma unroll
            for (int g2 = 0; g2 < 2; ++g2) {
              const int head = 4 * (tn - 4) + 2 * wn + g2;
              float s = 0.f;
#pragma unroll
              for (int i = 0; i < 16; ++i) s += acc[mi][2 * g2][i] * acc[mi][2 * g2][i] + acc[mi][2 * g2 + 1][i] * acc[mi][2 * g2 + 1][i];
              s += __shfl_xor(s, 32);
              const float rs = rsqrtf(s * (1.f / 64.f) + EPSF);
              u16* qp = p.Q + ((long)m * 8 + head) * 192 + 128;
#pragma unroll
              for (int g8 = 0; g8 < 2; ++g8) {
                const int cc = 16 * g8 + 8 * hh;
                const float* tp = p.rope + ((long)pos * 32 + cc) * 2;
                float o1[8], o2[8];
#pragma unroll
                for (int jj = 0; jj < 4; ++jj) {
                  const float4 t0 = *(const float4*)(tp + 4 * jj);
                  const float2 ga = *(const float2*)(g + cc + 2 * jj), gb = *(const float2*)(g + 32 + cc + 2 * jj);
                  const float y1a = acc[mi][2 * g2][8 * g8 + 2 * jj] * rs * ga.x, y2a = acc[mi][2 * g2 + 1][8 * g8 + 2 * jj] * rs * gb.x;
                  const float y1b = acc[mi][2 * g2][8 * g8 + 2 * jj + 1] * rs * ga.y, y2b = acc[mi][2 * g2 + 1][8 * g8 + 2 * jj + 1] * rs * gb.y;
                  o1[2 * jj] = (y1a * t0.x - y2a * t0.y) * QSCALE; o2[2 * jj] = (y1a * t0.y + y2a * t0.x) * QSCALE;
                  o1[2 * jj + 1] = (y1b * t0.z - y2b * t0.w) * QSCALE; o2[2 * jj + 1] = (y1b * t0.w + y2b * t0.z) * QSCALE;
                }
                *(uint4*)(qp + cc) = make_uint4(pk2(o1[0], o1[1]), pk2(o1[2], o1[3]), pk2(o1[4], o1[5]), pk2(o1[6], o1[7]));
                *(uint4*)(qp + 32 + cc) = make_uint4(pk2(o2[0], o2[1]), pk2(o2[2], o2[3]), pk2(o2[4], o2[5]), pk2(o2[6], o2[7]));
              }
            }
          }
        }
        return;
      }
      u -= NQT;
      {
        const int tm = u >> 2, tn = u & 3;
#pragma unroll
        for (int mi = 0; mi < 2; ++mi) {
          const long m = (long)tm * 256 + 64 * wm + 32 * mi + r;
#pragma unroll
          for (int ni = 0; ni < 4; ++ni)
#pragma unroll
            for (int g8 = 0; g8 < 2; ++g8) {
              const int n = tn * 256 + 128 * wn + 32 * ni + 16 * g8 + 8 * hh;
              *(uint4*)(p.PP + m * 1024 + n) = make_uint4(pk2(acc[mi][ni][8 * g8 + 0], acc[mi][ni][8 * g8 + 1]), pk2(acc[mi][ni][8 * g8 + 2], acc[mi][ni][8 * g8 + 3]),
                                                          pk2(acc[mi][ni][8 * g8 + 4], acc[mi][ni][8 * g8 + 5]), pk2(acc[mi][ni][8 * g8 + 6], acc[mi][ni][8 * g8 + 7]));
            }
        }
      }
    }, smem);
}

DI void attn_item(const u16* __restrict__ Qb, int qclamp, const u16* __restrict__ Kn, const u16* __restrict__ KR,
                  const u16* __restrict__ VT, long vt_stride, int ntiles, int ntw, int Lk, u16* __restrict__ Ob, char* smem) {
  const int tid = get_tid(), lane = tid & 63, w = tid >> 6, r = lane & 31, hh = lane >> 5;
  u16* Ks = (u16*)smem;
  u16* Vs = Ks + 64 * 200;
  bf16x8 qf[12];
  {
    const int qr = r < qclamp ? r : qclamp;
    const u16* qp = Qb + (long)(32 * w + qr) * (8 * 192) + 8 * hh;
#pragma unroll
    for (int ks = 0; ks < 12; ++ks) qf[ks] = *(const bf16x8*)(qp + 16 * ks);
  }
  f32x16 oacc[4];
#pragma unroll
  for (int dt = 0; dt < 4; ++dt)
#pragma unroll
    for (int i = 0; i < 16; ++i) oacc[dt][i] = 0.f;
  float mrun = -INFINITY, lrun = 0.f;

  uint4 rk0, rk1, rk2, rv0, rv1;
  const int lkey = tid >> 3, lq = tid & 7;
  unsigned koff = (unsigned)(lkey * 1024 + lq * 8) * 2u;
  unsigned kroff = (unsigned)(lkey * 64 + lq * 8) * 2u;
  const unsigned vstep = (unsigned)(64 * vt_stride * 2);
  unsigned voff = (unsigned)(lkey * vt_stride * 2 + lq * 16);
  const char* KnB = (const char*)Kn; const char* KRB = (const char*)KR; const char* VTB = (const char*)VT;
  char* KsW = (char*)Ks + lkey * 400 + lq * 16;
  char* VsW = (char*)Vs + lkey * 144 + lq * 16;
#define AGLOAD() { \
    rk0 = *(const uint4*)(KnB + (size_t)koff); rk1 = *(const uint4*)(KnB + (size_t)koff + 128); \
    rk2 = *(const uint4*)(KRB + (size_t)kroff); \
    rv0 = *(const uint4*)(VTB + (size_t)voff); rv1 = *(const uint4*)(VTB + (size_t)(voff + vstep)); \
    koff += 64 * 1024 * 2; kroff += 64 * 64 * 2; voff += 128; }
#define ASTORE() { \
    *(uint4*)(KsW) = rk0; *(uint4*)(KsW + 128) = rk1; *(uint4*)(KsW + 256) = rk2; \
    *(uint4*)(VsW) = rv0; *(uint4*)(VsW + 64 * 144) = rv1; }

  AGLOAD();
#pragma unroll 1
  for (int jt = 0; jt < ntiles; ++jt) {
    __syncthreads();
    ASTORE();
    __syncthreads();
    if (jt >= ntw) { if (jt + 1 < ntiles) AGLOAD(); }
    if (jt < ntw) {
      f32x16 sacc[2];
#pragma unroll
      for (int kt = 0; kt < 2; ++kt)
#pragma unroll
        for (int i = 0; i < 16; ++i) sacc[kt][i] = 0.f;
      const u16* kb = Ks + r * 200 + 8 * hh;
#pragma unroll
      for (int ks = 0; ks < 12; ++ks) {
        bf16x8 k0 = *(const bf16x8*)(kb + 16 * ks);
        bf16x8 k1 = *(const bf16x8*)(kb + 32 * 200 + 16 * ks);
        sacc[0] = MFMA(k0, qf[ks], sacc[0]);
        sacc[1] = MFMA(k1, qf[ks], sacc[1]);
        if ((ks & 3) == 3) __builtin_amdgcn_sched_barrier(0);
      }
      if ((jt + 1) * 64 > Lk) {
#pragma unroll
        for (int kt = 0; kt < 2; ++kt)
#pragma unroll
          for (int i = 0; i < 16; ++i) {
            const int key = jt * 64 + 32 * kt + (i & 3) + 8 * (i >> 2) + 4 * hh;
            if (key >= Lk) sacc[kt][i] = -INFINITY;
          }
      }
      float tmax = -INFINITY;
#pragma unroll
      for (int kt = 0; kt < 2; ++kt)
#pragma unroll
        for (int i = 0; i < 16; ++i) tmax = fmaxf(tmax, sacc[kt][i]);
      tmax = fmaxf(tmax, __shfl_xor(tmax, 32));
      const float mnew = fmaxf(mrun, tmax);
      const float alpha = __builtin_amdgcn_exp2f(mrun - mnew);
      mrun = mnew;
      float psum = 0.f;
#pragma unroll
      for (int kt = 0; kt < 2; ++kt)
#pragma unroll
        for (int i = 0; i < 16; ++i) { const float pv = __builtin_amdgcn_exp2f(sacc[kt][i] - mnew); sacc[kt][i] = pv; psum += pv; }
      lrun = lrun * alpha + psum;
#pragma unroll
      for (int dt = 0; dt < 4; ++dt)
#pragma unroll
        for (int i = 0; i < 16; ++i) oacc[dt][i] *= alpha;
      bf16x8 pf[2][2];
#pragma unroll
      for (int kt = 0; kt < 2; ++kt)
#pragma unroll
        for (int s = 0; s < 2; ++s) {
          uint4 pp = make_uint4(pk2(sacc[kt][8 * s + 0], sacc[kt][8 * s + 1]), pk2(sacc[kt][8 * s + 2], sacc[kt][8 * s + 3]),
                                pk2(sacc[kt][8 * s + 4], sacc[kt][8 * s + 5]), pk2(sacc[kt][8 * s + 6], sacc[kt][8 * s + 7]));
          pf[kt][s] = __builtin_bit_cast(bf16x8, pp);
        }
      if (jt + 1 < ntiles) AGLOAD();
      const u16* vb = Vs + r * 72 + 8 * hh;
#pragma unroll
      for (int dt = 0; dt < 4; ++dt)
#pragma unroll
        for (int kt = 0; kt < 2; ++kt)
#pragma unroll
          for (int s = 0; s < 2; ++s) {
            bf16x8 vf = *(const bf16x8*)(vb + 32 * dt * 72 + 32 * kt + 16 * s);
            oacc[dt] = MFMA(vf, pf[kt][s], oacc[dt]);
            if (kt == 1 && s == 1) __builtin_amdgcn_sched_barrier(0);
          }
    }
  }
  if (ntw > 0 && r <= qclamp) {
    const float ltot = lrun + __shfl_xor(lrun, 32);
    const float inv = 1.f / ltot;
    u16* op = Ob + (long)(32 * w + r) * 1024;
#pragma unroll
    for (int dt = 0; dt < 4; ++dt)
#pragma unroll
      for (int i4 = 0; i4 < 4; ++i4) {
        const int d = 32 * dt + 8 * i4 + 4 * hh;
        *(uint2*)(op + d) = make_uint2(pk2(oacc[dt][4 * i4 + 0] * inv, oacc[dt][4 * i4 + 1] * inv), pk2(oacc[dt][4 * i4 + 2] * inv, oacc[dt][4 * i4 + 3] * inv));
      }
  } else if (ntw > 0) {
    (void)__shfl_xor(lrun, 32);
  }
}

DI void attn_phase(const Params& p, int l, char* smem, int* s_item, int cidx) {
  const int tid = get_tid(), w = tid >> 6;
  const int NITEM = 256 + 512;
  for (;;) {
    __syncthreads();
    if (tid == 0) *s_item = (int)atomicAdd(p.ctr + cidx, 1u);
    __syncthreads();
    const int item = *s_item;
    if (item >= NITEM) break;
    if (item < 256) {
      const int b = item >> 3, h = item & 7;
      const u16* Qb = p.Q + ((long)(M_P + 16 * b) * 8 + h) * 192;
      const u16* Kn = p.Kns + ((long)b * LKS * 8 + h) * 128;
      const u16* KR = p.KRs + (long)b * LKS * 64;
      const u16* VT = p.VTs + ((long)b * 8 + h) * 128 * LKS;
      u16* Ob = p.OA + (long)(M_P + 16 * b) * 1024 + h * 128;
      attn_item(Qb, 15, Kn, KR, VT, LKS, 65, w == 0 ? 65 : 0, LKV, Ob, smem);
    } else {
      const int idx = item - 256;
      const int qb = 63 - (idx >> 3), h = idx & 7;
      const u16* Qb = p.Q + ((long)(256 * qb) * 8 + h) * 192;
      const u16* Kn = p.Knp + (long)h * 128;
      const u16* KR = p.KRp;
      const u16* VT = p.VTp + (long)h * 128 * M_P;
      u16* Ob = p.OA + (long)(256 * qb) * 1024 + h * 128;
      const int ntiles = 4 * qb + 4;
      attn_item(Qb, 31, Kn, KR, VT, M_P, ntiles, 4 * qb + (w >> 1) + 1, 1 << 30, Ob, smem);
    }
  }
}

DI void gmlp_phase(const Params& p, int l, char* smem_all) {
  const int half = get_tid() >> 8; char* smem = smem_all + half * HALF_BYTES;
  const int tid = get_tid() & 255, lane = tid & 63, w = tid >> 6, wm = w >> 1, wn = w & 1, r = lane & 31, hh = lane >> 5;
  const float* gvn = p.gvn + l * 1024;
  const float* gws = p.gws + (long)l * 8 * 128 * 128;
  const float* gbs = p.gbs + (long)l * 8 * 128;
  u16* Xs = (u16*)smem;
  u16* Ws = Xs + 128 * 136;
  const int NP = 128 * 8, NS = 32 * 4;
  for (int t2 = get_bid(); t2 < (NP + NS + 1) / 2; t2 += gridDim.x) {
    const int t = 2 * t2 + half;
    const bool valid = t < NP + NS;
    const bool isp = valid && t < NP;
    {
      const int ci = t >> 3, g = t & 7;
      const int t0 = ci * 128, c0 = g * 128;
      __syncthreads();
      if (isp) {
#pragma unroll
      for (int i = 0; i < 8; ++i) {
        const int c = tid + 256 * i; const int s = c >> 4, dc = (c & 15) * 8;
        const uint4 v = *(const uint4*)(p.Z + (long)(t0 + s) * LDZ + ZV + c0 + dc);
        const float rs = p.rsv[t0 + s];
        const float4 g0 = *(const float4*)(gvn + c0 + dc), g1 = *(const float4*)(gvn + c0 + dc + 4);
        Xs[(dc + 0) * 136 + s] = f2bf(bflo(v.x) * rs * g0.x); Xs[(dc + 1) * 136 + s] = f2bf(bfhi(v.x) * rs * g0.y);
        Xs[(dc + 2) * 136 + s] = f2bf(bflo(v.y) * rs * g0.z); Xs[(dc + 3) * 136 + s] = f2bf(bfhi(v.y) * rs * g0.w);
        Xs[(dc + 4) * 136 + s] = f2bf(bflo(v.z) * rs * g1.x); Xs[(dc + 5) * 136 + s] = f2bf(bfhi(v.z) * rs * g1.y);
        Xs[(dc + 6) * 136 + s] = f2bf(bflo(v.w) * rs * g1.z); Xs[(dc + 7) * 136 + s] = f2bf(bfhi(v.w) * rs * g1.w);
        const int tt = c >> 4, sc = (c & 15) * 8;
        const float* wp = gws + ((long)g * 128 + tt) * 128 + sc;
        float4 a = *(const float4*)wp, b = *(const float4*)(wp + 4);
        a.x = (sc + 0 <= tt) ? a.x : 0.f; a.y = (sc + 1 <= tt) ? a.y : 0.f; a.z = (sc + 2 <= tt) ? a.z : 0.f; a.w = (sc + 3 <= tt) ? a.w : 0.f;
        b.x = (sc + 4 <= tt) ? b.x : 0.f; b.y = (sc + 5 <= tt) ? b.y : 0.f; b.z = (sc + 6 <= tt) ? b.z : 0.f; b.w = (sc + 7 <= tt) ? b.w : 0.f;
        *(uint4*)(Ws + tt * 136 + sc) = pack8(a, b);
      }
      }
      __syncthreads();
      if (isp) {
      f32x16 acc[2][2];
#pragma unroll
      for (int mi = 0; mi < 2; ++mi)
#pragma unroll
        for (int ni = 0; ni < 2; ++ni)
#pragma unroll
          for (int i = 0; i < 16; ++i) acc[mi][ni][i] = 0.f;
      const u16* Ab = Ws + (64 * wm + r) * 136 + 8 * hh;
      const u16* Bb = Xs + (64 * wn + r) * 136 + 8 * hh;
#pragma unroll
      for (int ks = 0; ks < 8; ++ks) {
        bf16x8 a0 = *(const bf16x8*)(Ab + 16 * ks), a1 = *(const bf16x8*)(Ab + 32 * 136 + 16 * ks);
        bf16x8 b0 = *(const bf16x8*)(Bb + 16 * ks), b1 = *(const bf16x8*)(Bb + 32 * 136 + 16 * ks);
        acc[0][0] = MFMA(b0, a0, acc[0][0]); acc[0][1] = MFMA(b1, a0, acc[0][1]);
        acc[1][0] = MFMA(b0, a1, acc[1][0]); acc[1][1] = MFMA(b1, a1, acc[1][1]);
      }
#pragma unroll
      for (int mi = 0; mi < 2; ++mi) {
        const int tl = 64 * wm + 32 * mi + r;
        const long row = t0 + tl;
        const float bias = gbs[g * 128 + tl];
        const u16* zr = p.Z + row * LDZ;
#pragma unroll
        for (int ni = 0; ni < 2; ++ni)
#pragma unroll
          for (int i4 = 0; i4 < 4; ++i4) {
            const int col = c0 + 64 * wn + 32 * ni + 8 * i4 + 4 * hh;
            const uint2 uu = *(const uint2*)(zr + ZU + col), ga = *(const uint2*)(zr + ZGA + col), gb = *(const uint2*)(zr + ZGB + col);
            const uint2 oa = *(const uint2*)(p.OA + row * 1024 + col);
            const float o0 = sigm(bflo(ga.x)) * bflo(oa.x) + sigm(bflo(gb.x)) * bflo(uu.x) * (acc[mi][ni][4 * i4 + 0] + bias);
            const float o1 = sigm(bfhi(ga.x)) * bfhi(oa.x) + sigm(bfhi(gb.x)) * bfhi(uu.x) * (acc[mi][ni][4 * i4 + 1] + bias);
            const float o2 = sigm(bflo(ga.y)) * bflo(oa.y) + sigm(bflo(gb.y)) * bflo(uu.y) * (acc[mi][ni][4 * i4 + 2] + bias);
            const float o3 = sigm(bfhi(ga.y)) * bfhi(oa.y) + sigm(bfhi(gb.y)) * bfhi(uu.y) * (acc[mi][ni][4 * i4 + 3] + bias);
            *(uint2*)(p.MIX + row * 1024 + col) = make_uint2(pk2(o0, o1), pk2(o2, o3));
          }
      }
      }
    }
    if (valid && !isp) {
      const int u = t - NP; const int b = u >> 2, col = (u & 3) * 256 + tid; const int g = col >> 7;
      const long row0 = M_P + 16 * b;
      const float gv = gvn[col];
      float vn[16];
#pragma unroll
      for (int s = 0; s < 16; ++s) vn[s] = bf1(p.Z[(row0 + s) * LDZ + ZV + col]) * p.rsv[row0 + s] * gv;
#pragma unroll
      for (int tt = 0; tt < 16; ++tt) {
        float mx = gbs[g * 128 + tt];
#pragma unroll
        for (int s = 0; s <= tt; ++s) mx += gws[((long)g * 128 + tt) * 128 + s] * vn[s];
        const u16* zr = p.Z + (row0 + tt) * LDZ;
        const float uu = bf1(zr[ZU + col]), ga = bf1(zr[ZGA + col]), gb = bf1(zr[ZGB + col]);
        const float oa = bf1(p.OA[(row0 + tt) * 1024 + col]);
        p.MIX[(row0 + tt) * 1024 + col] = f2bf(sigm(ga) * oa + sigm(gb) * uu * mx);
      }
    }
  }
}

#define XB_TMO      128
#define XB_XCNT(j)  (256  + 64 * (j))
#define XB_XSUB(j)  (1280 + 64 * (j))
#define XB_XGEN(j)  (2304 + 64 * (j))
#define XB_TOP      3328
#define XB_TOPGEN   3392
#define XCD_BAR_WORDS 3456
#define XB_SPIN_CAP (1u << 22)
#define LAS __attribute__((address_space(3)))
DI unsigned xb_ld(unsigned* p) { return __hip_atomic_load(p, __ATOMIC_RELAXED, __HIP_MEMORY_SCOPE_AGENT); }
DI unsigned xb_add(unsigned* p, unsigned v) { return __hip_atomic_fetch_add(p, v, __ATOMIC_RELAXED, __HIP_MEMORY_SCOPE_AGENT); }
DI unsigned xb_xcc_id() { return (unsigned)__builtin_amdgcn_s_getreg((3 << 11) | 20) & 0xFu; }
#define XB_SPIN(cond, bar) do { unsigned _sp = 0; while (cond) { __builtin_amdgcn_s_sleep(1); \
    if ((++_sp & 255u) == 0u) { if (xb_ld(&(bar)[XB_TMO])) break; if (_sp > XB_SPIN_CAP) { atomicAdd(&(bar)[XB_TMO], 1u); break; } } } } while (0)
struct XcdBarrier { unsigned* bar; unsigned x; volatile LAS unsigned* st; };
DI XcdBarrier xcd_barrier_post(unsigned* bar, volatile LAS unsigned* st) {
  XcdBarrier b; b.bar = bar; b.x = xb_xcc_id(); b.st = st;
  if (threadIdx.x == 0) (void)xb_add(&bar[XB_XCNT(b.x)], 1u);
  return b;
}
DI void xcd_barrier_complete(unsigned* bar, unsigned x, unsigned& nloc, unsigned& nx) {
  const unsigned G = gridDim.x * gridDim.y * gridDim.z;
  unsigned sum, cnt, mine, sp = 0u;
  for (;;) {
    sum = 0u; cnt = 0u; mine = 0u;
#pragma unroll
    for (unsigned j = 0; j < 16; ++j) { const unsigned c = xb_ld(&bar[XB_XCNT(j)]); sum += c; cnt += (c > 0u) ? 1u : 0u; mine = (j == x) ? c : mine; }
    if (sum == G) break;
    __builtin_amdgcn_s_sleep(1);
    if ((++sp & 255u) == 0u) { if (xb_ld(&bar[XB_TMO])) break; if (sp > XB_SPIN_CAP) { atomicAdd(&bar[XB_TMO], 1u); break; } }
  }
  nloc = mine > 0u ? mine : 1u; nx = cnt > 0u ? cnt : 1u;
}
DI void xcd_barrier(const XcdBarrier& b) {
  asm volatile("s_waitcnt vmcnt(0)" ::: "memory");
  __syncthreads();
  if (threadIdx.x == 0) {
    unsigned* bar = b.bar;
    __builtin_amdgcn_s_waitcnt(0);
    unsigned nloc = b.st[0], nx = b.st[1];
    if (nloc == 0u) { xcd_barrier_complete(bar, b.x, nloc, nx); b.st[0] = nloc; b.st[1] = nx; }
    const unsigned old = xb_add(&bar[XB_XSUB(b.x)], 1u);
    const unsigned gen = old / nloc;
    if (old + 1u == (gen + 1u) * nloc) {
      __builtin_amdgcn_fence(__ATOMIC_RELEASE, "agent");
      asm volatile("s_waitcnt vmcnt(0)" ::: "memory");
      const unsigned og = xb_add(&bar[XB_TOP], 1u);
      const unsigned tg = og / nx;
      if (og + 1u == (tg + 1u) * nx) xb_add(&bar[XB_TOPGEN], 1u);
      else XB_SPIN(xb_ld(&bar[XB_TOPGEN]) == tg, bar);
      __builtin_amdgcn_fence(__ATOMIC_ACQUIRE, "agent");
      xb_add(&bar[XB_XGEN(b.x)], 1u);
      asm volatile("s_waitcnt vmcnt(0)" ::: "memory");
    } else {
      XB_SPIN(xb_ld(&bar[XB_XGEN(b.x)]) == gen, bar);
      __builtin_amdgcn_fence(__ATOMIC_ACQUIRE, "agent");
      asm volatile("s_waitcnt vmcnt(0)" ::: "memory");
    }
  }
  __syncthreads();
}

__global__ void __launch_bounds__(512, 2) mega_fwd(Params p) {
  __shared__ __attribute__((aligned(16))) char smem[SMEM_BYTES];
  __shared__ int s_item;
  __shared__ uint4 xb_words;
  cg::grid_group grid = cg::this_grid();
  if (threadIdx.x == 0) xb_words = make_uint4(0u, 0u, 0u, 0u);
  __syncthreads();
  XcdBarrier xb = xcd_barrier_post(p.bar, (volatile LAS unsigned*)&xb_words);

  prep_phase(p, smem);
  grid.sync();
#ifdef PROBE_PREP
  prep_phase(p, smem);
  grid.sync();
#endif
#pragma unroll 1
  for (int l = 0; l < 2; ++l) {
    norm_phase(p.out, p.f1n + l * 1024, p.NB);
    xcd_barrier(xb);
    ffn_up_phase(p, p.Wgu1 + (long)l * 2 * DFF * 1024, smem);
    xcd_barrier(xb);
#ifdef PROBE_FFN
    ffn_up_phase(p, p.Wgu1 + (long)l * 2 * DFF * 1024, smem);
    xcd_barrier(xb);
#endif
    resid_gemm_phase(p, p.ACT, DFF, p.Wd1 + (long)l * 1024 * DFF, 0.5f, smem);
    xcd_barrier(xb);
    norm_phase(p.out, p.mixn + l * 1024, p.NB);
    xcd_barrier(xb);
    win_phase(p, p.Win + (long)l * LDZ * 1024, smem);
    xcd_barrier(xb);
    rowpost_phase(p, l);
    xcd_barrier(xb);
    multi_phase(p, l, smem);
    xcd_barrier(xb);
    attn_phase(p, l, smem, &s_item, l);
    xcd_barrier(xb);
#ifdef PROBE_ATTN
    attn_phase(p, l, smem, &s_item, 2 + l);
    xcd_barrier(xb);
#endif
#ifdef PROBE_MULTI
    multi_phase(p, l, smem);
    xcd_barrier(xb);
#endif
    gmlp_phase(p, l, smem);
    xcd_barrier(xb);
#ifdef PROBE_GMLP
    gmlp_phase(p, l, smem);
    xcd_barrier(xb);
#endif
#ifdef PROBE_ROWPOST
    rowpost_phase(p, l);
    xcd_barrier(xb);
#endif
    resid_gemm_phase(p, p.MIX, 1024, p.Wo + (long)l * 1024 * 1024, 1.0f, smem);
    xcd_barrier(xb);
    norm_phase(p.out, p.f2n + l * 1024, p.NB);
    xcd_barrier(xb);
    ffn_up_phase(p, p.Wgu2 + (long)l * 2 * DFF * 1024, smem);
    xcd_barrier(xb);
#ifdef PROBE_FFN
    ffn_up_phase(p, p.Wgu2 + (long)l * 2 * DFF * 1024, smem);
    xcd_barrier(xb);
#endif
    resid_gemm_phase(p, p.ACT, DFF, p.Wd2 + (long)l * 1024 * DFF, 0.5f, smem);
    xcd_barrier(xb);
    norm_phase(p.out, p.plen + l * 1024, p.NB);
    xcd_barrier(xb);
    ple_phase(p, p.Wpg + (long)l * 1024 * 1024, smem);
    xcd_barrier(xb);
  }
}

extern "C" void kernel_launch(void* const* d_in, const int* in_sizes, int n_in, void* d_out, int out_size, void* d_ws,
                              size_t ws_size, hipStream_t stream) {
  (void)in_sizes; (void)n_in; (void)out_size; (void)ws_size;
  Params p{};
  auto F = [&](int i) { return (const float*)d_in[i]; };
  p.x_prompt = F(0); p.x_sample = F(1); p.cache_c = F(2); p.cache_kr = F(3); p.p_prompt = F(4); p.p_sample = F(5);
  p.f1n = F(6); p.mixn = F(10); p.qan = F(12); p.qnn = F(14); p.qrn = F(15); p.kvan = F(16); p.krn = F(17);
  p.knn = F(20); p.gvn = F(21); p.gws = F(22); p.gbs = F(23); p.f2n = F(25); p.plen = F(29);
  p.out = (float*)d_out;
  char* ws = (char*)d_ws; size_t off = 0;
  auto alloc = [&](size_t bytes) { char* r = ws + off; off += (bytes + 255) & ~(size_t)255; return r; };
  p.Wgu1 = (u16*)alloc(2UL * 2 * DFF * 1024 * 2);
  p.Wd1 = (u16*)alloc(2UL * 1024 * DFF * 2);
  p.Win = (u16*)alloc(2UL * LDZ * 1024 * 2);
  p.Wuq = (u16*)alloc(2UL * 1536 * 384 * 2);
  p.Wkv = (u16*)alloc(2UL * 2048 * 512 * 2);
  p.Wo = (u16*)alloc(2UL * 1024 * 1024 * 2);
  p.Wgu2 = (u16*)alloc(2UL * 2 * DFF * 1024 * 2);
  p.Wd2 = (u16*)alloc(2UL * 1024 * DFF * 2);
  p.Wpg = (u16*)alloc(2UL * 1024 * 1024 * 2);
  p.Wpe = (u16*)alloc(2UL * 1024 * 256 * 2);
  p.NB = (u16*)alloc((size_t)M_ALL * 1024 * 2);
  p.ACT = (u16*)alloc((size_t)M_ALL * DFF * 2);
  p.Z = (u16*)alloc((size_t)M_ALL * LDZ * 2);
  p.QN = (u16*)alloc((size_t)M_ALL * 384 * 2);
  p.C = (u16*)alloc((size_t)M_ALL * 512 * 2);
  p.KRp = (u16*)alloc((size_t)M_P * 64 * 2);
  p.KRs = (u16*)alloc((size_t)32 * LKS * 64 * 2);
  p.Q = (u16*)alloc((size_t)M_ALL * 8 * 192 * 2);
  p.Knp = (u16*)alloc((size_t)M_P * 1024 * 2);
  p.VTp = (u16*)alloc((size_t)M_P * 1024 * 2);
  p.Kns = (u16*)alloc((size_t)32 * LKS * 1024 * 2);
  p.VTs = (u16*)alloc((size_t)32 * LKS * 1024 * 2);
  p.OA = (u16*)alloc((size_t)M_ALL * 1024 * 2);
  p.MIX = (u16*)alloc((size_t)M_ALL * 1024 * 2);
  p.PP = (u16*)alloc((size_t)M_ALL * 1024 * 2);
  p.CB = (u16*)alloc((size_t)32 * PAST * 512 * 2);
  p.PB = (u16*)alloc((size_t)M_ALL * 256 * 2);
  p.rsv = (float*)alloc((size_t)M_ALL * 4);
  p.rope = (float*)alloc((size_t)16384 * 32 * 2 * 4);
  p.ctr = (unsigned*)alloc(256);
  p.bar = (unsigned*)alloc(XCD_BAR_WORDS * 4);

  int nj = 0, ts = 0;
  auto job = [&](const float* src, u16* dst, int K, int N, int kind) {
    p.jobs[nj].src = src; p.jobs[nj].dst = dst; p.jobs[nj].K = K; p.jobs[nj].N = N; p.jobs[nj].kind = kind; p.jobs[nj].tstart = ts;
    ts += (K / 64) * (N / 64); ++nj;
  };
  for (int l = 0; l < 2; ++l) {
    job(F(7) + (size_t)l * 1024 * DFF, p.Wgu1 + (size_t)l * 2 * DFF * 1024, 1024, DFF, 1);
    job(F(8) + (size_t)l * 1024 * DFF, p.Wgu1 + (size_t)l * 2 * DFF * 1024, 1024, DFF, 2);
    job(F(9) + (size_t)l * DFF * 1024, p.Wd1 + (size_t)l * 1024 * DFF, DFF, 1024, 0);
    job(F(11) + (size_t)l * 1024 * DIN, p.Win + (size_t)l * LDZ * 1024, 1024, DIN, 0);
    job(F(13) + (size_t)l * 384 * 1536, p.Wuq + (size_t)l * 1536 * 384, 384, 1536, 3);
    job(F(18) + (size_t)l * 512 * 1024, p.Wkv + (size_t)l * 2048 * 512, 512, 1024, 0);
    job(F(19) + (size_t)l * 512 * 1024, p.Wkv + (size_t)l * 2048 * 512, 512, 1024, 4);
    job(F(24) + (size_t)l * 1024 * 1024, p.Wo + (size_t)l * 1024 * 1024, 1024, 1024, 0);
    job(F(26) + (size_t)l * 1024 * DFF, p.Wgu2 + (size_t)l * 2 * DFF * 1024, 1024, DFF, 1);
    job(F(27) + (size_t)l * 1024 * DFF, p.Wgu2 + (size_t)l * 2 * DFF * 1024, 1024, DFF, 2);
    job(F(28) + (size_t)l * DFF * 1024, p.Wd2 + (size_t)l * 1024 * DFF, DFF, 1024, 0);
    job(F(30) + (size_t)l * 1024 * 1024, p.Wpg + (size_t)l * 1024 * 1024, 1024, 1024, 0);
    job(F(31) + (size_t)l * 256 * 1024, p.Wpe + (size_t)l * 1024 * 256, 256, 1024, 0);
  }
  p.ntile_prep = ts;

  static int grid_blocks = 0;
  if (!grid_blocks) {
    int dev = 0, cus = 0, per_cu = 0;
    hipGetDevice(&dev);
    hipDeviceGetAttribute(&cus, hipDeviceAttributeMultiprocessorCount, dev);
    hipOccupancyMaxActiveBlocksPerMultiprocessor(&per_cu, (const void*)mega_fwd, 512, 0);
    if (per_cu > 1) per_cu = 1;
    if (per_cu < 1) per_cu = 1;
    grid_blocks = cus * per_cu;
  }
  (void)hipMemsetAsync(p.bar, 0, XCD_BAR_WORDS * 4, stream);
  void* args[] = {&p};
  hipError_t e = hipLaunchCooperativeKernel((const void*)mega_fwd, dim3(grid_blocks), dim3(512), args, 0, stream);
  if (e != hipSuccess) fprintf(stderr, "cooperative launch failed: %s (grid %d)\n", hipGetErrorString(e), grid_blocks);
}
```

```cpp
#include <hip/hip_runtime.h>
#include <hip/hip_cooperative_groups.h>
#include <cstdio>
namespace cg = cooperative_groups;

#define DI __device__ __forceinline__
typedef unsigned short u16;
typedef __attribute__((ext_vector_type(8))) short bf16x8;
typedef __attribute__((ext_vector_type(16))) float f32x16;
typedef __attribute__((ext_vector_type(2))) __bf16 bf2_t;
typedef __attribute__((ext_vector_type(2))) float f2_t;

#define M_P 16384
#define M_S 512
#define M_ALL 16896
#define DM 1024
#define DFF 2816
#define DIN 5056
#define LDZ 5120
#define ZQ 0
#define ZKV 384
#define ZKR 896
#define ZU 960
#define ZV 1984
#define ZGA 3008
#define ZGB 4032
#define LKS 4160
#define LKV 4112
#define PAST 4096
#define EPSF 1e-6f
#define QSCALE (0.07216878364870322f * 1.4426950408889634f)

#define NJOBS 26
struct TJob { const float* src; u16* dst; int K, N, kind, tstart; };

struct Params {
  const float *x_prompt, *x_sample, *cache_c, *cache_kr, *p_prompt, *p_sample;
  const float *f1n, *mixn, *qan, *qnn, *qrn, *kvan, *krn, *knn, *gvn, *gws, *gbs, *f2n, *plen;
  float* out;
  u16 *Wgu1, *Wd1, *Win, *Wuq, *Wkv, *Wo, *Wgu2, *Wd2, *Wpg, *Wpe;
  u16 *CB, *PB;
  u16 *NB, *ACT, *Z, *QN, *C, *KRp, *KRs, *Q, *Knp, *VTp, *Kns, *VTs, *OA, *MIX, *PP;
  float *rsv, *rope;
  unsigned* ctr;
  unsigned* bar;
  TJob jobs[NJOBS];
  int ntile_prep; int pad0;
};

DI int get_tid_impl(int ws) { int t = (ws << 6) | (int)__builtin_amdgcn_mbcnt_hi(~0u, __builtin_amdgcn_mbcnt_lo(~0u, 0u)); asm volatile("" : "+v"(t)); return t; }
#define get_tid() get_tid_impl(g_wave_s)
DI int get_bid() { int t = blockIdx.x; asm volatile("" : "+s"(t)); return t; }
DI unsigned pk2(float a, float b) { f2_t v = {a, b}; bf2_t r = __builtin_convertvector(v, bf2_t); return __builtin_bit_cast(unsigned, r); }
DI float bflo(unsigned v) { return __uint_as_float(v << 16); }
DI float bfhi(unsigned v) { return __uint_as_float(v & 0xffff0000u); }
DI float bf1(u16 v) { return __uint_as_float(((unsigned)v) << 16); }
DI u16 f2bf(float a) { return (u16)(pk2(a, 0.f) & 0xffffu); }
DI float shfl_xor_l(float v, int lane, int o) { return __int_as_float(__builtin_amdgcn_ds_bpermute((lane ^ o) << 2, __float_as_int(v))); }
DI float wave_sum_l(float v, int lane) {
#pragma unroll
  for (int o = 32; o > 0; o >>= 1) v += shfl_xor_l(v, lane, o);
  return v;
}
DI float sigm(float x) { return 1.f / (1.f + __expf(-x)); }
DI uint4 pack8(float4 x, float4 y) { return make_uint4(pk2(x.x, x.y), pk2(x.z, x.w), pk2(y.x, y.y), pk2(y.z, y.w)); }
#define MFMA(a, b, c) __builtin_amdgcn_mfma_f32_32x32x16_bf16((a), (b), (c), 0, 0, 0)

#define HALF_BYTES (73728 + 1024)
#define SMEM_BYTES (2 * HALF_BYTES)
#define LDS_TOTAL (SMEM_BYTES + 32)

DI int job_dst_row(int kind, int n) {
  if (kind == 0) return n;
  if (kind == 1) return 256 * (n >> 7) + (n & 127);
  if (kind == 2) return 256 * (n >> 7) + 128 + (n & 127);
  if (kind == 3) { int h = n / 192, c = n - h * 192; if (c < 128) return h * 128 + c; c -= 128; const int x = c >> 5, cl = c & 31;
                   return 1024 + h * 64 + 32 * (cl >> 4) + 8 * ((cl >> 2) & 3) + 4 * x + (cl & 3); }
  return 1024 + n;
}

DI void prep_phase(const Params& p, char* smem, int g_wave_s) {
  const int tid = get_tid();
  {
    const int vt = tid & 255, half = tid >> 8;
    u16* Ts = (u16*)smem + half * (64 * 66);
    const int npair = (p.ntile_prep + 1) >> 1;
    for (int t2 = get_bid(); t2 < npair; t2 += gridDim.x) {
      const int t = 2 * t2 + half;
      const bool valid = t < p.ntile_prep;
      int j = 0;
#pragma unroll 1
      for (int q = 1; q < NJOBS; ++q) if (t >= p.jobs[q].tstart) j = q;
      const float* src = p.jobs[j].src; u16* dst = p.jobs[j].dst;
      const int K = p.jobs[j].K, N = p.jobs[j].N, kind = p.jobs[j].kind;
      const int lt = t - p.jobs[j].tstart;
      const int ntn = N >> 6;
      const int tk = lt / ntn, tn = lt - tk * ntn;
      const int k0 = tk * 64, n0 = tn * 64;
      __syncthreads();
      if (valid) {
#pragma unroll
        for (int i = 0; i < 4; ++i) {
          const int k = (vt >> 4) + 16 * i, nc = (vt & 15) * 4;
          float4 v = *(const float4*)(src + (long)(k0 + k) * N + n0 + nc);
          Ts[(nc + 0) * 66 + k] = f2bf(v.x); Ts[(nc + 1) * 66 + k] = f2bf(v.y);
          Ts[(nc + 2) * 66 + k] = f2bf(v.z); Ts[(nc + 3) * 66 + k] = f2bf(v.w);
        }
      }
      __syncthreads();
      if (valid) {
        const int n = vt >> 2, kc = (vt & 3) * 16;
        const unsigned* s32 = (const unsigned*)(Ts + n * 66 + kc);
        uint4 a = make_uint4(s32[0], s32[1], s32[2], s32[3]);
        uint4 b = make_uint4(s32[4], s32[5], s32[6], s32[7]);
        u16* d = dst + (long)job_dst_row(kind, n0 + n) * K + k0 + kc;
        *(uint4*)d = a; *(uint4*)(d + 8) = b;
      }
    }
  }
  const long gtid = (long)get_bid() * 512 + tid, gstride = (long)gridDim.x * 512;
  for (long e = gtid; e < 2L * 64 * 1024 / 8; e += gstride) {
    const int l = (int)(e / (64 * 1024 / 8)); const long r = e - (long)l * (64 * 1024 / 8);
    *(uint4*)(p.Win + (long)l * LDZ * 1024 + (long)DIN * 1024 + r * 8) = make_uint4(0, 0, 0, 0);
  }
  for (long e = gtid; e < 16384L * 32; e += gstride) {
    const int pos = (int)(e >> 5), i = (int)(e & 31);
    const float inv = powf(10000.0f, -(float)i / 32.0f);
    const float angf = (float)pos * inv;
    const double x = (double)angf;
    const double kq = rint(x * 0.63661977236758134308);
    const double y = (x - kq * 1.5707963267341256e+00) - kq * 6.0771005065061922e-11;
    const double y2 = y * y;
    const double s = y * (1.0 + y2 * (-1.0 / 6 + y2 * (1.0 / 120 + y2 * (-1.0 / 5040 + y2 * (1.0 / 362880 + y2 * (-1.0 / 39916800))))));
    const double c = 1.0 + y2 * (-0.5 + y2 * (1.0 / 24 + y2 * (-1.0 / 720 + y2 * (1.0 / 40320 + y2 * (-1.0 / 3628800 + y2 * (1.0 / 479001600))))));
    const int q = ((int)kq) & 3;
    double cc, ss;
    if (q == 0) { cc = c; ss = s; } else if (q == 1) { cc = -s; ss = c; } else if (q == 2) { cc = -c; ss = -s; } else { cc = s; ss = -c; }
    *(float2*)(p.rope + e * 2) = make_float2((float)cc, (float)ss);
  }
  for (long e = gtid; e < (long)M_ALL * 1024 / 4; e += gstride) {
    const long pe = (long)M_P * 1024 / 4;
    float4 v = e < pe ? ((const float4*)p.x_prompt)[e] : ((const float4*)p.x_sample)[e - pe];
    ((float4*)p.out)[e] = v;
  }
  if (get_bid() == 0 && tid < 16) p.ctr[tid] = 0u;
}

DI void norm_phase(const float* __restrict__ h, const float* __restrict__ g, u16* __restrict__ out, int g_wave_s) {
  const int tid = get_tid(); const int lane = tid & 63, w = tid >> 6;
  for (int row = get_bid() * 8 + w; row < M_ALL; row += gridDim.x * 8) {
    const float4* hr = (const float4*)(h + (long)row * 1024);
    float4 v[4]; float ss = 0.f;
#pragma unroll
    for (int i = 0; i < 4; ++i) { v[i] = hr[lane + 64 * i]; ss += v[i].x * v[i].x + v[i].y * v[i].y + v[i].z * v[i].z + v[i].w * v[i].w; }
    ss = wave_sum_l(ss, lane);
    const float rs = rsqrtf(ss * (1.f / 1024.f) + EPSF);
#pragma unroll
    for (int i = 0; i < 4; ++i) {
      const float4 gg = ((const float4*)g)[lane + 64 * i];
      uint2 o = make_uint2(pk2(v[i].x * rs * gg.x, v[i].y * rs * gg.y), pk2(v[i].z * rs * gg.z, v[i].w * rs * gg.w));
      ((uint2*)(out + (long)row * 1024))[lane + 64 * i] = o;
    }
  }
}

struct TD { const char* A; const char* B; unsigned sa, sb; int nk; int pb; };
#define RED_OFF 73728

template <class Desc, class Epi>
DI void gemm_stream(int nloc, int nmax, Desc desc, Epi epi, char* smem_all, int g_wave_s) {
  const int tid = get_tid() & 255, lane = tid & 63, w = tid >> 6, wm = w >> 1, wn = w & 1, r = lane & 31, hh = lane >> 5;
  char* smem = smem_all + (get_tid() >> 8) * HALF_BYTES;
  u16* As = (u16*)smem;
  u16* Bs = As + 2 * 128 * 72;
  const int lrow = tid >> 3, lkc = (tid & 7) * 8;
  int ct = 0;
  if (nmax <= 0) return;
  TD ltd = desc(0);
  const int lrot = ((get_bid() >> 3) * 2 + (get_tid() >> 8)) % ltd.nk;
  uint4 S0a0, S0a1, S0a2, S0a3, S0b0, S0b1, S0b2, S0b3, S1a0, S1a1, S1a2, S1a3, S1b0, S1b1, S1b2, S1b3;
#define LD1(dst, base, off) dst = *(const uint4*)((base) + (size_t)(off));
#define GLOADS(S, kk) { \
    int kr_ = (kk) + lrot; kr_ = kr_ >= ltd.nk ? kr_ - ltd.nk : kr_; \
    const unsigned oa_ = lrow * ltd.sa + (unsigned)(kr_ * 64 + lkc) * 2u, ob_ = lrow * ltd.sb + (unsigned)(kr_ * 64 + lkc) * 2u; \
    LD1(S##a0, ltd.A, oa_) LD1(S##a1, ltd.A, oa_ + 32u * ltd.sa) LD1(S##a2, ltd.A, oa_ + 64u * ltd.sa) LD1(S##a3, ltd.A, oa_ + 96u * ltd.sa) \
    LD1(S##b0, ltd.B, ob_) LD1(S##b1, ltd.B, ob_ + 32u * ltd.sb) LD1(S##b2, ltd.B, ob_ + 64u * ltd.sb) LD1(S##b3, ltd.B, ob_ + 96u * ltd.sb) }
#define SST1(arr, src, i, buf) *(uint4*)(arr + ((buf) * 128 + lrow + 32 * (i)) * 72 + lkc) = src;
#define SSTORES(S, buf) { SST1(As, S##a0, 0, buf) SST1(As, S##a1, 1, buf) SST1(As, S##a2, 2, buf) SST1(As, S##a3, 3, buf) \
    SST1(Bs, S##b0, 0, buf) SST1(Bs, S##b1, 1, buf) SST1(Bs, S##b2, 2, buf) SST1(Bs, S##b3, 3, buf) }
#define COMPUTE(buf) { \
    const u16* Ab = As + ((buf) * 128 + 64 * wm + r) * 72 + 8 * hh; \
    const u16* Bb = Bs + ((buf) * 128 + 64 * wn + r) * 72 + 8 * hh; \
    _Pragma("unroll") for (int ks = 0; ks < 4; ++ks) { \
      bf16x8 a0 = *(const bf16x8*)(Ab + 16 * ks), a1 = *(const bf16x8*)(Ab + 32 * 72 + 16 * ks); \
      bf16x8 b0 = *(const bf16x8*)(Bb + 16 * ks), b1 = *(const bf16x8*)(Bb + 32 * 72 + 16 * ks); \
      acc[0][0] = MFMA(b0, a0, acc[0][0]); acc[0][1] = MFMA(b1, a0, acc[0][1]); \
      acc[1][0] = MFMA(b0, a1, acc[1][0]); acc[1][1] = MFMA(b1, a1, acc[1][1]); } }
#define SCHED_STEP() { \
    __builtin_amdgcn_sched_group_barrier(0x020, 8, 0); \
    __builtin_amdgcn_sched_group_barrier(0x100, 4, 0); \
    _Pragma("unroll") for (int q_ = 0; q_ < 4; ++q_) { __builtin_amdgcn_sched_group_barrier(0x008, 1, 0); __builtin_amdgcn_sched_group_barrier(0x100, 1, 0); } \
    _Pragma("unroll") for (int q_ = 0; q_ < 8; ++q_) { __builtin_amdgcn_sched_group_barrier(0x008, 1, 0); __builtin_amdgcn_sched_group_barrier(0x100, 1, 0); __builtin_amdgcn_sched_group_barrier(0x200, 1, 0); } \
    _Pragma("unroll") for (int q_ = 0; q_ < 4; ++q_) { __builtin_amdgcn_sched_group_barrier(0x008, 1, 0); } }

  GLOADS(S0, 0)
  GLOADS(S1, 1)
  SSTORES(S0, 0)
  __syncthreads();
#pragma unroll 1
  for (; ct < nmax; ++ct) {
    const int nk2 = ltd.nk >> 1;
    f32x16 acc[2][2];
#pragma unroll
    for (int mi = 0; mi < 2; ++mi)
#pragma unroll
      for (int ni = 0; ni < 2; ++ni)
#pragma unroll
        for (int i = 0; i < 16; ++i) acc[mi][ni][i] = 0.f;
#pragma unroll 1
    for (int k2 = 0; k2 < nk2; ++k2) {
      int kb = 2 * k2 + 2;
      if (k2 == nk2 - 1) { kb = 0; if (ct + 1 < nloc) ltd = desc(ct + 1); }
      GLOADS(S0, kb)
      COMPUTE(0)
      SSTORES(S1, 1)
      SCHED_STEP()
      __syncthreads();
      GLOADS(S1, kb + 1)
      COMPUTE(1)
      SSTORES(S0, 0)
      SCHED_STEP()
      __syncthreads();
    }
    if (ct < nloc) epi(ct, acc);
  }
#undef LD1
#undef GLOADS
#undef SST1
#undef SSTORES
#undef COMPUTE
#undef SCHED_STEP
}

typedef __attribute__((ext_vector_type(4))) float f32x4;
#define G8_HT (128 * 64)
DI int g8_lds_byte(int r, int c) { const int st = (r >> 4) * 2 + (c >> 5), rr = r & 15, cc = c & 31, ob = rr * 64 + cc * 2; return st * 1024 + (ob ^ (((ob >> 9) & 1) << 5)); }
DI void g8_stage_rc(int b, int& R, int& C) { const int st = b / 1024, sb = b % 1024, swz = sb ^ (((sb >> 9) & 1) << 5); R = (st >> 1) * 16 + swz / 64; C = (st & 1) * 32 + (swz % 64) / 2; }
DI int g8_perm32(int rho) { const int n = rho >> 4, i = rho & 15; return 8 * (i >> 2) + 4 * n + (i & 3); }

DI int g8_permT(int s_) { return 16 * ((s_ >> 3) & 1) + 8 * (s_ >> 4) + 4 * ((s_ >> 2) & 1) + (s_ & 3); }
template <int PERMB>
DI void gemm256_tile(const u16* __restrict__ A, const u16* __restrict__ Bt, int K, char* smem, f32x4 (&acc)[2][2][4][2], int g_wave_s) {
  u16* shm = (u16*)smem;
  const int tid = get_tid();
  const int wid = tid >> 6, lane = tid & 63, wr = wid >> 2, wc = wid & 3, fr = lane & 15, fq = lane >> 4;
#define G8_SA(b, h) (shm + ((b) * 2 + (h)) * G8_HT)
#define G8_SB(b, h) (shm + (4 + (b) * 2 + (h)) * G8_HT)
  int sr0, sc0;
  g8_stage_rc(tid * 16, sr0, sc0);
  const int br0 = PERMB == 1 ? ((sr0 & ~31) + g8_perm32(sr0 & 31)) : (PERMB == 2 ? ((sr0 & ~31) + g8_permT(sr0 & 31)) : sr0);
  const unsigned aoff0 = (unsigned)(sr0 * K + sc0) * 2u;
  const unsigned boff0 = (unsigned)(br0 * K + sc0) * 2u;
#define G8_STAGE_A(P, br, kt) do { const char* g_ = (const char*)(A + (long)(br) * K + (long)(kt) * 64); \
    __builtin_amdgcn_global_load_lds((const unsigned*)(g_ + (size_t)aoff0), (unsigned*)((char*)(P) + tid * 16), 16, 0, 0); \
    __builtin_amdgcn_global_load_lds((const unsigned*)(g_ + (size_t)K * 128 + (size_t)aoff0), (unsigned*)((char*)(P) + tid * 16 + 8192), 16, 0, 0); } while (0)
#define G8_STAGE_B(P, br, kt) do { const char* g_ = (const char*)(Bt + (long)(br) * K + (long)(kt) * 64); \
    __builtin_amdgcn_global_load_lds((const unsigned*)(g_ + (size_t)boff0), (unsigned*)((char*)(P) + tid * 16), 16, 0, 0); \
    __builtin_amdgcn_global_load_lds((const unsigned*)(g_ + (size_t)K * 128 + (size_t)boff0), (unsigned*)((char*)(P) + tid * 16 + 8192), 16, 0, 0); } while (0)
#define G8_LDA(dst, b, h) _Pragma("unroll") for (int m = 0; m < 4; ++m) _Pragma("unroll") for (int k = 0; k < 2; ++k) \
    dst[m][k] = *reinterpret_cast<const bf16x8*>((char*)G8_SA(b, h) + g8_lds_byte(wr * 64 + m * 16 + fr, k * 32 + fq * 8))
#define G8_LDB(dst, b, h) _Pragma("unroll") for (int n = 0; n < 2; ++n) _Pragma("unroll") for (int k = 0; k < 2; ++k) \
    dst[n][k] = *reinterpret_cast<const bf16x8*>((char*)G8_SB(b, h) + g8_lds_byte(wc * 32 + n * 16 + fr, k * 32 + fq * 8))
#define G8_MMA(ai, bj, At_, Bt_) do { __builtin_amdgcn_s_setprio(1); \
    _Pragma("unroll") for (int m = 0; m < 4; ++m) _Pragma("unroll") for (int n = 0; n < 2; ++n) _Pragma("unroll") for (int k = 0; k < 2; ++k) \
      acc[ai][bj][m][n] = __builtin_amdgcn_mfma_f32_16x16x32_bf16(Bt_[n][k], At_[m][k], acc[ai][bj][m][n], 0, 0, 0); \
    __builtin_amdgcn_s_setprio(0); } while (0)
#define G8_WAIT_V(n) asm volatile("s_waitcnt vmcnt(" #n ")" ::: "memory")
#define G8_WAIT_L(n) asm volatile("s_waitcnt lgkmcnt(" #n ")" ::: "memory")
#define G8_BAR __builtin_amdgcn_s_barrier()
#define G8_SCHED __builtin_amdgcn_sched_barrier(0)
#pragma unroll
  for (int ai = 0; ai < 2; ++ai)
#pragma unroll
    for (int bj = 0; bj < 2; ++bj)
#pragma unroll
      for (int m = 0; m < 4; ++m)
#pragma unroll
        for (int n = 0; n < 2; ++n) acc[ai][bj][m][n] = (f32x4){0.f, 0.f, 0.f, 0.f};
  bf16x8 At[4][2], B0[2][2], B1[2][2];
  const int nt = K >> 6;
  G8_STAGE_B(G8_SB(0, 0), 0, 0); G8_STAGE_A(G8_SA(0, 0), 0, 0);
  G8_STAGE_B(G8_SB(0, 1), 128, 0); G8_STAGE_A(G8_SA(0, 1), 128, 0);
  if (wr == 1) G8_BAR;
  G8_WAIT_V(4); G8_BAR;
  G8_STAGE_B(G8_SB(1, 0), 0, 1); G8_STAGE_A(G8_SA(1, 0), 0, 1); G8_STAGE_B(G8_SB(1, 1), 128, 1);
  G8_WAIT_V(6); G8_BAR;
#pragma unroll 1
  for (int t = 0; t < nt - 2; t += 2) {
    G8_LDB(B0, 0, 0); G8_SCHED; G8_LDA(At, 0, 0); G8_STAGE_A(G8_SA(1, 1), 128, t + 1);
    G8_WAIT_L(8); G8_BAR; G8_WAIT_L(0); G8_MMA(0, 0, At, B0); G8_BAR; G8_SCHED;
    G8_LDB(B1, 0, 1); G8_STAGE_B(G8_SB(0, 0), 0, t + 2);
    G8_BAR; G8_WAIT_L(0); G8_MMA(0, 1, At, B1); G8_BAR;
    G8_LDA(At, 0, 1); G8_STAGE_A(G8_SA(0, 0), 0, t + 2);
    G8_BAR; G8_WAIT_L(0); G8_MMA(1, 0, At, B0); G8_BAR; G8_SCHED;
    G8_STAGE_B(G8_SB(0, 1), 128, t + 2);
    G8_WAIT_V(6); G8_BAR; G8_MMA(1, 1, At, B1); G8_BAR;
    G8_LDB(B0, 1, 0); G8_SCHED; G8_LDA(At, 1, 0); G8_STAGE_A(G8_SA(0, 1), 128, t + 2);
    G8_WAIT_L(8); G8_BAR; G8_WAIT_L(0); G8_MMA(0, 0, At, B0); G8_BAR; G8_SCHED;
    G8_LDB(B1, 1, 1); G8_STAGE_B(G8_SB(1, 0), 0, t + 3);
    G8_BAR; G8_WAIT_L(0); G8_MMA(0, 1, At, B1); G8_BAR;
    G8_LDA(At, 1, 1); G8_STAGE_A(G8_SA(1, 0), 0, t + 3);
    G8_BAR; G8_WAIT_L(0); G8_MMA(1, 0, At, B0); G8_BAR; G8_SCHED;
    G8_STAGE_B(G8_SB(1, 1), 128, t + 3);
    G8_WAIT_V(6); G8_BAR; G8_MMA(1, 1, At, B1); G8_BAR;
  }
  { G8_LDB(B0, 0, 0); G8_LDA(At, 0, 0); G8_STAGE_A(G8_SA(1, 1), 128, nt - 1);
    G8_BAR; G8_WAIT_L(0); G8_MMA(0, 0, At, B0); G8_BAR;
    G8_LDB(B1, 0, 1); G8_BAR; G8_WAIT_L(0); G8_MMA(0, 1, At, B1); G8_BAR;
    G8_LDA(At, 0, 1); G8_WAIT_V(4); G8_BAR; G8_WAIT_L(0); G8_MMA(1, 0, At, B0); G8_MMA(1, 1, At, B1); G8_BAR; }
  { G8_LDB(B0, 1, 0); G8_LDA(At, 1, 0); G8_WAIT_V(2); G8_BAR; G8_WAIT_L(0); G8_MMA(0, 0, At, B0); G8_BAR;
    G8_LDB(B1, 1, 1); G8_WAIT_V(0); G8_BAR; G8_WAIT_L(0); G8_MMA(0, 1, At, B1); G8_BAR;
    G8_LDA(At, 1, 1); G8_BAR; G8_WAIT_L(0); G8_MMA(1, 0, At, B0); G8_MMA(1, 1, At, B1); G8_BAR; }
  if (wr == 0) G8_BAR;
}

DI int tok_pos(int m) { return m < M_P ? m : PAST + ((m - M_P) & 15); }
DI int perm_pos(int key) {
  const int g4 = (key >> 2) & 3;
  const int pg = (g4 == 1) ? 2 : ((g4 == 2) ? 1 : g4);
  return (key & ~15) + 4 * pg;
}

DI int nloc_plain(int total) { const int b = get_bid(), G = gridDim.x; return b < total ? (total - b + G - 1) / G : 0; }
DI void grouped_tile(int L, int nM, int nN, int& tm, int& tn) {
  const int nwg = nM * nN;
  const int q = nwg >> 3, rr = nwg & 7, xcd = L & 7, off = L >> 3;
  const int wgid = (xcd < rr ? xcd * (q + 1) : rr * (q + 1) + (xcd - rr) * q) + off;
  const int nig = 8 * nN, gid = wgid / nig, fm = gid * 8;
  const int gsz = (nM - fm) < 8 ? (nM - fm) : 8;
  const int rem = wgid - gid * nig;
  tm = fm + rem % gsz; tn = rem / gsz;
}
#define LANE_COORDS8 const int tid = get_tid(), lane = tid & 63, w = tid >> 6, wm = w >> 1, wn = w & 1, r = lane & 31, hh = lane >> 5; (void)wm; (void)wn; (void)r; (void)hh;

DI void ffn_up_phase(const Params& p, const u16* W, char* smem, int g_wave_s) {
  const int tid = get_tid();
  const int wid = tid >> 6, lane = tid & 63, wr = wid >> 2, wc = wid & 3, fr = lane & 15, fq = lane >> 4;
  const int NT = (2 * DFF) / 256;
  const int G = gridDim.x;
  for (int L = get_bid(); L < 66 * NT; L += G) {
    int tm, tn; grouped_tile(L, 66, NT, tm, tn);
    f32x4 acc[2][2][4][2];
    gemm256_tile<1>(p.NB + (long)tm * 256 * 1024, W + (long)tn * 256 * 1024, 1024, smem, acc, g_wave_s);
#pragma unroll
    for (int ai = 0; ai < 2; ++ai)
#pragma unroll
      for (int m = 0; m < 4; ++m) {
        const long row = (long)tm * 256 + 128 * ai + 64 * wr + 16 * m + fr;
        const int col = tn * 128 + 32 * wc + 8 * fq;
        float a[8];
#pragma unroll
        for (int n = 0; n < 2; ++n)
#pragma unroll
          for (int j = 0; j < 4; ++j) { const float g = acc[ai][0][m][n][j], u = acc[ai][1][m][n][j]; a[4 * n + j] = g * sigm(g) * u; }
        *(uint4*)(p.ACT + row * DFF + col) = make_uint4(pk2(a[0], a[1]), pk2(a[2], a[3]), pk2(a[4], a[5]), pk2(a[6], a[7]));
      }
  }
}

DI void win_phase(const Params& p, const u16* W, char* smem, int g_wave_s) {
  const int tid = get_tid();
  const int wid = tid >> 6, lane = tid & 63, wr = wid >> 2, wc = wid & 3, fr = lane & 15, fq = lane >> 4;
  const int NT = LDZ / 256;
  const int G = gridDim.x;
  for (int L = get_bid(); L < 66 * NT; L += G) {
    int tm, tn; grouped_tile(L, 66, NT, tm, tn);
    f32x4 acc[2][2][4][2];
    gemm256_tile<1>(p.NB + (long)tm * 256 * 1024, W + (long)tn * 256 * 1024, 1024, smem, acc, g_wave_s);
#pragma unroll
    for (int ai = 0; ai < 2; ++ai)
#pragma unroll
      for (int m = 0; m < 4; ++m) {
        const long row = (long)tm * 256 + 128 * ai + 64 * wr + 16 * m + fr;
#pragma unroll
        for (int bj = 0; bj < 2; ++bj) {
          const int col = tn * 256 + 128 * bj + 32 * wc + 8 * fq;
          *(uint4*)(p.Z + row * LDZ + col) = make_uint4(pk2(acc[ai][bj][m][0][0], acc[ai][bj][m][0][1]), pk2(acc[ai][bj][m][0][2], acc[ai][bj][m][0][3]),
                                                        pk2(acc[ai][bj][m][1][0], acc[ai][bj][m][1][1]), pk2(acc[ai][bj][m][1][2], acc[ai][bj][m][1][3]));
        }
      }
  }
}

#define LANE_COORDS4 const int tid = get_tid() & 255, lane = tid & 63, w = tid >> 6, wm = w >> 1, wn = w & 1, r = lane & 31, hh = lane >> 5; (void)wm; (void)wn; (void)r; (void)hh; \
  const int vb = 2 * get_bid() + (get_tid() >> 8), VG = 2 * gridDim.x; \
  const int nl_mine = vb < 132 * 8 ? (132 * 8 - vb + VG - 1) / VG : 0; const int nl_max = (2 * get_bid()) < 132 * 8 ? (132 * 8 - 2 * get_bid() + VG - 1) / VG : 0;

DI void resid_gemm_phase(const Params& p, const u16* A, int K, const u16* W, float alpha, char* smem, int g_wave_s) {
  LANE_COORDS4
  gemm_stream(nl_mine, nl_max,
    [&](int k) { const int t = vb + k * VG; const int tm = t >> 3, tn = t & 7; TD d; d.A = (const char*)(A + (long)tm * 128 * K); d.B = (const char*)(W + (long)tn * 128 * K); d.sa = 2 * K; d.sb = 2 * K; d.nk = K >> 6; d.pb = 0; return d; },
    [&](int k, f32x16 (&acc)[2][2]) {
      const int t = vb + k * VG; const int tm = t >> 3, tn = t & 7;
#pragma unroll
      for (int mi = 0; mi < 2; ++mi) {
        const long m = (long)tm * 128 + 64 * wm + 32 * mi + r;
#pragma unroll
        for (int ni = 0; ni < 2; ++ni)
#pragma unroll
          for (int i4 = 0; i4 < 4; ++i4) {
            const int n = tn * 128 + 64 * wn + 32 * ni + 8 * i4 + 4 * hh;
            float4* hp = (float4*)(p.out + m * 1024 + n);
            float4 v = *hp;
            v.x += alpha * acc[mi][ni][4 * i4 + 0]; v.y += alpha * acc[mi][ni][4 * i4 + 1];
            v.z += alpha * acc[mi][ni][4 * i4 + 2]; v.w += alpha * acc[mi][ni][4 * i4 + 3];
            *hp = v;
          }
      }
    }, smem, g_wave_s);
}

DI void ple_phase(const Params& p, const u16* W, char* smem, int g_wave_s) {
  LANE_COORDS4
  gemm_stream(nl_mine, nl_max,
    [&](int k) { const int t = vb + k * VG; const int tm = t >> 3, tn = t & 7; TD d; d.A = (const char*)(p.NB + (long)tm * 128 * 1024); d.B = (const char*)(W + (long)tn * 128 * 1024); d.sa = 2048; d.sb = 2048; d.nk = 16; d.pb = 1; return d; },
    [&](int k, f32x16 (&acc)[2][2]) {
      const int t = vb + k * VG; const int tm = t >> 3, tn = t & 7;
#pragma unroll
      for (int mi = 0; mi < 2; ++mi) {
        const long m = (long)tm * 128 + 64 * wm + 32 * mi + r;
#pragma unroll
        for (int ni = 0; ni < 2; ++ni)
#pragma unroll
          for (int i4 = 0; i4 < 4; ++i4) {
            const int n = tn * 128 + 64 * wn + 32 * ni + 8 * i4 + 4 * hh;
            float4* hp = (float4*)(p.out + m * 1024 + n);
            const uint2 pp = *(const uint2*)(p.PP + m * 1024 + n);
            float4 v = *hp;
            v.x += sigm(acc[mi][ni][4 * i4 + 0]) * bflo(pp.x); v.y += sigm(acc[mi][ni][4 * i4 + 1]) * bfhi(pp.x);
            v.z += sigm(acc[mi][ni][4 * i4 + 2]) * bflo(pp.y); v.w += sigm(acc[mi][ni][4 * i4 + 3]) * bfhi(pp.y);
            *hp = v;
          }
      }
    }, smem, g_wave_s);
}

DI void rowpost_phase(const Params& p, int l, int g_wave_s) {
  const int tid = get_tid(); const int lane = tid & 63, w = tid >> 6;
  const float* qan = p.qan + l * 384; const float* kvan = p.kvan + l * 512; const float* krn = p.krn + l * 64; const float* gvn = p.gvn + l * 1024;
  float* o_pkv = p.out + 17301504L + (long)l * M_P * 512;
  float* o_pkr = p.out + 34078720L + (long)l * M_P * 64;
  float* o_skv = p.out + 36175872L + (long)l * M_S * 512;
  float* o_skr = p.out + 36700160L + (long)l * M_S * 64;
  float* o_sgv = p.out + 36765696L + (long)l * M_S * 1024;
  for (int row = get_bid() * 8 + w; row < M_ALL; row += gridDim.x * 8) {
    const u16* zr = p.Z + (long)row * LDZ;
    const bool is_s = row >= M_P; const int rs_ = row - M_P;
    {
      unsigned v[3]; float ss = 0.f;
#pragma unroll
      for (int i = 0; i < 3; ++i) { v[i] = *(const unsigned*)(zr + ZQ + 2 * lane + 128 * i); const float a = bflo(v[i]), b = bfhi(v[i]); ss += a * a + b * b; }
      ss = wave_sum_l(ss, lane);
      const float rs = rsqrtf(ss * (1.f / 384.f) + EPSF);
#pragma unroll
      for (int i = 0; i < 3; ++i) {
        const int c = 2 * lane + 128 * i; const float2 g = *(const float2*)(qan + c);
        *(unsigned*)(p.QN + (long)row * 384 + c) = pk2(bflo(v[i]) * rs * g.x, bfhi(v[i]) * rs * g.y);
      }
    }
    {
      const uint4 v = *(const uint4*)(zr + ZKV + 8 * lane);
      float x[8] = {bflo(v.x), bfhi(v.x), bflo(v.y), bfhi(v.y), bflo(v.z), bfhi(v.z), bflo(v.w), bfhi(v.w)};
      float ss = 0.f;
#pragma unroll
      for (int i = 0; i < 8; ++i) ss += x[i] * x[i];
      ss = wave_sum_l(ss, lane);
      const float rs = rsqrtf(ss * (1.f / 512.f) + EPSF);
      const float4 g0 = *(const float4*)(kvan + 8 * lane), g1 = *(const float4*)(kvan + 8 * lane + 4);
      float4 y0 = make_float4(x[0] * rs * g0.x, x[1] * rs * g0.y, x[2] * rs * g0.z, x[3] * rs * g0.w);
      float4 y1 = make_float4(x[4] * rs * g1.x, x[5] * rs * g1.y, x[6] * rs * g1.z, x[7] * rs * g1.w);
      float* od = is_s ? (o_skv + (long)rs_ * 512) : (o_pkv + (long)row * 512);
      *(float4*)(od + 8 * lane) = y0; *(float4*)(od + 8 * lane + 4) = y1;
      *(uint4*)(p.C + (long)row * 512 + 8 * lane) = pack8(y0, y1);
    }
    {
      const float x = bf1(zr[ZKR + lane]);
      const float ss = wave_sum_l(x * x, lane);
      const float rs = rsqrtf(ss * (1.f / 64.f) + EPSF);
      const float y = x * rs * krn[lane];
      const float other = shfl_xor_l(y, lane, 32);
      const int pos = tok_pos(row);
      const float2 cs = *(const float2*)(p.rope + ((long)pos * 32 + (lane & 31)) * 2);
      const float o = lane < 32 ? (y * cs.x - other * cs.y) : (other * cs.y + y * cs.x);
      if (is_s) {
        o_skr[(long)rs_ * 64 + lane] = o;
        p.KRs[((long)(rs_ >> 4) * LKS + PAST + (rs_ & 15)) * 64 + lane] = f2bf(o);
      } else {
        o_pkr[(long)row * 64 + lane] = o;
        p.KRp[(long)row * 64 + lane] = f2bf(o);
      }
    }
    {
      uint4 v[2]; float ss = 0.f;
#pragma unroll
      for (int i = 0; i < 2; ++i) {
        v[i] = *(const uint4*)(zr + ZV + 8 * lane + 512 * i);
        const float x[8] = {bflo(v[i].x), bfhi(v[i].x), bflo(v[i].y), bfhi(v[i].y), bflo(v[i].z), bfhi(v[i].z), bflo(v[i].w), bfhi(v[i].w)};
#pragma unroll
        for (int j = 0; j < 8; ++j) ss += x[j] * x[j];
      }
      ss = wave_sum_l(ss, lane);
      const float rs = rsqrtf(ss * (1.f / 1024.f) + EPSF);
      if (lane == 0) p.rsv[row] = rs;
      if (is_s) {
#pragma unroll
        for (int i = 0; i < 2; ++i) {
          const int c = 8 * lane + 512 * i;
          const float x[8] = {bflo(v[i].x), bfhi(v[i].x), bflo(v[i].y), bfhi(v[i].y), bflo(v[i].z), bfhi(v[i].z), bflo(v[i].w), bfhi(v[i].w)};
          const float4 g0 = *(const float4*)(gvn + c), g1 = *(const float4*)(gvn + c + 4);
          *(float4*)(o_sgv + (long)rs_ * 1024 + c) = make_float4(x[0] * rs * g0.x, x[1] * rs * g0.y, x[2] * rs * g0.z, x[3] * rs * g0.w);
          *(float4*)(o_sgv + (long)rs_ * 1024 + c + 4) = make_float4(x[4] * rs * g1.x, x[5] * rs * g1.y, x[6] * rs * g1.z, x[7] * rs * g1.w);
        }
      }
    }
  }
  {
    const float* cc = p.cache_c + (long)l * 32 * PAST * 512;
    const long gt = (long)get_bid() * 512 + tid, gs = (long)gridDim.x * 512;
    for (long e = gt; e < 32L * PAST * 512 / 8; e += gs) {
      const float4 a = *(const float4*)(cc + e * 8), c = *(const float4*)(cc + e * 8 + 4);
      *(uint4*)(p.CB + e * 8) = pack8(a, c);
    }
    const float* pp = p.p_prompt + (long)l * M_P * 256; const float* ps = p.p_sample + (long)l * M_S * 256;
    for (long e = gt; e < (long)M_ALL * 256 / 8; e += gs) {
      const long pe = (long)M_P * 256 / 8;
      const float* src = e < pe ? (pp + e * 8) : (ps + (e - pe) * 8);
      *(uint4*)(p.PB + e * 8) = pack8(*(const float4*)src, *(const float4*)(src + 4));
    }
  }
  const float* ckr = p.cache_kr + (long)l * 32 * PAST * 64;
  const long gtid = (long)get_bid() * 512 + tid, gstride = (long)gridDim.x * 512;
  for (long e = gtid; e < 32L * PAST * 64 / 8; e += gstride) {
    const long el = e * 8; const int b = (int)(el / (PAST * 64)); const long rem = el - (long)b * PAST * 64;
    const float4 a = *(const float4*)(ckr + el), c = *(const float4*)(ckr + el + 4);
    *(uint4*)(p.KRs + (long)b * LKS * 64 + rem) = pack8(a, c);
  }
}

#define NCKV (512 * 8)
#define NPKV (64 * 8)
#define NSKV (2 * 8)
#define NQT (66 * 6)
#define NPPT (66 * 4)
#define RED8_OFF 131072
template <class RowPtr>
DI void nope_epi256(f32x4 (&acc)[2][2][4][2], const float* __restrict__ gain, float scale, char* smem, RowPtr rowptr, int g_wave_s) {
  const int tid = get_tid();
  const int wid = tid >> 6, lane = tid & 63, wr = wid >> 2, wc = wid & 3, fr = lane & 15, fq = lane >> 4;
  float* red = (float*)(smem + RED8_OFF);
#pragma unroll
  for (int ai = 0; ai < 2; ++ai)
#pragma unroll
    for (int bj = 0; bj < 2; ++bj)
#pragma unroll
      for (int m = 0; m < 4; ++m) {
        float s = 0.f;
#pragma unroll
        for (int n = 0; n < 2; ++n)
#pragma unroll
          for (int j = 0; j < 4; ++j) s += acc[ai][bj][m][n][j] * acc[ai][bj][m][n][j];
        s += shfl_xor_l(s, lane, 16); s += shfl_xor_l(s, lane, 32);
        if (fq == 0) red[((wc * 2 + ai) * 2 + bj) * 128 + 64 * wr + 16 * m + fr] = s;
      }
  __syncthreads();
  const int c = 32 * wc + 8 * fq;
  const float4 ga = *(const float4*)(gain + c), gb = *(const float4*)(gain + c + 4);
#pragma unroll
  for (int ai = 0; ai < 2; ++ai)
#pragma unroll
    for (int bj = 0; bj < 2; ++bj)
#pragma unroll
      for (int m = 0; m < 4; ++m) {
        const int rl = 64 * wr + 16 * m + fr;
        float tot = 0.f;
#pragma unroll
        for (int q = 0; q < 4; ++q) tot += red[((q * 2 + ai) * 2 + bj) * 128 + rl];
        const float rs = rsqrtf(tot * (1.f / 128.f) + EPSF) * scale;
        u16* op = rowptr(128 * ai + rl, bj);
        *(uint4*)(op + c) = make_uint4(pk2(acc[ai][bj][m][0][0] * rs * ga.x, acc[ai][bj][m][0][1] * rs * ga.y), pk2(acc[ai][bj][m][0][2] * rs * ga.z, acc[ai][bj][m][0][3] * rs * ga.w),
                                       pk2(acc[ai][bj][m][1][0] * rs * gb.x, acc[ai][bj][m][1][1] * rs * gb.y), pk2(acc[ai][bj][m][1][2] * rs * gb.z, acc[ai][bj][m][1][3] * rs * gb.w));
      }
}

#define G8_COORDS const int tid = get_tid(); const int wid = tid >> 6, lane = tid & 63, wr = wid >> 2, wc = wid & 3, fr = lane & 15, fq = lane >> 4; (void)wr; (void)wc; (void)fr; (void)fq;
DI void vt_epi256(const Params& p, f32x4 (&acc)[2][2][4][2], int mode, int m0, int tn, int g_wave_s) {
  G8_COORDS
  const long dstride = (mode == 0) ? (long)M_P : (long)LKS;
#pragma unroll
  for (int bj = 0; bj < 2; ++bj) {
    const int m32 = m0 + 128 * bj + 32 * wc;
#pragma unroll
    for (int ai = 0; ai < 2; ++ai) {
      const int h = 2 * (tn - 4) + ai;
      u16* base;
      if (mode == 0) base = p.VTp + (long)h * 128 * M_P + m32 + 8 * fq;
      else if (mode == 1) base = p.VTs + ((long)(m32 >> 12) * 8 + h) * 128 * LKS + (m32 & 4095) + 8 * fq;
      else base = p.VTs + ((long)((m32 >> 4) + (fq >> 1)) * 8 + h) * 128 * LKS + PAST + 8 * (fq & 1);
#pragma unroll
      for (int m = 0; m < 4; ++m) {
        const int dd = 64 * wr + 16 * m + fr;
        *(uint4*)(base + (long)dd * dstride) = make_uint4(pk2(acc[ai][bj][m][0][0], acc[ai][bj][m][0][1]), pk2(acc[ai][bj][m][0][2], acc[ai][bj][m][0][3]),
                                                          pk2(acc[ai][bj][m][1][0], acc[ai][bj][m][1][1]), pk2(acc[ai][bj][m][1][2], acc[ai][bj][m][1][3]));
      }
    }
  }
}
DI void rope_epi256(const Params& p, int l, f32x4 (&acc)[2][2][4][2], int tm, int tn, char* smem, int g_wave_s) {
  G8_COORDS
  float* red = (float*)(smem + RED8_OFF);
#pragma unroll
  for (int ai = 0; ai < 2; ++ai)
#pragma unroll
    for (int bj = 0; bj < 2; ++bj)
#pragma unroll
      for (int m = 0; m < 4; ++m) {
        float s = 0.f;
#pragma unroll
        for (int n = 0; n < 2; ++n)
#pragma unroll
          for (int j = 0; j < 4; ++j) s += acc[ai][bj][m][n][j] * acc[ai][bj][m][n][j];
        s += shfl_xor_l(s, lane, 16); s += shfl_xor_l(s, lane, 32);
        if (fq == 0) red[((wc * 2 + ai) * 2 + bj) * 128 + 64 * wr + 16 * m + fr] = s;
      }
  __syncthreads();
  const float* g = p.qrn + l * 64;
  const int c0 = 16 * (wc & 1) + 4 * fq;
  const float4 g1 = *(const float4*)(g + c0), g2 = *(const float4*)(g + 32 + c0);
  const float gg1[4] = {g1.x, g1.y, g1.z, g1.w}, gg2[4] = {g2.x, g2.y, g2.z, g2.w};
#pragma unroll
  for (int ai = 0; ai < 2; ++ai)
#pragma unroll
    for (int m = 0; m < 4; ++m) {
      const int rl = 64 * wr + 16 * m + fr;
      const int row = tm * 256 + 128 * ai + rl;
      const int pos = tok_pos(row);
      const float4 t0 = *(const float4*)(p.rope + ((long)pos * 32 + c0) * 2);
      const float4 t1 = *(const float4*)(p.rope + ((long)pos * 32 + c0) * 2 + 4);
      const float cs[4] = {t0.x, t0.z, t1.x, t1.z}, sn[4] = {t0.y, t0.w, t1.y, t1.w};
#pragma unroll
      for (int bj = 0; bj < 2; ++bj) {
        const float tot = red[((wc * 2 + ai) * 2 + bj) * 128 + rl] + red[(((wc ^ 1) * 2 + ai) * 2 + bj) * 128 + rl];
        const float rs = rsqrtf(tot * (1.f / 64.f) + EPSF);
        const int head = 4 * (tn - 4) + 2 * bj + (wc >> 1);
        u16* qp = p.Q + ((long)row * 8 + head) * 192 + 128;
        float o1[4], o2[4];
#pragma unroll
        for (int j = 0; j < 4; ++j) {
          const float y1 = acc[ai][bj][m][0][j] * rs * gg1[j], y2 = acc[ai][bj][m][1][j] * rs * gg2[j];
          o1[j] = (y1 * cs[j] - y2 * sn[j]) * QSCALE; o2[j] = (y1 * sn[j] + y2 * cs[j]) * QSCALE;
        }
        *(uint2*)(qp + c0) = make_uint2(pk2(o1[0], o1[1]), pk2(o1[2], o1[3]));
        *(uint2*)(qp + 32 + c0) = make_uint2(pk2(o2[0], o2[1]), pk2(o2[2], o2[3]));
      }
    }
}
DI void pp_epi256(const Params& p, f32x4 (&acc)[2][2][4][2], int tm, int tn, int g_wave_s) {
  G8_COORDS
#pragma unroll
  for (int ai = 0; ai < 2; ++ai)
#pragma unroll
    for (int m = 0; m < 4; ++m) {
      const long row = (long)tm * 256 + 128 * ai + 64 * wr + 16 * m + fr;
#pragma unroll
      for (int bj = 0; bj < 2; ++bj) {
        const int col = tn * 256 + 128 * bj + 32 * wc + 8 * fq;
        *(uint4*)(p.PP + row * 1024 + col) = make_uint4(pk2(acc[ai][bj][m][0][0], acc[ai][bj][m][0][1]), pk2(acc[ai][bj][m][0][2], acc[ai][bj][m][0][3]),
                                                        pk2(acc[ai][bj][m][1][0], acc[ai][bj][m][1][1]), pk2(acc[ai][bj][m][1][2], acc[ai][bj][m][1][3]));
      }
    }
}

DI void multi_phase(const Params& p, int l, char* smem, int g_wave_s) {
  const u16* Wkv = p.Wkv + (long)l * 2048 * 512;
  const u16* Wuq = p.Wuq + (long)l * 1536 * 384;
  const u16* Wpe = p.Wpe + (long)l * 1024 * 256;
  const int total = NCKV + NPKV + NSKV + NQT + NPPT;
  const int G = gridDim.x;
#pragma unroll 1
  for (int t = get_bid(); t < NCKV + NPKV + NSKV; t += G) {
    f32x4 acc[2][2][4][2];
    {
      const u16* tok; int u = t, mode;
      if (u < NCKV) { tok = p.CB + (long)(u >> 3) * 256 * 512; mode = 1; }
      else if ((u -= NCKV) < NPKV) { tok = p.C + (long)(u >> 3) * 256 * 512; mode = 0; }
      else { u -= NPKV; tok = p.C + ((long)M_P + (u >> 3) * 256) * 512; mode = 2; }
      const int m0 = (u >> 3) * 256, tn = u & 7;
      const u16* wgt = Wkv + (long)tn * 256 * 512;
      if (tn < 4) {
        gemm256_tile<1>(tok, wgt, 512, smem, acc, g_wave_s);
        nope_epi256(acc, p.knn + l * 128, 1.0f, smem, [&](int rloc, int bj) -> u16* {
          const int m = m0 + rloc; const int h = 2 * tn + bj;
          if (mode == 0) return p.Knp + ((long)m * 8 + h) * 128;
          long key;
          if (mode == 1) key = (long)(m >> 12) * LKS + (m & 4095); else key = (long)(m >> 4) * LKS + PAST + (m & 15);
          return p.Kns + (key * 8 + h) * 128;
        }, g_wave_s);
      } else {
        gemm256_tile<2>(wgt, tok, 512, smem, acc, g_wave_s);
        vt_epi256(p, acc, mode, m0, tn, g_wave_s);
      }
    }
  }
#pragma unroll 1
  for (int t = get_bid() + ((NCKV + NPKV + NSKV) / G) * G; t < total; t += G) {
    if (t < NCKV + NPKV + NSKV) continue;
    f32x4 acc[2][2][4][2];
    int u = t - (NCKV + NPKV + NSKV);
    if (u < NQT) {
      const int tm = u / 6, tn = u - tm * 6;
      gemm256_tile<1>(p.QN + (long)tm * 256 * 384, Wuq + (long)tn * 256 * 384, 384, smem, acc, g_wave_s);
      if (tn < 4) nope_epi256(acc, p.qnn + l * 128, QSCALE, smem, [&](int rloc, int bj) -> u16* { return p.Q + ((long)(tm * 256 + rloc) * 8 + 2 * tn + bj) * 192; }, g_wave_s);
      else rope_epi256(p, l, acc, tm, tn, smem, g_wave_s);
      continue;
    }
    u -= NQT;
    {
      const int tm = u >> 2, tn = u & 3;
      gemm256_tile<1>(p.PB + (long)tm * 256 * 256, Wpe + (long)tn * 256 * 256, 256, smem, acc, g_wave_s);
      pp_epi256(p, acc, tm, tn, g_wave_s);
    }
  }
}

DI void attn_item(const u16* __restrict__ Qb, int qclamp, const u16* __restrict__ Kn, const u16* __restrict__ KR,
                  const u16* __restrict__ VT, long vt_stride, int ntiles, int ntw, int Lk, u16* __restrict__ Ob, char* smem, int g_wave_s) {
  const int tid = get_tid(), lane = tid & 63, w = tid >> 6, r = lane & 31, hh = lane >> 5;
  u16* Ks = (u16*)smem;
  u16* Vs = Ks + 64 * 200;
  bf16x8 qf[12];
  {
    const int qr = r < qclamp ? r : qclamp;
    const u16* qp = Qb + (long)(32 * w + qr) * (8 * 192) + 8 * hh;
#pragma unroll
    for (int ks = 0; ks < 12; ++ks) qf[ks] = *(const bf16x8*)(qp + 16 * ks);
  }
  f32x16 oacc[4];
#pragma unroll
  for (int dt = 0; dt < 4; ++dt)
#pragma unroll
    for (int i = 0; i < 16; ++i) oacc[dt][i] = 0.f;
  float mrun = -INFINITY, lrun = 0.f;

  uint4 rk0, rk1, rk2, rv0, rv1;
  const int lkey = tid >> 3, lq = tid & 7;
  unsigned koff = (unsigned)(lkey * 1024 + lq * 8) * 2u;
  unsigned kroff = (unsigned)(lkey * 64 + lq * 8) * 2u;
  const unsigned vstep = (unsigned)(64 * vt_stride * 2);
  unsigned voff = (unsigned)(lkey * vt_stride * 2 + lq * 16);
  const char* KnB = (const char*)Kn; const char* KRB = (const char*)KR; const char* VTB = (const char*)VT;
  char* KsW = (char*)Ks + lkey * 400 + lq * 16;
  char* VsW = (char*)Vs + lkey * 144 + lq * 16;
#define AGLOAD() { \
    rk0 = *(const uint4*)(KnB + (size_t)koff); rk1 = *(const uint4*)(KnB + (size_t)koff + 128); \
    rk2 = *(const uint4*)(KRB + (size_t)kroff); \
    rv0 = *(const uint4*)(VTB + (size_t)voff); rv1 = *(const uint4*)(VTB + (size_t)(voff + vstep)); \
    koff += 64 * 1024 * 2; kroff += 64 * 64 * 2; voff += 128; }
#define ASTORE() { \
    *(uint4*)(KsW) = rk0; *(uint4*)(KsW + 128) = rk1; *(uint4*)(KsW + 256) = rk2; \
    *(uint4*)(VsW) = rv0; *(uint4*)(VsW + 64 * 144) = rv1; }

  AGLOAD();
#pragma unroll 1
  for (int jt = 0; jt < ntiles; ++jt) {
    __syncthreads();
    ASTORE();
    __syncthreads();
    if (jt >= ntw) { if (jt + 1 < ntiles) AGLOAD(); }
    if (jt < ntw) {
      f32x16 sacc[2];
#pragma unroll
      for (int kt = 0; kt < 2; ++kt)
#pragma unroll
        for (int i = 0; i < 16; ++i) sacc[kt][i] = 0.f;
      const u16* kb = Ks + r * 200 + 8 * hh;
#pragma unroll
      for (int ks = 0; ks < 12; ++ks) {
        bf16x8 k0 = *(const bf16x8*)(kb + 16 * ks);
        bf16x8 k1 = *(const bf16x8*)(kb + 32 * 200 + 16 * ks);
        sacc[0] = MFMA(k0, qf[ks], sacc[0]);
        sacc[1] = MFMA(k1, qf[ks], sacc[1]);
        if ((ks & 3) == 3) __builtin_amdgcn_sched_barrier(0);
      }
      if ((jt + 1) * 64 > Lk) {
#pragma unroll
        for (int kt = 0; kt < 2; ++kt)
#pragma unroll
          for (int i = 0; i < 16; ++i) {
            const int key = jt * 64 + 32 * kt + (i & 3) + 8 * (i >> 2) + 4 * hh;
            if (key >= Lk) sacc[kt][i] = -INFINITY;
          }
      }
      float tmax = -INFINITY;
#pragma unroll
      for (int kt = 0; kt < 2; ++kt)
#pragma unroll
        for (int i = 0; i < 16; ++i) tmax = fmaxf(tmax, sacc[kt][i]);
      tmax = fmaxf(tmax, shfl_xor_l(tmax, lane, 32));
      const float mnew = fmaxf(mrun, tmax);
      const float alpha = __builtin_amdgcn_exp2f(mrun - mnew);
      mrun = mnew;
      float psum = 0.f;
#pragma unroll
      for (int kt = 0; kt < 2; ++kt)
#pragma unroll
        for (int i = 0; i < 16; ++i) { const float pv = __builtin_amdgcn_exp2f(sacc[kt][i] - mnew); sacc[kt][i] = pv; psum += pv; }
      lrun = lrun * alpha + psum;
#pragma unroll
      for (int dt = 0; dt < 4; ++dt)
#pragma unroll
        for (int i = 0; i < 16; ++i) oacc[dt][i] *= alpha;
      bf16x8 pf[2][2];
#pragma unroll
      for (int kt = 0; kt < 2; ++kt)
#pragma unroll
        for (int s = 0; s < 2; ++s) {
          uint4 pp = make_uint4(pk2(sacc[kt][8 * s + 0], sacc[kt][8 * s + 1]), pk2(sacc[kt][8 * s + 2], sacc[kt][8 * s + 3]),
                                pk2(sacc[kt][8 * s + 4], sacc[kt][8 * s + 5]), pk2(sacc[kt][8 * s + 6], sacc[kt][8 * s + 7]));
          pf[kt][s] = __builtin_bit_cast(bf16x8, pp);
        }
      if (jt + 1 < ntiles) AGLOAD();
      const u16* vb = Vs + r * 72 + 8 * hh;
#pragma unroll
      for (int dt = 0; dt < 4; ++dt)
#pragma unroll
        for (int kt = 0; kt < 2; ++kt)
#pragma unroll
          for (int s = 0; s < 2; ++s) {
            bf16x8 vf = *(const bf16x8*)(vb + 32 * dt * 72 + 32 * kt + 16 * s);
            oacc[dt] = MFMA(vf, pf[kt][s], oacc[dt]);
            if (kt == 1 && s == 1) __builtin_amdgcn_sched_barrier(0);
          }
    }
  }
  if (ntw > 0 && r <= qclamp) {
    const float ltot = lrun + shfl_xor_l(lrun, lane, 32);
    const float inv = 1.f / ltot;
    u16* op = Ob + (long)(32 * w + r) * 1024;
#pragma unroll
    for (int dt = 0; dt < 4; ++dt)
#pragma unroll
      for (int i4 = 0; i4 < 4; ++i4) {
        const int d = 32 * dt + 8 * i4 + 4 * hh;
        *(uint2*)(op + d) = make_uint2(pk2(oacc[dt][4 * i4 + 0] * inv, oacc[dt][4 * i4 + 1] * inv), pk2(oacc[dt][4 * i4 + 2] * inv, oacc[dt][4 * i4 + 3] * inv));
      }
  } else if (ntw > 0) {
    (void)shfl_xor_l(lrun, lane, 32);
  }
}

DI void attn_phase(const Params& p, int l, char* smem, int* s_item, int cidx, int g_wave_s) {
  const int tid = get_tid(), w = tid >> 6;
  const int NITEM = 256 + 512;
  for (;;) {
    __syncthreads();
    if (tid == 0) *s_item = (int)atomicAdd(p.ctr + cidx, 1u);
    __syncthreads();
    const int item = *s_item;
    if (item >= NITEM) break;
    if (item < 256) {
      const int b = item >> 3, h = item & 7;
      const u16* Qb = p.Q + ((long)(M_P + 16 * b) * 8 + h) * 192;
      const u16* Kn = p.Kns + ((long)b * LKS * 8 + h) * 128;
      const u16* KR = p.KRs + (long)b * LKS * 64;
      const u16* VT = p.VTs + ((long)b * 8 + h) * 128 * LKS;
      u16* Ob = p.OA + (long)(M_P + 16 * b) * 1024 + h * 128;
      attn_item(Qb, 15, Kn, KR, VT, LKS, 65, w == 0 ? 65 : 0, LKV, Ob, smem, g_wave_s);
    } else {
      const int idx = item - 256;
      const int qb = 63 - (idx >> 3), h = idx & 7;
      const u16* Qb = p.Q + ((long)(256 * qb) * 8 + h) * 192;
      const u16* Kn = p.Knp + (long)h * 128;
      const u16* KR = p.KRp;
      const u16* VT = p.VTp + (long)h * 128 * M_P;
      u16* Ob = p.OA + (long)(256 * qb) * 1024 + h * 128;
      const int ntiles = 4 * qb + 4;
      attn_item(Qb, 31, Kn, KR, VT, M_P, ntiles, 4 * qb + (w >> 1) + 1, 1 << 30, Ob, smem, g_wave_s);
    }
  }
}

DI void gmlp_phase(const Params& p, int l, char* smem_all, int g_wave_s) {
  const int half = get_tid() >> 8; char* smem = smem_all + half * HALF_BYTES;
  const int tid = get_tid() & 255, lane = tid & 63, w = tid >> 6, wm = w >> 1, wn = w & 1, r = lane & 31, hh = lane >> 5;
  const float* gvn = p.gvn + l * 1024;
  const float* gws = p.gws + (long)l * 8 * 128 * 128;
  const float* gbs = p.gbs + (long)l * 8 * 128;
  u16* Xs = (u16*)smem;
  u16* Ws = Xs + 128 * 136;
  const int NP = 128 * 8, NS = 32 * 4;
  for (int t2 = get_bid(); t2 < (NP + NS + 1) / 2; t2 += gridDim.x) {
    const int t = 2 * t2 + half;
    const bool valid = t < NP + NS;
    const bool isp = valid && t < NP;
    {
      const int ci = t >> 3, g = t & 7;
      const int t0 = ci * 128, c0 = g * 128;
      __syncthreads();
      if (isp) {
#pragma unroll
      for (int i = 0; i < 8; ++i) {
        const int c = tid + 256 * i; const int s = c >> 4, dc = (c & 15) * 8;
        const uint4 v = *(const uint4*)(p.Z + (long)(t0 + s) * LDZ + ZV + c0 + dc);
        const float rs = p.rsv[t0 + s];
        const float4 g0 = *(const float4*)(gvn + c0 + dc), g1 = *(const float4*)(gvn + c0 + dc + 4);
        Xs[(dc + 0) * 136 + s] = f2bf(bflo(v.x) * rs * g0.x); Xs[(dc + 1) * 136 + s] = f2bf(bfhi(v.x) * rs * g0.y);
        Xs[(dc + 2) * 136 + s] = f2bf(bflo(v.y) * rs * g0.z); Xs[(dc + 3) * 136 + s] = f2bf(bfhi(v.y) * rs * g0.w);
        Xs[(dc + 4) * 136 + s] = f2bf(bflo(v.z) * rs * g1.x); Xs[(dc + 5) * 136 + s] = f2bf(bfhi(v.z) * rs * g1.y);
        Xs[(dc + 6) * 136 + s] = f2bf(bflo(v.w) * rs * g1.z); Xs[(dc + 7) * 136 + s] = f2bf(bfhi(v.w) * rs * g1.w);
        const int tt = c >> 4, sc = (c & 15) * 8;
        const float* wp = gws + ((long)g * 128 + tt) * 128 + sc;
        float4 a = *(const float4*)wp, b = *(const float4*)(wp + 4);
        a.x = (sc + 0 <= tt) ? a.x : 0.f; a.y = (sc + 1 <= tt) ? a.y : 0.f; a.z = (sc + 2 <= tt) ? a.z : 0.f; a.w = (sc + 3 <= tt) ? a.w : 0.f;
        b.x = (sc + 4 <= tt) ? b.x : 0.f; b.y = (sc + 5 <= tt) ? b.y : 0.f; b.z = (sc + 6 <= tt) ? b.z : 0.f; b.w = (sc + 7 <= tt) ? b.w : 0.f;
        *(uint4*)(Ws + tt * 136 + sc) = pack8(a, b);
      }
      }
      __syncthreads();
      if (isp) {
      f32x16 acc[2][2];
#pragma unroll
      for (int mi = 0; mi < 2; ++mi)
#pragma unroll
        for (int ni = 0; ni < 2; ++ni)
#pragma unroll
          for (int i = 0; i < 16; ++i) acc[mi][ni][i] = 0.f;
      const u16* Ab = Ws + (64 * wm + r) * 136 + 8 * hh;
      const u16* Bb = Xs + (64 * wn + r) * 136 + 8 * hh;
#pragma unroll
      for (int ks = 0; ks < 8; ++ks) {
        bf16x8 a0 = *(const bf16x8*)(Ab + 16 * ks), a1 = *(const bf16x8*)(Ab + 32 * 136 + 16 * ks);
        bf16x8 b0 = *(const bf16x8*)(Bb + 16 * ks), b1 = *(const bf16x8*)(Bb + 32 * 136 + 16 * ks);
        acc[0][0] = MFMA(b0, a0, acc[0][0]); acc[0][1] = MFMA(b1, a0, acc[0][1]);
        acc[1][0] = MFMA(b0, a1, acc[1][0]); acc[1][1] = MFMA(b1, a1, acc[1][1]);
      }
#pragma unroll
      for (int mi = 0; mi < 2; ++mi) {
        const int tl = 64 * wm + 32 * mi + r;
        const long row = t0 + tl;
        const float bias = gbs[g * 128 + tl];
        const u16* zr = p.Z + row * LDZ;
#pragma unroll
        for (int ni = 0; ni < 2; ++ni)
#pragma unroll
          for (int i4 = 0; i4 < 4; ++i4) {
            const int col = c0 + 64 * wn + 32 * ni + 8 * i4 + 4 * hh;
            const uint2 uu = *(const uint2*)(zr + ZU + col), ga = *(const uint2*)(zr + ZGA + col), gb = *(const uint2*)(zr + ZGB + col);
            const uint2 oa = *(const uint2*)(p.OA + row * 1024 + col);
            const float o0 = sigm(bflo(ga.x)) * bflo(oa.x) + sigm(bflo(gb.x)) * bflo(uu.x) * (acc[mi][ni][4 * i4 + 0] + bias);
            const float o1 = sigm(bfhi(ga.x)) * bfhi(oa.x) + sigm(bfhi(gb.x)) * bfhi(uu.x) * (acc[mi][ni][4 * i4 + 1] + bias);
            const float o2 = sigm(bflo(ga.y)) * bflo(oa.y) + sigm(bflo(gb.y)) * bflo(uu.y) * (acc[mi][ni][4 * i4 + 2] + bias);
            const float o3 = sigm(bfhi(ga.y)) * bfhi(oa.y) + sigm(bfhi(gb.y)) * bfhi(uu.y) * (acc[mi][ni][4 * i4 + 3] + bias);
            *(uint2*)(p.MIX + row * 1024 + col) = make_uint2(pk2(o0, o1), pk2(o2, o3));
          }
      }
      }
    }
    if (valid && !isp) {
      const int u = t - NP; const int b = u >> 2, col = (u & 3) * 256 + tid; const int g = col >> 7;
      const long row0 = M_P + 16 * b;
      const float gv = gvn[col];
      float vn[16];
#pragma unroll
      for (int s = 0; s < 16; ++s) vn[s] = bf1(p.Z[(row0 + s) * LDZ + ZV + col]) * p.rsv[row0 + s] * gv;
#pragma unroll
      for (int tt = 0; tt < 16; ++tt) {
        float mx = gbs[g * 128 + tt];
#pragma unroll
        for (int s = 0; s <= tt; ++s) mx += gws[((long)g * 128 + tt) * 128 + s] * vn[s];
        const u16* zr = p.Z + (row0 + tt) * LDZ;
        const float uu = bf1(zr[ZU + col]), ga = bf1(zr[ZGA + col]), gb = bf1(zr[ZGB + col]);
        const float oa = bf1(p.OA[(row0 + tt) * 1024 + col]);
        p.MIX[(row0 + tt) * 1024 + col] = f2bf(sigm(ga) * oa + sigm(gb) * uu * mx);
      }
    }
  }
}

#define XB_TMO      128
#define XB_XCNT(j)  (256  + 64 * (j))
#define XB_XSUB(j)  (1280 + 64 * (j))
#define XB_XGEN(j)  (2304 + 64 * (j))
#define XB_TOP      3328
#define XB_TOPGEN   3392
#define XCD_BAR_WORDS 3456
#define XB_SPIN_CAP (1u << 22)
#define LAS __attribute__((address_space(3)))
DI unsigned xb_ld(unsigned* p) { return __hip_atomic_load(p, __ATOMIC_RELAXED, __HIP_MEMORY_SCOPE_AGENT); }
DI unsigned xb_add(unsigned* p, unsigned v) { return __hip_atomic_fetch_add(p, v, __ATOMIC_RELAXED, __HIP_MEMORY_SCOPE_AGENT); }
DI unsigned xb_xcc_id() { return (unsigned)__builtin_amdgcn_s_getreg((3 << 11) | 20) & 0xFu; }
#define XB_SPIN(cond, bar) do { unsigned _sp = 0; while (cond) { __builtin_amdgcn_s_sleep(1); \
    if ((++_sp & 255u) == 0u) { if (xb_ld(&(bar)[XB_TMO])) break; if (_sp > XB_SPIN_CAP) { atomicAdd(&(bar)[XB_TMO], 1u); break; } } } } while (0)
struct XcdBarrier { unsigned* bar; unsigned x; volatile LAS unsigned* st; };
DI XcdBarrier xcd_barrier_post(unsigned* bar, volatile LAS unsigned* st) {
  XcdBarrier b; b.bar = bar; b.x = xb_xcc_id(); b.st = st;
  if (threadIdx.x == 0) (void)xb_add(&bar[XB_XCNT(b.x)], 1u);
  return b;
}
DI void xcd_barrier_complete(unsigned* bar, unsigned x, unsigned& nloc, unsigned& nx) {
  const unsigned G = gridDim.x * gridDim.y * gridDim.z;
  unsigned sum, cnt, mine, sp = 0u;
  for (;;) {
    sum = 0u; cnt = 0u; mine = 0u;
#pragma unroll
    for (unsigned j = 0; j < 16; ++j) { const unsigned c = xb_ld(&bar[XB_XCNT(j)]); sum += c; cnt += (c > 0u) ? 1u : 0u; mine = (j == x) ? c : mine; }
    if (sum == G) break;
    __builtin_amdgcn_s_sleep(1);
    if ((++sp & 255u) == 0u) { if (xb_ld(&bar[XB_TMO])) break; if (sp > XB_SPIN_CAP) { atomicAdd(&bar[XB_TMO], 1u); break; } }
  }
  nloc = mine > 0u ? mine : 1u; nx = cnt > 0u ? cnt : 1u;
}
DI void xcd_barrier(const XcdBarrier& b) {
  asm volatile("s_waitcnt vmcnt(0)" ::: "memory");
  __syncthreads();
  if (threadIdx.x == 0) {
    unsigned* bar = b.bar;
    __builtin_amdgcn_s_waitcnt(0);
    unsigned nloc = b.st[0], nx = b.st[1];
    if (nloc == 0u) { xcd_barrier_complete(bar, b.x, nloc, nx); b.st[0] = nloc; b.st[1] = nx; }
    const unsigned old = xb_add(&bar[XB_XSUB(b.x)], 1u);
    const unsigned gen = old / nloc;
    if (old + 1u == (gen + 1u) * nloc) {
      __builtin_amdgcn_fence(__ATOMIC_RELEASE, "agent");
      asm volatile("s_waitcnt vmcnt(0)" ::: "memory");
      const unsigned og = xb_add(&bar[XB_TOP], 1u);
      const unsigned tg = og / nx;
      if (og + 1u == (tg + 1u) * nx) xb_add(&bar[XB_TOPGEN], 1u);
      else XB_SPIN(xb_ld(&bar[XB_TOPGEN]) == tg, bar);
      __builtin_amdgcn_fence(__ATOMIC_ACQUIRE, "agent");
      xb_add(&bar[XB_XGEN(b.x)], 1u);
      asm volatile("s_waitcnt vmcnt(0)" ::: "memory");
    } else {
      XB_SPIN(xb_ld(&bar[XB_XGEN(b.x)]) == gen, bar);
      __builtin_amdgcn_fence(__ATOMIC_ACQUIRE, "agent");
      asm volatile("s_waitcnt vmcnt(0)" ::: "memory");
    }
  }
  __syncthreads();
}

__global__ void __launch_bounds__(512, 2) mega_fwd(Params p) {
  const int g_wave_s = __builtin_amdgcn_readfirstlane((int)(threadIdx.x >> 6));
  extern __shared__ __attribute__((aligned(16))) char smem[];
  uint4& xb_words = *(uint4*)(smem + SMEM_BYTES);
  int& s_item = *(int*)(smem + SMEM_BYTES + 16);
  cg::grid_group grid = cg::this_grid();
  if (threadIdx.x == 0) xb_words = make_uint4(0u, 0u, 0u, 0u);
  __syncthreads();
  XcdBarrier xb = xcd_barrier_post(p.bar, (volatile LAS unsigned*)&xb_words);

  prep_phase(p, smem, g_wave_s);
  grid.sync();
#ifdef PROBE_PREP
  prep_phase(p, smem, g_wave_s);
  grid.sync();
#endif
#pragma unroll 1
  for (int l = 0; l < 2; ++l) {
    norm_phase(p.out, p.f1n + l * 1024, p.NB, g_wave_s);
    xcd_barrier(xb);
    ffn_up_phase(p, p.Wgu1 + (long)l * 2 * DFF * 1024, smem, g_wave_s);
    xcd_barrier(xb);
#ifdef PROBE_FFN
    ffn_up_phase(p, p.Wgu1 + (long)l * 2 * DFF * 1024, smem, g_wave_s);
    xcd_barrier(xb);
#endif
    resid_gemm_phase(p, p.ACT, DFF, p.Wd1 + (long)l * 1024 * DFF, 0.5f, smem, g_wave_s);
    xcd_barrier(xb);
    norm_phase(p.out, p.mixn + l * 1024, p.NB, g_wave_s);
    xcd_barrier(xb);
    win_phase(p, p.Win + (long)l * LDZ * 1024, smem, g_wave_s);
    xcd_barrier(xb);
    rowpost_phase(p, l, g_wave_s);
    xcd_barrier(xb);
    multi_phase(p, l, smem, g_wave_s);
    xcd_barrier(xb);
    attn_phase(p, l, smem, &s_item, l, g_wave_s);
    xcd_barrier(xb);
#ifdef PROBE_ATTN
    attn_phase(p, l, smem, &s_item, 2 + l, g_wave_s);
    xcd_barrier(xb);
#endif
#ifdef PROBE_MULTI
    multi_phase(p, l, smem, g_wave_s);
    xcd_barrier(xb);
#endif
    gmlp_phase(p, l, smem, g_wave_s);
    xcd_barrier(xb);
#ifdef PROBE_GMLP
    gmlp_phase(p, l, smem, g_wave_s);
    xcd_barrier(xb);
#endif
#ifdef PROBE_ROWPOST
    rowpost_phase(p, l, g_wave_s);
    xcd_barrier(xb);
#endif
    resid_gemm_phase(p, p.MIX, 1024, p.Wo + (long)l * 1024 * 1024, 1.0f, smem, g_wave_s);
    xcd_barrier(xb);
    norm_phase(p.out, p.f2n + l * 1024, p.NB, g_wave_s);
    xcd_barrier(xb);
    ffn_up_phase(p, p.Wgu2 + (long)l * 2 * DFF * 1024, smem, g_wave_s);
    xcd_barrier(xb);
#ifdef PROBE_FFN
    ffn_up_phase(p, p.Wgu2 + (long)l * 2 * DFF * 1024, smem, g_wave_s);
    xcd_barrier(xb);
#endif
    resid_gemm_phase(p, p.ACT, DFF, p.Wd2 + (long)l * 1024 * DFF, 0.5f, smem, g_wave_s);
    xcd_barrier(xb);
    norm_phase(p.out, p.plen + l * 1024, p.NB, g_wave_s);
    xcd_barrier(xb);
    ple_phase(p, p.Wpg + (long)l * 1024 * 1024, smem, g_wave_s);
    xcd_barrier(xb);
  }
}

extern "C" void kernel_launch(void* const* d_in, const int* in_sizes, int n_in, void* d_out, int out_size, void* d_ws,
                              size_t ws_size, hipStream_t stream) {
  (void)in_sizes; (void)n_in; (void)out_size; (void)ws_size;
  Params p{};
  auto F = [&](int i) { return (const float*)d_in[i]; };
  p.x_prompt = F(0); p.x_sample = F(1); p.cache_c = F(2); p.cache_kr = F(3); p.p_prompt = F(4); p.p_sample = F(5);
  p.f1n = F(6); p.mixn = F(10); p.qan = F(12); p.qnn = F(14); p.qrn = F(15); p.kvan = F(16); p.krn = F(17);
  p.knn = F(20); p.gvn = F(21); p.gws = F(22); p.gbs = F(23); p.f2n = F(25); p.plen = F(29);
  p.out = (float*)d_out;
  char* ws = (char*)d_ws; size_t off = 0;
  auto alloc = [&](size_t bytes) { char* r = ws + off; off += (bytes + 255) & ~(size_t)255; return r; };
  p.Wgu1 = (u16*)alloc(2UL * 2 * DFF * 1024 * 2);
  p.Wd1 = (u16*)alloc(2UL * 1024 * DFF * 2);
  p.Win = (u16*)alloc(2UL * LDZ * 1024 * 2);
  p.Wuq = (u16*)alloc(2UL * 1536 * 384 * 2);
  p.Wkv = (u16*)alloc(2UL * 2048 * 512 * 2);
  p.Wo = (u16*)alloc(2UL * 1024 * 1024 * 2);
  p.Wgu2 = (u16*)alloc(2UL * 2 * DFF * 1024 * 2);
  p.Wd2 = (u16*)alloc(2UL * 1024 * DFF * 2);
  p.Wpg = (u16*)alloc(2UL * 1024 * 1024 * 2);
  p.Wpe = (u16*)alloc(2UL * 1024 * 256 * 2);
  p.NB = (u16*)alloc((size_t)M_ALL * 1024 * 2);
  p.ACT = (u16*)alloc((size_t)M_ALL * DFF * 2);
  p.Z = (u16*)alloc((size_t)M_ALL * LDZ * 2);
  p.QN = (u16*)alloc((size_t)M_ALL * 384 * 2);
  p.C = (u16*)alloc((size_t)M_ALL * 512 * 2);
  p.KRp = (u16*)alloc((size_t)M_P * 64 * 2);
  p.KRs = (u16*)alloc((size_t)32 * LKS * 64 * 2);
  p.Q = (u16*)alloc((size_t)M_ALL * 8 * 192 * 2);
  p.Knp = (u16*)alloc((size_t)M_P * 1024 * 2);
  p.VTp = (u16*)alloc((size_t)M_P * 1024 * 2);
  p.Kns = (u16*)alloc((size_t)32 * LKS * 1024 * 2);
  p.VTs = (u16*)alloc((size_t)32 * LKS * 1024 * 2);
  p.OA = (u16*)alloc((size_t)M_ALL * 1024 * 2);
  p.MIX = (u16*)alloc((size_t)M_ALL * 1024 * 2);
  p.PP = (u16*)alloc((size_t)M_ALL * 1024 * 2);
  p.CB = (u16*)alloc((size_t)32 * PAST * 512 * 2);
  p.PB = (u16*)alloc((size_t)M_ALL * 256 * 2);
  p.rsv = (float*)alloc((size_t)M_ALL * 4);
  p.rope = (float*)alloc((size_t)16384 * 32 * 2 * 4);
  p.ctr = (unsigned*)alloc(256);
  p.bar = (unsigned*)alloc(XCD_BAR_WORDS * 4);

  int nj = 0, ts = 0;
  auto job = [&](const float* src, u16* dst, int K, int N, int kind) {
    p.jobs[nj].src = src; p.jobs[nj].dst = dst; p.jobs[nj].K = K; p.jobs[nj].N = N; p.jobs[nj].kind = kind; p.jobs[nj].tstart = ts;
    ts += (K / 64) * (N / 64); ++nj;
  };
  for (int l = 0; l < 2; ++l) {
    job(F(7) + (size_t)l * 1024 * DFF, p.Wgu1 + (size_t)l * 2 * DFF * 1024, 1024, DFF, 1);
    job(F(8) + (size_t)l * 1024 * DFF, p.Wgu1 + (size_t)l * 2 * DFF * 1024, 1024, DFF, 2);
    job(F(9) + (size_t)l * DFF * 1024, p.Wd1 + (size_t)l * 1024 * DFF, DFF, 1024, 0);
    job(F(11) + (size_t)l * 1024 * DIN, p.Win + (size_t)l * LDZ * 1024, 1024, DIN, 0);
    job(F(13) + (size_t)l * 384 * 1536, p.Wuq + (size_t)l * 1536 * 384, 384, 1536, 3);
    job(F(18) + (size_t)l * 512 * 1024, p.Wkv + (size_t)l * 2048 * 512, 512, 1024, 0);
    job(F(19) + (size_t)l * 512 * 1024, p.Wkv + (size_t)l * 2048 * 512, 512, 1024, 4);
    job(F(24) + (size_t)l * 1024 * 1024, p.Wo + (size_t)l * 1024 * 1024, 1024, 1024, 0);
    job(F(26) + (size_t)l * 1024 * DFF, p.Wgu2 + (size_t)l * 2 * DFF * 1024, 1024, DFF, 1);
    job(F(27) + (size_t)l * 1024 * DFF, p.Wgu2 + (size_t)l * 2 * DFF * 1024, 1024, DFF, 2);
    job(F(28) + (size_t)l * DFF * 1024, p.Wd2 + (size_t)l * 1024 * DFF, DFF, 1024, 0);
    job(F(30) + (size_t)l * 1024 * 1024, p.Wpg + (size_t)l * 1024 * 1024, 1024, 1024, 0);
    job(F(31) + (size_t)l * 256 * 1024, p.Wpe + (size_t)l * 1024 * 256, 256, 1024, 0);
  }
  p.ntile_prep = ts;

  static int grid_blocks = 0;
  if (!grid_blocks) {
    int dev = 0, cus = 0, per_cu = 0;
    hipGetDevice(&dev);
    hipDeviceGetAttribute(&cus, hipDeviceAttributeMultiprocessorCount, dev);
    hipFuncSetAttribute((const void*)mega_fwd, hipFuncAttributeMaxDynamicSharedMemorySize, LDS_TOTAL);
    hipOccupancyMaxActiveBlocksPerMultiprocessor(&per_cu, (const void*)mega_fwd, 512, LDS_TOTAL);
    if (per_cu > 1) per_cu = 1;
    if (per_cu < 1) per_cu = 1;
    grid_blocks = cus * per_cu;
  }
  (void)hipMemsetAsync(p.bar, 0, XCD_BAR_WORDS * 4, stream);
  void* args[] = {&p};
  hipError_t e = hipLaunchCooperativeKernel((const void*)mega_fwd, dim3(grid_blocks), dim3(512), args, LDS_TOTAL, stream);
  if (e != hipSuccess) fprintf(stderr, "cooperative launch failed: %s (grid %d)\n", hipGetErrorString(e), grid_blocks);
}
```

```cpp
#include <hip/hip_runtime.h>
#include <hip/hip_cooperative_groups.h>
#include <cstdio>
namespace cg = cooperative_groups;

#define DI __device__ __forceinline__
typedef unsigned short u16;
typedef __attribute__((ext_vector_type(8))) short bf16x8;
typedef __attribute__((ext_vector_type(16))) float f32x16;
typedef __attribute__((ext_vector_type(2))) __bf16 bf2_t;
typedef __attribute__((ext_vector_type(2))) float f2_t;

#define M_P 16384
#define M_S 512
#define M_ALL 16896
#define DM 1024
#define DFF 2816
#define DIN 5056
#define LDZ 5120
#define ZQ 0
#define ZKV 384
#define ZKR 896
#define ZU 960
#define ZV 1984
#define ZGA 3008
#define ZGB 4032
#define LKS 4160
#define LKV 4112
#define PAST 4096
#define EPSF 1e-6f
#define QSCALE (0.07216878364870322f * 1.4426950408889634f)

#define NJOBS 26
struct TJob { const float* src; u16* dst; int K, N, kind, tstart; };

struct Params {
  const float *x_prompt, *x_sample, *cache_c, *cache_kr, *p_prompt, *p_sample;
  const float *f1n, *mixn, *qan, *qnn, *qrn, *kvan, *krn, *knn, *gvn, *gws, *gbs, *f2n, *plen;
  float* out;
  u16 *Wgu1, *Wd1, *Win, *Wuq, *Wkv, *Wo, *Wgu2, *Wd2, *Wpg, *Wpe;
  u16 *CB, *PB;
  u16 *NB, *ACT, *Z, *QN, *C, *KRp, *KRs, *Q, *Knp, *VTp, *Kns, *VTs, *OA, *MIX, *PP;
  float *rsv, *rope;
  unsigned* ctr;
  unsigned* bar;
  TJob jobs[NJOBS];
  int ntile_prep; int pad0;
};

DI int get_tid_impl(int ws) { int t = (ws << 6) | (int)__builtin_amdgcn_mbcnt_hi(~0u, __builtin_amdgcn_mbcnt_lo(~0u, 0u)); asm volatile("" : "+v"(t)); return t; }
#define get_tid() get_tid_impl(g_wave_s)
DI int get_bid() { int t = blockIdx.x; asm volatile("" : "+s"(t)); return t; }
DI unsigned pk2(float a, float b) { f2_t v = {a, b}; bf2_t r = __builtin_convertvector(v, bf2_t); return __builtin_bit_cast(unsigned, r); }
DI float bflo(unsigned v) { return __uint_as_float(v << 16); }
DI float bfhi(unsigned v) { return __uint_as_float(v & 0xffff0000u); }
DI float bf1(u16 v) { return __uint_as_float(((unsigned)v) << 16); }
DI u16 f2bf(float a) { return (u16)(pk2(a, 0.f) & 0xffffu); }
DI float shfl_xor_l(float v, int lane, int o) { return __int_as_float(__builtin_amdgcn_ds_bpermute((lane ^ o) << 2, __float_as_int(v))); }
DI float wave_sum_l(float v, int lane) {
#pragma unroll
  for (int o = 32; o > 0; o >>= 1) v += shfl_xor_l(v, lane, o);
  return v;
}
DI float sigm(float x) { return 1.f / (1.f + __expf(-x)); }
DI uint4 pack8(float4 x, float4 y) { return make_uint4(pk2(x.x, x.y), pk2(x.z, x.w), pk2(y.x, y.y), pk2(y.z, y.w)); }
#define MFMA(a, b, c) __builtin_amdgcn_mfma_f32_32x32x16_bf16((a), (b), (c), 0, 0, 0)

#define HALF_BYTES (73728 + 1024)
#define SMEM_BYTES (2 * HALF_BYTES)
#define LDS_TOTAL (SMEM_BYTES + 32)

DI int job_dst_row(int kind, int n) {
  if (kind == 0) return n;
  if (kind == 1) return 256 * (n >> 7) + (n & 127);
  if (kind == 2) return 256 * (n >> 7) + 128 + (n & 127);
  if (kind == 3) { int h = n / 192, c = n - h * 192; if (c < 128) return h * 128 + c; c -= 128; const int x = c >> 5, cl = c & 31;
                   return 1024 + h * 64 + 32 * (cl >> 4) + 8 * ((cl >> 2) & 3) + 4 * x + (cl & 3); }
  return 1024 + n;
}

DI void prep_phase(const Params& p, char* smem, int g_wave_s) {
  const int tid = get_tid();
  {
    const int vt = tid & 255, half = tid >> 8;
    u16* Ts = (u16*)smem + half * (64 * 66);
    const int npair = (p.ntile_prep + 1) >> 1;
    for (int t2 = get_bid(); t2 < npair; t2 += gridDim.x) {
      const int t = 2 * t2 + half;
      const bool valid = t < p.ntile_prep;
      int j = 0;
#pragma unroll 1
      for (int q = 1; q < NJOBS; ++q) if (t >= p.jobs[q].tstart) j = q;
      const float* src = p.jobs[j].src; u16* dst = p.jobs[j].dst;
      const int K = p.jobs[j].K, N = p.jobs[j].N, kind = p.jobs[j].kind;
      const int lt = t - p.jobs[j].tstart;
      const int ntn = N >> 6;
      const int tk = lt / ntn, tn = lt - tk * ntn;
      const int k0 = tk * 64, n0 = tn * 64;
      __syncthreads();
      if (valid) {
        unsigned* Ts32 = (unsigned*)Ts;
#pragma unroll
        for (int i = 0; i < 2; ++i) {
          const int kp = (vt >> 4) + 16 * i, nc = (vt & 15) * 4;
          const float4 v0 = *(const float4*)(src + (long)(k0 + 2 * kp) * N + n0 + nc);
          const float4 v1 = *(const float4*)(src + (long)(k0 + 2 * kp + 1) * N + n0 + nc);
          Ts32[(nc + 0) * 33 + kp] = pk2(v0.x, v1.x); Ts32[(nc + 1) * 33 + kp] = pk2(v0.y, v1.y);
          Ts32[(nc + 2) * 33 + kp] = pk2(v0.z, v1.z); Ts32[(nc + 3) * 33 + kp] = pk2(v0.w, v1.w);
        }
      }
      __syncthreads();
      if (valid) {
        const int n = vt >> 2, kc = (vt & 3) * 16;
        const unsigned* s32 = (const unsigned*)(Ts + n * 66 + kc);
        uint4 a = make_uint4(s32[0], s32[1], s32[2], s32[3]);
        uint4 b = make_uint4(s32[4], s32[5], s32[6], s32[7]);
        u16* d = dst + (long)job_dst_row(kind, n0 + n) * K + k0 + kc;
        *(uint4*)d = a; *(uint4*)(d + 8) = b;
      }
    }
  }
  const long gtid = (long)get_bid() * 512 + tid, gstride = (long)gridDim.x * 512;
  for (long e = gtid; e < 2L * 64 * 1024 / 8; e += gstride) {
    const int l = (int)(e / (64 * 1024 / 8)); const long r = e - (long)l * (64 * 1024 / 8);
    *(uint4*)(p.Win + (long)l * LDZ * 1024 + (long)DIN * 1024 + r * 8) = make_uint4(0, 0, 0, 0);
  }
  for (long e = gtid; e < 16384L * 32; e += gstride) {
    const int pos = (int)(e >> 5), i = (int)(e & 31);
    const float inv = powf(10000.0f, -(float)i / 32.0f);
    const float angf = (float)pos * inv;
    const double x = (double)angf;
    const double kq = rint(x * 0.63661977236758134308);
    const double y = (x - kq * 1.5707963267341256e+00) - kq * 6.0771005065061922e-11;
    const double y2 = y * y;
    const double s = y * (1.0 + y2 * (-1.0 / 6 + y2 * (1.0 / 120 + y2 * (-1.0 / 5040 + y2 * (1.0 / 362880 + y2 * (-1.0 / 39916800))))));
    const double c = 1.0 + y2 * (-0.5 + y2 * (1.0 / 24 + y2 * (-1.0 / 720 + y2 * (1.0 / 40320 + y2 * (-1.0 / 3628800 + y2 * (1.0 / 479001600))))));
    const int q = ((int)kq) & 3;
    double cc, ss;
    if (q == 0) { cc = c; ss = s; } else if (q == 1) { cc = -s; ss = c; } else if (q == 2) { cc = -c; ss = -s; } else { cc = s; ss = -c; }
    *(float2*)(p.rope + e * 2) = make_float2((float)cc, (float)ss);
  }
  for (long e = gtid; e < (long)M_ALL * 1024 / 4; e += gstride) {
    const long pe = (long)M_P * 1024 / 4;
    float4 v = e < pe ? ((const float4*)p.x_prompt)[e] : ((const float4*)p.x_sample)[e - pe];
    ((float4*)p.out)[e] = v;
  }
  if (get_bid() == 0 && tid < 16) p.ctr[tid] = 0u;
}

DI void norm_phase(const float* __restrict__ h, const float* __restrict__ g, u16* __restrict__ out, int g_wave_s) {
  const int tid = get_tid(); const int lane = tid & 63, w = tid >> 6;
  for (int row = get_bid() * 8 + w; row < M_ALL; row += gridDim.x * 8) {
    const float4* hr = (const float4*)(h + (long)row * 1024);
    float4 v[4]; float ss = 0.f;
#pragma unroll
    for (int i = 0; i < 4; ++i) { v[i] = hr[lane + 64 * i]; ss += v[i].x * v[i].x + v[i].y * v[i].y + v[i].z * v[i].z + v[i].w * v[i].w; }
    ss = wave_sum_l(ss, lane);
    const float rs = rsqrtf(ss * (1.f / 1024.f) + EPSF);
#pragma unroll
    for (int i = 0; i < 4; ++i) {
      const float4 gg = ((const float4*)g)[lane + 64 * i];
      uint2 o = make_uint2(pk2(v[i].x * rs * gg.x, v[i].y * rs * gg.y), pk2(v[i].z * rs * gg.z, v[i].w * rs * gg.w));
      ((uint2*)(out + (long)row * 1024))[lane + 64 * i] = o;
    }
  }
}

struct TD { const char* A; const char* B; unsigned sa, sb; int nk; int pb; };
#define RED_OFF 73728

template <class Desc, class Epi>
DI void gemm_stream(int nloc, int nmax, Desc desc, Epi epi, char* smem_all, int g_wave_s) {
  const int tid = get_tid() & 255, lane = tid & 63, w = tid >> 6, wm = w >> 1, wn = w & 1, r = lane & 31, hh = lane >> 5;
  char* smem = smem_all + (get_tid() >> 8) * HALF_BYTES;
  u16* As = (u16*)smem;
  u16* Bs = As + 2 * 128 * 72;
  const int lrow = tid >> 3, lkc = (tid & 7) * 8;
  int ct = 0;
  if (nmax <= 0) return;
  TD ltd = desc(0);
  const int lrot = ((get_bid() >> 3) * 2 + (get_tid() >> 8)) % ltd.nk;
  uint4 S0a0, S0a1, S0a2, S0a3, S0b0, S0b1, S0b2, S0b3, S1a0, S1a1, S1a2, S1a3, S1b0, S1b1, S1b2, S1b3;
#define LD1(dst, base, off) dst = *(const uint4*)((base) + (size_t)(off));
#define GLOADS(S, kk) { \
    int kr_ = (kk) + lrot; kr_ = kr_ >= ltd.nk ? kr_ - ltd.nk : kr_; \
    const unsigned oa_ = lrow * ltd.sa + (unsigned)(kr_ * 64 + lkc) * 2u, ob_ = lrow * ltd.sb + (unsigned)(kr_ * 64 + lkc) * 2u; \
    LD1(S##a0, ltd.A, oa_) LD1(S##a1, ltd.A, oa_ + 32u * ltd.sa) LD1(S##a2, ltd.A, oa_ + 64u * ltd.sa) LD1(S##a3, ltd.A, oa_ + 96u * ltd.sa) \
    LD1(S##b0, ltd.B, ob_) LD1(S##b1, ltd.B, ob_ + 32u * ltd.sb) LD1(S##b2, ltd.B, ob_ + 64u * ltd.sb) LD1(S##b3, ltd.B, ob_ + 96u * ltd.sb) }
#define SST1(arr, src, i, buf) *(uint4*)(arr + ((buf) * 128 + lrow + 32 * (i)) * 72 + lkc) = src;
#define SSTORES(S, buf) { SST1(As, S##a0, 0, buf) SST1(As, S##a1, 1, buf) SST1(As, S##a2, 2, buf) SST1(As, S##a3, 3, buf) \
    SST1(Bs, S##b0, 0, buf) SST1(Bs, S##b1, 1, buf) SST1(Bs, S##b2, 2, buf) SST1(Bs, S##b3, 3, buf) }
#define COMPUTE(buf) { \
    const u16* Ab = As + ((buf) * 128 + 64 * wm + r) * 72 + 8 * hh; \
    const u16* Bb = Bs + ((buf) * 128 + 64 * wn + r) * 72 + 8 * hh; \
    _Pragma("unroll") for (int ks = 0; ks < 4; ++ks) { \
      bf16x8 a0 = *(const bf16x8*)(Ab + 16 * ks), a1 = *(const bf16x8*)(Ab + 32 * 72 + 16 * ks); \
      bf16x8 b0 = *(const bf16x8*)(Bb + 16 * ks), b1 = *(const bf16x8*)(Bb + 32 * 72 + 16 * ks); \
      acc[0][0] = MFMA(b0, a0, acc[0][0]); acc[0][1] = MFMA(b1, a0, acc[0][1]); \
      acc[1][0] = MFMA(b0, a1, acc[1][0]); acc[1][1] = MFMA(b1, a1, acc[1][1]); } }
#define SCHED_STEP() { \
    __builtin_amdgcn_sched_group_barrier(0x020, 8, 0); \
    __builtin_amdgcn_sched_group_barrier(0x100, 4, 0); \
    _Pragma("unroll") for (int q_ = 0; q_ < 4; ++q_) { __builtin_amdgcn_sched_group_barrier(0x008, 1, 0); __builtin_amdgcn_sched_group_barrier(0x100, 1, 0); } \
    _Pragma("unroll") for (int q_ = 0; q_ < 8; ++q_) { __builtin_amdgcn_sched_group_barrier(0x008, 1, 0); __builtin_amdgcn_sched_group_barrier(0x100, 1, 0); __builtin_amdgcn_sched_group_barrier(0x200, 1, 0); } \
    _Pragma("unroll") for (int q_ = 0; q_ < 4; ++q_) { __builtin_amdgcn_sched_group_barrier(0x008, 1, 0); } }

  GLOADS(S0, 0)
  GLOADS(S1, 1)
  SSTORES(S0, 0)
  __syncthreads();
#pragma unroll 1
  for (; ct < nmax; ++ct) {
    const int nk2 = ltd.nk >> 1;
    f32x16 acc[2][2];
#pragma unroll
    for (int mi = 0; mi < 2; ++mi)
#pragma unroll
      for (int ni = 0; ni < 2; ++ni)
#pragma unroll
        for (int i = 0; i < 16; ++i) acc[mi][ni][i] = 0.f;
#pragma unroll 1
    for (int k2 = 0; k2 < nk2; ++k2) {
      int kb = 2 * k2 + 2;
      if (k2 == nk2 - 1) { kb = 0; if (ct + 1 < nloc) ltd = desc(ct + 1); }
      GLOADS(S0, kb)
      COMPUTE(0)
      SSTORES(S1, 1)
      SCHED_STEP()
      __syncthreads();
      GLOADS(S1, kb + 1)
      COMPUTE(1)
      SSTORES(S0, 0)
      SCHED_STEP()
      __syncthreads();
    }
    if (ct < nloc) epi(ct, acc);
  }
#undef LD1
#undef GLOADS
#undef SST1
#undef SSTORES
#undef COMPUTE
#undef SCHED_STEP
}

typedef __attribute__((ext_vector_type(4))) float f32x4;
#define G8_HT (128 * 64)
DI int g8_lds_byte(int r, int c) { const int st = (r >> 4) * 2 + (c >> 5), rr = r & 15, cc = c & 31, ob = rr * 64 + cc * 2; return st * 1024 + (ob ^ (((ob >> 9) & 1) << 5)); }
DI void g8_stage_rc(int b, int& R, int& C) { const int st = b / 1024, sb = b % 1024, swz = sb ^ (((sb >> 9) & 1) << 5); R = (st >> 1) * 16 + swz / 64; C = (st & 1) * 32 + (swz % 64) / 2; }
DI int g8_perm32(int rho) { const int n = rho >> 4, i = rho & 15; return 8 * (i >> 2) + 4 * n + (i & 3); }

DI int g8_permT(int s_) { return 16 * ((s_ >> 3) & 1) + 8 * (s_ >> 4) + 4 * ((s_ >> 2) & 1) + (s_ & 3); }
template <int PERMB>
DI void gemm256_tile(const u16* __restrict__ A, const u16* __restrict__ Bt, int K, char* smem, f32x4 (&acc)[2][2][4][2], int g_wave_s) {
  u16* shm = (u16*)smem;
  const int tid = get_tid();
  const int wid = tid >> 6, lane = tid & 63, wr = wid >> 2, wc = wid & 3, fr = lane & 15, fq = lane >> 4;
#define G8_SA(b, h) (shm + ((b) * 2 + (h)) * G8_HT)
#define G8_SB(b, h) (shm + (4 + (b) * 2 + (h)) * G8_HT)
  int sr0, sc0;
  g8_stage_rc(tid * 16, sr0, sc0);
  const int br0 = PERMB == 1 ? ((sr0 & ~31) + g8_perm32(sr0 & 31)) : (PERMB == 2 ? ((sr0 & ~31) + g8_permT(sr0 & 31)) : sr0);
  const unsigned aoff0 = (unsigned)(sr0 * K + sc0) * 2u;
  const unsigned boff0 = (unsigned)(br0 * K + sc0) * 2u;
#define G8_STAGE_A(P, br, kt) do { const char* g_ = (const char*)(A + (long)(br) * K + (long)(kt) * 64); \
    __builtin_amdgcn_global_load_lds((const unsigned*)(g_ + (size_t)aoff0), (unsigned*)((char*)(P) + tid * 16), 16, 0, 0); \
    __builtin_amdgcn_global_load_lds((const unsigned*)(g_ + (size_t)K * 128 + (size_t)aoff0), (unsigned*)((char*)(P) + tid * 16 + 8192), 16, 0, 0); } while (0)
#define G8_STAGE_B(P, br, kt) do { const char* g_ = (const char*)(Bt + (long)(br) * K + (long)(kt) * 64); \
    __builtin_amdgcn_global_load_lds((const unsigned*)(g_ + (size_t)boff0), (unsigned*)((char*)(P) + tid * 16), 16, 0, 0); \
    __builtin_amdgcn_global_load_lds((const unsigned*)(g_ + (size_t)K * 128 + (size_t)boff0), (unsigned*)((char*)(P) + tid * 16 + 8192), 16, 0, 0); } while (0)
#define G8_LDA(dst, b, h) _Pragma("unroll") for (int m = 0; m < 4; ++m) _Pragma("unroll") for (int k = 0; k < 2; ++k) \
    dst[m][k] = *reinterpret_cast<const bf16x8*>((char*)G8_SA(b, h) + g8_lds_byte(wr * 64 + m * 16 + fr, k * 32 + fq * 8))
#define G8_LDB(dst, b, h) _Pragma("unroll") for (int n = 0; n < 2; ++n) _Pragma("unroll") for (int k = 0; k < 2; ++k) \
    dst[n][k] = *reinterpret_cast<const bf16x8*>((char*)G8_SB(b, h) + g8_lds_byte(wc * 32 + n * 16 + fr, k * 32 + fq * 8))
#define G8_MMA(ai, bj, At_, Bt_) do { __builtin_amdgcn_s_setprio(1); \
    _Pragma("unroll") for (int m = 0; m < 4; ++m) _Pragma("unroll") for (int n = 0; n < 2; ++n) _Pragma("unroll") for (int k = 0; k < 2; ++k) \
      acc[ai][bj][m][n] = __builtin_amdgcn_mfma_f32_16x16x32_bf16(Bt_[n][k], At_[m][k], acc[ai][bj][m][n], 0, 0, 0); \
    __builtin_amdgcn_s_setprio(0); } while (0)
#define G8_WAIT_V(n) asm volatile("s_waitcnt vmcnt(" #n ")" ::: "memory")
#define G8_WAIT_L(n) asm volatile("s_waitcnt lgkmcnt(" #n ")" ::: "memory")
#define G8_BAR __builtin_amdgcn_s_barrier()
#define G8_SCHED __builtin_amdgcn_sched_barrier(0)
#pragma unroll
  for (int ai = 0; ai < 2; ++ai)
#pragma unroll
    for (int bj = 0; bj < 2; ++bj)
#pragma unroll
      for (int m = 0; m < 4; ++m)
#pragma unroll
        for (int n = 0; n < 2; ++n) acc[ai][bj][m][n] = (f32x4){0.f, 0.f, 0.f, 0.f};
  bf16x8 At[4][2], B0[2][2], B1[2][2];
  const int nt = K >> 6;
  G8_STAGE_B(G8_SB(0, 0), 0, 0); G8_STAGE_A(G8_SA(0, 0), 0, 0);
  G8_STAGE_B(G8_SB(0, 1), 128, 0); G8_STAGE_A(G8_SA(0, 1), 128, 0);
  if (wr == 1) G8_BAR;
  G8_WAIT_V(4); G8_BAR;
  G8_STAGE_B(G8_SB(1, 0), 0, 1); G8_STAGE_A(G8_SA(1, 0), 0, 1); G8_STAGE_B(G8_SB(1, 1), 128, 1);
  G8_WAIT_V(6); G8_BAR;
#pragma unroll 1
  for (int t = 0; t < nt - 2; t += 2) {
    G8_LDB(B0, 0, 0); G8_SCHED; G8_LDA(At, 0, 0); G8_STAGE_A(G8_SA(1, 1), 128, t + 1);
    G8_WAIT_L(8); G8_BAR; G8_WAIT_L(0); G8_MMA(0, 0, At, B0); G8_BAR; G8_SCHED;
    G8_LDB(B1, 0, 1); G8_STAGE_B(G8_SB(0, 0), 0, t + 2);
    G8_BAR; G8_WAIT_L(0); G8_MMA(0, 1, At, B1); G8_BAR;
    G8_LDA(At, 0, 1); G8_STAGE_A(G8_SA(0, 0), 0, t + 2);
    G8_BAR; G8_WAIT_L(0); G8_MMA(1, 0, At, B0); G8_BAR; G8_SCHED;
    G8_STAGE_B(G8_SB(0, 1), 128, t + 2);
    G8_WAIT_V(6); G8_BAR; G8_MMA(1, 1, At, B1); G8_BAR;
    G8_LDB(B0, 1, 0); G8_SCHED; G8_LDA(At, 1, 0); G8_STAGE_A(G8_SA(0, 1), 128, t + 2);
    G8_WAIT_L(8); G8_BAR; G8_WAIT_L(0); G8_MMA(0, 0, At, B0); G8_BAR; G8_SCHED;
    G8_LDB(B1, 1, 1); G8_STAGE_B(G8_SB(1, 0), 0, t + 3);
    G8_BAR; G8_WAIT_L(0); G8_MMA(0, 1, At, B1); G8_BAR;
    G8_LDA(At, 1, 1); G8_STAGE_A(G8_SA(1, 0), 0, t + 3);
    G8_BAR; G8_WAIT_L(0); G8_MMA(1, 0, At, B0); G8_BAR; G8_SCHED;
    G8_STAGE_B(G8_SB(1, 1), 128, t + 3);
    G8_WAIT_V(6); G8_BAR; G8_MMA(1, 1, At, B1); G8_BAR;
  }
  { G8_LDB(B0, 0, 0); G8_LDA(At, 0, 0); G8_STAGE_A(G8_SA(1, 1), 128, nt - 1);
    G8_BAR; G8_WAIT_L(0); G8_MMA(0, 0, At, B0); G8_BAR;
    G8_LDB(B1, 0, 1); G8_BAR; G8_WAIT_L(0); G8_MMA(0, 1, At, B1); G8_BAR;
    G8_LDA(At, 0, 1); G8_WAIT_V(4); G8_BAR; G8_WAIT_L(0); G8_MMA(1, 0, At, B0); G8_MMA(1, 1, At, B1); G8_BAR; }
  { G8_LDB(B0, 1, 0); G8_LDA(At, 1, 0); G8_WAIT_V(2); G8_BAR; G8_WAIT_L(0); G8_MMA(0, 0, At, B0); G8_BAR;
    G8_LDB(B1, 1, 1); G8_WAIT_V(0); G8_BAR; G8_WAIT_L(0); G8_MMA(0, 1, At, B1); G8_BAR;
    G8_LDA(At, 1, 1); G8_BAR; G8_WAIT_L(0); G8_MMA(1, 0, At, B0); G8_MMA(1, 1, At, B1); G8_BAR; }
  if (wr == 0) G8_BAR;
}

DI int tok_pos(int m) { return m < M_P ? m : PAST + ((m - M_P) & 15); }
DI int perm_pos(int key) {
  const int g4 = (key >> 2) & 3;
  const int pg = (g4 == 1) ? 2 : ((g4 == 2) ? 1 : g4);
  return (key & ~15) + 4 * pg;
}

DI int nloc_plain(int total) { const int b = get_bid(), G = gridDim.x; return b < total ? (total - b + G - 1) / G : 0; }
DI void grouped_tile(int L, int nM, int nN, int& tm, int& tn) {
  const int nwg = nM * nN;
  const int q = nwg >> 3, rr = nwg & 7, xcd = L & 7, off = L >> 3;
  const int wgid = (xcd < rr ? xcd * (q + 1) : rr * (q + 1) + (xcd - rr) * q) + off;
  const int nig = 8 * nN, gid = wgid / nig, fm = gid * 8;
  const int gsz = (nM - fm) < 8 ? (nM - fm) : 8;
  const int rem = wgid - gid * nig;
  tm = fm + rem % gsz; tn = rem / gsz;
}
#define LANE_COORDS8 const int tid = get_tid(), lane = tid & 63, w = tid >> 6, wm = w >> 1, wn = w & 1, r = lane & 31, hh = lane >> 5; (void)wm; (void)wn; (void)r; (void)hh;

DI void ffn_up_phase(const Params& p, const u16* W, char* smem, int g_wave_s) {
  const int tid = get_tid();
  const int wid = tid >> 6, lane = tid & 63, wr = wid >> 2, wc = wid & 3, fr = lane & 15, fq = lane >> 4;
  const int NT = (2 * DFF) / 256;
  const int G = gridDim.x;
  for (int L = get_bid(); L < 66 * NT; L += G) {
    int tm, tn; grouped_tile(L, 66, NT, tm, tn);
    f32x4 acc[2][2][4][2];
    gemm256_tile<1>(p.NB + (long)tm * 256 * 1024, W + (long)tn * 256 * 1024, 1024, smem, acc, g_wave_s);
#pragma unroll
    for (int ai = 0; ai < 2; ++ai)
#pragma unroll
      for (int m = 0; m < 4; ++m) {
        const long row = (long)tm * 256 + 128 * ai + 64 * wr + 16 * m + fr;
        const int col = tn * 128 + 32 * wc + 8 * fq;
        float a[8];
#pragma unroll
        for (int n = 0; n < 2; ++n)
#pragma unroll
          for (int j = 0; j < 4; ++j) { const float g = acc[ai][0][m][n][j], u = acc[ai][1][m][n][j]; a[4 * n + j] = g * sigm(g) * u; }
        *(uint4*)(p.ACT + row * DFF + col) = make_uint4(pk2(a[0], a[1]), pk2(a[2], a[3]), pk2(a[4], a[5]), pk2(a[6], a[7]));
      }
  }
}

DI void win_phase(const Params& p, const u16* W, char* smem, int g_wave_s) {
  const int tid = get_tid();
  const int wid = tid >> 6, lane = tid & 63, wr = wid >> 2, wc = wid & 3, fr = lane & 15, fq = lane >> 4;
  const int NT = LDZ / 256;
  const int G = gridDim.x;
  for (int L = get_bid(); L < 66 * NT; L += G) {
    int tm, tn; grouped_tile(L, 66, NT, tm, tn);
    f32x4 acc[2][2][4][2];
    gemm256_tile<1>(p.NB + (long)tm * 256 * 1024, W + (long)tn * 256 * 1024, 1024, smem, acc, g_wave_s);
#pragma unroll
    for (int ai = 0; ai < 2; ++ai)
#pragma unroll
      for (int m = 0; m < 4; ++m) {
        const long row = (long)tm * 256 + 128 * ai + 64 * wr + 16 * m + fr;
#pragma unroll
        for (int bj = 0; bj < 2; ++bj) {
          const int col = tn * 256 + 128 * bj + 32 * wc + 8 * fq;
          *(uint4*)(p.Z + row * LDZ + col) = make_uint4(pk2(acc[ai][bj][m][0][0], acc[ai][bj][m][0][1]), pk2(acc[ai][bj][m][0][2], acc[ai][bj][m][0][3]),
                                                        pk2(acc[ai][bj][m][1][0], acc[ai][bj][m][1][1]), pk2(acc[ai][bj][m][1][2], acc[ai][bj][m][1][3]));
        }
      }
  }
}

#define LANE_COORDS4 const int tid = get_tid() & 255, lane = tid & 63, w = tid >> 6, wm = w >> 1, wn = w & 1, r = lane & 31, hh = lane >> 5; (void)wm; (void)wn; (void)r; (void)hh; \
  const int vb = 2 * get_bid() + (get_tid() >> 8), VG = 2 * gridDim.x; \
  const int nl_mine = vb < 132 * 8 ? (132 * 8 - vb + VG - 1) / VG : 0; const int nl_max = (2 * get_bid()) < 132 * 8 ? (132 * 8 - 2 * get_bid() + VG - 1) / VG : 0;

DI void resid_gemm_phase(const Params& p, const u16* A, int K, const u16* W, float alpha, char* smem, int g_wave_s) {
  LANE_COORDS4
  gemm_stream(nl_mine, nl_max,
    [&](int k) { const int t = vb + k * VG; const int tm = t >> 3, tn = t & 7; TD d; d.A = (const char*)(A + (long)tm * 128 * K); d.B = (const char*)(W + (long)tn * 128 * K); d.sa = 2 * K; d.sb = 2 * K; d.nk = K >> 6; d.pb = 0; return d; },
    [&](int k, f32x16 (&acc)[2][2]) {
      const int t = vb + k * VG; const int tm = t >> 3, tn = t & 7;
#pragma unroll
      for (int mi = 0; mi < 2; ++mi) {
        const long m = (long)tm * 128 + 64 * wm + 32 * mi + r;
#pragma unroll
        for (int ni = 0; ni < 2; ++ni)
#pragma unroll
          for (int i4 = 0; i4 < 4; ++i4) {
            const int n = tn * 128 + 64 * wn + 32 * ni + 8 * i4 + 4 * hh;
            float4* hp = (float4*)(p.out + m * 1024 + n);
            float4 v = *hp;
            v.x += alpha * acc[mi][ni][4 * i4 + 0]; v.y += alpha * acc[mi][ni][4 * i4 + 1];
            v.z += alpha * acc[mi][ni][4 * i4 + 2]; v.w += alpha * acc[mi][ni][4 * i4 + 3];
            *hp = v;
          }
      }
    }, smem, g_wave_s);
}

DI void ple_phase(const Params& p, const u16* W, char* smem, int g_wave_s) {
  LANE_COORDS4
  gemm_stream(nl_mine, nl_max,
    [&](int k) { const int t = vb + k * VG; const int tm = t >> 3, tn = t & 7; TD d; d.A = (const char*)(p.NB + (long)tm * 128 * 1024); d.B = (const char*)(W + (long)tn * 128 * 1024); d.sa = 2048; d.sb = 2048; d.nk = 16; d.pb = 1; return d; },
    [&](int k, f32x16 (&acc)[2][2]) {
      const int t = vb + k * VG; const int tm = t >> 3, tn = t & 7;
#pragma unroll
      for (int mi = 0; mi < 2; ++mi) {
        const long m = (long)tm * 128 + 64 * wm + 32 * mi + r;
#pragma unroll
        for (int ni = 0; ni < 2; ++ni)
#pragma unroll
          for (int i4 = 0; i4 < 4; ++i4) {
            const int n = tn * 128 + 64 * wn + 32 * ni + 8 * i4 + 4 * hh;
            float4* hp = (float4*)(p.out + m * 1024 + n);
            const uint2 pp = *(const uint2*)(p.PP + m * 1024 + n);
            float4 v = *hp;
            v.x += sigm(acc[mi][ni][4 * i4 + 0]) * bflo(pp.x); v.y += sigm(acc[mi][ni][4 * i4 + 1]) * bfhi(pp.x);
            v.z += sigm(acc[mi][ni][4 * i4 + 2]) * bflo(pp.y); v.w += sigm(acc[mi][ni][4 * i4 + 3]) * bfhi(pp.y);
            *hp = v;
          }
      }
    }, smem, g_wave_s);
}

DI void rowpost_phase(const Params& p, int l, int g_wave_s) {
  const int tid = get_tid(); const int lane = tid & 63, w = tid >> 6;
  const float* qan = p.qan + l * 384; const float* kvan = p.kvan + l * 512; const float* krn = p.krn + l * 64; const float* gvn = p.gvn + l * 1024;
  float* o_pkv = p.out + 17301504L + (long)l * M_P * 512;
  float* o_pkr = p.out + 34078720L + (long)l * M_P * 64;
  float* o_skv = p.out + 36175872L + (long)l * M_S * 512;
  float* o_skr = p.out + 36700160L + (long)l * M_S * 64;
  float* o_sgv = p.out + 36765696L + (long)l * M_S * 1024;
  for (int row = get_bid() * 8 + w; row < M_ALL; row += gridDim.x * 8) {
    const u16* zr = p.Z + (long)row * LDZ;
    const bool is_s = row >= M_P; const int rs_ = row - M_P;
    {
      unsigned v[3]; float ss = 0.f;
#pragma unroll
      for (int i = 0; i < 3; ++i) { v[i] = *(const unsigned*)(zr + ZQ + 2 * lane + 128 * i); const float a = bflo(v[i]), b = bfhi(v[i]); ss += a * a + b * b; }
      ss = wave_sum_l(ss, lane);
      const float rs = rsqrtf(ss * (1.f / 384.f) + EPSF);
#pragma unroll
      for (int i = 0; i < 3; ++i) {
        const int c = 2 * lane + 128 * i; const float2 g = *(const float2*)(qan + c);
        *(unsigned*)(p.QN + (long)row * 384 + c) = pk2(bflo(v[i]) * rs * g.x, bfhi(v[i]) * rs * g.y);
      }
    }
    {
      const uint4 v = *(const uint4*)(zr + ZKV + 8 * lane);
      float x[8] = {bflo(v.x), bfhi(v.x), bflo(v.y), bfhi(v.y), bflo(v.z), bfhi(v.z), bflo(v.w), bfhi(v.w)};
      float ss = 0.f;
#pragma unroll
      for (int i = 0; i < 8; ++i) ss += x[i] * x[i];
      ss = wave_sum_l(ss, lane);
      const float rs = rsqrtf(ss * (1.f / 512.f) + EPSF);
      const float4 g0 = *(const float4*)(kvan + 8 * lane), g1 = *(const float4*)(kvan + 8 * lane + 4);
      float4 y0 = make_float4(x[0] * rs * g0.x, x[1] * rs * g0.y, x[2] * rs * g0.z, x[3] * rs * g0.w);
      float4 y1 = make_float4(x[4] * rs * g1.x, x[5] * rs * g1.y, x[6] * rs * g1.z, x[7] * rs * g1.w);
      float* od = is_s ? (o_skv + (long)rs_ * 512) : (o_pkv + (long)row * 512);
      *(float4*)(od + 8 * lane) = y0; *(float4*)(od + 8 * lane + 4) = y1;
      *(uint4*)(p.C + (long)row * 512 + 8 * lane) = pack8(y0, y1);
    }
    {
      const float x = bf1(zr[ZKR + lane]);
      const float ss = wave_sum_l(x * x, lane);
      const float rs = rsqrtf(ss * (1.f / 64.f) + EPSF);
      const float y = x * rs * krn[lane];
      const float other = shfl_xor_l(y, lane, 32);
      const int pos = tok_pos(row);
      const float2 cs = *(const float2*)(p.rope + ((long)pos * 32 + (lane & 31)) * 2);
      const float o = lane < 32 ? (y * cs.x - other * cs.y) : (other * cs.y + y * cs.x);
      if (is_s) {
        o_skr[(long)rs_ * 64 + lane] = o;
        p.KRs[((long)(rs_ >> 4) * LKS + PAST + (rs_ & 15)) * 64 + lane] = f2bf(o);
      } else {
        o_pkr[(long)row * 64 + lane] = o;
        p.KRp[(long)row * 64 + lane] = f2bf(o);
      }
    }
    {
      uint4 v[2]; float ss = 0.f;
#pragma unroll
      for (int i = 0; i < 2; ++i) {
        v[i] = *(const uint4*)(zr + ZV + 8 * lane + 512 * i);
        const float x[8] = {bflo(v[i].x), bfhi(v[i].x), bflo(v[i].y), bfhi(v[i].y), bflo(v[i].z), bfhi(v[i].z), bflo(v[i].w), bfhi(v[i].w)};
#pragma unroll
        for (int j = 0; j < 8; ++j) ss += x[j] * x[j];
      }
      ss = wave_sum_l(ss, lane);
      const float rs = rsqrtf(ss * (1.f / 1024.f) + EPSF);
      if (lane == 0) p.rsv[row] = rs;
      if (is_s) {
#pragma unroll
        for (int i = 0; i < 2; ++i) {
          const int c = 8 * lane + 512 * i;
          const float x[8] = {bflo(v[i].x), bfhi(v[i].x), bflo(v[i].y), bfhi(v[i].y), bflo(v[i].z), bfhi(v[i].z), bflo(v[i].w), bfhi(v[i].w)};
          const float4 g0 = *(const float4*)(gvn + c), g1 = *(const float4*)(gvn + c + 4);
          *(float4*)(o_sgv + (long)rs_ * 1024 + c) = make_float4(x[0] * rs * g0.x, x[1] * rs * g0.y, x[2] * rs * g0.z, x[3] * rs * g0.w);
          *(float4*)(o_sgv + (long)rs_ * 1024 + c + 4) = make_float4(x[4] * rs * g1.x, x[5] * rs * g1.y, x[6] * rs * g1.z, x[7] * rs * g1.w);
        }
      }
    }
  }
  {
    const float* cc = p.cache_c + (long)l * 32 * PAST * 512;
    const long gt = (long)get_bid() * 512 + tid, gs = (long)gridDim.x * 512;
    for (long e = gt; e < 32L * PAST * 512 / 8; e += gs) {
      const float4 a = *(const float4*)(cc + e * 8), c = *(const float4*)(cc + e * 8 + 4);
      *(uint4*)(p.CB + e * 8) = pack8(a, c);
    }
    const float* pp = p.p_prompt + (long)l * M_P * 256; const float* ps = p.p_sample + (long)l * M_S * 256;
    for (long e = gt; e < (long)M_ALL * 256 / 8; e += gs) {
      const long pe = (long)M_P * 256 / 8;
      const float* src = e < pe ? (pp + e * 8) : (ps + (e - pe) * 8);
      *(uint4*)(p.PB + e * 8) = pack8(*(const float4*)src, *(const float4*)(src + 4));
    }
  }
  const float* ckr = p.cache_kr + (long)l * 32 * PAST * 64;
  const long gtid = (long)get_bid() * 512 + tid, gstride = (long)gridDim.x * 512;
  for (long e = gtid; e < 32L * PAST * 64 / 8; e += gstride) {
    const long el = e * 8; const int b = (int)(el / (PAST * 64)); const long rem = el - (long)b * PAST * 64;
    const float4 a = *(const float4*)(ckr + el), c = *(const float4*)(ckr + el + 4);
    *(uint4*)(p.KRs + (long)b * LKS * 64 + rem) = pack8(a, c);
  }
}

#define NCKV (512 * 8)
#define NPKV (64 * 8)
#define NSKV (2 * 8)
#define NQT (66 * 6)
#define NPPT (66 * 4)
#define RED8_OFF 131072
template <class RowPtr>
DI void nope_epi256(f32x4 (&acc)[2][2][4][2], const float* __restrict__ gain, float scale, char* smem, RowPtr rowptr, int g_wave_s) {
  const int tid = get_tid();
  const int wid = tid >> 6, lane = tid & 63, wr = wid >> 2, wc = wid & 3, fr = lane & 15, fq = lane >> 4;
  float* red = (float*)(smem + RED8_OFF);
#pragma unroll
  for (int ai = 0; ai < 2; ++ai)
#pragma unroll
    for (int bj = 0; bj < 2; ++bj)
#pragma unroll
      for (int m = 0; m < 4; ++m) {
        float s = 0.f;
#pragma unroll
        for (int n = 0; n < 2; ++n)
#pragma unroll
          for (int j = 0; j < 4; ++j) s += acc[ai][bj][m][n][j] * acc[ai][bj][m][n][j];
        s += shfl_xor_l(s, lane, 16); s += shfl_xor_l(s, lane, 32);
        if (fq == 0) red[((wc * 2 + ai) * 2 + bj) * 128 + 64 * wr + 16 * m + fr] = s;
      }
  __syncthreads();
  const int c = 32 * wc + 8 * fq;
  const float4 ga = *(const float4*)(gain + c), gb = *(const float4*)(gain + c + 4);
#pragma unroll
  for (int ai = 0; ai < 2; ++ai)
#pragma unroll
    for (int bj = 0; bj < 2; ++bj)
#pragma unroll
      for (int m = 0; m < 4; ++m) {
        const int rl = 64 * wr + 16 * m + fr;
        float tot = 0.f;
#pragma unroll
        for (int q = 0; q < 4; ++q) tot += red[((q * 2 + ai) * 2 + bj) * 128 + rl];
        const float rs = rsqrtf(tot * (1.f / 128.f) + EPSF) * scale;
        u16* op = rowptr(128 * ai + rl, bj);
        *(uint4*)(op + c) = make_uint4(pk2(acc[ai][bj][m][0][0] * rs * ga.x, acc[ai][bj][m][0][1] * rs * ga.y), pk2(acc[ai][bj][m][0][2] * rs * ga.z, acc[ai][bj][m][0][3] * rs * ga.w),
                                       pk2(acc[ai][bj][m][1][0] * rs * gb.x, acc[ai][bj][m][1][1] * rs * gb.y), pk2(acc[ai][bj][m][1][2] * rs * gb.z, acc[ai][bj][m][1][3] * rs * gb.w));
      }
}

#define G8_COORDS const int tid = get_tid(); const int wid = tid >> 6, lane = tid & 63, wr = wid >> 2, wc = wid & 3, fr = lane & 15, fq = lane >> 4; (void)wr; (void)wc; (void)fr; (void)fq;
DI void vt_epi256(const Params& p, f32x4 (&acc)[2][2][4][2], int mode, int m0, int tn, int g_wave_s) {
  G8_COORDS
  const long dstride = (mode == 0) ? (long)M_P : (long)LKS;
#pragma unroll
  for (int bj = 0; bj < 2; ++bj) {
    const int m32 = m0 + 128 * bj + 32 * wc;
#pragma unroll
    for (int ai = 0; ai < 2; ++ai) {
      const int h = 2 * (tn - 4) + ai;
      u16* base;
      if (mode == 0) base = p.VTp + (long)h * 128 * M_P + m32 + 8 * fq;
      else if (mode == 1) base = p.VTs + ((long)(m32 >> 12) * 8 + h) * 128 * LKS + (m32 & 4095) + 8 * fq;
      else base = p.VTs + ((long)((m32 >> 4) + (fq >> 1)) * 8 + h) * 128 * LKS + PAST + 8 * (fq & 1);
#pragma unroll
      for (int m = 0; m < 4; ++m) {
        const int dd = 64 * wr + 16 * m + fr;
        *(uint4*)(base + (long)dd * dstride) = make_uint4(pk2(acc[ai][bj][m][0][0], acc[ai][bj][m][0][1]), pk2(acc[ai][bj][m][0][2], acc[ai][bj][m][0][3]),
                                                          pk2(acc[ai][bj][m][1][0], acc[ai][bj][m][1][1]), pk2(acc[ai][bj][m][1][2], acc[ai][bj][m][1][3]));
      }
    }
  }
}
DI void rope_epi256(const Params& p, int l, f32x4 (&acc)[2][2][4][2], int tm, int tn, char* smem, int g_wave_s) {
  G8_COORDS
  float* red = (float*)(smem + RED8_OFF);
#pragma unroll
  for (int ai = 0; ai < 2; ++ai)
#pragma unroll
    for (int bj = 0; bj < 2; ++bj)
#pragma unroll
      for (int m = 0; m < 4; ++m) {
        float s = 0.f;
#pragma unroll
        for (int n = 0; n < 2; ++n)
#pragma unroll
          for (int j = 0; j < 4; ++j) s += acc[ai][bj][m][n][j] * acc[ai][bj][m][n][j];
        s += shfl_xor_l(s, lane, 16); s += shfl_xor_l(s, lane, 32);
        if (fq == 0) red[((wc * 2 + ai) * 2 + bj) * 128 + 64 * wr + 16 * m + fr] = s;
      }
  __syncthreads();
  const float* g = p.qrn + l * 64;
  const int c0 = 16 * (wc & 1) + 4 * fq;
  const float4 g1 = *(const float4*)(g + c0), g2 = *(const float4*)(g + 32 + c0);
  const float gg1[4] = {g1.x, g1.y, g1.z, g1.w}, gg2[4] = {g2.x, g2.y, g2.z, g2.w};
#pragma unroll
  for (int ai = 0; ai < 2; ++ai)
#pragma unroll
    for (int m = 0; m < 4; ++m) {
      const int rl = 64 * wr + 16 * m + fr;
      const int row = tm * 256 + 128 * ai + rl;
      const int pos = tok_pos(row);
      const float4 t0 = *(const float4*)(p.rope + ((long)pos * 32 + c0) * 2);
      const float4 t1 = *(const float4*)(p.rope + ((long)pos * 32 + c0) * 2 + 4);
      const float cs[4] = {t0.x, t0.z, t1.x, t1.z}, sn[4] = {t0.y, t0.w, t1.y, t1.w};
#pragma unroll
      for (int bj = 0; bj < 2; ++bj) {
        const float tot = red[((wc * 2 + ai) * 2 + bj) * 128 + rl] + red[(((wc ^ 1) * 2 + ai) * 2 + bj) * 128 + rl];
        const float rs = rsqrtf(tot * (1.f / 64.f) + EPSF);
        const int head = 4 * (tn - 4) + 2 * bj + (wc >> 1);
        u16* qp = p.Q + ((long)row * 8 + head) * 192 + 128;
        float o1[4], o2[4];
#pragma unroll
        for (int j = 0; j < 4; ++j) {
          const float y1 = acc[ai][bj][m][0][j] * rs * gg1[j], y2 = acc[ai][bj][m][1][j] * rs * gg2[j];
          o1[j] = (y1 * cs[j] - y2 * sn[j]) * QSCALE; o2[j] = (y1 * sn[j] + y2 * cs[j]) * QSCALE;
        }
        *(uint2*)(qp + c0) = make_uint2(pk2(o1[0], o1[1]), pk2(o1[2], o1[3]));
        *(uint2*)(qp + 32 + c0) = make_uint2(pk2(o2[0], o2[1]), pk2(o2[2], o2[3]));
      }
    }
}
DI void pp_epi256(const Params& p, f32x4 (&acc)[2][2][4][2], int tm, int tn, int g_wave_s) {
  G8_COORDS
#pragma unroll
  for (int ai = 0; ai < 2; ++ai)
#pragma unroll
    for (int m = 0; m < 4; ++m) {
      const long row = (long)tm * 256 + 128 * ai + 64 * wr + 16 * m + fr;
#pragma unroll
      for (int bj = 0; bj < 2; ++bj) {
        const int col = tn * 256 + 128 * bj + 32 * wc + 8 * fq;
        *(uint4*)(p.PP + row * 1024 + col) = make_uint4(pk2(acc[ai][bj][m][0][0], acc[ai][bj][m][0][1]), pk2(acc[ai][bj][m][0][2], acc[ai][bj][m][0][3]),
                                                        pk2(acc[ai][bj][m][1][0], acc[ai][bj][m][1][1]), pk2(acc[ai][bj][m][1][2], acc[ai][bj][m][1][3]));
      }
    }
}

DI void multi_phase(const Params& p, int l, char* smem, int g_wave_s) {
  const u16* Wkv = p.Wkv + (long)l * 2048 * 512;
  const u16* Wuq = p.Wuq + (long)l * 1536 * 384;
  const u16* Wpe = p.Wpe + (long)l * 1024 * 256;
  const int total = NCKV + NPKV + NSKV + NQT + NPPT;
  const int G = gridDim.x;
#pragma unroll 1
  for (int t = get_bid(); t < NCKV + NPKV + NSKV; t += G) {
    f32x4 acc[2][2][4][2];
    {
      const u16* tok; int u = t, mode;
      if (u < NCKV) { tok = p.CB + (long)(u >> 3) * 256 * 512; mode = 1; }
      else if ((u -= NCKV) < NPKV) { tok = p.C + (long)(u >> 3) * 256 * 512; mode = 0; }
      else { u -= NPKV; tok = p.C + ((long)M_P + (u >> 3) * 256) * 512; mode = 2; }
      const int m0 = (u >> 3) * 256, tn = u & 7;
      const u16* wgt = Wkv + (long)tn * 256 * 512;
      if (tn < 4) {
        gemm256_tile<1>(tok, wgt, 512, smem, acc, g_wave_s);
        nope_epi256(acc, p.knn + l * 128, 1.0f, smem, [&](int rloc, int bj) -> u16* {
          const int m = m0 + rloc; const int h = 2 * tn + bj;
          if (mode == 0) return p.Knp + ((long)m * 8 + h) * 128;
          long key;
          if (mode == 1) key = (long)(m >> 12) * LKS + (m & 4095); else key = (long)(m >> 4) * LKS + PAST + (m & 15);
          return p.Kns + (key * 8 + h) * 128;
        }, g_wave_s);
      } else {
        gemm256_tile<2>(wgt, tok, 512, smem, acc, g_wave_s);
        vt_epi256(p, acc, mode, m0, tn, g_wave_s);
      }
    }
  }
#pragma unroll 1
  for (int t = get_bid() + ((NCKV + NPKV + NSKV) / G) * G; t < total; t += G) {
    if (t < NCKV + NPKV + NSKV) continue;
    f32x4 acc[2][2][4][2];
    int u = t - (NCKV + NPKV + NSKV);
    if (u < NQT) {
      const int tm = u / 6, tn = u - tm * 6;
      gemm256_tile<1>(p.QN + (long)tm * 256 * 384, Wuq + (long)tn * 256 * 384, 384, smem, acc, g_wave_s);
      if (tn < 4) nope_epi256(acc, p.qnn + l * 128, QSCALE, smem, [&](int rloc, int bj) -> u16* { return p.Q + ((long)(tm * 256 + rloc) * 8 + 2 * tn + bj) * 192; }, g_wave_s);
      else rope_epi256(p, l, acc, tm, tn, smem, g_wave_s);
      continue;
    }
    u -= NQT;
    {
      const int tm = u >> 2, tn = u & 3;
      gemm256_tile<1>(p.PB + (long)tm * 256 * 256, Wpe + (long)tn * 256 * 256, 256, smem, acc, g_wave_s);
      pp_epi256(p, acc, tm, tn, g_wave_s);
    }
  }
}

#define ASTAGE 40960
DI void attn_item(const u16* __restrict__ Qb, int qclamp, const u16* __restrict__ Kn, const u16* __restrict__ KR,
                  const u16* __restrict__ VT, long vt_stride, int ntiles, int ntw, int Lk, u16* __restrict__ Ob, char* smem, int g_wave_s) {
  const int tid = get_tid(), lane = tid & 63, w = tid >> 6, r = lane & 31, hh = lane >> 5;
  bf16x8 qf[12];
  {
    const int qr = r < qclamp ? r : qclamp;
    const u16* qp = Qb + (long)(32 * w + qr) * (8 * 192) + 8 * hh;
#pragma unroll
    for (int ks = 0; ks < 12; ++ks) qf[ks] = *(const bf16x8*)(qp + 16 * ks);
  }
  f32x16 oacc[4];
#pragma unroll
  for (int dt = 0; dt < 4; ++dt)
#pragma unroll
    for (int i = 0; i < 16; ++i) oacc[dt][i] = 0.f;
  float mrun = -INFINITY, lrun = 0.f;

  const int lrow = tid >> 3, lq = tid & 7;
  const int sch = lq ^ ((lrow >> 1) & 7);
  unsigned koff = (unsigned)(lrow * 1024 + sch * 8) * 2u;
  unsigned kroff = (unsigned)(lrow * 64 + sch * 8) * 2u;
  const unsigned vstep = (unsigned)(64 * vt_stride * 2);
  unsigned voff = (unsigned)(lrow * vt_stride * 2 + sch * 16);
  const char* KnB = (const char*)Kn; const char* KRB = (const char*)KR; const char* VTB = (const char*)VT;
  char* dstT = smem + tid * 16;
#define ADMA(st_) { char* d_ = dstT + (st_) * ASTAGE; \
    __builtin_amdgcn_global_load_lds((const unsigned*)(KnB + (size_t)koff), (unsigned*)(d_), 16, 0, 0); \
    __builtin_amdgcn_global_load_lds((const unsigned*)(KnB + (size_t)koff + 128), (unsigned*)(d_ + 8192), 16, 0, 0); \
    __builtin_amdgcn_global_load_lds((const unsigned*)(KRB + (size_t)kroff), (unsigned*)(d_ + 16384), 16, 0, 0); \
    __builtin_amdgcn_global_load_lds((const unsigned*)(VTB + (size_t)voff), (unsigned*)(d_ + 24576), 16, 0, 0); \
    __builtin_amdgcn_global_load_lds((const unsigned*)(VTB + (size_t)(voff + vstep)), (unsigned*)(d_ + 32768), 16, 0, 0); \
    koff += 64 * 1024 * 2; kroff += 64 * 64 * 2; voff += 128; }
  const int xr = (r >> 1) & 7;
  const int xo0 = ((0 + hh) ^ xr) << 4, xo1 = ((2 + hh) ^ xr) << 4, xo2 = ((4 + hh) ^ xr) << 4, xo3 = ((6 + hh) ^ xr) << 4;
  const char* rbase = smem + r * 128;

  f32x16 sacc[2];
#define KFRAG(sb_, ks_, kt_) (*(const bf16x8*)((sb_) + ((ks_) >> 2) * 8192 + (kt_) * 4096 + ((((ks_) & 3) == 0) ? xo0 : (((ks_) & 3) == 1) ? xo1 : (((ks_) & 3) == 2) ? xo2 : xo3)))
#define VFRAG(sb_, dt_, q_) (*(const bf16x8*)((sb_) + 24576 + (dt_) * 4096 + (((q_) == 0) ? xo0 : ((q_) == 1) ? xo1 : ((q_) == 2) ? xo2 : xo3)))
#define ATT_S(st_) { \
    _Pragma("unroll") for (int kt = 0; kt < 2; ++kt) _Pragma("unroll") for (int i = 0; i < 16; ++i) sacc[kt][i] = 0.f; \
    const char* sb = rbase + (st_) * ASTAGE; \
    _Pragma("unroll") for (int ks = 0; ks < 12; ++ks) { \
      bf16x8 k0 = KFRAG(sb, ks, 0); \
      bf16x8 k1 = KFRAG(sb, ks, 1); \
      sacc[0] = MFMA(k0, qf[ks], sacc[0]); \
      sacc[1] = MFMA(k1, qf[ks], sacc[1]); \
      if ((ks & 3) == 3) __builtin_amdgcn_sched_barrier(0); } }
#define ATT_PV(jt_, st_) { \
    if (((jt_) + 1) * 64 > Lk) { \
      _Pragma("unroll") for (int kt = 0; kt < 2; ++kt) _Pragma("unroll") for (int i = 0; i < 16; ++i) { \
          const int key = (jt_) * 64 + 32 * kt + (i & 3) + 8 * (i >> 2) + 4 * hh; \
          if (key >= Lk) sacc[kt][i] = -INFINITY; } } \
    float tmax = -INFINITY; \
    _Pragma("unroll") for (int kt = 0; kt < 2; ++kt) _Pragma("unroll") for (int i = 0; i < 16; ++i) tmax = fmaxf(tmax, sacc[kt][i]); \
    tmax = fmaxf(tmax, shfl_xor_l(tmax, lane, 32)); \
      \
    if (__builtin_amdgcn_ballot_w64(tmax > mrun + 8.0f) != 0ull) { \
      const float mnew = fmaxf(mrun, tmax); \
      const float alpha = __builtin_amdgcn_exp2f(mrun - mnew); \
      mrun = mnew; \
      lrun *= alpha; \
      _Pragma("unroll") for (int dt = 0; dt < 4; ++dt) _Pragma("unroll") for (int i = 0; i < 16; ++i) oacc[dt][i] *= alpha; \
    } \
    float psum = 0.f; \
    _Pragma("unroll") for (int kt = 0; kt < 2; ++kt) _Pragma("unroll") for (int i = 0; i < 16; ++i) { const float pv = __builtin_amdgcn_exp2f(sacc[kt][i] - mrun); sacc[kt][i] = pv; psum += pv; } \
    lrun += psum; \
    bf16x8 pf[2][2]; \
    _Pragma("unroll") for (int kt = 0; kt < 2; ++kt) _Pragma("unroll") for (int s = 0; s < 2; ++s) { \
        uint4 pp = make_uint4(pk2(sacc[kt][8 * s + 0], sacc[kt][8 * s + 1]), pk2(sacc[kt][8 * s + 2], sacc[kt][8 * s + 3]), \
                              pk2(sacc[kt][8 * s + 4], sacc[kt][8 * s + 5]), pk2(sacc[kt][8 * s + 6], sacc[kt][8 * s + 7])); \
        pf[kt][s] = __builtin_bit_cast(bf16x8, pp); } \
    const char* sb = rbase + (st_) * ASTAGE; \
    _Pragma("unroll") for (int dt = 0; dt < 4; ++dt) _Pragma("unroll") for (int kt = 0; kt < 2; ++kt) _Pragma("unroll") for (int s = 0; s < 2; ++s) { \
          bf16x8 vf = VFRAG(sb, dt, 2 * kt + s); \
          oacc[dt] = MFMA(vf, pf[kt][s], oacc[dt]); \
          if (kt == 1 && s == 1) __builtin_amdgcn_sched_barrier(0); } }

  ADMA(0)
  int st = 0;
#pragma unroll 1
  for (int jt = 0; jt < ntiles; ++jt) {
    asm volatile("s_waitcnt vmcnt(0)" ::: "memory");
    __syncthreads();
    const int stn = st == 2 ? 0 : st + 1;
    if (jt + 1 < ntiles) ADMA(stn)
    if (jt < ntw) { ATT_S(st) ATT_PV(jt, st) }
    st = stn;
  }
#undef ATT_S
#undef ATT_PV
#undef KFRAG
#undef VFRAG
#undef ADMA
  if (ntw > 0 && r <= qclamp) {
    const float ltot = lrun + shfl_xor_l(lrun, lane, 32);
    const float inv = 1.f / ltot;
    u16* op = Ob + (long)(32 * w + r) * 1024;
#pragma unroll
    for (int dt = 0; dt < 4; ++dt)
#pragma unroll
      for (int i4 = 0; i4 < 4; ++i4) {
        const int d = 32 * dt + 8 * i4 + 4 * hh;
        *(uint2*)(op + d) = make_uint2(pk2(oacc[dt][4 * i4 + 0] * inv, oacc[dt][4 * i4 + 1] * inv), pk2(oacc[dt][4 * i4 + 2] * inv, oacc[dt][4 * i4 + 3] * inv));
      }
  } else if (ntw > 0) {
    (void)shfl_xor_l(lrun, lane, 32);
  }
}

DI void attn_phase(const Params& p, int l, char* smem, int* s_item, int cidx, int g_wave_s) {
  const int tid = get_tid(), w = tid >> 6;
  const int NITEM = 256 + 512;
  for (;;) {
    __syncthreads();
    if (tid == 0) *s_item = (int)atomicAdd(p.ctr + cidx, 1u);
    __syncthreads();
    const int item = *s_item;
    if (item >= NITEM) break;
    if (item < 256) {
      const int b = item >> 3, h = item & 7;
      const u16* Qb = p.Q + ((long)(M_P + 16 * b) * 8 + h) * 192;
      const u16* Kn = p.Kns + ((long)b * LKS * 8 + h) * 128;
      const u16* KR = p.KRs + (long)b * LKS * 64;
      const u16* VT = p.VTs + ((long)b * 8 + h) * 128 * LKS;
      u16* Ob = p.OA + (long)(M_P + 16 * b) * 1024 + h * 128;
      attn_item(Qb, 15, Kn, KR, VT, LKS, 65, w == 0 ? 65 : 0, LKV, Ob, smem, g_wave_s);
    } else {
      const int idx = item - 256;
      const int qb = 63 - (idx >> 3), h = idx & 7;
      const u16* Qb = p.Q + ((long)(256 * qb) * 8 + h) * 192;
      const u16* Kn = p.Knp + (long)h * 128;
      const u16* KR = p.KRp;
      const u16* VT = p.VTp + (long)h * 128 * M_P;
      u16* Ob = p.OA + (long)(256 * qb) * 1024 + h * 128;
      const int ntiles = 4 * qb + 4;
      attn_item(Qb, 31, Kn, KR, VT, M_P, ntiles, 4 * qb + (w >> 1) + 1, 1 << 30, Ob, smem, g_wave_s);
    }
  }
}

DI void gmlp_phase(const Params& p, int l, char* smem_all, int g_wave_s) {
  const int half = get_tid() >> 8; char* smem = smem_all + half * HALF_BYTES;
  const int tid = get_tid() & 255, lane = tid & 63, w = tid >> 6, wm = w >> 1, wn = w & 1, r = lane & 31, hh = lane >> 5;
  const float* gvn = p.gvn + l * 1024;
  const float* gws = p.gws + (long)l * 8 * 128 * 128;
  const float* gbs = p.gbs + (long)l * 8 * 128;
  u16* Xs = (u16*)smem;
  u16* Ws = Xs + 128 * 136;
  const int NP = 128 * 8, NS = 32 * 4;
  for (int t2 = get_bid(); t2 < (NP + NS + 1) / 2; t2 += gridDim.x) {
    const int t = 2 * t2 + half;
    const bool valid = t < NP + NS;
    const bool isp = valid && t < NP;
    {
      const int ci = t >> 3, g = t & 7;
      const int t0 = ci * 128, c0 = g * 128;
      __syncthreads();
      if (isp) {
      {
        unsigned* Xs32 = (unsigned*)Xs;
#pragma unroll
        for (int i = 0; i < 4; ++i) {
          const int c = tid + 256 * i; const int sp = c >> 4, dc = (c & 15) * 8;
          const uint4 v0 = *(const uint4*)(p.Z + (long)(t0 + 2 * sp) * LDZ + ZV + c0 + dc);
          const uint4 v1 = *(const uint4*)(p.Z + (long)(t0 + 2 * sp + 1) * LDZ + ZV + c0 + dc);
          const float r0 = p.rsv[t0 + 2 * sp], r1 = p.rsv[t0 + 2 * sp + 1];
          const float4 g0 = *(const float4*)(gvn + c0 + dc), g1 = *(const float4*)(gvn + c0 + dc + 4);
          Xs32[(dc + 0) * 68 + sp] = pk2(bflo(v0.x) * r0 * g0.x, bflo(v1.x) * r1 * g0.x); Xs32[(dc + 1) * 68 + sp] = pk2(bfhi(v0.x) * r0 * g0.y, bfhi(v1.x) * r1 * g0.y);
          Xs32[(dc + 2) * 68 + sp] = pk2(bflo(v0.y) * r0 * g0.z, bflo(v1.y) * r1 * g0.z); Xs32[(dc + 3) * 68 + sp] = pk2(bfhi(v0.y) * r0 * g0.w, bfhi(v1.y) * r1 * g0.w);
          Xs32[(dc + 4) * 68 + sp] = pk2(bflo(v0.z) * r0 * g1.x, bflo(v1.z) * r1 * g1.x); Xs32[(dc + 5) * 68 + sp] = pk2(bfhi(v0.z) * r0 * g1.y, bfhi(v1.z) * r1 * g1.y);
          Xs32[(dc + 6) * 68 + sp] = pk2(bflo(v0.w) * r0 * g1.z, bflo(v1.w) * r1 * g1.z); Xs32[(dc + 7) * 68 + sp] = pk2(bfhi(v0.w) * r0 * g1.w, bfhi(v1.w) * r1 * g1.w);
        }
      }
#pragma unroll
      for (int i = 0; i < 8; ++i) {
        const int c = tid + 256 * i;
        const int tt = c >> 4, sc = (c & 15) * 8;
        const float* wp = gws + ((long)g * 128 + tt) * 128 + sc;
        float4 a = *(const float4*)wp, b = *(const float4*)(wp + 4);
        a.x = (sc + 0 <= tt) ? a.x : 0.f; a.y = (sc + 1 <= tt) ? a.y : 0.f; a.z = (sc + 2 <= tt) ? a.z : 0.f; a.w = (sc + 3 <= tt) ? a.w : 0.f;
        b.x = (sc + 4 <= tt) ? b.x : 0.f; b.y = (sc + 5 <= tt) ? b.y : 0.f; b.z = (sc + 6 <= tt) ? b.z : 0.f; b.w = (sc + 7 <= tt) ? b.w : 0.f;
        *(uint4*)(Ws + tt * 136 + sc) = pack8(a, b);
      }
      }
      __syncthreads();
      if (isp) {
      f32x16 acc[2][2];
#pragma unroll
      for (int mi = 0; mi < 2; ++mi)
#pragma unroll
        for (int ni = 0; ni < 2; ++ni)
#pragma unroll
          for (int i = 0; i < 16; ++i) acc[mi][ni][i] = 0.f;
      const u16* Ab = Ws + (64 * wm + r) * 136 + 8 * hh;
      const u16* Bb = Xs + (64 * wn + r) * 136 + 8 * hh;
#pragma unroll
      for (int ks = 0; ks < 8; ++ks) {
        bf16x8 a0 = *(const bf16x8*)(Ab + 16 * ks), a1 = *(const bf16x8*)(Ab + 32 * 136 + 16 * ks);
        bf16x8 b0 = *(const bf16x8*)(Bb + 16 * ks), b1 = *(const bf16x8*)(Bb + 32 * 136 + 16 * ks);
        acc[0][0] = MFMA(b0, a0, acc[0][0]); acc[0][1] = MFMA(b1, a0, acc[0][1]);
        acc[1][0] = MFMA(b0, a1, acc[1][0]); acc[1][1] = MFMA(b1, a1, acc[1][1]);
      }
#pragma unroll
      for (int mi = 0; mi < 2; ++mi) {
        const int tl = 64 * wm + 32 * mi + r;
        const long row = t0 + tl;
        const float bias = gbs[g * 128 + tl];
        const u16* zr = p.Z + row * LDZ;
#pragma unroll
        for (int ni = 0; ni < 2; ++ni)
#pragma unroll
          for (int i4 = 0; i4 < 4; ++i4) {
            const int col = c0 + 64 * wn + 32 * ni + 8 * i4 + 4 * hh;
            const uint2 uu = *(const uint2*)(zr + ZU + col), ga = *(const uint2*)(zr + ZGA + col), gb = *(const uint2*)(zr + ZGB + col);
            const uint2 oa = *(const uint2*)(p.OA + row * 1024 + col);
            const float o0 = sigm(bflo(ga.x)) * bflo(oa.x) + sigm(bflo(gb.x)) * bflo(uu.x) * (acc[mi][ni][4 * i4 + 0] + bias);
            const float o1 = sigm(bfhi(ga.x)) * bfhi(oa.x) + sigm(bfhi(gb.x)) * bfhi(uu.x) * (acc[mi][ni][4 * i4 + 1] + bias);
            const float o2 = sigm(bflo(ga.y)) * bflo(oa.y) + sigm(bflo(gb.y)) * bflo(uu.y) * (acc[mi][ni][4 * i4 + 2] + bias);
            const float o3 = sigm(bfhi(ga.y)) * bfhi(oa.y) + sigm(bfhi(gb.y)) * bfhi(uu.y) * (acc[mi][ni][4 * i4 + 3] + bias);
            *(uint2*)(p.MIX + row * 1024 + col) = make_uint2(pk2(o0, o1), pk2(o2, o3));
          }
      }
      }
    }
    if (valid && !isp) {
      const int u = t - NP; const int b = u >> 2, col = (u & 3) * 256 + tid; const int g = col >> 7;
      const long row0 = M_P + 16 * b;
      const float gv = gvn[col];
      float vn[16];
#pragma unroll
      for (int s = 0; s < 16; ++s) vn[s] = bf1(p.Z[(row0 + s) * LDZ + ZV + col]) * p.rsv[row0 + s] * gv;
#pragma unroll
      for (int tt = 0; tt < 16; ++tt) {
        float mx = gbs[g * 128 + tt];
#pragma unroll
        for (int s = 0; s <= tt; ++s) mx += gws[((long)g * 128 + tt) * 128 + s] * vn[s];
        const u16* zr = p.Z + (row0 + tt) * LDZ;
        const float uu = bf1(zr[ZU + col]), ga = bf1(zr[ZGA + col]), gb = bf1(zr[ZGB + col]);
        const float oa = bf1(p.OA[(row0 + tt) * 1024 + col]);
        p.MIX[(row0 + tt) * 1024 + col] = f2bf(sigm(ga) * oa + sigm(gb) * uu * mx);
      }
    }
  }
}

#define XB_TMO      128
#define XB_XCNT(j)  (256  + 64 * (j))
#define XB_XSUB(j)  (1280 + 64 * (j))
#define XB_XGEN(j)  (2304 + 64 * (j))
#define XB_TOP      3328
#define XB_TOPGEN   3392
#define XCD_BAR_WORDS 3456
#define XB_SPIN_CAP (1u << 22)
#define LAS __attribute__((address_space(3)))
DI unsigned xb_ld(unsigned* p) { return __hip_atomic_load(p, __ATOMIC_RELAXED, __HIP_MEMORY_SCOPE_AGENT); }
DI unsigned xb_add(unsigned* p, unsigned v) { return __hip_atomic_fetch_add(p, v, __ATOMIC_RELAXED, __HIP_MEMORY_SCOPE_AGENT); }
DI unsigned xb_xcc_id() { return (unsigned)__builtin_amdgcn_s_getreg((3 << 11) | 20) & 0xFu; }
#define XB_SPIN(cond, bar) do { unsigned _sp = 0; while (cond) { __builtin_amdgcn_s_sleep(1); \
    if ((++_sp & 255u) == 0u) { if (xb_ld(&(bar)[XB_TMO])) break; if (_sp > XB_SPIN_CAP) { atomicAdd(&(bar)[XB_TMO], 1u); break; } } } } while (0)
struct XcdBarrier { unsigned* bar; unsigned x; volatile LAS unsigned* st; };
DI XcdBarrier xcd_barrier_post(unsigned* bar, volatile LAS unsigned* st) {
  XcdBarrier b; b.bar = bar; b.x = xb_xcc_id(); b.st = st;
  if (threadIdx.x == 0) (void)xb_add(&bar[XB_XCNT(b.x)], 1u);
  return b;
}
DI void xcd_barrier_complete(unsigned* bar, unsigned x, unsigned& nloc, unsigned& nx) {
  const unsigned G = gridDim.x * gridDim.y * gridDim.z;
  unsigned sum, cnt, mine, sp = 0u;
  for (;;) {
    sum = 0u; cnt = 0u; mine = 0u;
#pragma unroll
    for (unsigned j = 0; j < 16; ++j) { const unsigned c = xb_ld(&bar[XB_XCNT(j)]); sum += c; cnt += (c > 0u) ? 1u : 0u; mine = (j == x) ? c : mine; }
    if (sum == G) break;
    __builtin_amdgcn_s_sleep(1);
    if ((++sp & 255u) == 0u) { if (xb_ld(&bar[XB_TMO])) break; if (sp > XB_SPIN_CAP) { atomicAdd(&bar[XB_TMO], 1u); break; } }
  }
  nloc = mine > 0u ? mine : 1u; nx = cnt > 0u ? cnt : 1u;
}
DI void xcd_barrier(const XcdBarrier& b) {
  asm volatile("s_waitcnt vmcnt(0)" ::: "memory");
  __syncthreads();
  if (threadIdx.x == 0) {
    unsigned* bar = b.bar;
    __builtin_amdgcn_s_waitcnt(0);
    unsigned nloc = b.st[0], nx = b.st[1];
    if (nloc == 0u) { xcd_barrier_complete(bar, b.x, nloc, nx); b.st[0] = nloc; b.st[1] = nx; }
    const unsigned old = xb_add(&bar[XB_XSUB(b.x)], 1u);
    const unsigned gen = old / nloc;
    if (old + 1u == (gen + 1u) * nloc) {
      __builtin_amdgcn_fence(__ATOMIC_RELEASE, "agent");
      asm volatile("s_waitcnt vmcnt(0)" ::: "memory");
      const unsigned og = xb_add(&bar[XB_TOP], 1u);
      const unsigned tg = og / nx;
      if (og + 1u == (tg + 1u) * nx) xb_add(&bar[XB_TOPGEN], 1u);
      else XB_SPIN(xb_ld(&bar[XB_TOPGEN]) == tg, bar);
      __builtin_amdgcn_fence(__ATOMIC_ACQUIRE, "agent");
      xb_add(&bar[XB_XGEN(b.x)], 1u);
      asm volatile("s_waitcnt vmcnt(0)" ::: "memory");
    } else {
      XB_SPIN(xb_ld(&bar[XB_XGEN(b.x)]) == gen, bar);
      __builtin_amdgcn_fence(__ATOMIC_ACQUIRE, "agent");
      asm volatile("s_waitcnt vmcnt(0)" ::: "memory");
    }
  }
  __syncthreads();
}

__global__ void __launch_bounds__(512, 2) mega_fwd(Params p) {
  const int g_wave_s = __builtin_amdgcn_readfirstlane((int)(threadIdx.x >> 6));
  extern __shared__ __attribute__((aligned(16))) char smem[];
  uint4& xb_words = *(uint4*)(smem + SMEM_BYTES);
  int& s_item = *(int*)(smem + SMEM_BYTES + 16);
  cg::grid_group grid = cg::this_grid();
  if (threadIdx.x == 0) xb_words = make_uint4(0u, 0u, 0u, 0u);
  __syncthreads();
  XcdBarrier xb = xcd_barrier_post(p.bar, (volatile LAS unsigned*)&xb_words);

  prep_phase(p, smem, g_wave_s);
  grid.sync();
#ifdef PROBE_PREP
  prep_phase(p, smem, g_wave_s);
  grid.sync();
#endif
#pragma unroll 1
  for (int l = 0; l < 2; ++l) {
    norm_phase(p.out, p.f1n + l * 1024, p.NB, g_wave_s);
    xcd_barrier(xb);
    ffn_up_phase(p, p.Wgu1 + (long)l * 2 * DFF * 1024, smem, g_wave_s);
    xcd_barrier(xb);
#ifdef PROBE_FFN
    ffn_up_phase(p, p.Wgu1 + (long)l * 2 * DFF * 1024, smem, g_wave_s);
    xcd_barrier(xb);
#endif
    resid_gemm_phase(p, p.ACT, DFF, p.Wd1 + (long)l * 1024 * DFF, 0.5f, smem, g_wave_s);
    xcd_barrier(xb);
    norm_phase(p.out, p.mixn + l * 1024, p.NB, g_wave_s);
    xcd_barrier(xb);
    win_phase(p, p.Win + (long)l * LDZ * 1024, smem, g_wave_s);
    xcd_barrier(xb);
    rowpost_phase(p, l, g_wave_s);
    xcd_barrier(xb);
    multi_phase(p, l, smem, g_wave_s);
    xcd_barrier(xb);
    attn_phase(p, l, smem, &s_item, l, g_wave_s);
    xcd_barrier(xb);
#ifdef PROBE_ATTN
    attn_phase(p, l, smem, &s_item, 2 + l, g_wave_s);
    xcd_barrier(xb);
#endif
#ifdef PROBE_MULTI
    multi_phase(p, l, smem, g_wave_s);
    xcd_barrier(xb);
#endif
    gmlp_phase(p, l, smem, g_wave_s);
    xcd_barrier(xb);
#ifdef PROBE_GMLP
    gmlp_phase(p, l, smem, g_wave_s);
    xcd_barrier(xb);
#endif
#ifdef PROBE_ROWPOST
    rowpost_phase(p, l, g_wave_s);
    xcd_barrier(xb);
#endif
    resid_gemm_phase(p, p.MIX, 1024, p.Wo + (long)l * 1024 * 1024, 1.0f, smem, g_wave_s);
    xcd_barrier(xb);
    norm_phase(p.out, p.f2n + l * 1024, p.NB, g_wave_s);
    xcd_barrier(xb);
    ffn_up_phase(p, p.Wgu2 + (long)l * 2 * DFF * 1024, smem, g_wave_s);
    xcd_barrier(xb);
#ifdef PROBE_FFN
    ffn_up_phase(p, p.Wgu2 + (long)l * 2 * DFF * 1024, smem, g_wave_s);
    xcd_barrier(xb);
#endif
    resid_gemm_phase(p, p.ACT, DFF, p.Wd2 + (long)l * 1024 * DFF, 0.5f, smem, g_wave_s);
    xcd_barrier(xb);
    norm_phase(p.out, p.plen + l * 1024, p.NB, g_wave_s);
    xcd_barrier(xb);
    ple_phase(p, p.Wpg + (long)l * 1024 * 1024, smem, g_wave_s);
    xcd_barrier(xb);
  }
}

extern "C" void kernel_launch(void* const* d_in, const int* in_sizes, int n_in, void* d_out, int out_size, void* d_ws,
                              size_t ws_size, hipStream_t stream) {
  (void)in_sizes; (void)n_in; (void)out_size; (void)ws_size;
  Params p{};
  auto F = [&](int i) { return (const float*)d_in[i]; };
  p.x_prompt = F(0); p.x_sample = F(1); p.cache_c = F(2); p.cache_kr = F(3); p.p_prompt = F(4); p.p_sample = F(5);
  p.f1n = F(6); p.mixn = F(10); p.qan = F(12); p.qnn = F(14); p.qrn = F(15); p.kvan = F(16); p.krn = F(17);
  p.knn = F(20); p.gvn = F(21); p.gws = F(22); p.gbs = F(23); p.f2n = F(25); p.plen = F(29);
  p.out = (float*)d_out;
  char* ws = (char*)d_ws; size_t off = 0;
  auto alloc = [&](size_t bytes) { char* r = ws + off; off += (bytes + 255) & ~(size_t)255; return r; };
  p.Wgu1 = (u16*)alloc(2UL * 2 * DFF * 1024 * 2);
  p.Wd1 = (u16*)alloc(2UL * 1024 * DFF * 2);
  p.Win = (u16*)alloc(2UL * LDZ * 1024 * 2);
  p.Wuq = (u16*)alloc(2UL * 1536 * 384 * 2);
  p.Wkv = (u16*)alloc(2UL * 2048 * 512 * 2);
  p.Wo = (u16*)alloc(2UL * 1024 * 1024 * 2);
  p.Wgu2 = (u16*)alloc(2UL * 2 * DFF * 1024 * 2);
  p.Wd2 = (u16*)alloc(2UL * 1024 * DFF * 2);
  p.Wpg = (u16*)alloc(2UL * 1024 * 1024 * 2);
  p.Wpe = (u16*)alloc(2UL * 1024 * 256 * 2);
  p.NB = (u16*)alloc((size_t)M_ALL * 1024 * 2);
  p.ACT = (u16*)alloc((size_t)M_ALL * DFF * 2);
  p.Z = (u16*)alloc((size_t)M_ALL * LDZ * 2);
  p.QN = (u16*)alloc((size_t)M_ALL * 384 * 2);
  p.C = (u16*)alloc((size_t)M_ALL * 512 * 2);
  p.KRp = (u16*)alloc((size_t)M_P * 64 * 2);
  p.KRs = (u16*)alloc((size_t)32 * LKS * 64 * 2);
  p.Q = (u16*)alloc((size_t)M_ALL * 8 * 192 * 2);
  p.Knp = (u16*)alloc((size_t)M_P * 1024 * 2);
  p.VTp = (u16*)alloc((size_t)M_P * 1024 * 2);
  p.Kns = (u16*)alloc((size_t)32 * LKS * 1024 * 2);
  p.VTs = (u16*)alloc((size_t)32 * LKS * 1024 * 2);
  p.OA = (u16*)alloc((size_t)M_ALL * 1024 * 2);
  p.MIX = (u16*)alloc((size_t)M_ALL * 1024 * 2);
  p.PP = (u16*)alloc((size_t)M_ALL * 1024 * 2);
  p.CB = (u16*)alloc((size_t)32 * PAST * 512 * 2);
  p.PB = (u16*)alloc((size_t)M_ALL * 256 * 2);
  p.rsv = (float*)alloc((size_t)M_ALL * 4);
  p.rope = (float*)alloc((size_t)16384 * 32 * 2 * 4);
  p.ctr = (unsigned*)alloc(256);
  p.bar = (unsigned*)alloc(XCD_BAR_WORDS * 4);

  int nj = 0, ts = 0;
  auto job = [&](const float* src, u16* dst, int K, int N, int kind) {
    p.jobs[nj].src = src; p.jobs[nj].dst = dst; p.jobs[nj].K = K; p.jobs[nj].N = N; p.jobs[nj].kind = kind; p.jobs[nj].tstart = ts;
    ts += (K / 64) * (N / 64); ++nj;
  };
  for (int l = 0; l < 2; ++l) {
    job(F(7) + (size_t)l * 1024 * DFF, p.Wgu1 + (size_t)l * 2 * DFF * 1024, 1024, DFF, 1);
    job(F(8) + (size_t)l * 1024 * DFF, p.Wgu1 + (size_t)l * 2 * DFF * 1024, 1024, DFF, 2);
    job(F(9) + (size_t)l * DFF * 1024, p.Wd1 + (size_t)l * 1024 * DFF, DFF, 1024, 0);
    job(F(11) + (size_t)l * 1024 * DIN, p.Win + (size_t)l * LDZ * 1024, 1024, DIN, 0);
    job(F(13) + (size_t)l * 384 * 1536, p.Wuq + (size_t)l * 1536 * 384, 384, 1536, 3);
    job(F(18) + (size_t)l * 512 * 1024, p.Wkv + (size_t)l * 2048 * 512, 512, 1024, 0);
    job(F(19) + (size_t)l * 512 * 1024, p.Wkv + (size_t)l * 2048 * 512, 512, 1024, 4);
    job(F(24) + (size_t)l * 1024 * 1024, p.Wo + (size_t)l * 1024 * 1024, 1024, 1024, 0);
    job(F(26) + (size_t)l * 1024 * DFF, p.Wgu2 + (size_t)l * 2 * DFF * 1024, 1024, DFF, 1);
    job(F(27) + (size_t)l * 1024 * DFF, p.Wgu2 + (size_t)l * 2 * DFF * 1024, 1024, DFF, 2);
    job(F(28) + (size_t)l * DFF * 1024, p.Wd2 + (size_t)l * 1024 * DFF, DFF, 1024, 0);
    job(F(30) + (size_t)l * 1024 * 1024, p.Wpg + (size_t)l * 1024 * 1024, 1024, 1024, 0);
    job(F(31) + (size_t)l * 256 * 1024, p.Wpe + (size_t)l * 1024 * 256, 256, 1024, 0);
  }
  p.ntile_prep = ts;

  static int grid_blocks = 0;
  if (!grid_blocks) {
    int dev = 0, cus = 0, per_cu = 0;
    hipGetDevice(&dev);
    hipDeviceGetAttribute(&cus, hipDeviceAttributeMultiprocessorCount, dev);
    hipFuncSetAttribute((const void*)mega_fwd, hipFuncAttributeMaxDynamicSharedMemorySize, LDS_TOTAL);
    hipOccupancyMaxActiveBlocksPerMultiprocessor(&per_cu, (const void*)mega_fwd, 512, LDS_TOTAL);
    if (per_cu > 1) per_cu = 1;
    if (per_cu < 1) per_cu = 1;
    grid_blocks = cus * per_cu;
  }
  (void)hipMemsetAsync(p.bar, 0, XCD_BAR_WORDS * 4, stream);
  void* args[] = {&p};
  hipError_t e = hipLaunchCooperativeKernel((const void*)mega_fwd, dim3(grid_blocks), dim3(512), args, LDS_TOTAL, stream);
  if (e != hipSuccess) fprintf(stderr, "cooperative launch failed: %s (grid %d)\n", hipGetErrorString(e), grid_blocks);
}
```

```cpp
#include <hip/hip_runtime.h>
#include <hip/hip_cooperative_groups.h>
#include <cstdio>
namespace cg = cooperative_groups;

#define DI __device__ __forceinline__
typedef unsigned short u16;
typedef __attribute__((ext_vector_type(8))) short bf16x8;
typedef __attribute__((ext_vector_type(16))) float f32x16;
typedef __attribute__((ext_vector_type(2))) __bf16 bf2_t;
typedef __attribute__((ext_vector_type(2))) float f2_t;

#define M_P 16384
#define M_S 512
#define M_ALL 16896
#define DM 1024
#define DFF 2816
#define DIN 5056
#define LDZ 5120
#define ZQ 0
#define ZKV 384
#define ZKR 896
#define ZU 960
#define ZV 1984
#define ZGA 3008
#define ZGB 4032
#define LKS 4160
#define LKV 4112
#define PAST 4096
#define EPSF 1e-6f
#define QSCALE (0.07216878364870322f * 1.4426950408889634f)

#define NJOBS 26
struct TJob { const float* src; u16* dst; int K, N, kind, tstart; };

struct Params {
  const float *x_prompt, *x_sample, *cache_c, *cache_kr, *p_prompt, *p_sample;
  const float *f1n, *mixn, *qan, *qnn, *qrn, *kvan, *krn, *knn, *gvn, *gws, *gbs, *f2n, *plen;
  float* out;
  u16 *Wgu1, *Wd1, *Win, *Wuq, *Wkv, *Wo, *Wgu2, *Wd2, *Wpg, *Wpe;
  u16 *CB, *PB;
  u16 *NB, *ACT, *Z, *QN, *C, *KRp, *KRs, *Q, *Knp, *VTp, *Kns, *VTs, *OA, *MIX, *PP;
  float *rsv, *rope;
  unsigned* ctr;
  unsigned* bar;
  TJob jobs[NJOBS];
  int ntile_prep; int pad0;
};

DI int get_tid_impl(int ws) { int t = (ws << 6) | (int)__builtin_amdgcn_mbcnt_hi(~0u, __builtin_amdgcn_mbcnt_lo(~0u, 0u)); asm volatile("" : "+v"(t)); return t; }
#define get_tid() get_tid_impl(g_wave_s)
DI int get_bid() { int t = blockIdx.x; asm volatile("" : "+s"(t)); return t; }
DI unsigned pk2(float a, float b) { f2_t v = {a, b}; bf2_t r = __builtin_convertvector(v, bf2_t); return __builtin_bit_cast(unsigned, r); }
DI float bflo(unsigned v) { return __uint_as_float(v << 16); }
DI float bfhi(unsigned v) { return __uint_as_float(v & 0xffff0000u); }
DI float bf1(u16 v) { return __uint_as_float(((unsigned)v) << 16); }
DI u16 f2bf(float a) { return (u16)(pk2(a, 0.f) & 0xffffu); }
DI float shfl_xor_l(float v, int lane, int o) { return __int_as_float(__builtin_amdgcn_ds_bpermute((lane ^ o) << 2, __float_as_int(v))); }
DI float wave_sum_l(float v, int lane) {
#pragma unroll
  for (int o = 32; o > 0; o >>= 1) v += shfl_xor_l(v, lane, o);
  return v;
}
DI float sigm(float x) { return 1.f / (1.f + __expf(-x)); }
DI uint4 pack8(float4 x, float4 y) { return make_uint4(pk2(x.x, x.y), pk2(x.z, x.w), pk2(y.x, y.y), pk2(y.z, y.w)); }
#define MFMA(a, b, c) __builtin_amdgcn_mfma_f32_32x32x16_bf16((a), (b), (c), 0, 0, 0)

#define HALF_BYTES (73728 + 1024)
#define SMEM_BYTES (2 * HALF_BYTES)
#define LDS_TOTAL (SMEM_BYTES + 32)

DI int job_dst_row(int kind, int n) {
  if (kind == 0) return n;
  if (kind == 1) return 256 * (n >> 7) + (n & 127);
  if (kind == 2) return 256 * (n >> 7) + 128 + (n & 127);
  if (kind == 3) { int h = n / 192, c = n - h * 192; if (c < 128) return h * 128 + c; c -= 128; const int x = c >> 5, cl = c & 31;
                   return 1024 + h * 64 + 32 * (cl >> 4) + 8 * ((cl >> 2) & 3) + 4 * x + (cl & 3); }
  return 1024 + n;
}

DI void prep_phase(const Params& p, char* smem, int g_wave_s) {
  const int tid = get_tid();
  {
    const int vt = tid & 255, half = tid >> 8;
    u16* Ts = (u16*)smem + half * (64 * 66);
    const int npair = (p.ntile_prep + 1) >> 1;
    for (int t2 = get_bid(); t2 < npair; t2 += gridDim.x) {
      const int t = 2 * t2 + half;
      const bool valid = t < p.ntile_prep;
      int j = 0;
#pragma unroll 1
      for (int q = 1; q < NJOBS; ++q) if (t >= p.jobs[q].tstart) j = q;
      const float* src = p.jobs[j].src; u16* dst = p.jobs[j].dst;
      const int K = p.jobs[j].K, N = p.jobs[j].N, kind = p.jobs[j].kind;
      const int lt = t - p.jobs[j].tstart;
      const int ntn = N >> 6;
      const int tk = lt / ntn, tn = lt - tk * ntn;
      const int k0 = tk * 64, n0 = tn * 64;
      __syncthreads();
      if (valid) {
        unsigned* Ts32 = (unsigned*)Ts;
#pragma unroll
        for (int i = 0; i < 2; ++i) {
          const int kp = (vt >> 4) + 16 * i, nc = (vt & 15) * 4;
          const float4 v0 = *(const float4*)(src + (long)(k0 + 2 * kp) * N + n0 + nc);
          const float4 v1 = *(const float4*)(src + (long)(k0 + 2 * kp + 1) * N + n0 + nc);
          Ts32[(nc + 0) * 33 + kp] = pk2(v0.x, v1.x); Ts32[(nc + 1) * 33 + kp] = pk2(v0.y, v1.y);
          Ts32[(nc + 2) * 33 + kp] = pk2(v0.z, v1.z); Ts32[(nc + 3) * 33 + kp] = pk2(v0.w, v1.w);
        }
      }
      __syncthreads();
      if (valid) {
        const int n = vt >> 2, kc = (vt & 3) * 16;
        const unsigned* s32 = (const unsigned*)(Ts + n * 66 + kc);
        uint4 a = make_uint4(s32[0], s32[1], s32[2], s32[3]);
        uint4 b = make_uint4(s32[4], s32[5], s32[6], s32[7]);
        u16* d = dst + (long)job_dst_row(kind, n0 + n) * K + k0 + kc;
        *(uint4*)d = a; *(uint4*)(d + 8) = b;
      }
    }
  }
  const long gtid = (long)get_bid() * 512 + tid, gstride = (long)gridDim.x * 512;
  for (long e = gtid; e < 2L * 64 * 1024 / 8; e += gstride) {
    const int l = (int)(e / (64 * 1024 / 8)); const long r = e - (long)l * (64 * 1024 / 8);
    *(uint4*)(p.Win + (long)l * LDZ * 1024 + (long)DIN * 1024 + r * 8) = make_uint4(0, 0, 0, 0);
  }
  for (long e = gtid; e < 16384L * 32; e += gstride) {
    const int pos = (int)(e >> 5), i = (int)(e & 31);
    const float inv = powf(10000.0f, -(float)i / 32.0f);
    const float angf = (float)pos * inv;
    const double x = (double)angf;
    const double kq = rint(x * 0.63661977236758134308);
    const double y = (x - kq * 1.5707963267341256e+00) - kq * 6.0771005065061922e-11;
    const double y2 = y * y;
    const double s = y * (1.0 + y2 * (-1.0 / 6 + y2 * (1.0 / 120 + y2 * (-1.0 / 5040 + y2 * (1.0 / 362880 + y2 * (-1.0 / 39916800))))));
    const double c = 1.0 + y2 * (-0.5 + y2 * (1.0 / 24 + y2 * (-1.0 / 720 + y2 * (1.0 / 40320 + y2 * (-1.0 / 3628800 + y2 * (1.0 / 479001600))))));
    const int q = ((int)kq) & 3;
    double cc, ss;
    if (q == 0) { cc = c; ss = s; } else if (q == 1) { cc = -s; ss = c; } else if (q == 2) { cc = -c; ss = -s; } else { cc = s; ss = -c; }
    *(float2*)(p.rope + e * 2) = make_float2((float)cc, (float)ss);
  }
  for (long e = gtid; e < (long)M_ALL * 1024 / 4; e += gstride) {
    const long pe = (long)M_P * 1024 / 4;
    float4 v = e < pe ? ((const float4*)p.x_prompt)[e] : ((const float4*)p.x_sample)[e - pe];
    ((float4*)p.out)[e] = v;
  }
  if (get_bid() == 0 && tid < 16) p.ctr[tid] = 0u;
}

DI void norm_phase(const float* __restrict__ h, const float* __restrict__ g, u16* __restrict__ out, int g_wave_s) {
  const int tid = get_tid(); const int lane = tid & 63, w = tid >> 6;
  for (int row = get_bid() * 8 + w; row < M_ALL; row += gridDim.x * 8) {
    const float4* hr = (const float4*)(h + (long)row * 1024);
    float4 v[4]; float ss = 0.f;
#pragma unroll
    for (int i = 0; i < 4; ++i) { v[i] = hr[lane + 64 * i]; ss += v[i].x * v[i].x + v[i].y * v[i].y + v[i].z * v[i].z + v[i].w * v[i].w; }
    ss = wave_sum_l(ss, lane);
    const float rs = rsqrtf(ss * (1.f / 1024.f) + EPSF);
#pragma unroll
    for (int i = 0; i < 4; ++i) {
      const float4 gg = ((const float4*)g)[lane + 64 * i];
      uint2 o = make_uint2(pk2(v[i].x * rs * gg.x, v[i].y * rs * gg.y), pk2(v[i].z * rs * gg.z, v[i].w * rs * gg.w));
      ((uint2*)(out + (long)row * 1024))[lane + 64 * i] = o;
    }
  }
}

struct TD { const char* A; const char* B; unsigned sa, sb; int nk; int pb; };
#define RED_OFF 73728

template <class Desc, class Epi>
DI void gemm_stream(int nloc, int nmax, Desc desc, Epi epi, char* smem_all, int g_wave_s) {
  const int tid = get_tid() & 255, lane = tid & 63, w = tid >> 6, wm = w >> 1, wn = w & 1, r = lane & 31, hh = lane >> 5;
  char* smem = smem_all + (get_tid() >> 8) * HALF_BYTES;
  u16* As = (u16*)smem;
  u16* Bs = As + 2 * 128 * 72;
  const int lrow = tid >> 3, lkc = (tid & 7) * 8;
  int ct = 0;
  if (nmax <= 0) return;
  TD ltd = desc(0);
  const int lrot = ((get_bid() >> 3) * 2 + (get_tid() >> 8)) % ltd.nk;
  uint4 S0a0, S0a1, S0a2, S0a3, S0b0, S0b1, S0b2, S0b3, S1a0, S1a1, S1a2, S1a3, S1b0, S1b1, S1b2, S1b3;
#define LD1(dst, base, off) dst = *(const uint4*)((base) + (size_t)(off));
#define GLOADS(S, kk) { \
    int kr_ = (kk) + lrot; kr_ = kr_ >= ltd.nk ? kr_ - ltd.nk : kr_; \
    const unsigned oa_ = lrow * ltd.sa + (unsigned)(kr_ * 64 + lkc) * 2u, ob_ = lrow * ltd.sb + (unsigned)(kr_ * 64 + lkc) * 2u; \
    LD1(S##a0, ltd.A, oa_) LD1(S##a1, ltd.A, oa_ + 32u * ltd.sa) LD1(S##a2, ltd.A, oa_ + 64u * ltd.sa) LD1(S##a3, ltd.A, oa_ + 96u * ltd.sa) \
    LD1(S##b0, ltd.B, ob_) LD1(S##b1, ltd.B, ob_ + 32u * ltd.sb) LD1(S##b2, ltd.B, ob_ + 64u * ltd.sb) LD1(S##b3, ltd.B, ob_ + 96u * ltd.sb) }
#define SST1(arr, src, i, buf) *(uint4*)(arr + ((buf) * 128 + lrow + 32 * (i)) * 72 + lkc) = src;
#define SSTORES(S, buf) { SST1(As, S##a0, 0, buf) SST1(As, S##a1, 1, buf) SST1(As, S##a2, 2, buf) SST1(As, S##a3, 3, buf) \
    SST1(Bs, S##b0, 0, buf) SST1(Bs, S##b1, 1, buf) SST1(Bs, S##b2, 2, buf) SST1(Bs, S##b3, 3, buf) }
#define COMPUTE(buf) { \
    const u16* Ab = As + ((buf) * 128 + 64 * wm + r) * 72 + 8 * hh; \
    const u16* Bb = Bs + ((buf) * 128 + 64 * wn + r) * 72 + 8 * hh; \
    _Pragma("unroll") for (int ks = 0; ks < 4; ++ks) { \
      bf16x8 a0 = *(const bf16x8*)(Ab + 16 * ks), a1 = *(const bf16x8*)(Ab + 32 * 72 + 16 * ks); \
      bf16x8 b0 = *(const bf16x8*)(Bb + 16 * ks), b1 = *(const bf16x8*)(Bb + 32 * 72 + 16 * ks); \
      acc[0][0] = MFMA(b0, a0, acc[0][0]); acc[0][1] = MFMA(b1, a0, acc[0][1]); \
      acc[1][0] = MFMA(b0, a1, acc[1][0]); acc[1][1] = MFMA(b1, a1, acc[1][1]); } }
#define SCHED_STEP() { \
    __builtin_amdgcn_sched_group_barrier(0x020, 8, 0); \
    __builtin_amdgcn_sched_group_barrier(0x100, 4, 0); \
    _Pragma("unroll") for (int q_ = 0; q_ < 4; ++q_) { __builtin_amdgcn_sched_group_barrier(0x008, 1, 0); __builtin_amdgcn_sched_group_barrier(0x100, 1, 0); } \
    _Pragma("unroll") for (int q_ = 0; q_ < 8; ++q_) { __builtin_amdgcn_sched_group_barrier(0x008, 1, 0); __builtin_amdgcn_sched_group_barrier(0x100, 1, 0); __builtin_amdgcn_sched_group_barrier(0x200, 1, 0); } \
    _Pragma("unroll") for (int q_ = 0; q_ < 4; ++q_) { __builtin_amdgcn_sched_group_barrier(0x008, 1, 0); } }

  GLOADS(S0, 0)
  GLOADS(S1, 1)
  SSTORES(S0, 0)
  __syncthreads();
#pragma unroll 1
  for (; ct < nmax; ++ct) {
    const int nk2 = ltd.nk >> 1;
    f32x16 acc[2][2];
#pragma unroll
    for (int mi = 0; mi < 2; ++mi)
#pragma unroll
      for (int ni = 0; ni < 2; ++ni)
#pragma unroll
        for (int i = 0; i < 16; ++i) acc[mi][ni][i] = 0.f;
#pragma unroll 1
    for (int k2 = 0; k2 < nk2; ++k2) {
      int kb = 2 * k2 + 2;
      if (k2 == nk2 - 1) { kb = 0; if (ct + 1 < nloc) ltd = desc(ct + 1); }
      GLOADS(S0, kb)
      COMPUTE(0)
      SSTORES(S1, 1)
      SCHED_STEP()
      __syncthreads();
      GLOADS(S1, kb + 1)
      COMPUTE(1)
      SSTORES(S0, 0)
      SCHED_STEP()
      __syncthreads();
    }
    if (ct < nloc) epi(ct, acc);
  }
#undef LD1
#undef GLOADS
#undef SST1
#undef SSTORES
#undef COMPUTE
#undef SCHED_STEP
}

typedef __attribute__((ext_vector_type(4))) float f32x4;
#define G8_HT (128 * 64)
DI int g8_lds_byte(int r, int c) { const int st = (r >> 4) * 2 + (c >> 5), rr = r & 15, cc = c & 31, ob = rr * 64 + cc * 2; return st * 1024 + (ob ^ (((ob >> 9) & 1) << 5)); }
DI void g8_stage_rc(int b, int& R, int& C) { const int st = b / 1024, sb = b % 1024, swz = sb ^ (((sb >> 9) & 1) << 5); R = (st >> 1) * 16 + swz / 64; C = (st & 1) * 32 + (swz % 64) / 2; }
DI int g8_perm32(int rho) { const int n = rho >> 4, i = rho & 15; return 8 * (i >> 2) + 4 * n + (i & 3); }

DI int g8_permT(int s_) { return 16 * ((s_ >> 3) & 1) + 8 * (s_ >> 4) + 4 * ((s_ >> 2) & 1) + (s_ & 3); }
template <int PERMB>
DI void gemm256_tile(const u16* __restrict__ A, const u16* __restrict__ Bt, int K, char* smem, f32x4 (&acc)[2][2][4][2], int g_wave_s) {
  u16* shm = (u16*)smem;
  const int tid = get_tid();
  const int wid = tid >> 6, lane = tid & 63, wr = wid >> 2, wc = wid & 3, fr = lane & 15, fq = lane >> 4;
#define G8_SA(b, h) (shm + ((b) * 2 + (h)) * G8_HT)
#define G8_SB(b, h) (shm + (4 + (b) * 2 + (h)) * G8_HT)
  int sr0, sc0;
  g8_stage_rc(tid * 16, sr0, sc0);
  const int br0 = PERMB == 1 ? ((sr0 & ~31) + g8_perm32(sr0 & 31)) : (PERMB == 2 ? ((sr0 & ~31) + g8_permT(sr0 & 31)) : sr0);
  const unsigned aoff0 = (unsigned)(sr0 * K + sc0) * 2u;
  const unsigned boff0 = (unsigned)(br0 * K + sc0) * 2u;
#define G8_STAGE_A(P, br, kt) do { const char* g_ = (const char*)(A + (long)(br) * K + (long)(kt) * 64); \
    __builtin_amdgcn_global_load_lds((const unsigned*)(g_ + (size_t)aoff0), (unsigned*)((char*)(P) + tid * 16), 16, 0, 0); \
    __builtin_amdgcn_global_load_lds((const unsigned*)(g_ + (size_t)K * 128 + (size_t)aoff0), (unsigned*)((char*)(P) + tid * 16 + 8192), 16, 0, 0); } while (0)
#define G8_STAGE_B(P, br, kt) do { const char* g_ = (const char*)(Bt + (long)(br) * K + (long)(kt) * 64); \
    __builtin_amdgcn_global_load_lds((const unsigned*)(g_ + (size_t)boff0), (unsigned*)((char*)(P) + tid * 16), 16, 0, 0); \
    __builtin_amdgcn_global_load_lds((const unsigned*)(g_ + (size_t)K * 128 + (size_t)boff0), (unsigned*)((char*)(P) + tid * 16 + 8192), 16, 0, 0); } while (0)
#define G8_LDA(dst, b, h) _Pragma("unroll") for (int m = 0; m < 4; ++m) _Pragma("unroll") for (int k = 0; k < 2; ++k) \
    dst[m][k] = *reinterpret_cast<const bf16x8*>((char*)G8_SA(b, h) + g8_lds_byte(wr * 64 + m * 16 + fr, k * 32 + fq * 8))
#define G8_LDB(dst, b, h) _Pragma("unroll") for (int n = 0; n < 2; ++n) _Pragma("unroll") for (int k = 0; k < 2; ++k) \
    dst[n][k] = *reinterpret_cast<const bf16x8*>((char*)G8_SB(b, h) + g8_lds_byte(wc * 32 + n * 16 + fr, k * 32 + fq * 8))
#define G8_MMA(ai, bj, At_, Bt_) do { __builtin_amdgcn_s_setprio(1); \
    _Pragma("unroll") for (int m = 0; m < 4; ++m) _Pragma("unroll") for (int n = 0; n < 2; ++n) _Pragma("unroll") for (int k = 0; k < 2; ++k) \
      acc[ai][bj][m][n] = __builtin_amdgcn_mfma_f32_16x16x32_bf16(Bt_[n][k], At_[m][k], acc[ai][bj][m][n], 0, 0, 0); \
    __builtin_amdgcn_s_setprio(0); } while (0)
#define G8_WAIT_V(n) asm volatile("s_waitcnt vmcnt(" #n ")" ::: "memory")
#define G8_WAIT_L(n) asm volatile("s_waitcnt lgkmcnt(" #n ")" ::: "memory")
#define G8_BAR __builtin_amdgcn_s_barrier()
#define G8_SCHED __builtin_amdgcn_sched_barrier(0)
#pragma unroll
  for (int ai = 0; ai < 2; ++ai)
#pragma unroll
    for (int bj = 0; bj < 2; ++bj)
#pragma unroll
      for (int m = 0; m < 4; ++m)
#pragma unroll
        for (int n = 0; n < 2; ++n) acc[ai][bj][m][n] = (f32x4){0.f, 0.f, 0.f, 0.f};
  bf16x8 At[4][2], B0[2][2], B1[2][2];
  const int nt = K >> 6;
  G8_STAGE_B(G8_SB(0, 0), 0, 0); G8_STAGE_A(G8_SA(0, 0), 0, 0);
  G8_STAGE_B(G8_SB(0, 1), 128, 0); G8_STAGE_A(G8_SA(0, 1), 128, 0);
  if (wr == 1) G8_BAR;
  G8_WAIT_V(4); G8_BAR;
  G8_STAGE_B(G8_SB(1, 0), 0, 1); G8_STAGE_A(G8_SA(1, 0), 0, 1); G8_STAGE_B(G8_SB(1, 1), 128, 1);
  G8_WAIT_V(6); G8_BAR;
#pragma unroll 1
  for (int t = 0; t < nt - 2; t += 2) {
    G8_LDB(B0, 0, 0); G8_SCHED; G8_LDA(At, 0, 0); G8_STAGE_A(G8_SA(1, 1), 128, t + 1);
    G8_WAIT_L(8); G8_BAR; G8_WAIT_L(0); G8_MMA(0, 0, At, B0); G8_BAR; G8_SCHED;
    G8_LDB(B1, 0, 1); G8_STAGE_B(G8_SB(0, 0), 0, t + 2);
    G8_BAR; G8_WAIT_L(0); G8_MMA(0, 1, At, B1); G8_BAR;
    G8_LDA(At, 0, 1); G8_STAGE_A(G8_SA(0, 0), 0, t + 2);
    G8_BAR; G8_WAIT_L(0); G8_MMA(1, 0, At, B0); G8_BAR; G8_SCHED;
    G8_STAGE_B(G8_SB(0, 1), 128, t + 2);
    G8_WAIT_V(6); G8_BAR; G8_MMA(1, 1, At, B1); G8_BAR;
    G8_LDB(B0, 1, 0); G8_SCHED; G8_LDA(At, 1, 0); G8_STAGE_A(G8_SA(0, 1), 128, t + 2);
    G8_WAIT_L(8); G8_BAR; G8_WAIT_L(0); G8_MMA(0, 0, At, B0); G8_BAR; G8_SCHED;
    G8_LDB(B1, 1, 1); G8_STAGE_B(G8_SB(1, 0), 0, t + 3);
    G8_BAR; G8_WAIT_L(0); G8_MMA(0, 1, At, B1); G8_BAR;
    G8_LDA(At, 1, 1); G8_STAGE_A(G8_SA(1, 0), 0, t + 3);
    G8_BAR; G8_WAIT_L(0); G8_MMA(1, 0, At, B0); G8_BAR; G8_SCHED;
    G8_STAGE_B(G8_SB(1, 1), 128, t + 3);
    G8_WAIT_V(6); G8_BAR; G8_MMA(1, 1, At, B1); G8_BAR;
  }
  { G8_LDB(B0, 0, 0); G8_LDA(At, 0, 0); G8_STAGE_A(G8_SA(1, 1), 128, nt - 1);
    G8_BAR; G8_WAIT_L(0); G8_MMA(0, 0, At, B0); G8_BAR;
    G8_LDB(B1, 0, 1); G8_BAR; G8_WAIT_L(0); G8_MMA(0, 1, At, B1); G8_BAR;
    G8_LDA(At, 0, 1); G8_WAIT_V(4); G8_BAR; G8_WAIT_L(0); G8_MMA(1, 0, At, B0); G8_MMA(1, 1, At, B1); G8_BAR; }
  { G8_LDB(B0, 1, 0); G8_LDA(At, 1, 0); G8_WAIT_V(2); G8_BAR; G8_WAIT_L(0); G8_MMA(0, 0, At, B0); G8_BAR;
    G8_LDB(B1, 1, 1); G8_WAIT_V(0); G8_BAR; G8_WAIT_L(0); G8_MMA(0, 1, At, B1); G8_BAR;
    G8_LDA(At, 1, 1); G8_BAR; G8_WAIT_L(0); G8_MMA(1, 0, At, B0); G8_MMA(1, 1, At, B1); G8_BAR; }
  if (wr == 0) G8_BAR;
}

#define G8_COORDS const int tid = get_tid(); const int wid = tid >> 6, lane = tid & 63, wr = wid >> 2, wc = wid & 3, fr = lane & 15, fq = lane >> 4; (void)wr; (void)wc; (void)fr; (void)fq;
DI int tok_pos(int m) { return m < M_P ? m : PAST + ((m - M_P) & 15); }
DI int perm_pos(int key) {
  const int g4 = (key >> 2) & 3;
  const int pg = (g4 == 1) ? 2 : ((g4 == 2) ? 1 : g4);
  return (key & ~15) + 4 * pg;
}

DI int nloc_plain(int total) { const int b = get_bid(), G = gridDim.x; return b < total ? (total - b + G - 1) / G : 0; }
DI void grouped_tile(int L, int nM, int nN, int& tm, int& tn) {
  const int nwg = nM * nN;
  const int q = nwg >> 3, rr = nwg & 7, xcd = L & 7, off = L >> 3;
  const int wgid = (xcd < rr ? xcd * (q + 1) : rr * (q + 1) + (xcd - rr) * q) + off;
  const int nig = 8 * nN, gid = wgid / nig, fm = gid * 8;
  const int gsz = (nM - fm) < 8 ? (nM - fm) : 8;
  const int rem = wgid - gid * nig;
  tm = fm + rem % gsz; tn = rem / gsz;
}
#define LANE_COORDS8 const int tid = get_tid(), lane = tid & 63, w = tid >> 6, wm = w >> 1, wn = w & 1, r = lane & 31, hh = lane >> 5; (void)wm; (void)wn; (void)r; (void)hh;

DI void ffn_up_phase(const Params& p, const u16* W, char* smem, int g_wave_s) {
  const int tid = get_tid();
  const int wid = tid >> 6, lane = tid & 63, wr = wid >> 2, wc = wid & 3, fr = lane & 15, fq = lane >> 4;
  const int NT = (2 * DFF) / 256;
  const int G = gridDim.x;
  for (int L = get_bid(); L < 66 * NT; L += G) {
    int tm, tn; grouped_tile(L, 66, NT, tm, tn);
    f32x4 acc[2][2][4][2];
    gemm256_tile<1>(p.NB + (long)tm * 256 * 1024, W + (long)tn * 256 * 1024, 1024, smem, acc, g_wave_s);
#pragma unroll
    for (int ai = 0; ai < 2; ++ai)
#pragma unroll
      for (int m = 0; m < 4; ++m) {
        const long row = (long)tm * 256 + 128 * ai + 64 * wr + 16 * m + fr;
        const int col = tn * 128 + 32 * wc + 8 * fq;
        float a[8];
#pragma unroll
        for (int n = 0; n < 2; ++n)
#pragma unroll
          for (int j = 0; j < 4; ++j) { const float g = acc[ai][0][m][n][j], u = acc[ai][1][m][n][j]; a[4 * n + j] = g * sigm(g) * u; }
        *(uint4*)(p.ACT + row * DFF + col) = make_uint4(pk2(a[0], a[1]), pk2(a[2], a[3]), pk2(a[4], a[5]), pk2(a[6], a[7]));
      }
  }
}

DI void win_phase(const Params& p, const u16* W, char* smem, int g_wave_s) {
  const int tid = get_tid();
  const int wid = tid >> 6, lane = tid & 63, wr = wid >> 2, wc = wid & 3, fr = lane & 15, fq = lane >> 4;
  const int NT = LDZ / 256;
  const int G = gridDim.x;
  for (int L = get_bid(); L < 66 * NT; L += G) {
    int tm, tn; grouped_tile(L, 66, NT, tm, tn);
    f32x4 acc[2][2][4][2];
    gemm256_tile<1>(p.NB + (long)tm * 256 * 1024, W + (long)tn * 256 * 1024, 1024, smem, acc, g_wave_s);
#pragma unroll
    for (int ai = 0; ai < 2; ++ai)
#pragma unroll
      for (int m = 0; m < 4; ++m) {
        const long row = (long)tm * 256 + 128 * ai + 64 * wr + 16 * m + fr;
#pragma unroll
        for (int bj = 0; bj < 2; ++bj) {
          const int col = tn * 256 + 128 * bj + 32 * wc + 8 * fq;
          *(uint4*)(p.Z + row * LDZ + col) = make_uint4(pk2(acc[ai][bj][m][0][0], acc[ai][bj][m][0][1]), pk2(acc[ai][bj][m][0][2], acc[ai][bj][m][0][3]),
                                                        pk2(acc[ai][bj][m][1][0], acc[ai][bj][m][1][1]), pk2(acc[ai][bj][m][1][2], acc[ai][bj][m][1][3]));
        }
      }
  }
}

DI void resid_gemm_phase(const Params& p, const u16* A, int K, const u16* W, float alpha, char* smem, int g_wave_s) {
  const int G = gridDim.x;
#pragma unroll 1
  for (int L = get_bid(); L < 66 * 4; L += G) {
    const int tm = L >> 2, tn = L & 3;
    f32x4 acc[2][2][4][2];
    gemm256_tile<1>(A + (long)tm * 256 * K, W + (long)tn * 256 * K, K, smem, acc, g_wave_s);
    G8_COORDS
#pragma unroll
    for (int ai = 0; ai < 2; ++ai)
#pragma unroll
      for (int m = 0; m < 4; ++m) {
        const long row = (long)tm * 256 + 128 * ai + 64 * wr + 16 * m + fr;
#pragma unroll
        for (int bj = 0; bj < 2; ++bj) {
          float4* hp = (float4*)(p.out + row * 1024 + tn * 256 + 128 * bj + 32 * wc + 8 * fq);
          float4 v0 = hp[0], v1 = hp[1];
          v0.x += alpha * acc[ai][bj][m][0][0]; v0.y += alpha * acc[ai][bj][m][0][1]; v0.z += alpha * acc[ai][bj][m][0][2]; v0.w += alpha * acc[ai][bj][m][0][3];
          v1.x += alpha * acc[ai][bj][m][1][0]; v1.y += alpha * acc[ai][bj][m][1][1]; v1.z += alpha * acc[ai][bj][m][1][2]; v1.w += alpha * acc[ai][bj][m][1][3];
          hp[0] = v0; hp[1] = v1;
        }
      }
  }
}

DI void ple_phase(const Params& p, const u16* W, char* smem, int g_wave_s) {
  const int G = gridDim.x;
#pragma unroll 1
  for (int L = get_bid(); L < 66 * 4; L += G) {
    const int tm = L >> 2, tn = L & 3;
    f32x4 acc[2][2][4][2];
    gemm256_tile<1>(p.NB + (long)tm * 256 * 1024, W + (long)tn * 256 * 1024, 1024, smem, acc, g_wave_s);
    G8_COORDS
#pragma unroll
    for (int ai = 0; ai < 2; ++ai)
#pragma unroll
      for (int m = 0; m < 4; ++m) {
        const long row = (long)tm * 256 + 128 * ai + 64 * wr + 16 * m + fr;
#pragma unroll
        for (int bj = 0; bj < 2; ++bj) {
          const int col = tn * 256 + 128 * bj + 32 * wc + 8 * fq;
          float4* hp = (float4*)(p.out + row * 1024 + col);
          const uint4 pp = *(const uint4*)(p.PP + row * 1024 + col);
          float4 v0 = hp[0], v1 = hp[1];
          v0.x += sigm(acc[ai][bj][m][0][0]) * bflo(pp.x); v0.y += sigm(acc[ai][bj][m][0][1]) * bfhi(pp.x);
          v0.z += sigm(acc[ai][bj][m][0][2]) * bflo(pp.y); v0.w += sigm(acc[ai][bj][m][0][3]) * bfhi(pp.y);
          v1.x += sigm(acc[ai][bj][m][1][0]) * bflo(pp.z); v1.y += sigm(acc[ai][bj][m][1][1]) * bfhi(pp.z);
          v1.z += sigm(acc[ai][bj][m][1][2]) * bflo(pp.w); v1.w += sigm(acc[ai][bj][m][1][3]) * bfhi(pp.w);
          hp[0] = v0; hp[1] = v1;
        }
      }
  }
}

DI void rowpost_phase(const Params& p, int l, int g_wave_s) {
  const int tid = get_tid(); const int lane = tid & 63, w = tid >> 6;
  const float* qan = p.qan + l * 384; const float* kvan = p.kvan + l * 512; const float* krn = p.krn + l * 64; const float* gvn = p.gvn + l * 1024;
  float* o_pkv = p.out + 17301504L + (long)l * M_P * 512;
  float* o_pkr = p.out + 34078720L + (long)l * M_P * 64;
  float* o_skv = p.out + 36175872L + (long)l * M_S * 512;
  float* o_skr = p.out + 36700160L + (long)l * M_S * 64;
  float* o_sgv = p.out + 36765696L + (long)l * M_S * 1024;
  for (int row = get_bid() * 8 + w; row < M_ALL; row += gridDim.x * 8) {
    const u16* zr = p.Z + (long)row * LDZ;
    const bool is_s = row >= M_P; const int rs_ = row - M_P;
    {
      unsigned v[3]; float ss = 0.f;
#pragma unroll
      for (int i = 0; i < 3; ++i) { v[i] = *(const unsigned*)(zr + ZQ + 2 * lane + 128 * i); const float a = bflo(v[i]), b = bfhi(v[i]); ss += a * a + b * b; }
      ss = wave_sum_l(ss, lane);
      const float rs = rsqrtf(ss * (1.f / 384.f) + EPSF);
#pragma unroll
      for (int i = 0; i < 3; ++i) {
        const int c = 2 * lane + 128 * i; const float2 g = *(const float2*)(qan + c);
        *(unsigned*)(p.QN + (long)row * 384 + c) = pk2(bflo(v[i]) * rs * g.x, bfhi(v[i]) * rs * g.y);
      }
    }
    {
      const uint4 v = *(const uint4*)(zr + ZKV + 8 * lane);
      float x[8] = {bflo(v.x), bfhi(v.x), bflo(v.y), bfhi(v.y), bflo(v.z), bfhi(v.z), bflo(v.w), bfhi(v.w)};
      float ss = 0.f;
#pragma unroll
      for (int i = 0; i < 8; ++i) ss += x[i] * x[i];
      ss = wave_sum_l(ss, lane);
      const float rs = rsqrtf(ss * (1.f / 512.f) + EPSF);
      const float4 g0 = *(const float4*)(kvan + 8 * lane), g1 = *(const float4*)(kvan + 8 * lane + 4);
      float4 y0 = make_float4(x[0] * rs * g0.x, x[1] * rs * g0.y, x[2] * rs * g0.z, x[3] * rs * g0.w);
      float4 y1 = make_float4(x[4] * rs * g1.x, x[5] * rs * g1.y, x[6] * rs * g1.z, x[7] * rs * g1.w);
      float* od = is_s ? (o_skv + (long)rs_ * 512) : (o_pkv + (long)row * 512);
      *(float4*)(od + 8 * lane) = y0; *(float4*)(od + 8 * lane + 4) = y1;
      *(uint4*)(p.C + (long)row * 512 + 8 * lane) = pack8(y0, y1);
    }
    {
      const float x = bf1(zr[ZKR + lane]);
      const float ss = wave_sum_l(x * x, lane);
      const float rs = rsqrtf(ss * (1.f / 64.f) + EPSF);
      const float y = x * rs * krn[lane];
      const float other = shfl_xor_l(y, lane, 32);
      const int pos = tok_pos(row);
      const float2 cs = *(const float2*)(p.rope + ((long)pos * 32 + (lane & 31)) * 2);
      const float o = lane < 32 ? (y * cs.x - other * cs.y) : (other * cs.y + y * cs.x);
      if (is_s) {
        o_skr[(long)rs_ * 64 + lane] = o;
        p.KRs[((long)(rs_ >> 4) * LKS + PAST + (rs_ & 15)) * 64 + lane] = f2bf(o);
      } else {
        o_pkr[(long)row * 64 + lane] = o;
        p.KRp[(long)row * 64 + lane] = f2bf(o);
      }
    }
    {
      uint4 v[2]; float ss = 0.f;
#pragma unroll
      for (int i = 0; i < 2; ++i) {
        v[i] = *(const uint4*)(zr + ZV + 8 * lane + 512 * i);
        const float x[8] = {bflo(v[i].x), bfhi(v[i].x), bflo(v[i].y), bfhi(v[i].y), bflo(v[i].z), bfhi(v[i].z), bflo(v[i].w), bfhi(v[i].w)};
#pragma unroll
        for (int j = 0; j < 8; ++j) ss += x[j] * x[j];
      }
      ss = wave_sum_l(ss, lane);
      const float rs = rsqrtf(ss * (1.f / 1024.f) + EPSF);
      if (lane == 0) p.rsv[row] = rs;
      if (is_s) {
#pragma unroll
        for (int i = 0; i < 2; ++i) {
          const int c = 8 * lane + 512 * i;
          const float x[8] = {bflo(v[i].x), bfhi(v[i].x), bflo(v[i].y), bfhi(v[i].y), bflo(v[i].z), bfhi(v[i].z), bflo(v[i].w), bfhi(v[i].w)};
          const float4 g0 = *(const float4*)(gvn + c), g1 = *(const float4*)(gvn + c + 4);
          *(float4*)(o_sgv + (long)rs_ * 1024 + c) = make_float4(x[0] * rs * g0.x, x[1] * rs * g0.y, x[2] * rs * g0.z, x[3] * rs * g0.w);
          *(float4*)(o_sgv + (long)rs_ * 1024 + c + 4) = make_float4(x[4] * rs * g1.x, x[5] * rs * g1.y, x[6] * rs * g1.z, x[7] * rs * g1.w);
        }
      }
    }
  }
  {
    const float* cc = p.cache_c + (long)l * 32 * PAST * 512;
    const long gt = (long)get_bid() * 512 + tid, gs = (long)gridDim.x * 512;
    for (long e = gt; e < 32L * PAST * 512 / 8; e += gs) {
      const float4 a = *(const float4*)(cc + e * 8), c = *(const float4*)(cc + e * 8 + 4);
      *(uint4*)(p.CB + e * 8) = pack8(a, c);
    }
    const float* pp = p.p_prompt + (long)l * M_P * 256; const float* ps = p.p_sample + (long)l * M_S * 256;
    for (long e = gt; e < (long)M_ALL * 256 / 8; e += gs) {
      const long pe = (long)M_P * 256 / 8;
      const float* src = e < pe ? (pp + e * 8) : (ps + (e - pe) * 8);
      *(uint4*)(p.PB + e * 8) = pack8(*(const float4*)src, *(const float4*)(src + 4));
    }
  }
  const float* ckr = p.cache_kr + (long)l * 32 * PAST * 64;
  const long gtid = (long)get_bid() * 512 + tid, gstride = (long)gridDim.x * 512;
  for (long e = gtid; e < 32L * PAST * 64 / 8; e += gstride) {
    const long el = e * 8; const int b = (int)(el / (PAST * 64)); const long rem = el - (long)b * PAST * 64;
    const float4 a = *(const float4*)(ckr + el), c = *(const float4*)(ckr + el + 4);
    *(uint4*)(p.KRs + (long)b * LKS * 64 + rem) = pack8(a, c);
  }
}

#define NCKV (512 * 8)
#define NPKV (64 * 8)
#define NSKV (2 * 8)
#define NQT (66 * 6)
#define NPPT (66 * 4)
#define RED8_OFF 131072
template <class RowPtr>
DI void nope_epi256(f32x4 (&acc)[2][2][4][2], const float* __restrict__ gain, float scale, char* smem, RowPtr rowptr, int g_wave_s) {
  const int tid = get_tid();
  const int wid = tid >> 6, lane = tid & 63, wr = wid >> 2, wc = wid & 3, fr = lane & 15, fq = lane >> 4;
  float* red = (float*)(smem + RED8_OFF);
#pragma unroll
  for (int ai = 0; ai < 2; ++ai)
#pragma unroll
    for (int bj = 0; bj < 2; ++bj)
#pragma unroll
      for (int m = 0; m < 4; ++m) {
        float s = 0.f;
#pragma unroll
        for (int n = 0; n < 2; ++n)
#pragma unroll
          for (int j = 0; j < 4; ++j) s += acc[ai][bj][m][n][j] * acc[ai][bj][m][n][j];
        s += shfl_xor_l(s, lane, 16); s += shfl_xor_l(s, lane, 32);
        if (fq == 0) red[((wc * 2 + ai) * 2 + bj) * 128 + 64 * wr + 16 * m + fr] = s;
      }
  __syncthreads();
  const int c = 32 * wc + 8 * fq;
  const float4 ga = *(const float4*)(gain + c), gb = *(const float4*)(gain + c + 4);
#pragma unroll
  for (int ai = 0; ai < 2; ++ai)
#pragma unroll
    for (int bj = 0; bj < 2; ++bj)
#pragma unroll
      for (int m = 0; m < 4; ++m) {
        const int rl = 64 * wr + 16 * m + fr;
        float tot = 0.f;
#pragma unroll
        for (int q = 0; q < 4; ++q) tot += red[((q * 2 + ai) * 2 + bj) * 128 + rl];
        const float rs = rsqrtf(tot * (1.f / 128.f) + EPSF) * scale;
        u16* op = rowptr(128 * ai + rl, bj);
        *(uint4*)(op + c) = make_uint4(pk2(acc[ai][bj][m][0][0] * rs * ga.x, acc[ai][bj][m][0][1] * rs * ga.y), pk2(acc[ai][bj][m][0][2] * rs * ga.z, acc[ai][bj][m][0][3] * rs * ga.w),
                                       pk2(acc[ai][bj][m][1][0] * rs * gb.x, acc[ai][bj][m][1][1] * rs * gb.y), pk2(acc[ai][bj][m][1][2] * rs * gb.z, acc[ai][bj][m][1][3] * rs * gb.w));
      }
}

DI void vt_epi256(const Params& p, f32x4 (&acc)[2][2][4][2], int mode, int m0, int tn, int g_wave_s) {
  G8_COORDS
  const long dstride = (mode == 0) ? (long)M_P : (long)LKS;
#pragma unroll
  for (int bj = 0; bj < 2; ++bj) {
    const int m32 = m0 + 128 * bj + 32 * wc;
#pragma unroll
    for (int ai = 0; ai < 2; ++ai) {
      const int h = 2 * (tn - 4) + ai;
      u16* base;
      if (mode == 0) base = p.VTp + (long)h * 128 * M_P + m32 + 8 * fq;
      else if (mode == 1) base = p.VTs + ((long)(m32 >> 12) * 8 + h) * 128 * LKS + (m32 & 4095) + 8 * fq;
      else base = p.VTs + ((long)((m32 >> 4) + (fq >> 1)) * 8 + h) * 128 * LKS + PAST + 8 * (fq & 1);
#pragma unroll
      for (int m = 0; m < 4; ++m) {
        const int dd = 64 * wr + 16 * m + fr;
        *(uint4*)(base + (long)dd * dstride) = make_uint4(pk2(acc[ai][bj][m][0][0], acc[ai][bj][m][0][1]), pk2(acc[ai][bj][m][0][2], acc[ai][bj][m][0][3]),
                                                          pk2(acc[ai][bj][m][1][0], acc[ai][bj][m][1][1]), pk2(acc[ai][bj][m][1][2], acc[ai][bj][m][1][3]));
      }
    }
  }
}
DI void rope_epi256(const Params& p, int l, f32x4 (&acc)[2][2][4][2], int tm, int tn, char* smem, int g_wave_s) {
  G8_COORDS
  float* red = (float*)(smem + RED8_OFF);
#pragma unroll
  for (int ai = 0; ai < 2; ++ai)
#pragma unroll
    for (int bj = 0; bj < 2; ++bj)
#pragma unroll
      for (int m = 0; m < 4; ++m) {
        float s = 0.f;
#pragma unroll
        for (int n = 0; n < 2; ++n)
#pragma unroll
          for (int j = 0; j < 4; ++j) s += acc[ai][bj][m][n][j] * acc[ai][bj][m][n][j];
        s += shfl_xor_l(s, lane, 16); s += shfl_xor_l(s, lane, 32);
        if (fq == 0) red[((wc * 2 + ai) * 2 + bj) * 128 + 64 * wr + 16 * m + fr] = s;
      }
  __syncthreads();
  const float* g = p.qrn + l * 64;
  const int c0 = 16 * (wc & 1) + 4 * fq;
  const float4 g1 = *(const float4*)(g + c0), g2 = *(const float4*)(g + 32 + c0);
  const float gg1[4] = {g1.x, g1.y, g1.z, g1.w}, gg2[4] = {g2.x, g2.y, g2.z, g2.w};
#pragma unroll
  for (int ai = 0; ai < 2; ++ai)
#pragma unroll
    for (int m = 0; m < 4; ++m) {
      const int rl = 64 * wr + 16 * m + fr;
      const int row = tm * 256 + 128 * ai + rl;
      const int pos = tok_pos(row);
      const float4 t0 = *(const float4*)(p.rope + ((long)pos * 32 + c0) * 2);
      const float4 t1 = *(const float4*)(p.rope + ((long)pos * 32 + c0) * 2 + 4);
      const float cs[4] = {t0.x, t0.z, t1.x, t1.z}, sn[4] = {t0.y, t0.w, t1.y, t1.w};
#pragma unroll
      for (int bj = 0; bj < 2; ++bj) {
        const float tot = red[((wc * 2 + ai) * 2 + bj) * 128 + rl] + red[(((wc ^ 1) * 2 + ai) * 2 + bj) * 128 + rl];
        const float rs = rsqrtf(tot * (1.f / 64.f) + EPSF);
        const int head = 4 * (tn - 4) + 2 * bj + (wc >> 1);
        u16* qp = p.Q + ((long)row * 8 + head) * 192 + 128;
        float o1[4], o2[4];
#pragma unroll
        for (int j = 0; j < 4; ++j) {
          const float y1 = acc[ai][bj][m][0][j] * rs * gg1[j], y2 = acc[ai][bj][m][1][j] * rs * gg2[j];
          o1[j] = (y1 * cs[j] - y2 * sn[j]) * QSCALE; o2[j] = (y1 * sn[j] + y2 * cs[j]) * QSCALE;
        }
        *(uint2*)(qp + c0) = make_uint2(pk2(o1[0], o1[1]), pk2(o1[2], o1[3]));
        *(uint2*)(qp + 32 + c0) = make_uint2(pk2(o2[0], o2[1]), pk2(o2[2], o2[3]));
      }
    }
}
DI void pp_epi256(const Params& p, f32x4 (&acc)[2][2][4][2], int tm, int tn, int g_wave_s) {
  G8_COORDS
#pragma unroll
  for (int ai = 0; ai < 2; ++ai)
#pragma unroll
    for (int m = 0; m < 4; ++m) {
      const long row = (long)tm * 256 + 128 * ai + 64 * wr + 16 * m + fr;
#pragma unroll
      for (int bj = 0; bj < 2; ++bj) {
        const int col = tn * 256 + 128 * bj + 32 * wc + 8 * fq;
        *(uint4*)(p.PP + row * 1024 + col) = make_uint4(pk2(acc[ai][bj][m][0][0], acc[ai][bj][m][0][1]), pk2(acc[ai][bj][m][0][2], acc[ai][bj][m][0][3]),
                                                        pk2(acc[ai][bj][m][1][0], acc[ai][bj][m][1][1]), pk2(acc[ai][bj][m][1][2], acc[ai][bj][m][1][3]));
      }
    }
}

DI void multi_phase(const Params& p, int l, char* smem, int g_wave_s) {
  const u16* Wkv = p.Wkv + (long)l * 2048 * 512;
  const u16* Wuq = p.Wuq + (long)l * 1536 * 384;
  const u16* Wpe = p.Wpe + (long)l * 1024 * 256;
  const int total = NCKV + NPKV + NSKV + NQT + NPPT;
  const int G = gridDim.x;
#pragma unroll 1
  for (int t = get_bid(); t < NCKV + NPKV + NSKV; t += G) {
    f32x4 acc[2][2][4][2];
    {
      const u16* tok; int u = t, mode;
      if (u < NCKV) { tok = p.CB + (long)(u >> 3) * 256 * 512; mode = 1; }
      else if ((u -= NCKV) < NPKV) { tok = p.C + (long)(u >> 3) * 256 * 512; mode = 0; }
      else { u -= NPKV; tok = p.C + ((long)M_P + (u >> 3) * 256) * 512; mode = 2; }
      const int m0 = (u >> 3) * 256, tn = u & 7;
      const u16* wgt = Wkv + (long)tn * 256 * 512;
      if (tn < 4) {
        gemm256_tile<1>(tok, wgt, 512, smem, acc, g_wave_s);
        nope_epi256(acc, p.knn + l * 128, 1.0f, smem, [&](int rloc, int bj) -> u16* {
          const int m = m0 + rloc; const int h = 2 * tn + bj;
          if (mode == 0) return p.Knp + ((long)m * 8 + h) * 128;
          long key;
          if (mode == 1) key = (long)(m >> 12) * LKS + (m & 4095); else key = (long)(m >> 4) * LKS + PAST + (m & 15);
          return p.Kns + (key * 8 + h) * 128;
        }, g_wave_s);
      } else {
        gemm256_tile<2>(wgt, tok, 512, smem, acc, g_wave_s);
        vt_epi256(p, acc, mode, m0, tn, g_wave_s);
      }
    }
  }
#pragma unroll 1
  for (int t = get_bid() + ((NCKV + NPKV + NSKV) / G) * G; t < total; t += G) {
    if (t < NCKV + NPKV + NSKV) continue;
    f32x4 acc[2][2][4][2];
    int u = t - (NCKV + NPKV + NSKV);
    if (u < NQT) {
      const int tm = u / 6, tn = u - tm * 6;
      gemm256_tile<1>(p.QN + (long)tm * 256 * 384, Wuq + (long)tn * 256 * 384, 384, smem, acc, g_wave_s);
      if (tn < 4) nope_epi256(acc, p.qnn + l * 128, QSCALE, smem, [&](int rloc, int bj) -> u16* { return p.Q + ((long)(tm * 256 + rloc) * 8 + 2 * tn + bj) * 192; }, g_wave_s);
      else rope_epi256(p, l, acc, tm, tn, smem, g_wave_s);
      continue;
    }
    u -= NQT;
    {
      const int tm = u >> 2, tn = u & 3;
      gemm256_tile<1>(p.PB + (long)tm * 256 * 256, Wpe + (long)tn * 256 * 256, 256, smem, acc, g_wave_s);
      pp_epi256(p, acc, tm, tn, g_wave_s);
    }
  }
}

#define ASTAGE 40960
DI void attn_item(const u16* __restrict__ Qb, int qclamp, const u16* __restrict__ Kn, const u16* __restrict__ KR,
                  const u16* __restrict__ VT, long vt_stride, int ntiles, int ntw, int Lk, u16* __restrict__ Ob, char* smem, int g_wave_s) {
  const int tid = get_tid(), lane = tid & 63, w = tid >> 6, r = lane & 31, hh = lane >> 5;
  bf16x8 qf[12];
  {
    const int qr = r < qclamp ? r : qclamp;
    const u16* qp = Qb + (long)(32 * w + qr) * (8 * 192) + 8 * hh;
#pragma unroll
    for (int ks = 0; ks < 12; ++ks) qf[ks] = *(const bf16x8*)(qp + 16 * ks);
  }
  f32x16 oacc[4];
#pragma unroll
  for (int dt = 0; dt < 4; ++dt)
#pragma unroll
    for (int i = 0; i < 16; ++i) oacc[dt][i] = 0.f;
  float mrun = 0.f, lrun = 0.f;

  const int lrow = tid >> 3, lq = tid & 7;
  const int sch = lq ^ ((lrow >> 1) & 7);
  unsigned koff = (unsigned)(lrow * 1024 + sch * 8) * 2u;
  unsigned kroff = (unsigned)(lrow * 64 + sch * 8) * 2u;
  const unsigned vstep = (unsigned)(64 * vt_stride * 2);
  unsigned voff = (unsigned)(lrow * vt_stride * 2 + sch * 16);
  const char* KnB = (const char*)Kn; const char* KRB = (const char*)KR; const char* VTB = (const char*)VT;
  char* dstT = smem + tid * 16;
#define ADMA(st_) { char* d_ = dstT + (st_) * ASTAGE; \
    __builtin_amdgcn_global_load_lds((const unsigned*)(KnB + (size_t)koff), (unsigned*)(d_), 16, 0, 0); \
    __builtin_amdgcn_global_load_lds((const unsigned*)(KnB + (size_t)koff + 128), (unsigned*)(d_ + 8192), 16, 0, 0); \
    __builtin_amdgcn_global_load_lds((const unsigned*)(KRB + (size_t)kroff), (unsigned*)(d_ + 16384), 16, 0, 0); \
    __builtin_amdgcn_global_load_lds((const unsigned*)(VTB + (size_t)voff), (unsigned*)(d_ + 24576), 16, 0, 0); \
    __builtin_amdgcn_global_load_lds((const unsigned*)(VTB + (size_t)(voff + vstep)), (unsigned*)(d_ + 32768), 16, 0, 0); \
    koff += 64 * 1024 * 2; kroff += 64 * 64 * 2; voff += 128; }
  const int xr = (r >> 1) & 7;
  const int xo0 = ((0 + hh) ^ xr) << 4, xo1 = ((2 + hh) ^ xr) << 4, xo2 = ((4 + hh) ^ xr) << 4, xo3 = ((6 + hh) ^ xr) << 4;
  const char* rbase = smem + r * 128;

  f32x16 sacc[2];
#define KFRAG(sb_, ks_, kt_) (*(const bf16x8*)((sb_) + ((ks_) >> 2) * 8192 + (kt_) * 4096 + ((((ks_) & 3) == 0) ? xo0 : (((ks_) & 3) == 1) ? xo1 : (((ks_) & 3) == 2) ? xo2 : xo3)))
#define VFRAG(sb_, dt_, q_) (*(const bf16x8*)((sb_) + 24576 + (dt_) * 4096 + (((q_) == 0) ? xo0 : ((q_) == 1) ? xo1 : ((q_) == 2) ? xo2 : xo3)))
#define ATT_S(st_) { \
    { const float ninit = -mrun; _Pragma("unroll") for (int kt = 0; kt < 2; ++kt) _Pragma("unroll") for (int i = 0; i < 16; ++i) sacc[kt][i] = ninit; }     \
    const char* sb = rbase + (st_) * ASTAGE; \
    _Pragma("unroll") for (int ks = 0; ks < 12; ++ks) { \
      bf16x8 k0 = KFRAG(sb, ks, 0); \
      bf16x8 k1 = KFRAG(sb, ks, 1); \
      sacc[0] = MFMA(k0, qf[ks], sacc[0]); \
      sacc[1] = MFMA(k1, qf[ks], sacc[1]); \
      if ((ks & 3) == 3) __builtin_amdgcn_sched_barrier(0); } }
#define ATT_PV(jt_, st_) { \
    if (((jt_) + 1) * 64 > Lk) { \
      _Pragma("unroll") for (int kt = 0; kt < 2; ++kt) _Pragma("unroll") for (int i = 0; i < 16; ++i) { \
          const int key = (jt_) * 64 + 32 * kt + (i & 3) + 8 * (i >> 2) + 4 * hh; \
          if (key >= Lk) sacc[kt][i] = -INFINITY; } } \
    float tmax = -INFINITY; \
    _Pragma("unroll") for (int kt = 0; kt < 2; ++kt) _Pragma("unroll") for (int i = 0; i < 16; ++i) tmax = fmaxf(tmax, sacc[kt][i]); \
    tmax = fmaxf(tmax, shfl_xor_l(tmax, lane, 32)); \
      \
    if (__builtin_amdgcn_ballot_w64(tmax > 8.0f) != 0ull) { \
      const float dlt = fmaxf(tmax, 0.f); \
      const float alpha = __builtin_amdgcn_exp2f(-dlt); \
      mrun += dlt; \
      lrun *= alpha; \
      _Pragma("unroll") for (int kt = 0; kt < 2; ++kt) _Pragma("unroll") for (int i = 0; i < 16; ++i) sacc[kt][i] -= dlt; \
      _Pragma("unroll") for (int dt = 0; dt < 4; ++dt) _Pragma("unroll") for (int i = 0; i < 16; ++i) oacc[dt][i] *= alpha; \
    } \
    float psum = 0.f; \
    _Pragma("unroll") for (int kt = 0; kt < 2; ++kt) _Pragma("unroll") for (int i = 0; i < 16; ++i) { const float pv = __builtin_amdgcn_exp2f(sacc[kt][i]); sacc[kt][i] = pv; psum += pv; } \
    lrun += psum; \
    bf16x8 pf[2][2]; \
    _Pragma("unroll") for (int kt = 0; kt < 2; ++kt) _Pragma("unroll") for (int s = 0; s < 2; ++s) { \
        uint4 pp = make_uint4(pk2(sacc[kt][8 * s + 0], sacc[kt][8 * s + 1]), pk2(sacc[kt][8 * s + 2], sacc[kt][8 * s + 3]), \
                              pk2(sacc[kt][8 * s + 4], sacc[kt][8 * s + 5]), pk2(sacc[kt][8 * s + 6], sacc[kt][8 * s + 7])); \
        pf[kt][s] = __builtin_bit_cast(bf16x8, pp); } \
    const char* sb = rbase + (st_) * ASTAGE; \
    _Pragma("unroll") for (int dt = 0; dt < 4; ++dt) _Pragma("unroll") for (int kt = 0; kt < 2; ++kt) _Pragma("unroll") for (int s = 0; s < 2; ++s) { \
          bf16x8 vf = VFRAG(sb, dt, 2 * kt + s); \
          oacc[dt] = MFMA(vf, pf[kt][s], oacc[dt]); \
          if (kt == 1 && s == 1) __builtin_amdgcn_sched_barrier(0); } }

  ADMA(0)
  int st = 0;
#pragma unroll 1
  for (int jt = 0; jt < ntiles; ++jt) {
    asm volatile("s_waitcnt vmcnt(0)" ::: "memory");
    __syncthreads();
    const int stn = st == 2 ? 0 : st + 1;
    if (jt + 1 < ntiles) ADMA(stn)
    if (jt < ntw) { ATT_S(st) ATT_PV(jt, st) }
    st = stn;
  }
#undef ATT_S
#undef ATT_PV
#undef KFRAG
#undef VFRAG
#undef ADMA
  if (ntw > 0 && r <= qclamp) {
    const float ltot = lrun + shfl_xor_l(lrun, lane, 32);
    const float inv = 1.f / ltot;
    u16* op = Ob + (long)(32 * w + r) * 1024;
#pragma unroll
    for (int dt = 0; dt < 4; ++dt)
#pragma unroll
      for (int i4 = 0; i4 < 4; ++i4) {
        const int d = 32 * dt + 8 * i4 + 4 * hh;
        *(uint2*)(op + d) = make_uint2(pk2(oacc[dt][4 * i4 + 0] * inv, oacc[dt][4 * i4 + 1] * inv), pk2(oacc[dt][4 * i4 + 2] * inv, oacc[dt][4 * i4 + 3] * inv));
      }
  } else if (ntw > 0) {
    (void)shfl_xor_l(lrun, lane, 32);
  }
}

DI void attn_phase(const Params& p, int l, char* smem, int* s_item, int cidx, int g_wave_s) {
  const int tid = get_tid(), w = tid >> 6;
  const int NITEM = 256 + 512;
  for (;;) {
    __syncthreads();
    if (tid == 0) *s_item = (int)atomicAdd(p.ctr + cidx, 1u);
    __syncthreads();
    const int item = *s_item;
    if (item >= NITEM) break;
    if (item < 256) {
      const int b = item >> 3, h = item & 7;
      const u16* Qb = p.Q + ((long)(M_P + 16 * b) * 8 + h) * 192;
      const u16* Kn = p.Kns + ((long)b * LKS * 8 + h) * 128;
      const u16* KR = p.KRs + (long)b * LKS * 64;
      const u16* VT = p.VTs + ((long)b * 8 + h) * 128 * LKS;
      u16* Ob = p.OA + (long)(M_P + 16 * b) * 1024 + h * 128;
      attn_item(Qb, 15, Kn, KR, VT, LKS, 65, w == 0 ? 65 : 0, LKV, Ob, smem, g_wave_s);
    } else {
      const int idx = item - 256;
      const int qb = 63 - (idx >> 3), h = idx & 7;
      const u16* Qb = p.Q + ((long)(256 * qb) * 8 + h) * 192;
      const u16* Kn = p.Knp + (long)h * 128;
      const u16* KR = p.KRp;
      const u16* VT = p.VTp + (long)h * 128 * M_P;
      u16* Ob = p.OA + (long)(256 * qb) * 1024 + h * 128;
      const int ntiles = 4 * qb + 4;
      attn_item(Qb, 31, Kn, KR, VT, M_P, ntiles, 4 * qb + (w >> 1) + 1, 1 << 30, Ob, smem, g_wave_s);
    }
  }
}

DI void gmlp_phase(const Params& p, int l, char* smem_all, int g_wave_s) {
  const int half = get_tid() >> 8; char* smem = smem_all + half * HALF_BYTES;
  const int tid = get_tid() & 255, lane = tid & 63, w = tid >> 6, wm = w >> 1, wn = w & 1, r = lane & 31, hh = lane >> 5;
  const float* gvn = p.gvn + l * 1024;
  const float* gws = p.gws + (long)l * 8 * 128 * 128;
  const float* gbs = p.gbs + (long)l * 8 * 128;
  u16* Xs = (u16*)smem;
  u16* Ws = Xs + 128 * 136;
  const int NP = 128 * 8, NS = 32 * 4;
  for (int t2 = get_bid(); t2 < (NP + NS + 1) / 2; t2 += gridDim.x) {
    const int t = 2 * t2 + half;
    const bool valid = t < NP + NS;
    const bool isp = valid && t < NP;
    {
      const int ci = t >> 3, g = t & 7;
      const int t0 = ci * 128, c0 = g * 128;
      __syncthreads();
      if (isp) {
      {
        unsigned* Xs32 = (unsigned*)Xs;
#pragma unroll
        for (int i = 0; i < 4; ++i) {
          const int c = tid + 256 * i; const int sp = c >> 4, dc = (c & 15) * 8;
          const uint4 v0 = *(const uint4*)(p.Z + (long)(t0 + 2 * sp) * LDZ + ZV + c0 + dc);
          const uint4 v1 = *(const uint4*)(p.Z + (long)(t0 + 2 * sp + 1) * LDZ + ZV + c0 + dc);
          const float r0 = p.rsv[t0 + 2 * sp], r1 = p.rsv[t0 + 2 * sp + 1];
          const float4 g0 = *(const float4*)(gvn + c0 + dc), g1 = *(const float4*)(gvn + c0 + dc + 4);
          Xs32[(dc + 0) * 68 + sp] = pk2(bflo(v0.x) * r0 * g0.x, bflo(v1.x) * r1 * g0.x); Xs32[(dc + 1) * 68 + sp] = pk2(bfhi(v0.x) * r0 * g0.y, bfhi(v1.x) * r1 * g0.y);
          Xs32[(dc + 2) * 68 + sp] = pk2(bflo(v0.y) * r0 * g0.z, bflo(v1.y) * r1 * g0.z); Xs32[(dc + 3) * 68 + sp] = pk2(bfhi(v0.y) * r0 * g0.w, bfhi(v1.y) * r1 * g0.w);
          Xs32[(dc + 4) * 68 + sp] = pk2(bflo(v0.z) * r0 * g1.x, bflo(v1.z) * r1 * g1.x); Xs32[(dc + 5) * 68 + sp] = pk2(bfhi(v0.z) * r0 * g1.y, bfhi(v1.z) * r1 * g1.y);
          Xs32[(dc + 6) * 68 + sp] = pk2(bflo(v0.w) * r0 * g1.z, bflo(v1.w) * r1 * g1.z); Xs32[(dc + 7) * 68 + sp] = pk2(bfhi(v0.w) * r0 * g1.w, bfhi(v1.w) * r1 * g1.w);
        }
      }
#pragma unroll
      for (int i = 0; i < 8; ++i) {
        const int c = tid + 256 * i;
        const int tt = c >> 4, sc = (c & 15) * 8;
        const float* wp = gws + ((long)g * 128 + tt) * 128 + sc;
        float4 a = *(const float4*)wp, b = *(const float4*)(wp + 4);
        a.x = (sc + 0 <= tt) ? a.x : 0.f; a.y = (sc + 1 <= tt) ? a.y : 0.f; a.z = (sc + 2 <= tt) ? a.z : 0.f; a.w = (sc + 3 <= tt) ? a.w : 0.f;
        b.x = (sc + 4 <= tt) ? b.x : 0.f; b.y = (sc + 5 <= tt) ? b.y : 0.f; b.z = (sc + 6 <= tt) ? b.z : 0.f; b.w = (sc + 7 <= tt) ? b.w : 0.f;
        *(uint4*)(Ws + tt * 136 + sc) = pack8(a, b);
      }
      }
      __syncthreads();
      if (isp) {
      f32x16 acc[2][2];
#pragma unroll
      for (int mi = 0; mi < 2; ++mi)
#pragma unroll
        for (int ni = 0; ni < 2; ++ni)
#pragma unroll
          for (int i = 0; i < 16; ++i) acc[mi][ni][i] = 0.f;
      const u16* Ab = Ws + (64 * wm + r) * 136 + 8 * hh;
      const u16* Bb = Xs + (64 * wn + r) * 136 + 8 * hh;
#pragma unroll
      for (int ks = 0; ks < 8; ++ks) {
        bf16x8 a0 = *(const bf16x8*)(Ab + 16 * ks), a1 = *(const bf16x8*)(Ab + 32 * 136 + 16 * ks);
        bf16x8 b0 = *(const bf16x8*)(Bb + 16 * ks), b1 = *(const bf16x8*)(Bb + 32 * 136 + 16 * ks);
        acc[0][0] = MFMA(b0, a0, acc[0][0]); acc[0][1] = MFMA(b1, a0, acc[0][1]);
        acc[1][0] = MFMA(b0, a1, acc[1][0]); acc[1][1] = MFMA(b1, a1, acc[1][1]);
      }
#pragma unroll
      for (int mi = 0; mi < 2; ++mi) {
        const int tl = 64 * wm + 32 * mi + r;
        const long row = t0 + tl;
        const float bias = gbs[g * 128 + tl];
        const u16* zr = p.Z + row * LDZ;
#pragma unroll
        for (int ni = 0; ni < 2; ++ni)
#pragma unroll
          for (int i4 = 0; i4 < 4; ++i4) {
            const int col = c0 + 64 * wn + 32 * ni + 8 * i4 + 4 * hh;
            const uint2 uu = *(const uint2*)(zr + ZU + col), ga = *(const uint2*)(zr + ZGA + col), gb = *(const uint2*)(zr + ZGB + col);
            const uint2 oa = *(const uint2*)(p.OA + row * 1024 + col);
            const float o0 = sigm(bflo(ga.x)) * bflo(oa.x) + sigm(bflo(gb.x)) * bflo(uu.x) * (acc[mi][ni][4 * i4 + 0] + bias);
            const float o1 = sigm(bfhi(ga.x)) * bfhi(oa.x) + sigm(bfhi(gb.x)) * bfhi(uu.x) * (acc[mi][ni][4 * i4 + 1] + bias);
            const float o2 = sigm(bflo(ga.y)) * bflo(oa.y) + sigm(bflo(gb.y)) * bflo(uu.y) * (acc[mi][ni][4 * i4 + 2] + bias);
            const float o3 = sigm(bfhi(ga.y)) * bfhi(oa.y) + sigm(bfhi(gb.y)) * bfhi(uu.y) * (acc[mi][ni][4 * i4 + 3] + bias);
            *(uint2*)(p.MIX + row * 1024 + col) = make_uint2(pk2(o0, o1), pk2(o2, o3));
          }
      }
      }
    }
    if (valid && !isp) {
      const int u = t - NP; const int b = u >> 2, col = (u & 3) * 256 + tid; const int g = col >> 7;
      const long row0 = M_P + 16 * b;
      const float gv = gvn[col];
      float vn[16];
#pragma unroll
      for (int s = 0; s < 16; ++s) vn[s] = bf1(p.Z[(row0 + s) * LDZ + ZV + col]) * p.rsv[row0 + s] * gv;
#pragma unroll
      for (int tt = 0; tt < 16; ++tt) {
        float mx = gbs[g * 128 + tt];
#pragma unroll
        for (int s = 0; s <= tt; ++s) mx += gws[((long)g * 128 + tt) * 128 + s] * vn[s];
        const u16* zr = p.Z + (row0 + tt) * LDZ;
        const float uu = bf1(zr[ZU + col]), ga = bf1(zr[ZGA + col]), gb = bf1(zr[ZGB + col]);
        const float oa = bf1(p.OA[(row0 + tt) * 1024 + col]);
        p.MIX[(row0 + tt) * 1024 + col] = f2bf(sigm(ga) * oa + sigm(gb) * uu * mx);
      }
    }
  }
}

#define XB_TMO      128
#define XB_XCNT(j)  (256  + 64 * (j))
#define XB_XSUB(j)  (1280 + 64 * (j))
#define XB_XGEN(j)  (2304 + 64 * (j))
#define XB_TOP      3328
#define XB_TOPGEN   3392
#define XCD_BAR_WORDS 3456
#define XB_SPIN_CAP (1u << 22)
#define LAS __attribute__((address_space(3)))
DI unsigned xb_ld(unsigned* p) { return __hip_atomic_load(p, __ATOMIC_RELAXED, __HIP_MEMORY_SCOPE_AGENT); }
DI unsigned xb_add(unsigned* p, unsigned v) { return __hip_atomic_fetch_add(p, v, __ATOMIC_RELAXED, __HIP_MEMORY_SCOPE_AGENT); }
DI unsigned xb_xcc_id() { return (unsigned)__builtin_amdgcn_s_getreg((3 << 11) | 20) & 0xFu; }
#define XB_SPIN(cond, bar) do { unsigned _sp = 0; while (cond) { __builtin_amdgcn_s_sleep(1); \
    if ((++_sp & 255u) == 0u) { if (xb_ld(&(bar)[XB_TMO])) break; if (_sp > XB_SPIN_CAP) { atomicAdd(&(bar)[XB_TMO], 1u); break; } } } } while (0)
struct XcdBarrier { unsigned* bar; unsigned x; volatile LAS unsigned* st; };
DI XcdBarrier xcd_barrier_post(unsigned* bar, volatile LAS unsigned* st) {
  XcdBarrier b; b.bar = bar; b.x = xb_xcc_id(); b.st = st;
  if (threadIdx.x == 0) (void)xb_add(&bar[XB_XCNT(b.x)], 1u);
  return b;
}
DI void xcd_barrier_complete(unsigned* bar, unsigned x, unsigned& nloc, unsigned& nx) {
  const unsigned G = gridDim.x * gridDim.y * gridDim.z;
  unsigned sum, cnt, mine, sp = 0u;
  for (;;) {
    sum = 0u; cnt = 0u; mine = 0u;
#pragma unroll
    for (unsigned j = 0; j < 16; ++j) { const unsigned c = xb_ld(&bar[XB_XCNT(j)]); sum += c; cnt += (c > 0u) ? 1u : 0u; mine = (j == x) ? c : mine; }
    if (sum == G) break;
    __builtin_amdgcn_s_sleep(1);
    if ((++sp & 255u) == 0u) { if (xb_ld(&bar[XB_TMO])) break; if (sp > XB_SPIN_CAP) { atomicAdd(&bar[XB_TMO], 1u); break; } }
  }
  nloc = mine > 0u ? mine : 1u; nx = cnt > 0u ? cnt : 1u;
}
DI void xcd_barrier(const XcdBarrier& b) {
  asm volatile("s_waitcnt vmcnt(0)" ::: "memory");
  __syncthreads();
  if (threadIdx.x == 0) {
    unsigned* bar = b.bar;
    __builtin_amdgcn_s_waitcnt(0);
    unsigned nloc = b.st[0], nx = b.st[1];
    if (nloc == 0u) { xcd_barrier_complete(bar, b.x, nloc, nx); b.st[0] = nloc; b.st[1] = nx; }
    const unsigned old = xb_add(&bar[XB_XSUB(b.x)], 1u);
    const unsigned gen = old / nloc;
    if (old + 1u == (gen + 1u) * nloc) {
      __builtin_amdgcn_fence(__ATOMIC_RELEASE, "agent");
      asm volatile("s_waitcnt vmcnt(0)" ::: "memory");
      const unsigned og = xb_add(&bar[XB_TOP], 1u);
      const unsigned tg = og / nx;
      if (og + 1u == (tg + 1u) * nx) xb_add(&bar[XB_TOPGEN], 1u);
      else XB_SPIN(xb_ld(&bar[XB_TOPGEN]) == tg, bar);
      __builtin_amdgcn_fence(__ATOMIC_ACQUIRE, "agent");
      xb_add(&bar[XB_XGEN(b.x)], 1u);
      asm volatile("s_waitcnt vmcnt(0)" ::: "memory");
    } else {
      XB_SPIN(xb_ld(&bar[XB_XGEN(b.x)]) == gen, bar);
      __builtin_amdgcn_fence(__ATOMIC_ACQUIRE, "agent");
      asm volatile("s_waitcnt vmcnt(0)" ::: "memory");
    }
  }
  __syncthreads();
}

__global__ void __launch_bounds__(512, 2) mega_fwd(Params p) {
  const int g_wave_s = __builtin_amdgcn_readfirstlane((int)(threadIdx.x >> 6));
  extern __shared__ __attribute__((aligned(16))) char smem[];
  uint4& xb_words = *(uint4*)(smem + SMEM_BYTES);
  int& s_item = *(int*)(smem + SMEM_BYTES + 16);
  cg::grid_group grid = cg::this_grid();
  if (threadIdx.x == 0) xb_words = make_uint4(0u, 0u, 0u, 0u);
  __syncthreads();
  XcdBarrier xb = xcd_barrier_post(p.bar, (volatile LAS unsigned*)&xb_words);

  prep_phase(p, smem, g_wave_s);
  grid.sync();
#ifdef PROBE_PREP
  prep_phase(p, smem, g_wave_s);
  grid.sync();
#endif
#pragma unroll 1
  for (int l = 0; l < 2; ++l) {
    norm_phase(p.out, p.f1n + l * 1024, p.NB, g_wave_s);
    xcd_barrier(xb);
    ffn_up_phase(p, p.Wgu1 + (long)l * 2 * DFF * 1024, smem, g_wave_s);
    xcd_barrier(xb);
#ifdef PROBE_FFN
    ffn_up_phase(p, p.Wgu1 + (long)l * 2 * DFF * 1024, smem, g_wave_s);
    xcd_barrier(xb);
#endif
    resid_gemm_phase(p, p.ACT, DFF, p.Wd1 + (long)l * 1024 * DFF, 0.5f, smem, g_wave_s);
    xcd_barrier(xb);
    norm_phase(p.out, p.mixn + l * 1024, p.NB, g_wave_s);
    xcd_barrier(xb);
    win_phase(p, p.Win + (long)l * LDZ * 1024, smem, g_wave_s);
    xcd_barrier(xb);
    rowpost_phase(p, l, g_wave_s);
    xcd_barrier(xb);
    multi_phase(p, l, smem, g_wave_s);
    xcd_barrier(xb);
    attn_phase(p, l, smem, &s_item, l, g_wave_s);
    xcd_barrier(xb);
#ifdef PROBE_ATTN
    attn_phase(p, l, smem, &s_item, 2 + l, g_wave_s);
    xcd_barrier(xb);
#endif
#ifdef PROBE_MULTI
    multi_phase(p, l, smem, g_wave_s);
    xcd_barrier(xb);
#endif
    gmlp_phase(p, l, smem, g_wave_s);
    xcd_barrier(xb);
#ifdef PROBE_GMLP
    gmlp_phase(p, l, smem, g_wave_s);
    xcd_barrier(xb);
#endif
#ifdef PROBE_ROWPOST
    rowpost_phase(p, l, g_wave_s);
    xcd_barrier(xb);
#endif
    resid_gemm_phase(p, p.MIX, 1024, p.Wo + (long)l * 1024 * 1024, 1.0f, smem, g_wave_s);
    xcd_barrier(xb);
    norm_phase(p.out, p.f2n + l * 1024, p.NB, g_wave_s);
    xcd_barrier(xb);
    ffn_up_phase(p, p.Wgu2 + (long)l * 2 * DFF * 1024, smem, g_wave_s);
    xcd_barrier(xb);
#ifdef PROBE_FFN
    ffn_up_phase(p, p.Wgu2 + (long)l * 2 * DFF * 1024, smem, g_wave_s);
    xcd_barrier(xb);
#endif
    resid_gemm_phase(p, p.ACT, DFF, p.Wd2 + (long)l * 1024 * DFF, 0.5f, smem, g_wave_s);
    xcd_barrier(xb);
    norm_phase(p.out, p.plen + l * 1024, p.NB, g_wave_s);
    xcd_barrier(xb);
    ple_phase(p, p.Wpg + (long)l * 1024 * 1024, smem, g_wave_s);
    xcd_barrier(xb);
  }
}

extern "C" void kernel_launch(void* const* d_in, const int* in_sizes, int n_in, void* d_out, int out_size, void* d_ws,
                              size_t ws_size, hipStream_t stream) {
  (void)in_sizes; (void)n_in; (void)out_size; (void)ws_size;
  Params p{};
  auto F = [&](int i) { return (const float*)d_in[i]; };
  p.x_prompt = F(0); p.x_sample = F(1); p.cache_c = F(2); p.cache_kr = F(3); p.p_prompt = F(4); p.p_sample = F(5);
  p.f1n = F(6); p.mixn = F(10); p.qan = F(12); p.qnn = F(14); p.qrn = F(15); p.kvan = F(16); p.krn = F(17);
  p.knn = F(20); p.gvn = F(21); p.gws = F(22); p.gbs = F(23); p.f2n = F(25); p.plen = F(29);
  p.out = (float*)d_out;
  char* ws = (char*)d_ws; size_t off = 0;
  auto alloc = [&](size_t bytes) { char* r = ws + off; off += (bytes + 255) & ~(size_t)255; return r; };
  p.Wgu1 = (u16*)alloc(2UL * 2 * DFF * 1024 * 2);
  p.Wd1 = (u16*)alloc(2UL * 1024 * DFF * 2);
  p.Win = (u16*)alloc(2UL * LDZ * 1024 * 2);
  p.Wuq = (u16*)alloc(2UL * 1536 * 384 * 2);
  p.Wkv = (u16*)alloc(2UL * 2048 * 512 * 2);
  p.Wo = (u16*)alloc(2UL * 1024 * 1024 * 2);
  p.Wgu2 = (u16*)alloc(2UL * 2 * DFF * 1024 * 2);
  p.Wd2 = (u16*)alloc(2UL * 1024 * DFF * 2);
  p.Wpg = (u16*)alloc(2UL * 1024 * 1024 * 2);
  p.Wpe = (u16*)alloc(2UL * 1024 * 256 * 2);
  p.NB = (u16*)alloc((size_t)M_ALL * 1024 * 2);
  p.ACT = (u16*)alloc((size_t)M_ALL * DFF * 2);
  p.Z = (u16*)alloc((size_t)M_ALL * LDZ * 2);
  p.QN = (u16*)alloc((size_t)M_ALL * 384 * 2);
  p.C = (u16*)alloc((size_t)M_ALL * 512 * 2);
  p.KRp = (u16*)alloc((size_t)M_P * 64 * 2);
  p.KRs = (u16*)alloc((size_t)32 * LKS * 64 * 2);
  p.Q = (u16*)alloc((size_t)M_ALL * 8 * 192 * 2);
  p.Knp = (u16*)alloc((size_t)M_P * 1024 * 2);
  p.VTp = (u16*)alloc((size_t)M_P * 1024 * 2);
  p.Kns = (u16*)alloc((size_t)32 * LKS * 1024 * 2);
  p.VTs = (u16*)alloc((size_t)32 * LKS * 1024 * 2);
  p.OA = (u16*)alloc((size_t)M_ALL * 1024 * 2);
  p.MIX = (u16*)alloc((size_t)M_ALL * 1024 * 2);
  p.PP = (u16*)alloc((size_t)M_ALL * 1024 * 2);
  p.CB = (u16*)alloc((size_t)32 * PAST * 512 * 2);
  p.PB = (u16*)alloc((size_t)M_ALL * 256 * 2);
  p.rsv = (float*)alloc((size_t)M_ALL * 4);
  p.rope = (float*)alloc((size_t)16384 * 32 * 2 * 4);
  p.ctr = (unsigned*)alloc(256);
  p.bar = (unsigned*)alloc(XCD_BAR_WORDS * 4);

  int nj = 0, ts = 0;
  auto job = [&](const float* src, u16* dst, int K, int N, int kind) {
    p.jobs[nj].src = src; p.jobs[nj].dst = dst; p.jobs[nj].K = K; p.jobs[nj].N = N; p.jobs[nj].kind = kind; p.jobs[nj].tstart = ts;
    ts += (K / 64) * (N / 64); ++nj;
  };
  for (int l = 0; l < 2; ++l) {
    job(F(7) + (size_t)l * 1024 * DFF, p.Wgu1 + (size_t)l * 2 * DFF * 1024, 1024, DFF, 1);
    job(F(8) + (size_t)l * 1024 * DFF, p.Wgu1 + (size_t)l * 2 * DFF * 1024, 1024, DFF, 2);
    job(F(9) + (size_t)l * DFF * 1024, p.Wd1 + (size_t)l * 1024 * DFF, DFF, 1024, 0);
    job(F(11) + (size_t)l * 1024 * DIN, p.Win + (size_t)l * LDZ * 1024, 1024, DIN, 0);
    job(F(13) + (size_t)l * 384 * 1536, p.Wuq + (size_t)l * 1536 * 384, 384, 1536, 3);
    job(F(18) + (size_t)l * 512 * 1024, p.Wkv + (size_t)l * 2048 * 512, 512, 1024, 0);
    job(F(19) + (size_t)l * 512 * 1024, p.Wkv + (size_t)l * 2048 * 512, 512, 1024, 4);
    job(F(24) + (size_t)l * 1024 * 1024, p.Wo + (size_t)l * 1024 * 1024, 1024, 1024, 0);
    job(F(26) + (size_t)l * 1024 * DFF, p.Wgu2 + (size_t)l * 2 * DFF * 1024, 1024, DFF, 1);
    job(F(27) + (size_t)l * 1024 * DFF, p.Wgu2 + (size_t)l * 2 * DFF * 1024, 1024, DFF, 2);
    job(F(28) + (size_t)l * DFF * 1024, p.Wd2 + (size_t)l * 1024 * DFF, DFF, 1024, 0);
    job(F(30) + (size_t)l * 1024 * 1024, p.Wpg + (size_t)l * 1024 * 1024, 1024, 1024, 0);
    job(F(31) + (size_t)l * 256 * 1024, p.Wpe + (size_t)l * 1024 * 256, 256, 1024, 0);
  }
  p.ntile_prep = ts;

  static int grid_blocks = 0;
  if (!grid_blocks) {
    int dev = 0, cus = 0, per_cu = 0;
    hipGetDevice(&dev);
    hipDeviceGetAttribute(&cus, hipDeviceAttributeMultiprocessorCount, dev);
    hipFuncSetAttribute((const void*)mega_fwd, hipFuncAttributeMaxDynamicSharedMemorySize, LDS_TOTAL);
    hipOccupancyMaxActiveBlocksPerMultiprocessor(&per_cu, (const void*)mega_fwd, 512, LDS_TOTAL);
    if (per_cu > 1) per_cu = 1;
    if (per_cu < 1) per_cu = 1;
    grid_blocks = cus * per_cu;
  }
  (void)hipMemsetAsync(p.bar, 0, XCD_BAR_WORDS * 4, stream);
  void* args[] = {&p};
  hipError_t e = hipLaunchCooperativeKernel((const void*)mega_fwd, dim3(grid_blocks), dim3(512), args, LDS_TOTAL, stream);
  if (e != hipSuccess) fprintf(stderr, "cooperative launch failed: %s (grid %d)\n", hipGetErrorString(e), grid_blocks);
}
```

```cpp
#include <hip/hip_runtime.h>
#include <hip/hip_cooperative_groups.h>
#include <cstdio>
namespace cg = cooperative_groups;

#define DI __device__ __forceinline__
typedef unsigned short u16;
typedef __attribute__((ext_vector_type(8))) short bf16x8;
typedef __attribute__((ext_vector_type(16))) float f32x16;
typedef __attribute__((ext_vector_type(2))) __bf16 bf2_t;
typedef __attribute__((ext_vector_type(2))) float f2_t;

#define M_P 16384
#define M_S 512
#define M_ALL 16896
#define DM 1024
#define DFF 2816
#define DIN 5056
#define LDZ 5120
#define ZQ 0
#define ZKV 384
#define ZKR 896
#define ZU 960
#define ZV 1984
#define ZGA 3008
#define ZGB 4032
#define LKS 4160
#define LKV 4112
#define PAST 4096
#define EPSF 1e-6f
#define QSCALE (0.07216878364870322f * 1.4426950408889634f)

#define NJOBS 26
struct TJob { const float* src; u16* dst; int K, N, kind, tstart; };

struct Params {
  const float *x_prompt, *x_sample, *cache_c, *cache_kr, *p_prompt, *p_sample;
  const float *f1n, *mixn, *qan, *qnn, *qrn, *kvan, *krn, *knn, *gvn, *gws, *gbs, *f2n, *plen;
  float* out;
  u16 *Wgu1, *Wd1, *Win, *Wuq, *Wkv, *Wo, *Wgu2, *Wd2, *Wpg, *Wpe;
  u16 *CB, *PB;
  u16 *NB, *ACT, *Z, *QN, *C, *KRp, *KRs, *Q, *Knp, *VTp, *Kns, *VTs, *OA, *MIX, *PP;
  float *rsv, *rope, *PART;
  unsigned* ctr;
  unsigned* bar;
  TJob jobs[NJOBS];
  int ntile_prep; int pad0;
};

DI int get_tid_impl(int ws) { int t = (ws << 6) | (int)__builtin_amdgcn_mbcnt_hi(~0u, __builtin_amdgcn_mbcnt_lo(~0u, 0u)); asm volatile("" : "+v"(t)); return t; }
#define get_tid() get_tid_impl(g_wave_s)
DI int get_bid() { int t = blockIdx.x; asm volatile("" : "+s"(t)); return t; }
DI unsigned pk2(float a, float b) { f2_t v = {a, b}; bf2_t r = __builtin_convertvector(v, bf2_t); return __builtin_bit_cast(unsigned, r); }
DI float bflo(unsigned v) { return __uint_as_float(v << 16); }
DI float bfhi(unsigned v) { return __uint_as_float(v & 0xffff0000u); }
DI float bf1(u16 v) { return __uint_as_float(((unsigned)v) << 16); }
DI u16 f2bf(float a) { return (u16)(pk2(a, 0.f) & 0xffffu); }
DI float shfl_xor_l(float v, int lane, int o) { return __int_as_float(__builtin_amdgcn_ds_bpermute((lane ^ o) << 2, __float_as_int(v))); }
DI float wave_sum_l(float v, int lane) {
#pragma unroll
  for (int o = 32; o > 0; o >>= 1) v += shfl_xor_l(v, lane, o);
  return v;
}
DI float sigm(float x) { return 1.f / (1.f + __expf(-x)); }
DI uint4 pack8(float4 x, float4 y) { return make_uint4(pk2(x.x, x.y), pk2(x.z, x.w), pk2(y.x, y.y), pk2(y.z, y.w)); }
#define MFMA(a, b, c) __builtin_amdgcn_mfma_f32_32x32x16_bf16((a), (b), (c), 0, 0, 0)

#define HALF_BYTES (73728 + 1024)
#define SMEM_BYTES (2 * HALF_BYTES)
#define LDS_TOTAL (SMEM_BYTES + 32)

DI int job_dst_row(int kind, int n) {
  if (kind == 0) return n;
  if (kind == 1) return 256 * (n >> 7) + (n & 127);
  if (kind == 2) return 256 * (n >> 7) + 128 + (n & 127);
  if (kind == 3) { int h = n / 192, c = n - h * 192; if (c < 128) return h * 128 + c; c -= 128; const int x = c >> 5, cl = c & 31;
                   return 1024 + h * 64 + 32 * (cl >> 4) + 8 * ((cl >> 2) & 3) + 4 * x + (cl & 3); }
  return 1024 + n;
}

DI void prep_phase(const Params& p, char* smem, int g_wave_s) {
  const int tid = get_tid();
  {
    const int vt = tid & 255, half = tid >> 8;
    u16* Ts = (u16*)smem + half * (64 * 66);
    const int npair = (p.ntile_prep + 1) >> 1;
    for (int t2 = get_bid(); t2 < npair; t2 += gridDim.x) {
      const int t = 2 * t2 + half;
      const bool valid = t < p.ntile_prep;
      int j = 0;
#pragma unroll 1
      for (int q = 1; q < NJOBS; ++q) if (t >= p.jobs[q].tstart) j = q;
      const float* src = p.jobs[j].src; u16* dst = p.jobs[j].dst;
      const int K = p.jobs[j].K, N = p.jobs[j].N, kind = p.jobs[j].kind;
      const int lt = t - p.jobs[j].tstart;
      const int ntn = N >> 6;
      const int tk = lt / ntn, tn = lt - tk * ntn;
      const int k0 = tk * 64, n0 = tn * 64;
      __syncthreads();
      if (valid) {
        unsigned* Ts32 = (unsigned*)Ts;
#pragma unroll
        for (int i = 0; i < 2; ++i) {
          const int kp = (vt >> 4) + 16 * i, nc = (vt & 15) * 4;
          const float4 v0 = *(const float4*)(src + (long)(k0 + 2 * kp) * N + n0 + nc);
          const float4 v1 = *(const float4*)(src + (long)(k0 + 2 * kp + 1) * N + n0 + nc);
          Ts32[(nc + 0) * 33 + kp] = pk2(v0.x, v1.x); Ts32[(nc + 1) * 33 + kp] = pk2(v0.y, v1.y);
          Ts32[(nc + 2) * 33 + kp] = pk2(v0.z, v1.z); Ts32[(nc + 3) * 33 + kp] = pk2(v0.w, v1.w);
        }
      }
      __syncthreads();
      if (valid) {
        const int n = vt >> 2, kc = (vt & 3) * 16;
        const unsigned* s32 = (const unsigned*)(Ts + n * 66 + kc);
        uint4 a = make_uint4(s32[0], s32[1], s32[2], s32[3]);
        uint4 b = make_uint4(s32[4], s32[5], s32[6], s32[7]);
        u16* d = dst + (long)job_dst_row(kind, n0 + n) * K + k0 + kc;
        *(uint4*)d = a; *(uint4*)(d + 8) = b;
      }
    }
  }
  const long gtid = (long)get_bid() * 512 + tid, gstride = (long)gridDim.x * 512;
  for (long e = gtid; e < 2L * 64 * 1024 / 8; e += gstride) {
    const int l = (int)(e / (64 * 1024 / 8)); const long r = e - (long)l * (64 * 1024 / 8);
    *(uint4*)(p.Win + (long)l * LDZ * 1024 + (long)DIN * 1024 + r * 8) = make_uint4(0, 0, 0, 0);
  }
  for (long e = gtid; e < 16384L * 32; e += gstride) {
    const int pos = (int)(e >> 5), i = (int)(e & 31);
    const float inv = powf(10000.0f, -(float)i / 32.0f);
    const float angf = (float)pos * inv;
    const double x = (double)angf;
    const double kq = rint(x * 0.63661977236758134308);
    const double y = (x - kq * 1.5707963267341256e+00) - kq * 6.0771005065061922e-11;
    const double y2 = y * y;
    const double s = y * (1.0 + y2 * (-1.0 / 6 + y2 * (1.0 / 120 + y2 * (-1.0 / 5040 + y2 * (1.0 / 362880 + y2 * (-1.0 / 39916800))))));
    const double c = 1.0 + y2 * (-0.5 + y2 * (1.0 / 24 + y2 * (-1.0 / 720 + y2 * (1.0 / 40320 + y2 * (-1.0 / 3628800 + y2 * (1.0 / 479001600))))));
    const int q = ((int)kq) & 3;
    double cc, ss;
    if (q == 0) { cc = c; ss = s; } else if (q == 1) { cc = -s; ss = c; } else if (q == 2) { cc = -c; ss = -s; } else { cc = s; ss = -c; }
    *(float2*)(p.rope + e * 2) = make_float2((float)cc, (float)ss);
  }
  for (long e = gtid; e < (long)M_ALL * 1024 / 4; e += gstride) {
    const long pe = (long)M_P * 1024 / 4;
    float4 v = e < pe ? ((const float4*)p.x_prompt)[e] : ((const float4*)p.x_sample)[e - pe];
    ((float4*)p.out)[e] = v;
  }
  if (get_bid() == 0 && tid < 16) p.ctr[tid] = 0u;
}

DI void norm_phase(float* __restrict__ h, const float* __restrict__ g, u16* __restrict__ out, const float* __restrict__ part, int nsplit, int g_wave_s) {
  const int tid = get_tid(); const int lane = tid & 63, w = tid >> 6;
  for (int row = get_bid() * 8 + w; row < M_ALL; row += gridDim.x * 8) {
    const float4* hr = (const float4*)(h + (long)row * 1024);
    float4 v[4]; float ss = 0.f;
#pragma unroll
    for (int i = 0; i < 4; ++i) v[i] = hr[lane + 64 * i];
    if (nsplit > 0 && row >= M_P) {
#pragma unroll 1
      for (int s_ = 0; s_ < nsplit; ++s_) {
        const float4* pr = (const float4*)(part + ((long)s_ * M_S + (row - M_P)) * 1024);
#pragma unroll
        for (int i = 0; i < 4; ++i) { const float4 q = pr[lane + 64 * i]; v[i].x += q.x; v[i].y += q.y; v[i].z += q.z; v[i].w += q.w; }
      }
#pragma unroll
      for (int i = 0; i < 4; ++i) ((float4*)(h + (long)row * 1024))[lane + 64 * i] = v[i];
    }
#pragma unroll
    for (int i = 0; i < 4; ++i) ss += v[i].x * v[i].x + v[i].y * v[i].y + v[i].z * v[i].z + v[i].w * v[i].w;
    ss = wave_sum_l(ss, lane);
    const float rs = rsqrtf(ss * (1.f / 1024.f) + EPSF);
#pragma unroll
    for (int i = 0; i < 4; ++i) {
      const float4 gg = ((const float4*)g)[lane + 64 * i];
      uint2 o = make_uint2(pk2(v[i].x * rs * gg.x, v[i].y * rs * gg.y), pk2(v[i].z * rs * gg.z, v[i].w * rs * gg.w));
      ((uint2*)(out + (long)row * 1024))[lane + 64 * i] = o;
    }
  }
}

struct TD { const char* A; const char* B; unsigned sa, sb; int nk; int pb; };
#define RED_OFF 73728

template <class Desc, class Epi>
DI void gemm_stream(int nloc, int nmax, Desc desc, Epi epi, char* smem_all, int g_wave_s) {
  const int tid = get_tid() & 255, lane = tid & 63, w = tid >> 6, wm = w >> 1, wn = w & 1, r = lane & 31, hh = lane >> 5;
  char* smem = smem_all + (get_tid() >> 8) * HALF_BYTES;
  u16* As = (u16*)smem;
  u16* Bs = As + 2 * 128 * 72;
  const int lrow = tid >> 3, lkc = (tid & 7) * 8;
  int ct = 0;
  if (nmax <= 0) return;
  TD ltd = desc(0);
  const int lrot = ((get_bid() >> 3) * 2 + (get_tid() >> 8)) % ltd.nk;
  uint4 S0a0, S0a1, S0a2, S0a3, S0b0, S0b1, S0b2, S0b3, S1a0, S1a1, S1a2, S1a3, S1b0, S1b1, S1b2, S1b3;
#define LD1(dst, base, off) dst = *(const uint4*)((base) + (size_t)(off));
#define GLOADS(S, kk) { \
    int kr_ = (kk) + lrot; kr_ = kr_ >= ltd.nk ? kr_ - ltd.nk : kr_; \
    const unsigned oa_ = lrow * ltd.sa + (unsigned)(kr_ * 64 + lkc) * 2u, ob_ = lrow * ltd.sb + (unsigned)(kr_ * 64 + lkc) * 2u; \
    LD1(S##a0, ltd.A, oa_) LD1(S##a1, ltd.A, oa_ + 32u * ltd.sa) LD1(S##a2, ltd.A, oa_ + 64u * ltd.sa) LD1(S##a3, ltd.A, oa_ + 96u * ltd.sa) \
    LD1(S##b0, ltd.B, ob_) LD1(S##b1, ltd.B, ob_ + 32u * ltd.sb) LD1(S##b2, ltd.B, ob_ + 64u * ltd.sb) LD1(S##b3, ltd.B, ob_ + 96u * ltd.sb) }
#define SST1(arr, src, i, buf) *(uint4*)(arr + ((buf) * 128 + lrow + 32 * (i)) * 72 + lkc) = src;
#define SSTORES(S, buf) { SST1(As, S##a0, 0, buf) SST1(As, S##a1, 1, buf) SST1(As, S##a2, 2, buf) SST1(As, S##a3, 3, buf) \
    SST1(Bs, S##b0, 0, buf) SST1(Bs, S##b1, 1, buf) SST1(Bs, S##b2, 2, buf) SST1(Bs, S##b3, 3, buf) }
#define COMPUTE(buf) { \
    const u16* Ab = As + ((buf) * 128 + 64 * wm + r) * 72 + 8 * hh; \
    const u16* Bb = Bs + ((buf) * 128 + 64 * wn + r) * 72 + 8 * hh; \
    _Pragma("unroll") for (int ks = 0; ks < 4; ++ks) { \
      bf16x8 a0 = *(const bf16x8*)(Ab + 16 * ks), a1 = *(const bf16x8*)(Ab + 32 * 72 + 16 * ks); \
      bf16x8 b0 = *(const bf16x8*)(Bb + 16 * ks), b1 = *(const bf16x8*)(Bb + 32 * 72 + 16 * ks); \
      acc[0][0] = MFMA(b0, a0, acc[0][0]); acc[0][1] = MFMA(b1, a0, acc[0][1]); \
      acc[1][0] = MFMA(b0, a1, acc[1][0]); acc[1][1] = MFMA(b1, a1, acc[1][1]); } }
#define SCHED_STEP() { \
    __builtin_amdgcn_sched_group_barrier(0x020, 8, 0); \
    __builtin_amdgcn_sched_group_barrier(0x100, 4, 0); \
    _Pragma("unroll") for (int q_ = 0; q_ < 4; ++q_) { __builtin_amdgcn_sched_group_barrier(0x008, 1, 0); __builtin_amdgcn_sched_group_barrier(0x100, 1, 0); } \
    _Pragma("unroll") for (int q_ = 0; q_ < 8; ++q_) { __builtin_amdgcn_sched_group_barrier(0x008, 1, 0); __builtin_amdgcn_sched_group_barrier(0x100, 1, 0); __builtin_amdgcn_sched_group_barrier(0x200, 1, 0); } \
    _Pragma("unroll") for (int q_ = 0; q_ < 4; ++q_) { __builtin_amdgcn_sched_group_barrier(0x008, 1, 0); } }

  GLOADS(S0, 0)
  GLOADS(S1, 1)
  SSTORES(S0, 0)
  __syncthreads();
#pragma unroll 1
  for (; ct < nmax; ++ct) {
    const int nk2 = ltd.nk >> 1;
    f32x16 acc[2][2];
#pragma unroll
    for (int mi = 0; mi < 2; ++mi)
#pragma unroll
      for (int ni = 0; ni < 2; ++ni)
#pragma unroll
        for (int i = 0; i < 16; ++i) acc[mi][ni][i] = 0.f;
#pragma unroll 1
    for (int k2 = 0; k2 < nk2; ++k2) {
      int kb = 2 * k2 + 2;
      if (k2 == nk2 - 1) { kb = 0; if (ct + 1 < nloc) ltd = desc(ct + 1); }
      GLOADS(S0, kb)
      COMPUTE(0)
      SSTORES(S1, 1)
      SCHED_STEP()
      __syncthreads();
      GLOADS(S1, kb + 1)
      COMPUTE(1)
      SSTORES(S0, 0)
      SCHED_STEP()
      __syncthreads();
    }
    if (ct < nloc) epi(ct, acc);
  }
#undef LD1
#undef GLOADS
#undef SST1
#undef SSTORES
#undef COMPUTE
#undef SCHED_STEP
}

typedef __attribute__((ext_vector_type(4))) float f32x4;
#define G8_HT (128 * 64)
DI int g8_lds_byte(int r, int c) { const int st = (r >> 4) * 2 + (c >> 5), rr = r & 15, cc = c & 31, ob = rr * 64 + cc * 2; return st * 1024 + (ob ^ (((ob >> 9) & 1) << 5)); }
DI void g8_stage_rc(int b, int& R, int& C) { const int st = b / 1024, sb = b % 1024, swz = sb ^ (((sb >> 9) & 1) << 5); R = (st >> 1) * 16 + swz / 64; C = (st & 1) * 32 + (swz % 64) / 2; }
DI int g8_perm32(int rho) { const int n = rho >> 4, i = rho & 15; return 8 * (i >> 2) + 4 * n + (i & 3); }

DI int g8_permT(int s_) { return 16 * ((s_ >> 3) & 1) + 8 * (s_ >> 4) + 4 * ((s_ >> 2) & 1) + (s_ & 3); }
template <int PERMB>
DI void gemm256_tile(const u16* __restrict__ A, const u16* __restrict__ Bt, int ld, int K, char* smem, f32x4 (&acc)[2][2][4][2], int g_wave_s) {
  u16* shm = (u16*)smem;
  const int tid = get_tid();
  const int wid = tid >> 6, lane = tid & 63, wr = wid >> 2, wc = wid & 3, fr = lane & 15, fq = lane >> 4;
#define G8_SA(b, h) (shm + ((b) * 2 + (h)) * G8_HT)
#define G8_SB(b, h) (shm + (4 + (b) * 2 + (h)) * G8_HT)
  int sr0, sc0;
  g8_stage_rc(tid * 16, sr0, sc0);
  const int br0 = PERMB == 1 ? ((sr0 & ~31) + g8_perm32(sr0 & 31)) : (PERMB == 2 ? ((sr0 & ~31) + g8_permT(sr0 & 31)) : sr0);
  const unsigned aoff0 = (unsigned)(sr0 * ld + sc0) * 2u;
  const unsigned boff0 = (unsigned)(br0 * ld + sc0) * 2u;
#define G8_STAGE_A(P, br, kt) do { const char* g_ = (const char*)(A + (long)(br) * ld + (long)(kt) * 64); \
    __builtin_amdgcn_global_load_lds((const unsigned*)(g_ + (size_t)aoff0), (unsigned*)((char*)(P) + tid * 16), 16, 0, 0); \
    __builtin_amdgcn_global_load_lds((const unsigned*)(g_ + (size_t)ld * 128 + (size_t)aoff0), (unsigned*)((char*)(P) + tid * 16 + 8192), 16, 0, 0); } while (0)
#define G8_STAGE_B(P, br, kt) do { const char* g_ = (const char*)(Bt + (long)(br) * ld + (long)(kt) * 64); \
    __builtin_amdgcn_global_load_lds((const unsigned*)(g_ + (size_t)boff0), (unsigned*)((char*)(P) + tid * 16), 16, 0, 0); \
    __builtin_amdgcn_global_load_lds((const unsigned*)(g_ + (size_t)ld * 128 + (size_t)boff0), (unsigned*)((char*)(P) + tid * 16 + 8192), 16, 0, 0); } while (0)
#define G8_LDA(dst, b, h) _Pragma("unroll") for (int m = 0; m < 4; ++m) _Pragma("unroll") for (int k = 0; k < 2; ++k) \
    dst[m][k] = *reinterpret_cast<const bf16x8*>((char*)G8_SA(b, h) + g8_lds_byte(wr * 64 + m * 16 + fr, k * 32 + fq * 8))
#define G8_LDB(dst, b, h) _Pragma("unroll") for (int n = 0; n < 2; ++n) _Pragma("unroll") for (int k = 0; k < 2; ++k) \
    dst[n][k] = *reinterpret_cast<const bf16x8*>((char*)G8_SB(b, h) + g8_lds_byte(wc * 32 + n * 16 + fr, k * 32 + fq * 8))
#define G8_MMA(ai, bj, At_, Bt_) do { __builtin_amdgcn_s_setprio(1); \
    _Pragma("unroll") for (int m = 0; m < 4; ++m) _Pragma("unroll") for (int n = 0; n < 2; ++n) _Pragma("unroll") for (int k = 0; k < 2; ++k) \
      acc[ai][bj][m][n] = __builtin_amdgcn_mfma_f32_16x16x32_bf16(Bt_[n][k], At_[m][k], acc[ai][bj][m][n], 0, 0, 0); \
    __builtin_amdgcn_s_setprio(0); } while (0)
#define G8_WAIT_V(n) asm volatile("s_waitcnt vmcnt(" #n ")" ::: "memory")
#define G8_WAIT_L(n) asm volatile("s_waitcnt lgkmcnt(" #n ")" ::: "memory")
#define G8_BAR __builtin_amdgcn_s_barrier()
#define G8_SCHED __builtin_amdgcn_sched_barrier(0)
#pragma unroll
  for (int ai = 0; ai < 2; ++ai)
#pragma unroll
    for (int bj = 0; bj < 2; ++bj)
#pragma unroll
      for (int m = 0; m < 4; ++m)
#pragma unroll
        for (int n = 0; n < 2; ++n) acc[ai][bj][m][n] = (f32x4){0.f, 0.f, 0.f, 0.f};
  bf16x8 At[4][2], B0[2][2], B1[2][2];
  const int nt = K >> 6;
  G8_STAGE_B(G8_SB(0, 0), 0, 0); G8_STAGE_A(G8_SA(0, 0), 0, 0);
  G8_STAGE_B(G8_SB(0, 1), 128, 0); G8_STAGE_A(G8_SA(0, 1), 128, 0);
  if (wr == 1) G8_BAR;
  G8_WAIT_V(4); G8_BAR;
  G8_STAGE_B(G8_SB(1, 0), 0, 1); G8_STAGE_A(G8_SA(1, 0), 0, 1); G8_STAGE_B(G8_SB(1, 1), 128, 1);
  G8_WAIT_V(6); G8_BAR;
#pragma unroll 1
  for (int t = 0; t < nt - 2; t += 2) {
    G8_LDB(B0, 0, 0); G8_SCHED; G8_LDA(At, 0, 0); G8_STAGE_A(G8_SA(1, 1), 128, t + 1);
    G8_WAIT_L(8); G8_BAR; G8_WAIT_L(0); G8_MMA(0, 0, At, B0); G8_BAR; G8_SCHED;
    G8_LDB(B1, 0, 1); G8_STAGE_B(G8_SB(0, 0), 0, t + 2);
    G8_BAR; G8_WAIT_L(0); G8_MMA(0, 1, At, B1); G8_BAR;
    G8_LDA(At, 0, 1); G8_STAGE_A(G8_SA(0, 0), 0, t + 2);
    G8_BAR; G8_WAIT_L(0); G8_MMA(1, 0, At, B0); G8_BAR; G8_SCHED;
    G8_STAGE_B(G8_SB(0, 1), 128, t + 2);
    G8_WAIT_V(6); G8_BAR; G8_MMA(1, 1, At, B1); G8_BAR;
    G8_LDB(B0, 1, 0); G8_SCHED; G8_LDA(At, 1, 0); G8_STAGE_A(G8_SA(0, 1), 128, t + 2);
    G8_WAIT_L(8); G8_BAR; G8_WAIT_L(0); G8_MMA(0, 0, At, B0); G8_BAR; G8_SCHED;
    G8_LDB(B1, 1, 1); G8_STAGE_B(G8_SB(1, 0), 0, t + 3);
    G8_BAR; G8_WAIT_L(0); G8_MMA(0, 1, At, B1); G8_BAR;
    G8_LDA(At, 1, 1); G8_STAGE_A(G8_SA(1, 0), 0, t + 3);
    G8_BAR; G8_WAIT_L(0); G8_MMA(1, 0, At, B0); G8_BAR; G8_SCHED;
    G8_STAGE_B(G8_SB(1, 1), 128, t + 3);
    G8_WAIT_V(6); G8_BAR; G8_MMA(1, 1, At, B1); G8_BAR;
  }
  { G8_LDB(B0, 0, 0); G8_LDA(At, 0, 0); G8_STAGE_A(G8_SA(1, 1), 128, nt - 1);
    G8_BAR; G8_WAIT_L(0); G8_MMA(0, 0, At, B0); G8_BAR;
    G8_LDB(B1, 0, 1); G8_BAR; G8_WAIT_L(0); G8_MMA(0, 1, At, B1); G8_BAR;
    G8_LDA(At, 0, 1); G8_WAIT_V(4); G8_BAR; G8_WAIT_L(0); G8_MMA(1, 0, At, B0); G8_MMA(1, 1, At, B1); G8_BAR; }
  { G8_LDB(B0, 1, 0); G8_LDA(At, 1, 0); G8_WAIT_V(2); G8_BAR; G8_WAIT_L(0); G8_MMA(0, 0, At, B0); G8_BAR;
    G8_LDB(B1, 1, 1); G8_WAIT_V(0); G8_BAR; G8_WAIT_L(0); G8_MMA(0, 1, At, B1); G8_BAR;
    G8_LDA(At, 1, 1); G8_BAR; G8_WAIT_L(0); G8_MMA(1, 0, At, B0); G8_MMA(1, 1, At, B1); G8_BAR; }
  if (wr == 0) G8_BAR;
}

#define G8_COORDS const int tid = get_tid(); const int wid = tid >> 6, lane = tid & 63, wr = wid >> 2, wc = wid & 3, fr = lane & 15, fq = lane >> 4; (void)wr; (void)wc; (void)fr; (void)fq;
DI int tok_pos(int m) { return m < M_P ? m : PAST + ((m - M_P) & 15); }
DI int perm_pos(int key) {
  const int g4 = (key >> 2) & 3;
  const int pg = (g4 == 1) ? 2 : ((g4 == 2) ? 1 : g4);
  return (key & ~15) + 4 * pg;
}

DI int nloc_plain(int total) { const int b = get_bid(), G = gridDim.x; return b < total ? (total - b + G - 1) / G : 0; }
DI void grouped_tile(int L, int nM, int nN, int& tm, int& tn) {
  const int nwg = nM * nN;
  const int q = nwg >> 3, rr = nwg & 7, xcd = L & 7, off = L >> 3;
  const int wgid = (xcd < rr ? xcd * (q + 1) : rr * (q + 1) + (xcd - rr) * q) + off;
  const int nig = 8 * nN, gid = wgid / nig, fm = gid * 8;
  const int gsz = (nM - fm) < 8 ? (nM - fm) : 8;
  const int rem = wgid - gid * nig;
  tm = fm + rem % gsz; tn = rem / gsz;
}
#define LANE_COORDS8 const int tid = get_tid(), lane = tid & 63, w = tid >> 6, wm = w >> 1, wn = w & 1, r = lane & 31, hh = lane >> 5; (void)wm; (void)wn; (void)r; (void)hh;

DI void ffn_up_phase(const Params& p, const u16* W, char* smem, int g_wave_s) {
  const int tid = get_tid();
  const int wid = tid >> 6, lane = tid & 63, wr = wid >> 2, wc = wid & 3, fr = lane & 15, fq = lane >> 4;
  const int NT = (2 * DFF) / 256;
  const int G = gridDim.x;
  for (int L = get_bid(); L < 66 * NT; L += G) {
    int tm, tn; grouped_tile(L, 66, NT, tm, tn);
    f32x4 acc[2][2][4][2];
    gemm256_tile<1>(p.NB + (long)tm * 256 * 1024, W + (long)tn * 256 * 1024, 1024, 1024, smem, acc, g_wave_s);
#pragma unroll
    for (int ai = 0; ai < 2; ++ai)
#pragma unroll
      for (int m = 0; m < 4; ++m) {
        const long row = (long)tm * 256 + 128 * ai + 64 * wr + 16 * m + fr;
        const int col = tn * 128 + 32 * wc + 8 * fq;
        float a[8];
#pragma unroll
        for (int n = 0; n < 2; ++n)
#pragma unroll
          for (int j = 0; j < 4; ++j) { const float g = acc[ai][0][m][n][j], u = acc[ai][1][m][n][j]; a[4 * n + j] = g * sigm(g) * u; }
        *(uint4*)(p.ACT + row * DFF + col) = make_uint4(pk2(a[0], a[1]), pk2(a[2], a[3]), pk2(a[4], a[5]), pk2(a[6], a[7]));
      }
  }
}

DI void win_phase(const Params& p, const u16* W, char* smem, int g_wave_s) {
  const int tid = get_tid();
  const int wid = tid >> 6, lane = tid & 63, wr = wid >> 2, wc = wid & 3, fr = lane & 15, fq = lane >> 4;
  const int NT = LDZ / 256;
  const int G = gridDim.x;
  for (int L = get_bid(); L < 66 * NT; L += G) {
    int tm, tn; grouped_tile(L, 66, NT, tm, tn);
    f32x4 acc[2][2][4][2];
    gemm256_tile<1>(p.NB + (long)tm * 256 * 1024, W + (long)tn * 256 * 1024, 1024, 1024, smem, acc, g_wave_s);
#pragma unroll
    for (int ai = 0; ai < 2; ++ai)
#pragma unroll
      for (int m = 0; m < 4; ++m) {
        const long row = (long)tm * 256 + 128 * ai + 64 * wr + 16 * m + fr;
#pragma unroll
        for (int bj = 0; bj < 2; ++bj) {
          const int col = tn * 256 + 128 * bj + 32 * wc + 8 * fq;
          *(uint4*)(p.Z + row * LDZ + col) = make_uint4(pk2(acc[ai][bj][m][0][0], acc[ai][bj][m][0][1]), pk2(acc[ai][bj][m][0][2], acc[ai][bj][m][0][3]),
                                                        pk2(acc[ai][bj][m][1][0], acc[ai][bj][m][1][1]), pk2(acc[ai][bj][m][1][2], acc[ai][bj][m][1][3]));
        }
      }
  }
}

DI void resid_gemm_phase(const Params& p, const u16* A, int K, const u16* W, float alpha, char* smem, int g_wave_s) {
  const int G = gridDim.x;
#pragma unroll 1
  for (int L = get_bid(); L < 64 * 4; L += G) {
    const int tm = L >> 2, tn = L & 3;
    f32x4 acc[2][2][4][2];
    gemm256_tile<1>(A + (long)tm * 256 * K, W + (long)tn * 256 * K, K, K, smem, acc, g_wave_s);
    G8_COORDS
#pragma unroll
    for (int ai = 0; ai < 2; ++ai)
#pragma unroll
      for (int m = 0; m < 4; ++m) {
        const long row = (long)tm * 256 + 128 * ai + 64 * wr + 16 * m + fr;
#pragma unroll
        for (int bj = 0; bj < 2; ++bj) {
          float4* hp = (float4*)(p.out + row * 1024 + tn * 256 + 128 * bj + 32 * wc + 8 * fq);
          float4 v0 = hp[0], v1 = hp[1];
          v0.x += alpha * acc[ai][bj][m][0][0]; v0.y += alpha * acc[ai][bj][m][0][1]; v0.z += alpha * acc[ai][bj][m][0][2]; v0.w += alpha * acc[ai][bj][m][0][3];
          v1.x += alpha * acc[ai][bj][m][1][0]; v1.y += alpha * acc[ai][bj][m][1][1]; v1.z += alpha * acc[ai][bj][m][1][2]; v1.w += alpha * acc[ai][bj][m][1][3];
          hp[0] = v0; hp[1] = v1;
        }
      }
  }
  const int nsplit = K >> 8;
#pragma unroll 1
  for (int it = get_bid(); it < 8 * nsplit; it += G) {
    const int tile = it / nsplit, ks = it - tile * nsplit;
    const int tm = 64 + (tile >> 2), tn = tile & 3;
    f32x4 acc[2][2][4][2];
    gemm256_tile<1>(A + (long)tm * 256 * K + ks * 256, W + (long)tn * 256 * K + ks * 256, K, 256, smem, acc, g_wave_s);
    G8_COORDS
#pragma unroll
    for (int ai = 0; ai < 2; ++ai)
#pragma unroll
      for (int m = 0; m < 4; ++m) {
        const long rs_ = (long)(tm - 64) * 256 + 128 * ai + 64 * wr + 16 * m + fr;
#pragma unroll
        for (int bj = 0; bj < 2; ++bj) {
          float4* pp = (float4*)(p.PART + ((long)ks * M_S + rs_) * 1024 + tn * 256 + 128 * bj + 32 * wc + 8 * fq);
          pp[0] = make_float4(alpha * acc[ai][bj][m][0][0], alpha * acc[ai][bj][m][0][1], alpha * acc[ai][bj][m][0][2], alpha * acc[ai][bj][m][0][3]);
          pp[1] = make_float4(alpha * acc[ai][bj][m][1][0], alpha * acc[ai][bj][m][1][1], alpha * acc[ai][bj][m][1][2], alpha * acc[ai][bj][m][1][3]);
        }
      }
  }
}

DI void ple_phase(const Params& p, const u16* W, char* smem, int g_wave_s) {
  const int G = gridDim.x;
#pragma unroll 1
  for (int L = get_bid(); L < 66 * 4; L += G) {
    const int tm = L >> 2, tn = L & 3;
    f32x4 acc[2][2][4][2];
    gemm256_tile<1>(p.NB + (long)tm * 256 * 1024, W + (long)tn * 256 * 1024, 1024, 1024, smem, acc, g_wave_s);
    G8_COORDS
#pragma unroll
    for (int ai = 0; ai < 2; ++ai)
#pragma unroll
      for (int m = 0; m < 4; ++m) {
        const long row = (long)tm * 256 + 128 * ai + 64 * wr + 16 * m + fr;
#pragma unroll
        for (int bj = 0; bj < 2; ++bj) {
          const int col = tn * 256 + 128 * bj + 32 * wc + 8 * fq;
          float4* hp = (float4*)(p.out + row * 1024 + col);
          const uint4 pp = *(const uint4*)(p.PP + row * 1024 + col);
          float4 v0 = hp[0], v1 = hp[1];
          v0.x += sigm(acc[ai][bj][m][0][0]) * bflo(pp.x); v0.y += sigm(acc[ai][bj][m][0][1]) * bfhi(pp.x);
          v0.z += sigm(acc[ai][bj][m][0][2]) * bflo(pp.y); v0.w += sigm(acc[ai][bj][m][0][3]) * bfhi(pp.y);
          v1.x += sigm(acc[ai][bj][m][1][0]) * bflo(pp.z); v1.y += sigm(acc[ai][bj][m][1][1]) * bfhi(pp.z);
          v1.z += sigm(acc[ai][bj][m][1][2]) * bflo(pp.w); v1.w += sigm(acc[ai][bj][m][1][3]) * bfhi(pp.w);
          hp[0] = v0; hp[1] = v1;
        }
      }
  }
}

DI void rowpost_phase(const Params& p, int l, int g_wave_s) {
  const int tid = get_tid(); const int lane = tid & 63, w = tid >> 6;
  const float* qan = p.qan + l * 384; const float* kvan = p.kvan + l * 512; const float* krn = p.krn + l * 64; const float* gvn = p.gvn + l * 1024;
  float* o_pkv = p.out + 17301504L + (long)l * M_P * 512;
  float* o_pkr = p.out + 34078720L + (long)l * M_P * 64;
  float* o_skv = p.out + 36175872L + (long)l * M_S * 512;
  float* o_skr = p.out + 36700160L + (long)l * M_S * 64;
  float* o_sgv = p.out + 36765696L + (long)l * M_S * 1024;
  for (int row = get_bid() * 8 + w; row < M_ALL; row += gridDim.x * 8) {
    const u16* zr = p.Z + (long)row * LDZ;
    const bool is_s = row >= M_P; const int rs_ = row - M_P;
    {
      unsigned v[3]; float ss = 0.f;
#pragma unroll
      for (int i = 0; i < 3; ++i) { v[i] = *(const unsigned*)(zr + ZQ + 2 * lane + 128 * i); const float a = bflo(v[i]), b = bfhi(v[i]); ss += a * a + b * b; }
      ss = wave_sum_l(ss, lane);
      const float rs = rsqrtf(ss * (1.f / 384.f) + EPSF);
#pragma unroll
      for (int i = 0; i < 3; ++i) {
        const int c = 2 * lane + 128 * i; const float2 g = *(const float2*)(qan + c);
        *(unsigned*)(p.QN + (long)row * 384 + c) = pk2(bflo(v[i]) * rs * g.x, bfhi(v[i]) * rs * g.y);
      }
    }
    {
      const uint4 v = *(const uint4*)(zr + ZKV + 8 * lane);
      float x[8] = {bflo(v.x), bfhi(v.x), bflo(v.y), bfhi(v.y), bflo(v.z), bfhi(v.z), bflo(v.w), bfhi(v.w)};
      float ss = 0.f;
#pragma unroll
      for (int i = 0; i < 8; ++i) ss += x[i] * x[i];
      ss = wave_sum_l(ss, lane);
      const float rs = rsqrtf(ss * (1.f / 512.f) + EPSF);
      const float4 g0 = *(const float4*)(kvan + 8 * lane), g1 = *(const float4*)(kvan + 8 * lane + 4);
      float4 y0 = make_float4(x[0] * rs * g0.x, x[1] * rs * g0.y, x[2] * rs * g0.z, x[3] * rs * g0.w);
      float4 y1 = make_float4(x[4] * rs * g1.x, x[5] * rs * g1.y, x[6] * rs * g1.z, x[7] * rs * g1.w);
      float* od = is_s ? (o_skv + (long)rs_ * 512) : (o_pkv + (long)row * 512);
      *(float4*)(od + 8 * lane) = y0; *(float4*)(od + 8 * lane + 4) = y1;
      *(uint4*)(p.C + (long)row * 512 + 8 * lane) = pack8(y0, y1);
    }
    {
      const float x = bf1(zr[ZKR + lane]);
      const float ss = wave_sum_l(x * x, lane);
      const float rs = rsqrtf(ss * (1.f / 64.f) + EPSF);
      const float y = x * rs * krn[lane];
      const float other = shfl_xor_l(y, lane, 32);
      const int pos = tok_pos(row);
      const float2 cs = *(const float2*)(p.rope + ((long)pos * 32 + (lane & 31)) * 2);
      const float o = lane < 32 ? (y * cs.x - other * cs.y) : (other * cs.y + y * cs.x);
      if (is_s) {
        o_skr[(long)rs_ * 64 + lane] = o;
        p.KRs[((long)(rs_ >> 4) * LKS + PAST + (rs_ & 15)) * 64 + lane] = f2bf(o);
      } else {
        o_pkr[(long)row * 64 + lane] = o;
        p.KRp[(long)row * 64 + lane] = f2bf(o);
      }
    }
    {
      uint4 v[2]; float ss = 0.f;
#pragma unroll
      for (int i = 0; i < 2; ++i) {
        v[i] = *(const uint4*)(zr + ZV + 8 * lane + 512 * i);
        const float x[8] = {bflo(v[i].x), bfhi(v[i].x), bflo(v[i].y), bfhi(v[i].y), bflo(v[i].z), bfhi(v[i].z), bflo(v[i].w), bfhi(v[i].w)};
#pragma unroll
        for (int j = 0; j < 8; ++j) ss += x[j] * x[j];
      }
      ss = wave_sum_l(ss, lane);
      const float rs = rsqrtf(ss * (1.f / 1024.f) + EPSF);
      if (lane == 0) p.rsv[row] = rs;
      if (is_s) {
#pragma unroll
        for (int i = 0; i < 2; ++i) {
          const int c = 8 * lane + 512 * i;
          const float x[8] = {bflo(v[i].x), bfhi(v[i].x), bflo(v[i].y), bfhi(v[i].y), bflo(v[i].z), bfhi(v[i].z), bflo(v[i].w), bfhi(v[i].w)};
          const float4 g0 = *(const float4*)(gvn + c), g1 = *(const float4*)(gvn + c + 4);
          *(float4*)(o_sgv + (long)rs_ * 1024 + c) = make_float4(x[0] * rs * g0.x, x[1] * rs * g0.y, x[2] * rs * g0.z, x[3] * rs * g0.w);
          *(float4*)(o_sgv + (long)rs_ * 1024 + c + 4) = make_float4(x[4] * rs * g1.x, x[5] * rs * g1.y, x[6] * rs * g1.z, x[7] * rs * g1.w);
        }
      }
    }
  }
  {
    const float* cc = p.cache_c + (long)l * 32 * PAST * 512;
    const long gt = (long)get_bid() * 512 + tid, gs = (long)gridDim.x * 512;
    for (long e = gt; e < 32L * PAST * 512 / 8; e += gs) {
      const float4 a = *(const float4*)(cc + e * 8), c = *(const float4*)(cc + e * 8 + 4);
      *(uint4*)(p.CB + e * 8) = pack8(a, c);
    }
    const float* pp = p.p_prompt + (long)l * M_P * 256; const float* ps = p.p_sample + (long)l * M_S * 256;
    for (long e = gt; e < (long)M_ALL * 256 / 8; e += gs) {
      const long pe = (long)M_P * 256 / 8;
      const float* src = e < pe ? (pp + e * 8) : (ps + (e - pe) * 8);
      *(uint4*)(p.PB + e * 8) = pack8(*(const float4*)src, *(const float4*)(src + 4));
    }
  }
  const float* ckr = p.cache_kr + (long)l * 32 * PAST * 64;
  const long gtid = (long)get_bid() * 512 + tid, gstride = (long)gridDim.x * 512;
  for (long e = gtid; e < 32L * PAST * 64 / 8; e += gstride) {
    const long el = e * 8; const int b = (int)(el / (PAST * 64)); const long rem = el - (long)b * PAST * 64;
    const float4 a = *(const float4*)(ckr + el), c = *(const float4*)(ckr + el + 4);
    *(uint4*)(p.KRs + (long)b * LKS * 64 + rem) = pack8(a, c);
  }
}

#define NCKV (512 * 8)
#define NPKV (64 * 8)
#define NSKV (2 * 8)
#define NQT (66 * 6)
#define NPPT (66 * 4)
#define RED8_OFF 131072
template <class RowPtr>
DI void nope_epi256(f32x4 (&acc)[2][2][4][2], const float* __restrict__ gain, float scale, char* smem, RowPtr rowptr, int g_wave_s) {
  const int tid = get_tid();
  const int wid = tid >> 6, lane = tid & 63, wr = wid >> 2, wc = wid & 3, fr = lane & 15, fq = lane >> 4;
  float* red = (float*)(smem + RED8_OFF);
#pragma unroll
  for (int ai = 0; ai < 2; ++ai)
#pragma unroll
    for (int bj = 0; bj < 2; ++bj)
#pragma unroll
      for (int m = 0; m < 4; ++m) {
        float s = 0.f;
#pragma unroll
        for (int n = 0; n < 2; ++n)
#pragma unroll
          for (int j = 0; j < 4; ++j) s += acc[ai][bj][m][n][j] * acc[ai][bj][m][n][j];
        s += shfl_xor_l(s, lane, 16); s += shfl_xor_l(s, lane, 32);
        if (fq == 0) red[((wc * 2 + ai) * 2 + bj) * 128 + 64 * wr + 16 * m + fr] = s;
      }
  __syncthreads();
  const int c = 32 * wc + 8 * fq;
  const float4 ga = *(const float4*)(gain + c), gb = *(const float4*)(gain + c + 4);
#pragma unroll
  for (int ai = 0; ai < 2; ++ai)
#pragma unroll
    for (int bj = 0; bj < 2; ++bj)
#pragma unroll
      for (int m = 0; m < 4; ++m) {
        const int rl = 64 * wr + 16 * m + fr;
        float tot = 0.f;
#pragma unroll
        for (int q = 0; q < 4; ++q) tot += red[((q * 2 + ai) * 2 + bj) * 128 + rl];
        const float rs = rsqrtf(tot * (1.f / 128.f) + EPSF) * scale;
        u16* op = rowptr(128 * ai + rl, bj);
        *(uint4*)(op + c) = make_uint4(pk2(acc[ai][bj][m][0][0] * rs * ga.x, acc[ai][bj][m][0][1] * rs * ga.y), pk2(acc[ai][bj][m][0][2] * rs * ga.z, acc[ai][bj][m][0][3] * rs * ga.w),
                                       pk2(acc[ai][bj][m][1][0] * rs * gb.x, acc[ai][bj][m][1][1] * rs * gb.y), pk2(acc[ai][bj][m][1][2] * rs * gb.z, acc[ai][bj][m][1][3] * rs * gb.w));
      }
}

DI void vt_epi256(const Params& p, f32x4 (&acc)[2][2][4][2], int mode, int m0, int tn, int g_wave_s) {
  G8_COORDS
  const long dstride = (mode == 0) ? (long)M_P : (long)LKS;
#pragma unroll
  for (int bj = 0; bj < 2; ++bj) {
    const int m32 = m0 + 128 * bj + 32 * wc;
#pragma unroll
    for (int ai = 0; ai < 2; ++ai) {
      const int h = 2 * (tn - 4) + ai;
      u16* base;
      if (mode == 0) base = p.VTp + (long)h * 128 * M_P + m32 + 8 * fq;
      else if (mode == 1) base = p.VTs + ((long)(m32 >> 12) * 8 + h) * 128 * LKS + (m32 & 4095) + 8 * fq;
      else base = p.VTs + ((long)((m32 >> 4) + (fq >> 1)) * 8 + h) * 128 * LKS + PAST + 8 * (fq & 1);
#pragma unroll
      for (int m = 0; m < 4; ++m) {
        const int dd = 64 * wr + 16 * m + fr;
        *(uint4*)(base + (long)dd * dstride) = make_uint4(pk2(acc[ai][bj][m][0][0], acc[ai][bj][m][0][1]), pk2(acc[ai][bj][m][0][2], acc[ai][bj][m][0][3]),
                                                          pk2(acc[ai][bj][m][1][0], acc[ai][bj][m][1][1]), pk2(acc[ai][bj][m][1][2], acc[ai][bj][m][1][3]));
      }
    }
  }
}
DI void rope_epi256(const Params& p, int l, f32x4 (&acc)[2][2][4][2], int tm, int tn, char* smem, int g_wave_s) {
  G8_COORDS
  float* red = (float*)(smem + RED8_OFF);
#pragma unroll
  for (int ai = 0; ai < 2; ++ai)
#pragma unroll
    for (int bj = 0; bj < 2; ++bj)
#pragma unroll
      for (int m = 0; m < 4; ++m) {
        float s = 0.f;
#pragma unroll
        for (int n = 0; n < 2; ++n)
#pragma unroll
          for (int j = 0; j < 4; ++j) s += acc[ai][bj][m][n][j] * acc[ai][bj][m][n][j];
        s += shfl_xor_l(s, lane, 16); s += shfl_xor_l(s, lane, 32);
        if (fq == 0) red[((wc * 2 + ai) * 2 + bj) * 128 + 64 * wr + 16 * m + fr] = s;
      }
  __syncthreads();
  const float* g = p.qrn + l * 64;
  const int c0 = 16 * (wc & 1) + 4 * fq;
  const float4 g1 = *(const float4*)(g + c0), g2 = *(const float4*)(g + 32 + c0);
  const float gg1[4] = {g1.x, g1.y, g1.z, g1.w}, gg2[4] = {g2.x, g2.y, g2.z, g2.w};
#pragma unroll
  for (int ai = 0; ai < 2; ++ai)
#pragma unroll
    for (int m = 0; m < 4; ++m) {
      const int rl = 64 * wr + 16 * m + fr;
      const int row = tm * 256 + 128 * ai + rl;
      const int pos = tok_pos(row);
      const float4 t0 = *(const float4*)(p.rope + ((long)pos * 32 + c0) * 2);
      const float4 t1 = *(const float4*)(p.rope + ((long)pos * 32 + c0) * 2 + 4);
      const float cs[4] = {t0.x, t0.z, t1.x, t1.z}, sn[4] = {t0.y, t0.w, t1.y, t1.w};
#pragma unroll
      for (int bj = 0; bj < 2; ++bj) {
        const float tot = red[((wc * 2 + ai) * 2 + bj) * 128 + rl] + red[(((wc ^ 1) * 2 + ai) * 2 + bj) * 128 + rl];
        const float rs = rsqrtf(tot * (1.f / 64.f) + EPSF);
        const int head = 4 * (tn - 4) + 2 * bj + (wc >> 1);
        u16* qp = p.Q + ((long)row * 8 + head) * 192 + 128;
        float o1[4], o2[4];
#pragma unroll
        for (int j = 0; j < 4; ++j) {
          const float y1 = acc[ai][bj][m][0][j] * rs * gg1[j], y2 = acc[ai][bj][m][1][j] * rs * gg2[j];
          o1[j] = (y1 * cs[j] - y2 * sn[j]) * QSCALE; o2[j] = (y1 * sn[j] + y2 * cs[j]) * QSCALE;
        }
        *(uint2*)(qp + c0) = make_uint2(pk2(o1[0], o1[1]), pk2(o1[2], o1[3]));
        *(uint2*)(qp + 32 + c0) = make_uint2(pk2(o2[0], o2[1]), pk2(o2[2], o2[3]));
      }
    }
}
DI void pp_epi256(const Params& p, f32x4 (&acc)[2][2][4][2], int tm, int tn, int g_wave_s) {
  G8_COORDS
#pragma unroll
  for (int ai = 0; ai < 2; ++ai)
#pragma unroll
    for (int m = 0; m < 4; ++m) {
      const long row = (long)tm * 256 + 128 * ai + 64 * wr + 16 * m + fr;
#pragma unroll
      for (int bj = 0; bj < 2; ++bj) {
        const int col = tn * 256 + 128 * bj + 32 * wc + 8 * fq;
        *(uint4*)(p.PP + row * 1024 + col) = make_uint4(pk2(acc[ai][bj][m][0][0], acc[ai][bj][m][0][1]), pk2(acc[ai][bj][m][0][2], acc[ai][bj][m][0][3]),
                                                        pk2(acc[ai][bj][m][1][0], acc[ai][bj][m][1][1]), pk2(acc[ai][bj][m][1][2], acc[ai][bj][m][1][3]));
      }
    }
}

DI void multi_phase(const Params& p, int l, char* smem, int g_wave_s) {
  const u16* Wkv = p.Wkv + (long)l * 2048 * 512;
  const u16* Wuq = p.Wuq + (long)l * 1536 * 384;
  const u16* Wpe = p.Wpe + (long)l * 1024 * 256;
  const int total = NCKV + NPKV + NSKV + NQT + NPPT;
  const int G = gridDim.x;
#pragma unroll 1
  for (int t = get_bid(); t < NCKV + NPKV + NSKV; t += G) {
    f32x4 acc[2][2][4][2];
    {
      const u16* tok; int u = t, mode;
      if (u < NCKV) { tok = p.CB + (long)(u >> 3) * 256 * 512; mode = 1; }
      else if ((u -= NCKV) < NPKV) { tok = p.C + (long)(u >> 3) * 256 * 512; mode = 0; }
      else { u -= NPKV; tok = p.C + ((long)M_P + (u >> 3) * 256) * 512; mode = 2; }
      const int m0 = (u >> 3) * 256, tn = u & 7;
      const u16* wgt = Wkv + (long)tn * 256 * 512;
      if (tn < 4) {
        gemm256_tile<1>(tok, wgt, 512, 512, smem, acc, g_wave_s);
        nope_epi256(acc, p.knn + l * 128, 1.0f, smem, [&](int rloc, int bj) -> u16* {
          const int m = m0 + rloc; const int h = 2 * tn + bj;
          if (mode == 0) return p.Knp + ((long)m * 8 + h) * 128;
          long key;
          if (mode == 1) key = (long)(m >> 12) * LKS + (m & 4095); else key = (long)(m >> 4) * LKS + PAST + (m & 15);
          return p.Kns + (key * 8 + h) * 128;
        }, g_wave_s);
      } else {
        gemm256_tile<2>(wgt, tok, 512, 512, smem, acc, g_wave_s);
        vt_epi256(p, acc, mode, m0, tn, g_wave_s);
      }
    }
  }
#pragma unroll 1
  for (int t = get_bid() + ((NCKV + NPKV + NSKV) / G) * G; t < total; t += G) {
    if (t < NCKV + NPKV + NSKV) continue;
    f32x4 acc[2][2][4][2];
    int u = t - (NCKV + NPKV + NSKV);
    if (u < NQT) {
      const int tm = u / 6, tn = u - tm * 6;
      gemm256_tile<1>(p.QN + (long)tm * 256 * 384, Wuq + (long)tn * 256 * 384, 384, 384, smem, acc, g_wave_s);
      if (tn < 4) nope_epi256(acc, p.qnn + l * 128, QSCALE, smem, [&](int rloc, int bj) -> u16* { return p.Q + ((long)(tm * 256 + rloc) * 8 + 2 * tn + bj) * 192; }, g_wave_s);
      else rope_epi256(p, l, acc, tm, tn, smem, g_wave_s);
      continue;
    }
    u -= NQT;
    {
      const int tm = u >> 2, tn = u & 3;
      gemm256_tile<1>(p.PB + (long)tm * 256 * 256, Wpe + (long)tn * 256 * 256, 256, 256, smem, acc, g_wave_s);
      pp_epi256(p, acc, tm, tn, g_wave_s);
    }
  }
}

#define ASTAGE 40960
DI void attn_item(const u16* __restrict__ Qb, int qclamp, const u16* __restrict__ Kn, const u16* __restrict__ KR,
                  const u16* __restrict__ VT, long vt_stride, int ntiles, int ntw, int Lk, u16* __restrict__ Ob, char* smem, int g_wave_s) {
  const int tid = get_tid(), lane = tid & 63, w = tid >> 6, r = lane & 31, hh = lane >> 5;
  bf16x8 qf[12];
  {
    const int qr = r < qclamp ? r : qclamp;
    const u16* qp = Qb + (long)(32 * w + qr) * (8 * 192) + 8 * hh;
#pragma unroll
    for (int ks = 0; ks < 12; ++ks) qf[ks] = *(const bf16x8*)(qp + 16 * ks);
  }
  f32x16 oacc[4];
#pragma unroll
  for (int dt = 0; dt < 4; ++dt)
#pragma unroll
    for (int i = 0; i < 16; ++i) oacc[dt][i] = 0.f;
  float mrun = 0.f, lrun = 0.f;

  const int lrow = tid >> 3, lq = tid & 7;
  const int sch = lq ^ ((lrow >> 1) & 7);
  unsigned koff = (unsigned)(lrow * 1024 + sch * 8) * 2u;
  unsigned kroff = (unsigned)(lrow * 64 + sch * 8) * 2u;
  const unsigned vstep = (unsigned)(64 * vt_stride * 2);
  unsigned voff = (unsigned)(lrow * vt_stride * 2 + sch * 16);
  const char* KnB = (const char*)Kn; const char* KRB = (const char*)KR; const char* VTB = (const char*)VT;
  char* dstT = smem + tid * 16;
#define ADMA(st_) { char* d_ = dstT + (st_) * ASTAGE; \
    __builtin_amdgcn_global_load_lds((const unsigned*)(KnB + (size_t)koff), (unsigned*)(d_), 16, 0, 0); \
    __builtin_amdgcn_global_load_lds((const unsigned*)(KnB + (size_t)koff + 128), (unsigned*)(d_ + 8192), 16, 0, 0); \
    __builtin_amdgcn_global_load_lds((const unsigned*)(KRB + (size_t)kroff), (unsigned*)(d_ + 16384), 16, 0, 0); \
    __builtin_amdgcn_global_load_lds((const unsigned*)(VTB + (size_t)voff), (unsigned*)(d_ + 24576), 16, 0, 0); \
    __builtin_amdgcn_global_load_lds((const unsigned*)(VTB + (size_t)(voff + vstep)), (unsigned*)(d_ + 32768), 16, 0, 0); \
    koff += 64 * 1024 * 2; kroff += 64 * 64 * 2; voff += 128; }
  const int xr = (r >> 1) & 7;
  const int xo0 = ((0 + hh) ^ xr) << 4, xo1 = ((2 + hh) ^ xr) << 4, xo2 = ((4 + hh) ^ xr) << 4, xo3 = ((6 + hh) ^ xr) << 4;
  const char* rbase = smem + r * 128;

  f32x16 sacc[2];
#define KFRAG(sb_, ks_, kt_) (*(const bf16x8*)((sb_) + ((ks_) >> 2) * 8192 + (kt_) * 4096 + ((((ks_) & 3) == 0) ? xo0 : (((ks_) & 3) == 1) ? xo1 : (((ks_) & 3) == 2) ? xo2 : xo3)))
#define VFRAG(sb_, dt_, q_) (*(const bf16x8*)((sb_) + 24576 + (dt_) * 4096 + (((q_) == 0) ? xo0 : ((q_) == 1) ? xo1 : ((q_) == 2) ? xo2 : xo3)))
#define ATT_S(st_) { \
    { const float ninit = -mrun; _Pragma("unroll") for (int kt = 0; kt < 2; ++kt) _Pragma("unroll") for (int i = 0; i < 16; ++i) sacc[kt][i] = ninit; }     \
    const char* sb = rbase + (st_) * ASTAGE; \
    _Pragma("unroll") for (int ks = 0; ks < 12; ++ks) { \
      bf16x8 k0 = KFRAG(sb, ks, 0); \
      bf16x8 k1 = KFRAG(sb, ks, 1); \
      sacc[0] = MFMA(k0, qf[ks], sacc[0]); \
      sacc[1] = MFMA(k1, qf[ks], sacc[1]); \
      if ((ks & 3) == 3) __builtin_amdgcn_sched_barrier(0); } }
#define ATT_PV(jt_, st_) { \
    if (((jt_) + 1) * 64 > Lk) { \
      _Pragma("unroll") for (int kt = 0; kt < 2; ++kt) _Pragma("unroll") for (int i = 0; i < 16; ++i) { \
          const int key = (jt_) * 64 + 32 * kt + (i & 3) + 8 * (i >> 2) + 4 * hh; \
          if (key >= Lk) sacc[kt][i] = -INFINITY; } } \
    float tmax = -INFINITY; \
    _Pragma("unroll") for (int kt = 0; kt < 2; ++kt) _Pragma("unroll") for (int i = 0; i < 16; ++i) tmax = fmaxf(tmax, sacc[kt][i]); \
    tmax = fmaxf(tmax, shfl_xor_l(tmax, lane, 32)); \
      \
    if (__builtin_amdgcn_ballot_w64(tmax > 8.0f) != 0ull) { \
      const float dlt = fmaxf(tmax, 0.f); \
      const float alpha = __builtin_amdgcn_exp2f(-dlt); \
      mrun += dlt; \
      lrun *= alpha; \
      _Pragma("unroll") for (int kt = 0; kt < 2; ++kt) _Pragma("unroll") for (int i = 0; i < 16; ++i) sacc[kt][i] -= dlt; \
      _Pragma("unroll") for (int dt = 0; dt < 4; ++dt) _Pragma("unroll") for (int i = 0; i < 16; ++i) oacc[dt][i] *= alpha; \
    } \
    float psum = 0.f; \
    _Pragma("unroll") for (int kt = 0; kt < 2; ++kt) _Pragma("unroll") for (int i = 0; i < 16; ++i) { const float pv = __builtin_amdgcn_exp2f(sacc[kt][i]); sacc[kt][i] = pv; psum += pv; } \
    lrun += psum; \
    bf16x8 pf[2][2]; \
    _Pragma("unroll") for (int kt = 0; kt < 2; ++kt) _Pragma("unroll") for (int s = 0; s < 2; ++s) { \
        uint4 pp = make_uint4(pk2(sacc[kt][8 * s + 0], sacc[kt][8 * s + 1]), pk2(sacc[kt][8 * s + 2], sacc[kt][8 * s + 3]), \
                              pk2(sacc[kt][8 * s + 4], sacc[kt][8 * s + 5]), pk2(sacc[kt][8 * s + 6], sacc[kt][8 * s + 7])); \
        pf[kt][s] = __builtin_bit_cast(bf16x8, pp); } \
    const char* sb = rbase + (st_) * ASTAGE; \
    _Pragma("unroll") for (int dt = 0; dt < 4; ++dt) _Pragma("unroll") for (int kt = 0; kt < 2; ++kt) _Pragma("unroll") for (int s = 0; s < 2; ++s) { \
          bf16x8 vf = VFRAG(sb, dt, 2 * kt + s); \
          oacc[dt] = MFMA(vf, pf[kt][s], oacc[dt]); \
          if (kt == 1 && s == 1) __builtin_amdgcn_sched_barrier(0); } }

  ADMA(0)
  int st = 0;
#pragma unroll 1
  for (int jt = 0; jt < ntiles; ++jt) {
    asm volatile("s_waitcnt vmcnt(0)" ::: "memory");
    __syncthreads();
    const int stn = st == 2 ? 0 : st + 1;
    if (jt + 1 < ntiles) ADMA(stn)
    if (jt < ntw) { ATT_S(st) ATT_PV(jt, st) }
    st = stn;
  }
#undef ATT_S
#undef ATT_PV
#undef KFRAG
#undef VFRAG
#undef ADMA
  if (ntw > 0 && r <= qclamp) {
    const float ltot = lrun + shfl_xor_l(lrun, lane, 32);
    const float inv = 1.f / ltot;
    u16* op = Ob + (long)(32 * w + r) * 1024;
#pragma unroll
    for (int dt = 0; dt < 4; ++dt)
#pragma unroll
      for (int i4 = 0; i4 < 4; ++i4) {
        const int d = 32 * dt + 8 * i4 + 4 * hh;
        *(uint2*)(op + d) = make_uint2(pk2(oacc[dt][4 * i4 + 0] * inv, oacc[dt][4 * i4 + 1] * inv), pk2(oacc[dt][4 * i4 + 2] * inv, oacc[dt][4 * i4 + 3] * inv));
      }
  } else if (ntw > 0) {
    (void)shfl_xor_l(lrun, lane, 32);
  }
}

DI void attn_phase(const Params& p, int l, char* smem, int* s_item, int cidx, int g_wave_s) {
  const int tid = get_tid(), w = tid >> 6;
  const int NITEM = 256 + 512;
  for (;;) {
    __syncthreads();
    if (tid == 0) *s_item = (int)atomicAdd(p.ctr + cidx, 1u);
    __syncthreads();
    const int item = *s_item;
    if (item >= NITEM) break;
    if (item < 256) {
      const int b = item >> 3, h = item & 7;
      const u16* Qb = p.Q + ((long)(M_P + 16 * b) * 8 + h) * 192;
      const u16* Kn = p.Kns + ((long)b * LKS * 8 + h) * 128;
      const u16* KR = p.KRs + (long)b * LKS * 64;
      const u16* VT = p.VTs + ((long)b * 8 + h) * 128 * LKS;
      u16* Ob = p.OA + (long)(M_P + 16 * b) * 1024 + h * 128;
      attn_item(Qb, 15, Kn, KR, VT, LKS, 65, w == 0 ? 65 : 0, LKV, Ob, smem, g_wave_s);
    } else {
      const int idx = item - 256;
      const int qb = 63 - (idx >> 3), h = idx & 7;
      const u16* Qb = p.Q + ((long)(256 * qb) * 8 + h) * 192;
      const u16* Kn = p.Knp + (long)h * 128;
      const u16* KR = p.KRp;
      const u16* VT = p.VTp + (long)h * 128 * M_P;
      u16* Ob = p.OA + (long)(256 * qb) * 1024 + h * 128;
      const int ntiles = 4 * qb + 4;
      attn_item(Qb, 31, Kn, KR, VT, M_P, ntiles, 4 * qb + (w >> 1) + 1, 1 << 30, Ob, smem, g_wave_s);
    }
  }
}

DI void gmlp_phase(const Params& p, int l, char* smem_all, int g_wave_s) {
  const int half = get_tid() >> 8; char* smem = smem_all + half * HALF_BYTES;
  const int tid = get_tid() & 255, lane = tid & 63, w = tid >> 6, wm = w >> 1, wn = w & 1, r = lane & 31, hh = lane >> 5;
  const float* gvn = p.gvn + l * 1024;
  const float* gws = p.gws + (long)l * 8 * 128 * 128;
  const float* gbs = p.gbs + (long)l * 8 * 128;
  u16* Xs = (u16*)smem;
  u16* Ws = Xs + 128 * 136;
  const int NP = 128 * 8, NS = 32 * 4;
  for (int t2 = get_bid(); t2 < (NP + NS + 1) / 2; t2 += gridDim.x) {
    const int t = 2 * t2 + half;
    const bool valid = t < NP + NS;
    const bool isp = valid && t < NP;
    {
      const int ci = t >> 3, g = t & 7;
      const int t0 = ci * 128, c0 = g * 128;
      __syncthreads();
      if (isp) {
      {
        unsigned* Xs32 = (unsigned*)Xs;
#pragma unroll
        for (int i = 0; i < 4; ++i) {
          const int c = tid + 256 * i; const int sp = c >> 4, dc = (c & 15) * 8;
          const uint4 v0 = *(const uint4*)(p.Z + (long)(t0 + 2 * sp) * LDZ + ZV + c0 + dc);
          const uint4 v1 = *(const uint4*)(p.Z + (long)(t0 + 2 * sp + 1) * LDZ + ZV + c0 + dc);
          const float r0 = p.rsv[t0 + 2 * sp], r1 = p.rsv[t0 + 2 * sp + 1];
          const float4 g0 = *(const float4*)(gvn + c0 + dc), g1 = *(const float4*)(gvn + c0 + dc + 4);
          Xs32[(dc + 0) * 68 + sp] = pk2(bflo(v0.x) * r0 * g0.x, bflo(v1.x) * r1 * g0.x); Xs32[(dc + 1) * 68 + sp] = pk2(bfhi(v0.x) * r0 * g0.y, bfhi(v1.x) * r1 * g0.y);
          Xs32[(dc + 2) * 68 + sp] = pk2(bflo(v0.y) * r0 * g0.z, bflo(v1.y) * r1 * g0.z); Xs32[(dc + 3) * 68 + sp] = pk2(bfhi(v0.y) * r0 * g0.w, bfhi(v1.y) * r1 * g0.w);
          Xs32[(dc + 4) * 68 + sp] = pk2(bflo(v0.z) * r0 * g1.x, bflo(v1.z) * r1 * g1.x); Xs32[(dc + 5) * 68 + sp] = pk2(bfhi(v0.z) * r0 * g1.y, bfhi(v1.z) * r1 * g1.y);
          Xs32[(dc + 6) * 68 + sp] = pk2(bflo(v0.w) * r0 * g1.z, bflo(v1.w) * r1 * g1.z); Xs32[(dc + 7) * 68 + sp] = pk2(bfhi(v0.w) * r0 * g1.w, bfhi(v1.w) * r1 * g1.w);
        }
      }
#pragma unroll
      for (int i = 0; i < 8; ++i) {
        const int c = tid + 256 * i;
        const int tt = c >> 4, sc = (c & 15) * 8;
        const float* wp = gws + ((long)g * 128 + tt) * 128 + sc;
        float4 a = *(const float4*)wp, b = *(const float4*)(wp + 4);
        a.x = (sc + 0 <= tt) ? a.x : 0.f; a.y = (sc + 1 <= tt) ? a.y : 0.f; a.z = (sc + 2 <= tt) ? a.z : 0.f; a.w = (sc + 3 <= tt) ? a.w : 0.f;
        b.x = (sc + 4 <= tt) ? b.x : 0.f; b.y = (sc + 5 <= tt) ? b.y : 0.f; b.z = (sc + 6 <= tt) ? b.z : 0.f; b.w = (sc + 7 <= tt) ? b.w : 0.f;
        *(uint4*)(Ws + tt * 136 + sc) = pack8(a, b);
      }
      }
      __syncthreads();
      if (isp) {
      f32x16 acc[2][2];
#pragma unroll
      for (int mi = 0; mi < 2; ++mi)
#pragma unroll
        for (int ni = 0; ni < 2; ++ni)
#pragma unroll
          for (int i = 0; i < 16; ++i) acc[mi][ni][i] = 0.f;
      const u16* Ab = Ws + (64 * wm + r) * 136 + 8 * hh;
      const u16* Bb = Xs + (64 * wn + r) * 136 + 8 * hh;
#pragma unroll
      for (int ks = 0; ks < 8; ++ks) {
        bf16x8 a0 = *(const bf16x8*)(Ab + 16 * ks), a1 = *(const bf16x8*)(Ab + 32 * 136 + 16 * ks);
        bf16x8 b0 = *(const bf16x8*)(Bb + 16 * ks), b1 = *(const bf16x8*)(Bb + 32 * 136 + 16 * ks);
        acc[0][0] = MFMA(b0, a0, acc[0][0]); acc[0][1] = MFMA(b1, a0, acc[0][1]);
        acc[1][0] = MFMA(b0, a1, acc[1][0]); acc[1][1] = MFMA(b1, a1, acc[1][1]);
      }
#pragma unroll
      for (int mi = 0; mi < 2; ++mi) {
        const int tl = 64 * wm + 32 * mi + r;
        const long row = t0 + tl;
        const float bias = gbs[g * 128 + tl];
        const u16* zr = p.Z + row * LDZ;
#pragma unroll
        for (int ni = 0; ni < 2; ++ni)
#pragma unroll
          for (int i4 = 0; i4 < 4; ++i4) {
            const int col = c0 + 64 * wn + 32 * ni + 8 * i4 + 4 * hh;
            const uint2 uu = *(const uint2*)(zr + ZU + col), ga = *(const uint2*)(zr + ZGA + col), gb = *(const uint2*)(zr + ZGB + col);
            const uint2 oa = *(const uint2*)(p.OA + row * 1024 + col);
            const float o0 = sigm(bflo(ga.x)) * bflo(oa.x) + sigm(bflo(gb.x)) * bflo(uu.x) * (acc[mi][ni][4 * i4 + 0] + bias);
            const float o1 = sigm(bfhi(ga.x)) * bfhi(oa.x) + sigm(bfhi(gb.x)) * bfhi(uu.x) * (acc[mi][ni][4 * i4 + 1] + bias);
            const float o2 = sigm(bflo(ga.y)) * bflo(oa.y) + sigm(bflo(gb.y)) * bflo(uu.y) * (acc[mi][ni][4 * i4 + 2] + bias);
            const float o3 = sigm(bfhi(ga.y)) * bfhi(oa.y) + sigm(bfhi(gb.y)) * bfhi(uu.y) * (acc[mi][ni][4 * i4 + 3] + bias);
            *(uint2*)(p.MIX + row * 1024 + col) = make_uint2(pk2(o0, o1), pk2(o2, o3));
          }
      }
      }
    }
    if (valid && !isp) {
      const int u = t - NP; const int b = u >> 2, col = (u & 3) * 256 + tid; const int g = col >> 7;
      const long row0 = M_P + 16 * b;
      const float gv = gvn[col];
      float vn[16];
#pragma unroll
      for (int s = 0; s < 16; ++s) vn[s] = bf1(p.Z[(row0 + s) * LDZ + ZV + col]) * p.rsv[row0 + s] * gv;
#pragma unroll
      for (int tt = 0; tt < 16; ++tt) {
        float mx = gbs[g * 128 + tt];
#pragma unroll
        for (int s = 0; s <= tt; ++s) mx += gws[((long)g * 128 + tt) * 128 + s] * vn[s];
        const u16* zr = p.Z + (row0 + tt) * LDZ;
        const float uu = bf1(zr[ZU + col]), ga = bf1(zr[ZGA + col]), gb = bf1(zr[ZGB + col]);
        const float oa = bf1(p.OA[(row0 + tt) * 1024 + col]);
        p.MIX[(row0 + tt) * 1024 + col] = f2bf(sigm(ga) * oa + sigm(gb) * uu * mx);
      }
    }
  }
}

#define XB_TMO      128
#define XB_XCNT(j)  (256  + 64 * (j))
#define XB_XSUB(j)  (1280 + 64 * (j))
#define XB_XGEN(j)  (2304 + 64 * (j))
#define XB_TOP      3328
#define XB_TOPGEN   3392
#define XCD_BAR_WORDS 3456
#define XB_SPIN_CAP (1u << 22)
#define LAS __attribute__((address_space(3)))
DI unsigned xb_ld(unsigned* p) { return __hip_atomic_load(p, __ATOMIC_RELAXED, __HIP_MEMORY_SCOPE_AGENT); }
DI unsigned xb_add(unsigned* p, unsigned v) { return __hip_atomic_fetch_add(p, v, __ATOMIC_RELAXED, __HIP_MEMORY_SCOPE_AGENT); }
DI unsigned xb_xcc_id() { return (unsigned)__builtin_amdgcn_s_getreg((3 << 11) | 20) & 0xFu; }
#define XB_SPIN(cond, bar) do { unsigned _sp = 0; while (cond) { __builtin_amdgcn_s_sleep(1); \
    if ((++_sp & 255u) == 0u) { if (xb_ld(&(bar)[XB_TMO])) break; if (_sp > XB_SPIN_CAP) { atomicAdd(&(bar)[XB_TMO], 1u); break; } } } } while (0)
struct XcdBarrier { unsigned* bar; unsigned x; volatile LAS unsigned* st; };
DI XcdBarrier xcd_barrier_post(unsigned* bar, volatile LAS unsigned* st) {
  XcdBarrier b; b.bar = bar; b.x = xb_xcc_id(); b.st = st;
  if (threadIdx.x == 0) (void)xb_add(&bar[XB_XCNT(b.x)], 1u);
  return b;
}
DI void xcd_barrier_complete(unsigned* bar, unsigned x, unsigned& nloc, unsigned& nx) {
  const unsigned G = gridDim.x * gridDim.y * gridDim.z;
  unsigned sum, cnt, mine, sp = 0u;
  for (;;) {
    sum = 0u; cnt = 0u; mine = 0u;
#pragma unroll
    for (unsigned j = 0; j < 16; ++j) { const unsigned c = xb_ld(&bar[XB_XCNT(j)]); sum += c; cnt += (c > 0u) ? 1u : 0u; mine = (j == x) ? c : mine; }
    if (sum == G) break;
    __builtin_amdgcn_s_sleep(1);
    if ((++sp & 255u) == 0u) { if (xb_ld(&bar[XB_TMO])) break; if (sp > XB_SPIN_CAP) { atomicAdd(&bar[XB_TMO], 1u); break; } }
  }
  nloc = mine > 0u ? mine : 1u; nx = cnt > 0u ? cnt : 1u;
}
DI void xcd_barrier(const XcdBarrier& b) {
  asm volatile("s_waitcnt vmcnt(0)" ::: "memory");
  __syncthreads();
  if (threadIdx.x == 0) {
    unsigned* bar = b.bar;
    __builtin_amdgcn_s_waitcnt(0);
    unsigned nloc = b.st[0], nx = b.st[1];
    if (nloc == 0u) { xcd_barrier_complete(bar, b.x, nloc, nx); b.st[0] = nloc; b.st[1] = nx; }
    const unsigned old = xb_add(&bar[XB_XSUB(b.x)], 1u);
    const unsigned gen = old / nloc;
    if (old + 1u == (gen + 1u) * nloc) {
      __builtin_amdgcn_fence(__ATOMIC_RELEASE, "agent");
      asm volatile("s_waitcnt vmcnt(0)" ::: "memory");
      const unsigned og = xb_add(&bar[XB_TOP], 1u);
      const unsigned tg = og / nx;
      if (og + 1u == (tg + 1u) * nx) xb_add(&bar[XB_TOPGEN], 1u);
      else XB_SPIN(xb_ld(&bar[XB_TOPGEN]) == tg, bar);
      __builtin_amdgcn_fence(__ATOMIC_ACQUIRE, "agent");
      xb_add(&bar[XB_XGEN(b.x)], 1u);
      asm volatile("s_waitcnt vmcnt(0)" ::: "memory");
    } else {
      XB_SPIN(xb_ld(&bar[XB_XGEN(b.x)]) == gen, bar);
      __builtin_amdgcn_fence(__ATOMIC_ACQUIRE, "agent");
      asm volatile("s_waitcnt vmcnt(0)" ::: "memory");
    }
  }
  __syncthreads();
}

__global__ void __launch_bounds__(512, 2) mega_fwd(Params p) {
  const int g_wave_s = __builtin_amdgcn_readfirstlane((int)(threadIdx.x >> 6));
  extern __shared__ __attribute__((aligned(16))) char smem[];
  uint4& xb_words = *(uint4*)(smem + SMEM_BYTES);
  int& s_item = *(int*)(smem + SMEM_BYTES + 16);
  cg::grid_group grid = cg::this_grid();
  if (threadIdx.x == 0) xb_words = make_uint4(0u, 0u, 0u, 0u);
  __syncthreads();
  XcdBarrier xb = xcd_barrier_post(p.bar, (volatile LAS unsigned*)&xb_words);

  prep_phase(p, smem, g_wave_s);
  grid.sync();
#ifdef PROBE_PREP
  prep_phase(p, smem, g_wave_s);
  grid.sync();
#endif
#pragma unroll 1
  for (int l = 0; l < 2; ++l) {
    norm_phase(p.out, p.f1n + l * 1024, p.NB, p.PART, 0, g_wave_s);
    xcd_barrier(xb);
    ffn_up_phase(p, p.Wgu1 + (long)l * 2 * DFF * 1024, smem, g_wave_s);
    xcd_barrier(xb);
#ifdef PROBE_FFN
    ffn_up_phase(p, p.Wgu1 + (long)l * 2 * DFF * 1024, smem, g_wave_s);
    xcd_barrier(xb);
#endif
    resid_gemm_phase(p, p.ACT, DFF, p.Wd1 + (long)l * 1024 * DFF, 0.5f, smem, g_wave_s);
    xcd_barrier(xb);
    norm_phase(p.out, p.mixn + l * 1024, p.NB, p.PART, DFF / 256, g_wave_s);
    xcd_barrier(xb);
    win_phase(p, p.Win + (long)l * LDZ * 1024, smem, g_wave_s);
    xcd_barrier(xb);
    rowpost_phase(p, l, g_wave_s);
    xcd_barrier(xb);
    multi_phase(p, l, smem, g_wave_s);
    xcd_barrier(xb);
    attn_phase(p, l, smem, &s_item, l, g_wave_s);
    xcd_barrier(xb);
#ifdef PROBE_ATTN
    attn_phase(p, l, smem, &s_item, 2 + l, g_wave_s);
    xcd_barrier(xb);
#endif
#ifdef PROBE_MULTI
    multi_phase(p, l, smem, g_wave_s);
    xcd_barrier(xb);
#endif
    gmlp_phase(p, l, smem, g_wave_s);
    xcd_barrier(xb);
#ifdef PROBE_GMLP
    gmlp_phase(p, l, smem, g_wave_s);
    xcd_barrier(xb);
#endif
#ifdef PROBE_ROWPOST
    rowpost_phase(p, l, g_wave_s);
    xcd_barrier(xb);
#endif
    resid_gemm_phase(p, p.MIX, 1024, p.Wo + (long)l * 1024 * 1024, 1.0f, smem, g_wave_s);
    xcd_barrier(xb);
    norm_phase(p.out, p.f2n + l * 1024, p.NB, p.PART, 1024 / 256, g_wave_s);
    xcd_barrier(xb);
    ffn_up_phase(p, p.Wgu2 + (long)l * 2 * DFF * 1024, smem, g_wave_s);
    xcd_barrier(xb);
#ifdef PROBE_FFN
    ffn_up_phase(p, p.Wgu2 + (long)l * 2 * DFF * 1024, smem, g_wave_s);
    xcd_barrier(xb);
#endif
    resid_gemm_phase(p, p.ACT, DFF, p.Wd2 + (long)l * 1024 * DFF, 0.5f, smem, g_wave_s);
    xcd_barrier(xb);
    norm_phase(p.out, p.plen + l * 1024, p.NB, p.PART, DFF / 256, g_wave_s);
    xcd_barrier(xb);
    ple_phase(p, p.Wpg + (long)l * 1024 * 1024, smem, g_wave_s);
    xcd_barrier(xb);
  }
}

extern "C" void kernel_launch(void* const* d_in, const int* in_sizes, int n_in, void* d_out, int out_size, void* d_ws,
                              size_t ws_size, hipStream_t stream) {
  (void)in_sizes; (void)n_in; (void)out_size; (void)ws_size;
  Params p{};
  auto F = [&](int i) { return (const float*)d_in[i]; };
  p.x_prompt = F(0); p.x_sample = F(1); p.cache_c = F(2); p.cache_kr = F(3); p.p_prompt = F(4); p.p_sample = F(5);
  p.f1n = F(6); p.mixn = F(10); p.qan = F(12); p.qnn = F(14); p.qrn = F(15); p.kvan = F(16); p.krn = F(17);
  p.knn = F(20); p.gvn = F(21); p.gws = F(22); p.gbs = F(23); p.f2n = F(25); p.plen = F(29);
  p.out = (float*)d_out;
  char* ws = (char*)d_ws; size_t off = 0;
  auto alloc = [&](size_t bytes) { char* r = ws + off; off += (bytes + 255) & ~(size_t)255; return r; };
  p.Wgu1 = (u16*)alloc(2UL * 2 * DFF * 1024 * 2);
  p.Wd1 = (u16*)alloc(2UL * 1024 * DFF * 2);
  p.Win = (u16*)alloc(2UL * LDZ * 1024 * 2);
  p.Wuq = (u16*)alloc(2UL * 1536 * 384 * 2);
  p.Wkv = (u16*)alloc(2UL * 2048 * 512 * 2);
  p.Wo = (u16*)alloc(2UL * 1024 * 1024 * 2);
  p.Wgu2 = (u16*)alloc(2UL * 2 * DFF * 1024 * 2);
  p.Wd2 = (u16*)alloc(2UL * 1024 * DFF * 2);
  p.Wpg = (u16*)alloc(2UL * 1024 * 1024 * 2);
  p.Wpe = (u16*)alloc(2UL * 1024 * 256 * 2);
  p.NB = (u16*)alloc((size_t)M_ALL * 1024 * 2);
  p.ACT = (u16*)alloc((size_t)M_ALL * DFF * 2);
  p.Z = (u16*)alloc((size_t)M_ALL * LDZ * 2);
  p.QN = (u16*)alloc((size_t)M_ALL * 384 * 2);
  p.C = (u16*)alloc((size_t)M_ALL * 512 * 2);
  p.KRp = (u16*)alloc((size_t)M_P * 64 * 2);
  p.KRs = (u16*)alloc((size_t)32 * LKS * 64 * 2);
  p.Q = (u16*)alloc((size_t)M_ALL * 8 * 192 * 2);
  p.Knp = (u16*)alloc((size_t)M_P * 1024 * 2);
  p.VTp = (u16*)alloc((size_t)M_P * 1024 * 2);
  p.Kns = (u16*)alloc((size_t)32 * LKS * 1024 * 2);
  p.VTs = (u16*)alloc((size_t)32 * LKS * 1024 * 2);
  p.OA = (u16*)alloc((size_t)M_ALL * 1024 * 2);
  p.MIX = (u16*)alloc((size_t)M_ALL * 1024 * 2);
  p.PP = (u16*)alloc((size_t)M_ALL * 1024 * 2);
  p.CB = (u16*)alloc((size_t)32 * PAST * 512 * 2);
  p.PB = (u16*)alloc((size_t)M_ALL * 256 * 2);
  p.rsv = (float*)alloc((size_t)M_ALL * 4);
  p.PART = (float*)alloc((size_t)11 * M_S * 1024 * 4);
  p.rope = (float*)alloc((size_t)16384 * 32 * 2 * 4);
  p.ctr = (unsigned*)alloc(256);
  p.bar = (unsigned*)alloc(XCD_BAR_WORDS * 4);

  int nj = 0, ts = 0;
  auto job = [&](const float* src, u16* dst, int K, int N, int kind) {
    p.jobs[nj].src = src; p.jobs[nj].dst = dst; p.jobs[nj].K = K; p.jobs[nj].N = N; p.jobs[nj].kind = kind; p.jobs[nj].tstart = ts;
    ts += (K / 64) * (N / 64); ++nj;
  };
  for (int l = 0; l < 2; ++l) {
    job(F(7) + (size_t)l * 1024 * DFF, p.Wgu1 + (size_t)l * 2 * DFF * 1024, 1024, DFF, 1);
    job(F(8) + (size_t)l * 1024 * DFF, p.Wgu1 + (size_t)l * 2 * DFF * 1024, 1024, DFF, 2);
    job(F(9) + (size_t)l * DFF * 1024, p.Wd1 + (size_t)l * 1024 * DFF, DFF, 1024, 0);
    job(F(11) + (size_t)l * 1024 * DIN, p.Win + (size_t)l * LDZ * 1024, 1024, DIN, 0);
    job(F(13) + (size_t)l * 384 * 1536, p.Wuq + (size_t)l * 1536 * 384, 384, 1536, 3);
    job(F(18) + (size_t)l * 512 * 1024, p.Wkv + (size_t)l * 2048 * 512, 512, 1024, 0);
    job(F(19) + (size_t)l * 512 * 1024, p.Wkv + (size_t)l * 2048 * 512, 512, 1024, 4);
    job(F(24) + (size_t)l * 1024 * 1024, p.Wo + (size_t)l * 1024 * 1024, 1024, 1024, 0);
    job(F(26) + (size_t)l * 1024 * DFF, p.Wgu2 + (size_t)l * 2 * DFF * 1024, 1024, DFF, 1);
    job(F(27) + (size_t)l * 1024 * DFF, p.Wgu2 + (size_t)l * 2 * DFF * 1024, 1024, DFF, 2);
    job(F(28) + (size_t)l * DFF * 1024, p.Wd2 + (size_t)l * 1024 * DFF, DFF, 1024, 0);
    job(F(30) + (size_t)l * 1024 * 1024, p.Wpg + (size_t)l * 1024 * 1024, 1024, 1024, 0);
    job(F(31) + (size_t)l * 256 * 1024, p.Wpe + (size_t)l * 1024 * 256, 256, 1024, 0);
  }
  p.ntile_prep = ts;

  static int grid_blocks = 0;
  if (!grid_blocks) {
    int dev = 0, cus = 0, per_cu = 0;
    hipGetDevice(&dev);
    hipDeviceGetAttribute(&cus, hipDeviceAttributeMultiprocessorCount, dev);
    hipFuncSetAttribute((const void*)mega_fwd, hipFuncAttributeMaxDynamicSharedMemorySize, LDS_TOTAL);
    hipOccupancyMaxActiveBlocksPerMultiprocessor(&per_cu, (const void*)mega_fwd, 512, LDS_TOTAL);
    if (per_cu > 1) per_cu = 1;
    if (per_cu < 1) per_cu = 1;
    grid_blocks = cus * per_cu;
  }
  (void)hipMemsetAsync(p.bar, 0, XCD_BAR_WORDS * 4, stream);
  void* args[] = {&p};
  hipError_t e = hipLaunchCooperativeKernel((const void*)mega_fwd, dim3(grid_blocks), dim3(512), args, LDS_TOTAL, stream);
  if (e != hipSuccess) fprintf(stderr, "cooperative launch failed: %s (grid %d)\n", hipGetErrorString(e), grid_blocks);
}
```

```cpp
#include <hip/hip_runtime.h>
#include <hip/hip_cooperative_groups.h>
#include <cstdio>
namespace cg = cooperative_groups;

#define DI __device__ __forceinline__
typedef unsigned short u16;
typedef __attribute__((ext_vector_type(8))) short bf16x8;
typedef __attribute__((ext_vector_type(16))) float f32x16;
typedef __attribute__((ext_vector_type(2))) __bf16 bf2_t;
typedef __attribute__((ext_vector_type(2))) float f2_t;

#define M_P 16384
#define M_S 512
#define M_ALL 16896
#define DM 1024
#define DFF 2816
#define DIN 5056
#define LDZ 5120
#define ZQ 0
#define ZKV 384
#define ZKR 896
#define ZU 960
#define ZV 1984
#define ZGA 3008
#define ZGB 4032
#define LKS 4160
#define LKV 4112
#define PAST 4096
#define EPSF 1e-6f
#define QSCALE (0.07216878364870322f * 1.4426950408889634f)

#define NJOBS 26
struct TJob { const float* src; u16* dst; int K, N, kind, tstart; };

struct Params {
  const float *x_prompt, *x_sample, *cache_c, *cache_kr, *p_prompt, *p_sample;
  const float *f1n, *mixn, *qan, *qnn, *qrn, *kvan, *krn, *knn, *gvn, *gws, *gbs, *f2n, *plen;
  float* out;
  u16 *Wgu1, *Wd1, *Win, *Wuq, *Wkv, *Wo, *Wgu2, *Wd2, *Wpg, *Wpe;
  u16 *CB, *PB;
  u16 *NB, *ACT, *Z, *QN, *C, *KRp, *KRs, *Q, *Knp, *VTp, *Kns, *VTs, *OA, *MIX, *PP;
  float *rsv, *rope, *PART;
  unsigned* ctr;
  unsigned* bar;
  TJob jobs[NJOBS];
  int ntile_prep; int pad0;
};

DI int get_tid_impl(int ws) { int t = (ws << 6) | (int)__builtin_amdgcn_mbcnt_hi(~0u, __builtin_amdgcn_mbcnt_lo(~0u, 0u)); asm volatile("" : "+v"(t)); return t; }
#define get_tid() get_tid_impl(g_wave_s)
DI int get_bid() { int t = blockIdx.x; asm volatile("" : "+s"(t)); return t; }
DI unsigned pk2(float a, float b) { f2_t v = {a, b}; bf2_t r = __builtin_convertvector(v, bf2_t); return __builtin_bit_cast(unsigned, r); }
DI float bflo(unsigned v) { return __uint_as_float(v << 16); }
DI float bfhi(unsigned v) { return __uint_as_float(v & 0xffff0000u); }
DI float bf1(u16 v) { return __uint_as_float(((unsigned)v) << 16); }
DI u16 f2bf(float a) { return (u16)(pk2(a, 0.f) & 0xffffu); }
DI float shfl_xor_l(float v, int lane, int o) { return __int_as_float(__builtin_amdgcn_ds_bpermute((lane ^ o) << 2, __float_as_int(v))); }
DI float wave_sum_l(float v, int lane) {
#pragma unroll
  for (int o = 32; o > 0; o >>= 1) v += shfl_xor_l(v, lane, o);
  return v;
}
DI float sigm(float x) { return 1.f / (1.f + __expf(-x)); }
DI uint4 pack8(float4 x, float4 y) { return make_uint4(pk2(x.x, x.y), pk2(x.z, x.w), pk2(y.x, y.y), pk2(y.z, y.w)); }
#define MFMA(a, b, c) __builtin_amdgcn_mfma_f32_32x32x16_bf16((a), (b), (c), 0, 0, 0)

#define HALF_BYTES (73728 + 1024)
#define SMEM_BYTES (2 * HALF_BYTES)
#define LDS_TOTAL (SMEM_BYTES + 32)

DI int job_dst_row(int kind, int n) {
  if (kind == 0) return n;
  if (kind == 1) return 256 * (n >> 7) + (n & 127);
  if (kind == 2) return 256 * (n >> 7) + 128 + (n & 127);
  if (kind == 3) { int h = n / 192, c = n - h * 192; if (c < 128) return h * 128 + c; c -= 128; const int x = c >> 5, cl = c & 31;
                   return 1024 + h * 64 + 32 * (cl >> 4) + 8 * ((cl >> 2) & 3) + 4 * x + (cl & 3); }
  return 1024 + n;
}

DI void prep_phase(const Params& p, char* smem, int g_wave_s) {
  const int tid = get_tid();
  {
    const int vt = tid & 255, half = tid >> 8;
    unsigned* Ts32 = (unsigned*)smem + half * (4 * 64 * 33);
    const int npair = (p.ntile_prep + 1) >> 1;
    for (int t2 = get_bid(); t2 < npair; t2 += gridDim.x) {
      const int t = 2 * t2 + half;
      const bool valid = t < p.ntile_prep;
      int j = 0;
#pragma unroll 1
      for (int q = 1; q < NJOBS; ++q) if (t >= p.jobs[q].tstart) j = q;
      const float* src = p.jobs[j].src; u16* dst = p.jobs[j].dst;
      const int K = p.jobs[j].K, N = p.jobs[j].N, kind = p.jobs[j].kind;
      const int lt = t - p.jobs[j].tstart;
      const int ntn = N >> 6, nst = (ntn + 3) >> 2;
      const int tk = lt / nst, st = lt - tk * nst;
      const int k0 = tk * 64;
      float4 v0[4][2], v1[4][2];
      if (valid) {
#pragma unroll
        for (int q = 0; q < 4; ++q) {
          const int tn = 4 * st + q;
          if (tn < ntn) {
#pragma unroll
            for (int i = 0; i < 2; ++i) {
              const int kp = (vt >> 4) + 16 * i, nc = (vt & 15) * 4;
              v0[q][i] = *(const float4*)(src + (long)(k0 + 2 * kp) * N + tn * 64 + nc);
              v1[q][i] = *(const float4*)(src + (long)(k0 + 2 * kp + 1) * N + tn * 64 + nc);
            }
          }
        }
      }
      __syncthreads();
      if (valid) {
#pragma unroll
        for (int q = 0; q < 4; ++q) {
          if (4 * st + q < ntn) {
#pragma unroll
            for (int i = 0; i < 2; ++i) {
              const int kp = (vt >> 4) + 16 * i, nc = (vt & 15) * 4;
              unsigned* T = Ts32 + q * (64 * 33);
              T[(nc + 0) * 33 + kp] = pk2(v0[q][i].x, v1[q][i].x); T[(nc + 1) * 33 + kp] = pk2(v0[q][i].y, v1[q][i].y);
              T[(nc + 2) * 33 + kp] = pk2(v0[q][i].z, v1[q][i].z); T[(nc + 3) * 33 + kp] = pk2(v0[q][i].w, v1[q][i].w);
            }
          }
        }
      }
      __syncthreads();
      if (valid) {
#pragma unroll
        for (int q = 0; q < 4; ++q) {
          const int tn = 4 * st + q;
          if (tn < ntn) {
            const int n = vt >> 2, kc = (vt & 3) * 16;
            const unsigned* s32 = Ts32 + q * (64 * 33) + n * 33 + (kc >> 1);
            uint4 a = make_uint4(s32[0], s32[1], s32[2], s32[3]);
            uint4 b = make_uint4(s32[4], s32[5], s32[6], s32[7]);
            u16* d = dst + (long)job_dst_row(kind, tn * 64 + n) * K + k0 + kc;
            *(uint4*)d = a; *(uint4*)(d + 8) = b;
          }
        }
      }
    }
  }
  const long gtid = (long)get_bid() * 512 + tid, gstride = (long)gridDim.x * 512;
  for (long e = gtid; e < 2L * 64 * 1024 / 8; e += gstride) {
    const int l = (int)(e / (64 * 1024 / 8)); const long r = e - (long)l * (64 * 1024 / 8);
    *(uint4*)(p.Win + (long)l * LDZ * 1024 + (long)DIN * 1024 + r * 8) = make_uint4(0, 0, 0, 0);
  }
  for (long e = gtid; e < 16384L * 32; e += gstride) {
    const int pos = (int)(e >> 5), i = (int)(e & 31);
    const float inv = powf(10000.0f, -(float)i / 32.0f);
    const float angf = (float)pos * inv;
    const double x = (double)angf;
    const double kq = rint(x * 0.63661977236758134308);
    const double y = (x - kq * 1.5707963267341256e+00) - kq * 6.0771005065061922e-11;
    const double y2 = y * y;
    const double s = y * (1.0 + y2 * (-1.0 / 6 + y2 * (1.0 / 120 + y2 * (-1.0 / 5040 + y2 * (1.0 / 362880 + y2 * (-1.0 / 39916800))))));
    const double c = 1.0 + y2 * (-0.5 + y2 * (1.0 / 24 + y2 * (-1.0 / 720 + y2 * (1.0 / 40320 + y2 * (-1.0 / 3628800 + y2 * (1.0 / 479001600))))));
    const int q = ((int)kq) & 3;
    double cc, ss;
    if (q == 0) { cc = c; ss = s; } else if (q == 1) { cc = -s; ss = c; } else if (q == 2) { cc = -c; ss = -s; } else { cc = s; ss = -c; }
    *(float2*)(p.rope + e * 2) = make_float2((float)cc, (float)ss);
  }
  for (long e = gtid; e < (long)M_ALL * 1024 / 4; e += gstride) {
    const long pe = (long)M_P * 1024 / 4;
    float4 v = e < pe ? ((const float4*)p.x_prompt)[e] : ((const float4*)p.x_sample)[e - pe];
    ((float4*)p.out)[e] = v;
  }
  if (get_bid() == 0 && tid < 16) p.ctr[tid] = 0u;
}

DI void norm_phase(float* __restrict__ h, const float* __restrict__ g, u16* __restrict__ out, const float* __restrict__ part, int nsplit, int g_wave_s) {
  const int tid = get_tid(); const int lane = tid & 63, w = tid >> 6;
  for (int row = get_bid() * 8 + w; row < M_ALL; row += gridDim.x * 8) {
    const float4* hr = (const float4*)(h + (long)row * 1024);
    float4 v[4]; float ss = 0.f;
#pragma unroll
    for (int i = 0; i < 4; ++i) v[i] = hr[lane + 64 * i];
    if (nsplit > 0 && row >= M_P) {
#pragma unroll 1
      for (int s_ = 0; s_ < nsplit; ++s_) {
        const float4* pr = (const float4*)(part + ((long)s_ * M_S + (row - M_P)) * 1024);
#pragma unroll
        for (int i = 0; i < 4; ++i) { const float4 q = pr[lane + 64 * i]; v[i].x += q.x; v[i].y += q.y; v[i].z += q.z; v[i].w += q.w; }
      }
#pragma unroll
      for (int i = 0; i < 4; ++i) ((float4*)(h + (long)row * 1024))[lane + 64 * i] = v[i];
    }
#pragma unroll
    for (int i = 0; i < 4; ++i) ss += v[i].x * v[i].x + v[i].y * v[i].y + v[i].z * v[i].z + v[i].w * v[i].w;
    ss = wave_sum_l(ss, lane);
    const float rs = rsqrtf(ss * (1.f / 1024.f) + EPSF);
#pragma unroll
    for (int i = 0; i < 4; ++i) {
      const float4 gg = ((const float4*)g)[lane + 64 * i];
      uint2 o = make_uint2(pk2(v[i].x * rs * gg.x, v[i].y * rs * gg.y), pk2(v[i].z * rs * gg.z, v[i].w * rs * gg.w));
      ((uint2*)(out + (long)row * 1024))[lane + 64 * i] = o;
    }
  }
}

struct TD { const char* A; const char* B; unsigned sa, sb; int nk; int pb; };
#define RED_OFF 73728

template <class Desc, class Epi>
DI void gemm_stream(int nloc, int nmax, Desc desc, Epi epi, char* smem_all, int g_wave_s) {
  const int tid = get_tid() & 255, lane = tid & 63, w = tid >> 6, wm = w >> 1, wn = w & 1, r = lane & 31, hh = lane >> 5;
  char* smem = smem_all + (get_tid() >> 8) * HALF_BYTES;
  u16* As = (u16*)smem;
  u16* Bs = As + 2 * 128 * 72;
  const int lrow = tid >> 3, lkc = (tid & 7) * 8;
  int ct = 0;
  if (nmax <= 0) return;
  TD ltd = desc(0);
  const int lrot = ((get_bid() >> 3) * 2 + (get_tid() >> 8)) % ltd.nk;
  uint4 S0a0, S0a1, S0a2, S0a3, S0b0, S0b1, S0b2, S0b3, S1a0, S1a1, S1a2, S1a3, S1b0, S1b1, S1b2, S1b3;
#define LD1(dst, base, off) dst = *(const uint4*)((base) + (size_t)(off));
#define GLOADS(S, kk) { \
    int kr_ = (kk) + lrot; kr_ = kr_ >= ltd.nk ? kr_ - ltd.nk : kr_; \
    const unsigned oa_ = lrow * ltd.sa + (unsigned)(kr_ * 64 + lkc) * 2u, ob_ = lrow * ltd.sb + (unsigned)(kr_ * 64 + lkc) * 2u; \
    LD1(S##a0, ltd.A, oa_) LD1(S##a1, ltd.A, oa_ + 32u * ltd.sa) LD1(S##a2, ltd.A, oa_ + 64u * ltd.sa) LD1(S##a3, ltd.A, oa_ + 96u * ltd.sa) \
    LD1(S##b0, ltd.B, ob_) LD1(S##b1, ltd.B, ob_ + 32u * ltd.sb) LD1(S##b2, ltd.B, ob_ + 64u * ltd.sb) LD1(S##b3, ltd.B, ob_ + 96u * ltd.sb) }
#define SST1(arr, src, i, buf) *(uint4*)(arr + ((buf) * 128 + lrow + 32 * (i)) * 72 + lkc) = src;
#define SSTORES(S, buf) { SST1(As, S##a0, 0, buf) SST1(As, S##a1, 1, buf) SST1(As, S##a2, 2, buf) SST1(As, S##a3, 3, buf) \
    SST1(Bs, S##b0, 0, buf) SST1(Bs, S##b1, 1, buf) SST1(Bs, S##b2, 2, buf) SST1(Bs, S##b3, 3, buf) }
#define COMPUTE(buf) { \
    const u16* Ab = As + ((buf) * 128 + 64 * wm + r) * 72 + 8 * hh; \
    const u16* Bb = Bs + ((buf) * 128 + 64 * wn + r) * 72 + 8 * hh; \
    _Pragma("unroll") for (int ks = 0; ks < 4; ++ks) { \
      bf16x8 a0 = *(const bf16x8*)(Ab + 16 * ks), a1 = *(const bf16x8*)(Ab + 32 * 72 + 16 * ks); \
      bf16x8 b0 = *(const bf16x8*)(Bb + 16 * ks), b1 = *(const bf16x8*)(Bb + 32 * 72 + 16 * ks); \
      acc[0][0] = MFMA(b0, a0, acc[0][0]); acc[0][1] = MFMA(b1, a0, acc[0][1]); \
      acc[1][0] = MFMA(b0, a1, acc[1][0]); acc[1][1] = MFMA(b1, a1, acc[1][1]); } }
#define SCHED_STEP() { \
    __builtin_amdgcn_sched_group_barrier(0x020, 8, 0); \
    __builtin_amdgcn_sched_group_barrier(0x100, 4, 0); \
    _Pragma("unroll") for (int q_ = 0; q_ < 4; ++q_) { __builtin_amdgcn_sched_group_barrier(0x008, 1, 0); __builtin_amdgcn_sched_group_barrier(0x100, 1, 0); } \
    _Pragma("unroll") for (int q_ = 0; q_ < 8; ++q_) { __builtin_amdgcn_sched_group_barrier(0x008, 1, 0); __builtin_amdgcn_sched_group_barrier(0x100, 1, 0); __builtin_amdgcn_sched_group_barrier(0x200, 1, 0); } \
    _Pragma("unroll") for (int q_ = 0; q_ < 4; ++q_) { __builtin_amdgcn_sched_group_barrier(0x008, 1, 0); } }

  GLOADS(S0, 0)
  GLOADS(S1, 1)
  SSTORES(S0, 0)
  __syncthreads();
#pragma unroll 1
  for (; ct < nmax; ++ct) {
    const int nk2 = ltd.nk >> 1;
    f32x16 acc[2][2];
#pragma unroll
    for (int mi = 0; mi < 2; ++mi)
#pragma unroll
      for (int ni = 0; ni < 2; ++ni)
#pragma unroll
        for (int i = 0; i < 16; ++i) acc[mi][ni][i] = 0.f;
#pragma unroll 1
    for (int k2 = 0; k2 < nk2; ++k2) {
      int kb = 2 * k2 + 2;
      if (k2 == nk2 - 1) { kb = 0; if (ct + 1 < nloc) ltd = desc(ct + 1); }
      GLOADS(S0, kb)
      COMPUTE(0)
      SSTORES(S1, 1)
      SCHED_STEP()
      __syncthreads();
      GLOADS(S1, kb + 1)
      COMPUTE(1)
      SSTORES(S0, 0)
      SCHED_STEP()
      __syncthreads();
    }
    if (ct < nloc) epi(ct, acc);
  }
#undef LD1
#undef GLOADS
#undef SST1
#undef SSTORES
#undef COMPUTE
#undef SCHED_STEP
}

typedef __attribute__((ext_vector_type(4))) float f32x4;
#define G8_HT (128 * 64)
DI int g8_lds_byte(int r, int c) { const int st = (r >> 4) * 2 + (c >> 5), rr = r & 15, cc = c & 31, ob = rr * 64 + cc * 2; return st * 1024 + (ob ^ (((ob >> 9) & 1) << 5)); }
DI void g8_stage_rc(int b, int& R, int& C) { const int st = b / 1024, sb = b % 1024, swz = sb ^ (((sb >> 9) & 1) << 5); R = (st >> 1) * 16 + swz / 64; C = (st & 1) * 32 + (swz % 64) / 2; }
DI int g8_perm32(int rho) { const int n = rho >> 4, i = rho & 15; return 8 * (i >> 2) + 4 * n + (i & 3); }

DI int g8_permT(int s_) { return 16 * ((s_ >> 3) & 1) + 8 * (s_ >> 4) + 4 * ((s_ >> 2) & 1) + (s_ & 3); }
template <int PERMB>
DI void gemm256_tile(const u16* __restrict__ A, const u16* __restrict__ Bt, int ld, int K, char* smem, f32x4 (&acc)[2][2][4][2], int g_wave_s) {
  u16* shm = (u16*)smem;
  const int tid = get_tid();
  const int wid = tid >> 6, lane = tid & 63, wr = wid >> 2, wc = wid & 3, fr = lane & 15, fq = lane >> 4;
#define G8_SA(b, h) (shm + ((b) * 2 + (h)) * G8_HT)
#define G8_SB(b, h) (shm + (4 + (b) * 2 + (h)) * G8_HT)
  int sr0, sc0;
  g8_stage_rc(tid * 16, sr0, sc0);
  const int br0 = PERMB == 1 ? ((sr0 & ~31) + g8_perm32(sr0 & 31)) : (PERMB == 2 ? ((sr0 & ~31) + g8_permT(sr0 & 31)) : sr0);
  const unsigned aoff0 = (unsigned)(sr0 * ld + sc0) * 2u;
  const unsigned boff0 = (unsigned)(br0 * ld + sc0) * 2u;
#define G8_STAGE_A(P, br, kt) do { const char* g_ = (const char*)(A + (long)(br) * ld + (long)(kt) * 64); \
    __builtin_amdgcn_global_load_lds((const unsigned*)(g_ + (size_t)aoff0), (unsigned*)((char*)(P) + tid * 16), 16, 0, 0); \
    __builtin_amdgcn_global_load_lds((const unsigned*)(g_ + (size_t)ld * 128 + (size_t)aoff0), (unsigned*)((char*)(P) + tid * 16 + 8192), 16, 0, 0); } while (0)
#define G8_STAGE_B(P, br, kt) do { const char* g_ = (const char*)(Bt + (long)(br) * ld + (long)(kt) * 64); \
    __builtin_amdgcn_global_load_lds((const unsigned*)(g_ + (size_t)boff0), (unsigned*)((char*)(P) + tid * 16), 16, 0, 0); \
    __builtin_amdgcn_global_load_lds((const unsigned*)(g_ + (size_t)ld * 128 + (size_t)boff0), (unsigned*)((char*)(P) + tid * 16 + 8192), 16, 0, 0); } while (0)
#define G8_LDA(dst, b, h) _Pragma("unroll") for (int m = 0; m < 4; ++m) _Pragma("unroll") for (int k = 0; k < 2; ++k) \
    dst[m][k] = *reinterpret_cast<const bf16x8*>((char*)G8_SA(b, h) + g8_lds_byte(wr * 64 + m * 16 + fr, k * 32 + fq * 8))
#define G8_LDB(dst, b, h) _Pragma("unroll") for (int n = 0; n < 2; ++n) _Pragma("unroll") for (int k = 0; k < 2; ++k) \
    dst[n][k] = *reinterpret_cast<const bf16x8*>((char*)G8_SB(b, h) + g8_lds_byte(wc * 32 + n * 16 + fr, k * 32 + fq * 8))
#define G8_MMA(ai, bj, At_, Bt_) do { __builtin_amdgcn_s_setprio(1); \
    _Pragma("unroll") for (int m = 0; m < 4; ++m) _Pragma("unroll") for (int n = 0; n < 2; ++n) _Pragma("unroll") for (int k = 0; k < 2; ++k) \
      acc[ai][bj][m][n] = __builtin_amdgcn_mfma_f32_16x16x32_bf16(Bt_[n][k], At_[m][k], acc[ai][bj][m][n], 0, 0, 0); \
    __builtin_amdgcn_s_setprio(0); } while (0)
#define G8_WAIT_V(n) asm volatile("s_waitcnt vmcnt(" #n ")" ::: "memory")
#define G8_WAIT_L(n) asm volatile("s_waitcnt lgkmcnt(" #n ")" ::: "memory")
#define G8_BAR __builtin_amdgcn_s_barrier()
#define G8_SCHED __builtin_amdgcn_sched_barrier(0)
#pragma unroll
  for (int ai = 0; ai < 2; ++ai)
#pragma unroll
    for (int bj = 0; bj < 2; ++bj)
#pragma unroll
      for (int m = 0; m < 4; ++m)
#pragma unroll
        for (int n = 0; n < 2; ++n) acc[ai][bj][m][n] = (f32x4){0.f, 0.f, 0.f, 0.f};
  bf16x8 At[4][2], B0[2][2], B1[2][2];
  const int nt = K >> 6;
  G8_STAGE_B(G8_SB(0, 0), 0, 0); G8_STAGE_A(G8_SA(0, 0), 0, 0);
  G8_STAGE_B(G8_SB(0, 1), 128, 0); G8_STAGE_A(G8_SA(0, 1), 128, 0);
  if (wr == 1) G8_BAR;
  G8_WAIT_V(4); G8_BAR;
  G8_STAGE_B(G8_SB(1, 0), 0, 1); G8_STAGE_A(G8_SA(1, 0), 0, 1); G8_STAGE_B(G8_SB(1, 1), 128, 1);
  G8_WAIT_V(6); G8_BAR;
#pragma unroll 1
  for (int t = 0; t < nt - 2; t += 2) {
    G8_LDB(B0, 0, 0); G8_SCHED; G8_LDA(At, 0, 0); G8_STAGE_A(G8_SA(1, 1), 128, t + 1);
    G8_WAIT_L(8); G8_BAR; G8_WAIT_L(0); G8_MMA(0, 0, At, B0); G8_BAR; G8_SCHED;
    G8_LDB(B1, 0, 1); G8_STAGE_B(G8_SB(0, 0), 0, t + 2);
    G8_BAR; G8_WAIT_L(0); G8_MMA(0, 1, At, B1); G8_BAR;
    G8_LDA(At, 0, 1); G8_STAGE_A(G8_SA(0, 0), 0, t + 2);
    G8_BAR; G8_WAIT_L(0); G8_MMA(1, 0, At, B0); G8_BAR; G8_SCHED;
    G8_STAGE_B(G8_SB(0, 1), 128, t + 2);
    G8_WAIT_V(6); G8_BAR; G8_MMA(1, 1, At, B1); G8_BAR;
    G8_LDB(B0, 1, 0); G8_SCHED; G8_LDA(At, 1, 0); G8_STAGE_A(G8_SA(0, 1), 128, t + 2);
    G8_WAIT_L(8); G8_BAR; G8_WAIT_L(0); G8_MMA(0, 0, At, B0); G8_BAR; G8_SCHED;
    G8_LDB(B1, 1, 1); G8_STAGE_B(G8_SB(1, 0), 0, t + 3);
    G8_BAR; G8_WAIT_L(0); G8_MMA(0, 1, At, B1); G8_BAR;
    G8_LDA(At, 1, 1); G8_STAGE_A(G8_SA(1, 0), 0, t + 3);
    G8_BAR; G8_WAIT_L(0); G8_MMA(1, 0, At, B0); G8_BAR; G8_SCHED;
    G8_STAGE_B(G8_SB(1, 1), 128, t + 3);
    G8_WAIT_V(6); G8_BAR; G8_MMA(1, 1, At, B1); G8_BAR;
  }
  { G8_LDB(B0, 0, 0); G8_LDA(At, 0, 0); G8_STAGE_A(G8_SA(1, 1), 128, nt - 1);
    G8_BAR; G8_WAIT_L(0); G8_MMA(0, 0, At, B0); G8_BAR;
    G8_LDB(B1, 0, 1); G8_BAR; G8_WAIT_L(0); G8_MMA(0, 1, At, B1); G8_BAR;
    G8_LDA(At, 0, 1); G8_WAIT_V(4); G8_BAR; G8_WAIT_L(0); G8_MMA(1, 0, At, B0); G8_MMA(1, 1, At, B1); G8_BAR; }
  { G8_LDB(B0, 1, 0); G8_LDA(At, 1, 0); G8_WAIT_V(2); G8_BAR; G8_WAIT_L(0); G8_MMA(0, 0, At, B0); G8_BAR;
    G8_LDB(B1, 1, 1); G8_WAIT_V(0); G8_BAR; G8_WAIT_L(0); G8_MMA(0, 1, At, B1); G8_BAR;
    G8_LDA(At, 1, 1); G8_BAR; G8_WAIT_L(0); G8_MMA(1, 0, At, B0); G8_MMA(1, 1, At, B1); G8_BAR; }
  if (wr == 0) G8_BAR;
}

#define G8_COORDS const int tid = get_tid(); const int wid = tid >> 6, lane = tid & 63, wr = wid >> 2, wc = wid & 3, fr = lane & 15, fq = lane >> 4; (void)wr; (void)wc; (void)fr; (void)fq;
DI int tok_pos(int m) { return m < M_P ? m : PAST + ((m - M_P) & 15); }
DI int perm_pos(int key) {
  const int g4 = (key >> 2) & 3;
  const int pg = (g4 == 1) ? 2 : ((g4 == 2) ? 1 : g4);
  return (key & ~15) + 4 * pg;
}

DI int nloc_plain(int total) { const int b = get_bid(), G = gridDim.x; return b < total ? (total - b + G - 1) / G : 0; }
DI void grouped_tile(int L, int nM, int nN, int& tm, int& tn) {
  const int nwg = nM * nN;
  const int q = nwg >> 3, rr = nwg & 7, xcd = L & 7, off = L >> 3;
  const int wgid = (xcd < rr ? xcd * (q + 1) : rr * (q + 1) + (xcd - rr) * q) + off;
  const int nig = 8 * nN, gid = wgid / nig, fm = gid * 8;
  const int gsz = (nM - fm) < 8 ? (nM - fm) : 8;
  const int rem = wgid - gid * nig;
  tm = fm + rem % gsz; tn = rem / gsz;
}
#define LANE_COORDS8 const int tid = get_tid(), lane = tid & 63, w = tid >> 6, wm = w >> 1, wn = w & 1, r = lane & 31, hh = lane >> 5; (void)wm; (void)wn; (void)r; (void)hh;

DI void ffn_up_phase(const Params& p, const u16* W, char* smem, int g_wave_s) {
  const int tid = get_tid();
  const int wid = tid >> 6, lane = tid & 63, wr = wid >> 2, wc = wid & 3, fr = lane & 15, fq = lane >> 4;
  const int NT = (2 * DFF) / 256;
  const int G = gridDim.x;
  for (int L = get_bid(); L < 66 * NT; L += G) {
    int tm, tn; grouped_tile(L, 66, NT, tm, tn);
    f32x4 acc[2][2][4][2];
    gemm256_tile<1>(p.NB + (long)tm * 256 * 1024, W + (long)tn * 256 * 1024, 1024, 1024, smem, acc, g_wave_s);
#pragma unroll
    for (int ai = 0; ai < 2; ++ai)
#pragma unroll
      for (int m = 0; m < 4; ++m) {
        const long row = (long)tm * 256 + 128 * ai + 64 * wr + 16 * m + fr;
        const int col = tn * 128 + 32 * wc + 8 * fq;
        float a[8];
#pragma unroll
        for (int n = 0; n < 2; ++n)
#pragma unroll
          for (int j = 0; j < 4; ++j) { const float g = acc[ai][0][m][n][j], u = acc[ai][1][m][n][j]; a[4 * n + j] = g * sigm(g) * u; }
        *(uint4*)(p.ACT + row * DFF + col) = make_uint4(pk2(a[0], a[1]), pk2(a[2], a[3]), pk2(a[4], a[5]), pk2(a[6], a[7]));
      }
  }
}

DI void win_phase(const Params& p, const u16* W, char* smem, int g_wave_s) {
  const int tid = get_tid();
  const int wid = tid >> 6, lane = tid & 63, wr = wid >> 2, wc = wid & 3, fr = lane & 15, fq = lane >> 4;
  const int NT = LDZ / 256;
  const int G = gridDim.x;
  for (int L = get_bid(); L < 66 * NT; L += G) {
    int tm, tn; grouped_tile(L, 66, NT, tm, tn);
    f32x4 acc[2][2][4][2];
    gemm256_tile<1>(p.NB + (long)tm * 256 * 1024, W + (long)tn * 256 * 1024, 1024, 1024, smem, acc, g_wave_s);
#pragma unroll
    for (int ai = 0; ai < 2; ++ai)
#pragma unroll
      for (int m = 0; m < 4; ++m) {
        const long row = (long)tm * 256 + 128 * ai + 64 * wr + 16 * m + fr;
#pragma unroll
        for (int bj = 0; bj < 2; ++bj) {
          const int col = tn * 256 + 128 * bj + 32 * wc + 8 * fq;
          *(uint4*)(p.Z + row * LDZ + col) = make_uint4(pk2(acc[ai][bj][m][0][0], acc[ai][bj][m][0][1]), pk2(acc[ai][bj][m][0][2], acc[ai][bj][m][0][3]),
                                                        pk2(acc[ai][bj][m][1][0], acc[ai][bj][m][1][1]), pk2(acc[ai][bj][m][1][2], acc[ai][bj][m][1][3]));
        }
      }
  }
}

DI void resid_gemm_phase(const Params& p, const u16* A, int K, const u16* W, float alpha, char* smem, int g_wave_s) {
  const int G = gridDim.x;
#pragma unroll 1
  for (int L = get_bid(); L < 64 * 4; L += G) {
    const int tm = L >> 2, tn = L & 3;
    f32x4 acc[2][2][4][2];
    gemm256_tile<1>(A + (long)tm * 256 * K, W + (long)tn * 256 * K, K, K, smem, acc, g_wave_s);
    G8_COORDS
#pragma unroll
    for (int ai = 0; ai < 2; ++ai)
#pragma unroll
      for (int m = 0; m < 4; ++m) {
        const long row = (long)tm * 256 + 128 * ai + 64 * wr + 16 * m + fr;
#pragma unroll
        for (int bj = 0; bj < 2; ++bj) {
          float4* hp = (float4*)(p.out + row * 1024 + tn * 256 + 128 * bj + 32 * wc + 8 * fq);
          float4 v0 = hp[0], v1 = hp[1];
          v0.x += alpha * acc[ai][bj][m][0][0]; v0.y += alpha * acc[ai][bj][m][0][1]; v0.z += alpha * acc[ai][bj][m][0][2]; v0.w += alpha * acc[ai][bj][m][0][3];
          v1.x += alpha * acc[ai][bj][m][1][0]; v1.y += alpha * acc[ai][bj][m][1][1]; v1.z += alpha * acc[ai][bj][m][1][2]; v1.w += alpha * acc[ai][bj][m][1][3];
          hp[0] = v0; hp[1] = v1;
        }
      }
  }
  const int nsplit = K >> 8;
#pragma unroll 1
  for (int it = get_bid(); it < 8 * nsplit; it += G) {
    const int tile = it / nsplit, ks = it - tile * nsplit;
    const int tm = 64 + (tile >> 2), tn = tile & 3;
    f32x4 acc[2][2][4][2];
    gemm256_tile<1>(A + (long)tm * 256 * K + ks * 256, W + (long)tn * 256 * K + ks * 256, K, 256, smem, acc, g_wave_s);
    G8_COORDS
#pragma unroll
    for (int ai = 0; ai < 2; ++ai)
#pragma unroll
      for (int m = 0; m < 4; ++m) {
        const long rs_ = (long)(tm - 64) * 256 + 128 * ai + 64 * wr + 16 * m + fr;
#pragma unroll
        for (int bj = 0; bj < 2; ++bj) {
          float4* pp = (float4*)(p.PART + ((long)ks * M_S + rs_) * 1024 + tn * 256 + 128 * bj + 32 * wc + 8 * fq);
          pp[0] = make_float4(alpha * acc[ai][bj][m][0][0], alpha * acc[ai][bj][m][0][1], alpha * acc[ai][bj][m][0][2], alpha * acc[ai][bj][m][0][3]);
          pp[1] = make_float4(alpha * acc[ai][bj][m][1][0], alpha * acc[ai][bj][m][1][1], alpha * acc[ai][bj][m][1][2], alpha * acc[ai][bj][m][1][3]);
        }
      }
  }
}

DI void ple_phase(const Params& p, const u16* W, char* smem, int g_wave_s) {
  const int G = gridDim.x;
#pragma unroll 1
  for (int L = get_bid(); L < 66 * 4; L += G) {
    const int tm = L >> 2, tn = L & 3;
    f32x4 acc[2][2][4][2];
    gemm256_tile<1>(p.NB + (long)tm * 256 * 1024, W + (long)tn * 256 * 1024, 1024, 1024, smem, acc, g_wave_s);
    G8_COORDS
#pragma unroll
    for (int ai = 0; ai < 2; ++ai)
#pragma unroll
      for (int m = 0; m < 4; ++m) {
        const long row = (long)tm * 256 + 128 * ai + 64 * wr + 16 * m + fr;
#pragma unroll
        for (int bj = 0; bj < 2; ++bj) {
          const int col = tn * 256 + 128 * bj + 32 * wc + 8 * fq;
          float4* hp = (float4*)(p.out + row * 1024 + col);
          const uint4 pp = *(const uint4*)(p.PP + row * 1024 + col);
          float4 v0 = hp[0], v1 = hp[1];
          v0.x += sigm(acc[ai][bj][m][0][0]) * bflo(pp.x); v0.y += sigm(acc[ai][bj][m][0][1]) * bfhi(pp.x);
          v0.z += sigm(acc[ai][bj][m][0][2]) * bflo(pp.y); v0.w += sigm(acc[ai][bj][m][0][3]) * bfhi(pp.y);
          v1.x += sigm(acc[ai][bj][m][1][0]) * bflo(pp.z); v1.y += sigm(acc[ai][bj][m][1][1]) * bfhi(pp.z);
          v1.z += sigm(acc[ai][bj][m][1][2]) * bflo(pp.w); v1.w += sigm(acc[ai][bj][m][1][3]) * bfhi(pp.w);
          hp[0] = v0; hp[1] = v1;
        }
      }
  }
}

DI void rowpost_phase(const Params& p, int l, int g_wave_s) {
  const int tid = get_tid(); const int lane = tid & 63, w = tid >> 6;
  const float* qan = p.qan + l * 384; const float* kvan = p.kvan + l * 512; const float* krn = p.krn + l * 64; const float* gvn = p.gvn + l * 1024;
  float* o_pkv = p.out + 17301504L + (long)l * M_P * 512;
  float* o_pkr = p.out + 34078720L + (long)l * M_P * 64;
  float* o_skv = p.out + 36175872L + (long)l * M_S * 512;
  float* o_skr = p.out + 36700160L + (long)l * M_S * 64;
  float* o_sgv = p.out + 36765696L + (long)l * M_S * 1024;
  for (int row = get_bid() * 8 + w; row < M_ALL; row += gridDim.x * 8) {
    const u16* zr = p.Z + (long)row * LDZ;
    const bool is_s = row >= M_P; const int rs_ = row - M_P;
    {
      unsigned v[3]; float ss = 0.f;
#pragma unroll
      for (int i = 0; i < 3; ++i) { v[i] = *(const unsigned*)(zr + ZQ + 2 * lane + 128 * i); const float a = bflo(v[i]), b = bfhi(v[i]); ss += a * a + b * b; }
      ss = wave_sum_l(ss, lane);
      const float rs = rsqrtf(ss * (1.f / 384.f) + EPSF);
#pragma unroll
      for (int i = 0; i < 3; ++i) {
        const int c = 2 * lane + 128 * i; const float2 g = *(const float2*)(qan + c);
        *(unsigned*)(p.QN + (long)row * 384 + c) = pk2(bflo(v[i]) * rs * g.x, bfhi(v[i]) * rs * g.y);
      }
    }
    {
      const uint4 v = *(const uint4*)(zr + ZKV + 8 * lane);
      float x[8] = {bflo(v.x), bfhi(v.x), bflo(v.y), bfhi(v.y), bflo(v.z), bfhi(v.z), bflo(v.w), bfhi(v.w)};
      float ss = 0.f;
#pragma unroll
      for (int i = 0; i < 8; ++i) ss += x[i] * x[i];
      ss = wave_sum_l(ss, lane);
      const float rs = rsqrtf(ss * (1.f / 512.f) + EPSF);
      const float4 g0 = *(const float4*)(kvan + 8 * lane), g1 = *(const float4*)(kvan + 8 * lane + 4);
      float4 y0 = make_float4(x[0] * rs * g0.x, x[1] * rs * g0.y, x[2] * rs * g0.z, x[3] * rs * g0.w);
      float4 y1 = make_float4(x[4] * rs * g1.x, x[5] * rs * g1.y, x[6] * rs * g1.z, x[7] * rs * g1.w);
      float* od = is_s ? (o_skv + (long)rs_ * 512) : (o_pkv + (long)row * 512);
      *(float4*)(od + 8 * lane) = y0; *(float4*)(od + 8 * lane + 4) = y1;
      *(uint4*)(p.C + (long)row * 512 + 8 * lane) = pack8(y0, y1);
    }
    {
      const float x = bf1(zr[ZKR + lane]);
      const float ss = wave_sum_l(x * x, lane);
      const float rs = rsqrtf(ss * (1.f / 64.f) + EPSF);
      const float y = x * rs * krn[lane];
      const float other = shfl_xor_l(y, lane, 32);
      const int pos = tok_pos(row);
      const float2 cs = *(const float2*)(p.rope + ((long)pos * 32 + (lane & 31)) * 2);
      const float o = lane < 32 ? (y * cs.x - other * cs.y) : (other * cs.y + y * cs.x);
      if (is_s) {
        o_skr[(long)rs_ * 64 + lane] = o;
        p.KRs[((long)(rs_ >> 4) * LKS + PAST + (rs_ & 15)) * 64 + lane] = f2bf(o);
      } else {
        o_pkr[(long)row * 64 + lane] = o;
        p.KRp[(long)row * 64 + lane] = f2bf(o);
      }
    }
    {
      uint4 v[2]; float ss = 0.f;
#pragma unroll
      for (int i = 0; i < 2; ++i) {
        v[i] = *(const uint4*)(zr + ZV + 8 * lane + 512 * i);
        const float x[8] = {bflo(v[i].x), bfhi(v[i].x), bflo(v[i].y), bfhi(v[i].y), bflo(v[i].z), bfhi(v[i].z), bflo(v[i].w), bfhi(v[i].w)};
#pragma unroll
        for (int j = 0; j < 8; ++j) ss += x[j] * x[j];
      }
      ss = wave_sum_l(ss, lane);
      const float rs = rsqrtf(ss * (1.f / 1024.f) + EPSF);
      if (lane == 0) p.rsv[row] = rs;
      if (is_s) {
#pragma unroll
        for (int i = 0; i < 2; ++i) {
          const int c = 8 * lane + 512 * i;
          const float x[8] = {bflo(v[i].x), bfhi(v[i].x), bflo(v[i].y), bfhi(v[i].y), bflo(v[i].z), bfhi(v[i].z), bflo(v[i].w), bfhi(v[i].w)};
          const float4 g0 = *(const float4*)(gvn + c), g1 = *(const float4*)(gvn + c + 4);
          *(float4*)(o_sgv + (long)rs_ * 1024 + c) = make_float4(x[0] * rs * g0.x, x[1] * rs * g0.y, x[2] * rs * g0.z, x[3] * rs * g0.w);
          *(float4*)(o_sgv + (long)rs_ * 1024 + c + 4) = make_float4(x[4] * rs * g1.x, x[5] * rs * g1.y, x[6] * rs * g1.z, x[7] * rs * g1.w);
        }
      }
    }
  }
  {
    const float* cc = p.cache_c + (long)l * 32 * PAST * 512;
    const long gt = (long)get_bid() * 512 + tid, gs = (long)gridDim.x * 512;
    for (long e = gt; e < 32L * PAST * 512 / 8; e += gs) {
      const float4 a = *(const float4*)(cc + e * 8), c = *(const float4*)(cc + e * 8 + 4);
      *(uint4*)(p.CB + e * 8) = pack8(a, c);
    }
    const float* pp = p.p_prompt + (long)l * M_P * 256; const float* ps = p.p_sample + (long)l * M_S * 256;
    for (long e = gt; e < (long)M_ALL * 256 / 8; e += gs) {
      const long pe = (long)M_P * 256 / 8;
      const float* src = e < pe ? (pp + e * 8) : (ps + (e - pe) * 8);
      *(uint4*)(p.PB + e * 8) = pack8(*(const float4*)src, *(const float4*)(src + 4));
    }
  }
  const float* ckr = p.cache_kr + (long)l * 32 * PAST * 64;
  const long gtid = (long)get_bid() * 512 + tid, gstride = (long)gridDim.x * 512;
  for (long e = gtid; e < 32L * PAST * 64 / 8; e += gstride) {
    const long el = e * 8; const int b = (int)(el / (PAST * 64)); const long rem = el - (long)b * PAST * 64;
    const float4 a = *(const float4*)(ckr + el), c = *(const float4*)(ckr + el + 4);
    *(uint4*)(p.KRs + (long)b * LKS * 64 + rem) = pack8(a, c);
  }
}

#define NCKV (512 * 8)
#define NPKV (64 * 8)
#define NSKV (2 * 8)
#define NQT (66 * 6)
#define NPPT (66 * 4)
#define RED8_OFF 131072
template <class RowPtr>
DI void nope_epi256(f32x4 (&acc)[2][2][4][2], const float* __restrict__ gain, float scale, char* smem, RowPtr rowptr, int g_wave_s) {
  const int tid = get_tid();
  const int wid = tid >> 6, lane = tid & 63, wr = wid >> 2, wc = wid & 3, fr = lane & 15, fq = lane >> 4;
  float* red = (float*)(smem + RED8_OFF);
#pragma unroll
  for (int ai = 0; ai < 2; ++ai)
#pragma unroll
    for (int bj = 0; bj < 2; ++bj)
#pragma unroll
      for (int m = 0; m < 4; ++m) {
        float s = 0.f;
#pragma unroll
        for (int n = 0; n < 2; ++n)
#pragma unroll
          for (int j = 0; j < 4; ++j) s += acc[ai][bj][m][n][j] * acc[ai][bj][m][n][j];
        s += shfl_xor_l(s, lane, 16); s += shfl_xor_l(s, lane, 32);
        if (fq == 0) red[((wc * 2 + ai) * 2 + bj) * 128 + 64 * wr + 16 * m + fr] = s;
      }
  __syncthreads();
  const int c = 32 * wc + 8 * fq;
  const float4 ga = *(const float4*)(gain + c), gb = *(const float4*)(gain + c + 4);
#pragma unroll
  for (int ai = 0; ai < 2; ++ai)
#pragma unroll
    for (int bj = 0; bj < 2; ++bj)
#pragma unroll
      for (int m = 0; m < 4; ++m) {
        const int rl = 64 * wr + 16 * m + fr;
        float tot = 0.f;
#pragma unroll
        for (int q = 0; q < 4; ++q) tot += red[((q * 2 + ai) * 2 + bj) * 128 + rl];
        const float rs = rsqrtf(tot * (1.f / 128.f) + EPSF) * scale;
        u16* op = rowptr(128 * ai + rl, bj);
        *(uint4*)(op + c) = make_uint4(pk2(acc[ai][bj][m][0][0] * rs * ga.x, acc[ai][bj][m][0][1] * rs * ga.y), pk2(acc[ai][bj][m][0][2] * rs * ga.z, acc[ai][bj][m][0][3] * rs * ga.w),
                                       pk2(acc[ai][bj][m][1][0] * rs * gb.x, acc[ai][bj][m][1][1] * rs * gb.y), pk2(acc[ai][bj][m][1][2] * rs * gb.z, acc[ai][bj][m][1][3] * rs * gb.w));
      }
}

DI void vt_epi256(const Params& p, f32x4 (&acc)[2][2][4][2], int mode, int m0, int tn, int g_wave_s) {
  G8_COORDS
  const long dstride = (mode == 0) ? (long)M_P : (long)LKS;
#pragma unroll
  for (int bj = 0; bj < 2; ++bj) {
    const int m32 = m0 + 128 * bj + 32 * wc;
#pragma unroll
    for (int ai = 0; ai < 2; ++ai) {
      const int h = 2 * (tn - 4) + ai;
      u16* base;
      if (mode == 0) base = p.VTp + (long)h * 128 * M_P + m32 + 8 * fq;
      else if (mode == 1) base = p.VTs + ((long)(m32 >> 12) * 8 + h) * 128 * LKS + (m32 & 4095) + 8 * fq;
      else base = p.VTs + ((long)((m32 >> 4) + (fq >> 1)) * 8 + h) * 128 * LKS + PAST + 8 * (fq & 1);
#pragma unroll
      for (int m = 0; m < 4; ++m) {
        const int dd = 64 * wr + 16 * m + fr;
        *(uint4*)(base + (long)dd * dstride) = make_uint4(pk2(acc[ai][bj][m][0][0], acc[ai][bj][m][0][1]), pk2(acc[ai][bj][m][0][2], acc[ai][bj][m][0][3]),
                                                          pk2(acc[ai][bj][m][1][0], acc[ai][bj][m][1][1]), pk2(acc[ai][bj][m][1][2], acc[ai][bj][m][1][3]));
      }
    }
  }
}
DI void rope_epi256(const Params& p, int l, f32x4 (&acc)[2][2][4][2], int tm, int tn, char* smem, int g_wave_s) {
  G8_COORDS
  float* red = (float*)(smem + RED8_OFF);
#pragma unroll
  for (int ai = 0; ai < 2; ++ai)
#pragma unroll
    for (int bj = 0; bj < 2; ++bj)
#pragma unroll
      for (int m = 0; m < 4; ++m) {
        float s = 0.f;
#pragma unroll
        for (int n = 0; n < 2; ++n)
#pragma unroll
          for (int j = 0; j < 4; ++j) s += acc[ai][bj][m][n][j] * acc[ai][bj][m][n][j];
        s += shfl_xor_l(s, lane, 16); s += shfl_xor_l(s, lane, 32);
        if (fq == 0) red[((wc * 2 + ai) * 2 + bj) * 128 + 64 * wr + 16 * m + fr] = s;
      }
  __syncthreads();
  const float* g = p.qrn + l * 64;
  const int c0 = 16 * (wc & 1) + 4 * fq;
  const float4 g1 = *(const float4*)(g + c0), g2 = *(const float4*)(g + 32 + c0);
  const float gg1[4] = {g1.x, g1.y, g1.z, g1.w}, gg2[4] = {g2.x, g2.y, g2.z, g2.w};
#pragma unroll
  for (int ai = 0; ai < 2; ++ai)
#pragma unroll
    for (int m = 0; m < 4; ++m) {
      const int rl = 64 * wr + 16 * m + fr;
      const int row = tm * 256 + 128 * ai + rl;
      const int pos = tok_pos(row);
      const float4 t0 = *(const float4*)(p.rope + ((long)pos * 32 + c0) * 2);
      const float4 t1 = *(const float4*)(p.rope + ((long)pos * 32 + c0) * 2 + 4);
      const float cs[4] = {t0.x, t0.z, t1.x, t1.z}, sn[4] = {t0.y, t0.w, t1.y, t1.w};
#pragma unroll
      for (int bj = 0; bj < 2; ++bj) {
        const float tot = red[((wc * 2 + ai) * 2 + bj) * 128 + rl] + red[(((wc ^ 1) * 2 + ai) * 2 + bj) * 128 + rl];
        const float rs = rsqrtf(tot * (1.f / 64.f) + EPSF);
        const int head = 4 * (tn - 4) + 2 * bj + (wc >> 1);
        u16* qp = p.Q + ((long)row * 8 + head) * 192 + 128;
        float o1[4], o2[4];
#pragma unroll
        for (int j = 0; j < 4; ++j) {
          const float y1 = acc[ai][bj][m][0][j] * rs * gg1[j], y2 = acc[ai][bj][m][1][j] * rs * gg2[j];
          o1[j] = (y1 * cs[j] - y2 * sn[j]) * QSCALE; o2[j] = (y1 * sn[j] + y2 * cs[j]) * QSCALE;
        }
        *(uint2*)(qp + c0) = make_uint2(pk2(o1[0], o1[1]), pk2(o1[2], o1[3]));
        *(uint2*)(qp + 32 + c0) = make_uint2(pk2(o2[0], o2[1]), pk2(o2[2], o2[3]));
      }
    }
}
DI void pp_epi256(const Params& p, f32x4 (&acc)[2][2][4][2], int tm, int tn, int g_wave_s) {
  G8_COORDS
#pragma unroll
  for (int ai = 0; ai < 2; ++ai)
#pragma unroll
    for (int m = 0; m < 4; ++m) {
      const long row = (long)tm * 256 + 128 * ai + 64 * wr + 16 * m + fr;
#pragma unroll
      for (int bj = 0; bj < 2; ++bj) {
        const int col = tn * 256 + 128 * bj + 32 * wc + 8 * fq;
        *(uint4*)(p.PP + row * 1024 + col) = make_uint4(pk2(acc[ai][bj][m][0][0], acc[ai][bj][m][0][1]), pk2(acc[ai][bj][m][0][2], acc[ai][bj][m][0][3]),
                                                        pk2(acc[ai][bj][m][1][0], acc[ai][bj][m][1][1]), pk2(acc[ai][bj][m][1][2], acc[ai][bj][m][1][3]));
      }
    }
}

DI void multi_phase(const Params& p, int l, char* smem, int g_wave_s) {
  const u16* Wkv = p.Wkv + (long)l * 2048 * 512;
  const u16* Wuq = p.Wuq + (long)l * 1536 * 384;
  const u16* Wpe = p.Wpe + (long)l * 1024 * 256;
  const int total = NCKV + NPKV + NSKV + NQT + NPPT;
  const int G = gridDim.x;
#pragma unroll 1
  for (int t = get_bid(); t < NCKV + NPKV + NSKV; t += G) {
    f32x4 acc[2][2][4][2];
    {
      const u16* tok; int u = t, mode;
      if (u < NCKV) { tok = p.CB + (long)(u >> 3) * 256 * 512; mode = 1; }
      else if ((u -= NCKV) < NPKV) { tok = p.C + (long)(u >> 3) * 256 * 512; mode = 0; }
      else { u -= NPKV; tok = p.C + ((long)M_P + (u >> 3) * 256) * 512; mode = 2; }
      const int m0 = (u >> 3) * 256, tn = u & 7;
      const u16* wgt = Wkv + (long)tn * 256 * 512;
      if (tn < 4) {
        gemm256_tile<1>(tok, wgt, 512, 512, smem, acc, g_wave_s);
        nope_epi256(acc, p.knn + l * 128, 1.0f, smem, [&](int rloc, int bj) -> u16* {
          const int m = m0 + rloc; const int h = 2 * tn + bj;
          if (mode == 0) return p.Knp + ((long)m * 8 + h) * 128;
          long key;
          if (mode == 1) key = (long)(m >> 12) * LKS + (m & 4095); else key = (long)(m >> 4) * LKS + PAST + (m & 15);
          return p.Kns + (key * 8 + h) * 128;
        }, g_wave_s);
      } else {
        gemm256_tile<2>(wgt, tok, 512, 512, smem, acc, g_wave_s);
        vt_epi256(p, acc, mode, m0, tn, g_wave_s);
      }
    }
  }
#pragma unroll 1
  for (int t = get_bid() + ((NCKV + NPKV + NSKV) / G) * G; t < total; t += G) {
    if (t < NCKV + NPKV + NSKV) continue;
    f32x4 acc[2][2][4][2];
    int u = t - (NCKV + NPKV + NSKV);
    if (u < NQT) {
      const int tm = u / 6, tn = u - tm * 6;
      gemm256_tile<1>(p.QN + (long)tm * 256 * 384, Wuq + (long)tn * 256 * 384, 384, 384, smem, acc, g_wave_s);
      if (tn < 4) nope_epi256(acc, p.qnn + l * 128, QSCALE, smem, [&](int rloc, int bj) -> u16* { return p.Q + ((long)(tm * 256 + rloc) * 8 + 2 * tn + bj) * 192; }, g_wave_s);
      else rope_epi256(p, l, acc, tm, tn, smem, g_wave_s);
      continue;
    }
    u -= NQT;
    {
      const int tm = u >> 2, tn = u & 3;
      gemm256_tile<1>(p.PB + (long)tm * 256 * 256, Wpe + (long)tn * 256 * 256, 256, 256, smem, acc, g_wave_s);
      pp_epi256(p, acc, tm, tn, g_wave_s);
    }
  }
}

#define ASTAGE 40960
DI void attn_item(const u16* __restrict__ Qb, int qclamp, const u16* __restrict__ Kn, const u16* __restrict__ KR,
                  const u16* __restrict__ VT, long vt_stride, int ntiles, int ntw, int Lk, u16* __restrict__ Ob, char* smem, int g_wave_s) {
  const int tid = get_tid(), lane = tid & 63, w = tid >> 6, r = lane & 31, hh = lane >> 5;
  bf16x8 qf[12];
  {
    const int qr = r < qclamp ? r : qclamp;
    const u16* qp = Qb + (long)(32 * w + qr) * (8 * 192) + 8 * hh;
#pragma unroll
    for (int ks = 0; ks < 12; ++ks) qf[ks] = *(const bf16x8*)(qp + 16 * ks);
  }
  f32x16 oacc[4];
#pragma unroll
  for (int dt = 0; dt < 4; ++dt)
#pragma unroll
    for (int i = 0; i < 16; ++i) oacc[dt][i] = 0.f;
  float mrun = 0.f, lrun = 0.f;

  const int lrow = tid >> 3, lq = tid & 7;
  const int sch = lq ^ ((lrow >> 1) & 7);
  unsigned koff = (unsigned)(lrow * 1024 + sch * 8) * 2u;
  unsigned kroff = (unsigned)(lrow * 64 + sch * 8) * 2u;
  const unsigned vstep = (unsigned)(64 * vt_stride * 2);
  unsigned voff = (unsigned)(lrow * vt_stride * 2 + sch * 16);
  const char* KnB = (const char*)Kn; const char* KRB = (const char*)KR; const char* VTB = (const char*)VT;
  char* dstT = smem + tid * 16;
#define ADMA(st_) { char* d_ = dstT + (st_) * ASTAGE; \
    __builtin_amdgcn_global_load_lds((const unsigned*)(KnB + (size_t)koff), (unsigned*)(d_), 16, 0, 0); \
    __builtin_amdgcn_global_load_lds((const unsigned*)(KnB + (size_t)koff + 128), (unsigned*)(d_ + 8192), 16, 0, 0); \
    __builtin_amdgcn_global_load_lds((const unsigned*)(KRB + (size_t)kroff), (unsigned*)(d_ + 16384), 16, 0, 0); \
    __builtin_amdgcn_global_load_lds((const unsigned*)(VTB + (size_t)voff), (unsigned*)(d_ + 24576), 16, 0, 0); \
    __builtin_amdgcn_global_load_lds((const unsigned*)(VTB + (size_t)(voff + vstep)), (unsigned*)(d_ + 32768), 16, 0, 0); \
    koff += 64 * 1024 * 2; kroff += 64 * 64 * 2; voff += 128; }
  const int xr = (r >> 1) & 7;
  const int xo0 = ((0 + hh) ^ xr) << 4, xo1 = ((2 + hh) ^ xr) << 4, xo2 = ((4 + hh) ^ xr) << 4, xo3 = ((6 + hh) ^ xr) << 4;
  const char* rbase = smem + r * 128;

  f32x16 sacc[2];
#define KFRAG(sb_, ks_, kt_) (*(const bf16x8*)((sb_) + ((ks_) >> 2) * 8192 + (kt_) * 4096 + ((((ks_) & 3) == 0) ? xo0 : (((ks_) & 3) == 1) ? xo1 : (((ks_) & 3) == 2) ? xo2 : xo3)))
#define VFRAG(sb_, dt_, q_) (*(const bf16x8*)((sb_) + 24576 + (dt_) * 4096 + (((q_) == 0) ? xo0 : ((q_) == 1) ? xo1 : ((q_) == 2) ? xo2 : xo3)))
#define ATT_S(st_) { \
    { const float ninit = -mrun; _Pragma("unroll") for (int kt = 0; kt < 2; ++kt) _Pragma("unroll") for (int i = 0; i < 16; ++i) sacc[kt][i] = ninit; }     \
    const char* sb = rbase + (st_) * ASTAGE; \
    _Pragma("unroll") for (int ks = 0; ks < 12; ++ks) { \
      bf16x8 k0 = KFRAG(sb, ks, 0); \
      bf16x8 k1 = KFRAG(sb, ks, 1); \
      sacc[0] = MFMA(k0, qf[ks], sacc[0]); \
      sacc[1] = MFMA(k1, qf[ks], sacc[1]); \
      if ((ks & 3) == 3) __builtin_amdgcn_sched_barrier(0); } }
#define ATT_PV(jt_, st_) { \
    if (((jt_) + 1) * 64 > Lk) { \
      _Pragma("unroll") for (int kt = 0; kt < 2; ++kt) _Pragma("unroll") for (int i = 0; i < 16; ++i) { \
          const int key = (jt_) * 64 + 32 * kt + (i & 3) + 8 * (i >> 2) + 4 * hh; \
          if (key >= Lk) sacc[kt][i] = -INFINITY; } } \
    float tmax = -INFINITY; \
    _Pragma("unroll") for (int kt = 0; kt < 2; ++kt) _Pragma("unroll") for (int i = 0; i < 16; ++i) tmax = fmaxf(tmax, sacc[kt][i]); \
    tmax = fmaxf(tmax, shfl_xor_l(tmax, lane, 32)); \
      \
    if (__builtin_amdgcn_ballot_w64(tmax > 8.0f) != 0ull) { \
      const float dlt = fmaxf(tmax, 0.f); \
      const float alpha = __builtin_amdgcn_exp2f(-dlt); \
      mrun += dlt; \
      lrun *= alpha; \
      _Pragma("unroll") for (int kt = 0; kt < 2; ++kt) _Pragma("unroll") for (int i = 0; i < 16; ++i) sacc[kt][i] -= dlt; \
      _Pragma("unroll") for (int dt = 0; dt < 4; ++dt) _Pragma("unroll") for (int i = 0; i < 16; ++i) oacc[dt][i] *= alpha; \
    } \
    float psum = 0.f; \
    _Pragma("unroll") for (int kt = 0; kt < 2; ++kt) _Pragma("unroll") for (int i = 0; i < 16; ++i) { const float pv = __builtin_amdgcn_exp2f(sacc[kt][i]); sacc[kt][i] = pv; psum += pv; } \
    lrun += psum; \
    bf16x8 pf[2][2]; \
    _Pragma("unroll") for (int kt = 0; kt < 2; ++kt) _Pragma("unroll") for (int s = 0; s < 2; ++s) { \
        uint4 pp = make_uint4(pk2(sacc[kt][8 * s + 0], sacc[kt][8 * s + 1]), pk2(sacc[kt][8 * s + 2], sacc[kt][8 * s + 3]), \
                              pk2(sacc[kt][8 * s + 4], sacc[kt][8 * s + 5]), pk2(sacc[kt][8 * s + 6], sacc[kt][8 * s + 7])); \
        pf[kt][s] = __builtin_bit_cast(bf16x8, pp); } \
    const char* sb = rbase + (st_) * ASTAGE; \
    _Pragma("unroll") for (int dt = 0; dt < 4; ++dt) _Pragma("unroll") for (int kt = 0; kt < 2; ++kt) _Pragma("unroll") for (int s = 0; s < 2; ++s) { \
          bf16x8 vf = VFRAG(sb, dt, 2 * kt + s); \
          oacc[dt] = MFMA(vf, pf[kt][s], oacc[dt]); \
          if (kt == 1 && s == 1) __builtin_amdgcn_sched_barrier(0); } }

  ADMA(0)
  int st = 0;
#pragma unroll 1
  for (int jt = 0; jt < ntiles; ++jt) {
    asm volatile("s_waitcnt vmcnt(0)" ::: "memory");
    __syncthreads();
    const int stn = st == 2 ? 0 : st + 1;
    if (jt + 1 < ntiles) ADMA(stn)
    if (jt < ntw) { ATT_S(st) ATT_PV(jt, st) }
    st = stn;
  }
#undef ATT_S
#undef ATT_PV
#undef KFRAG
#undef VFRAG
#undef ADMA
  if (ntw > 0 && r <= qclamp) {
    const float ltot = lrun + shfl_xor_l(lrun, lane, 32);
    const float inv = 1.f / ltot;
    u16* op = Ob + (long)(32 * w + r) * 1024;
#pragma unroll
    for (int dt = 0; dt < 4; ++dt)
#pragma unroll
      for (int i4 = 0; i4 < 4; ++i4) {
        const int d = 32 * dt + 8 * i4 + 4 * hh;
        *(uint2*)(op + d) = make_uint2(pk2(oacc[dt][4 * i4 + 0] * inv, oacc[dt][4 * i4 + 1] * inv), pk2(oacc[dt][4 * i4 + 2] * inv, oacc[dt][4 * i4 + 3] * inv));
      }
  } else if (ntw > 0) {
    (void)shfl_xor_l(lrun, lane, 32);
  }
}

DI void attn_phase(const Params& p, int l, char* smem, int* s_item, int cidx, int g_wave_s) {
  const int tid = get_tid(), w = tid >> 6;
  const int NITEM = 256 + 512;
  for (;;) {
    __syncthreads();
    if (tid == 0) *s_item = (int)atomicAdd(p.ctr + cidx, 1u);
    __syncthreads();
    const int item = *s_item;
    if (item >= NITEM) break;
    if (item < 256) {
      const int b = item >> 3, h = item & 7;
      const u16* Qb = p.Q + ((long)(M_P + 16 * b) * 8 + h) * 192;
      const u16* Kn = p.Kns + ((long)b * LKS * 8 + h) * 128;
      const u16* KR = p.KRs + (long)b * LKS * 64;
      const u16* VT = p.VTs + ((long)b * 8 + h) * 128 * LKS;
      u16* Ob = p.OA + (long)(M_P + 16 * b) * 1024 + h * 128;
      attn_item(Qb, 15, Kn, KR, VT, LKS, 65, w == 0 ? 65 : 0, LKV, Ob, smem, g_wave_s);
    } else {
      const int idx = item - 256;
      const int qb = 63 - (idx >> 3), h = idx & 7;
      const u16* Qb = p.Q + ((long)(256 * qb) * 8 + h) * 192;
      const u16* Kn = p.Knp + (long)h * 128;
      const u16* KR = p.KRp;
      const u16* VT = p.VTp + (long)h * 128 * M_P;
      u16* Ob = p.OA + (long)(256 * qb) * 1024 + h * 128;
      const int ntiles = 4 * qb + 4;
      attn_item(Qb, 31, Kn, KR, VT, M_P, ntiles, 4 * qb + (w >> 1) + 1, 1 << 30, Ob, smem, g_wave_s);
    }
  }
}

DI void gmlp_phase(const Params& p, int l, char* smem_all, int g_wave_s) {
  const int half = get_tid() >> 8; char* smem = smem_all + half * HALF_BYTES;
  const int tid = get_tid() & 255, lane = tid & 63, w = tid >> 6, wm = w >> 1, wn = w & 1, r = lane & 31, hh = lane >> 5;
  const float* gvn = p.gvn + l * 1024;
  const float* gws = p.gws + (long)l * 8 * 128 * 128;
  const float* gbs = p.gbs + (long)l * 8 * 128;
  u16* Xs = (u16*)smem;
  u16* Ws = Xs + 128 * 136;
  const int NP = 128 * 8, NS = 32 * 4;
  for (int t2 = get_bid(); t2 < (NP + NS + 1) / 2; t2 += gridDim.x) {
    const int t = 2 * t2 + half;
    const bool valid = t < NP + NS;
    const bool isp = valid && t < NP;
    {
      const int ci = t >> 3, g = t & 7;
      const int t0 = ci * 128, c0 = g * 128;
      __syncthreads();
      if (isp) {
      {
        unsigned* Xs32 = (unsigned*)Xs;
#pragma unroll
        for (int i = 0; i < 4; ++i) {
          const int sp = (tid & 15) + 16 * i, dq = (tid >> 4) & 15, dc = dq * 8;
          const int sl0 = (dc & ~15) | ((dq & 1) ? 4 : 0), sl1 = (dc & ~15) | ((dq & 1) ? 12 : 8);
          const uint4 v0 = *(const uint4*)(p.Z + (long)(t0 + 2 * sp) * LDZ + ZV + c0 + dc);
          const uint4 v1 = *(const uint4*)(p.Z + (long)(t0 + 2 * sp + 1) * LDZ + ZV + c0 + dc);
          const float r0 = p.rsv[t0 + 2 * sp], r1 = p.rsv[t0 + 2 * sp + 1];
          const float4 g0 = *(const float4*)(gvn + c0 + dc), g1 = *(const float4*)(gvn + c0 + dc + 4);
          Xs32[(sl0 + 0) * 68 + sp] = pk2(bflo(v0.x) * r0 * g0.x, bflo(v1.x) * r1 * g0.x); Xs32[(sl0 + 1) * 68 + sp] = pk2(bfhi(v0.x) * r0 * g0.y, bfhi(v1.x) * r1 * g0.y);
          Xs32[(sl0 + 2) * 68 + sp] = pk2(bflo(v0.y) * r0 * g0.z, bflo(v1.y) * r1 * g0.z); Xs32[(sl0 + 3) * 68 + sp] = pk2(bfhi(v0.y) * r0 * g0.w, bfhi(v1.y) * r1 * g0.w);
          Xs32[(sl1 + 0) * 68 + sp] = pk2(bflo(v0.z) * r0 * g1.x, bflo(v1.z) * r1 * g1.x); Xs32[(sl1 + 1) * 68 + sp] = pk2(bfhi(v0.z) * r0 * g1.y, bfhi(v1.z) * r1 * g1.y);
          Xs32[(sl1 + 2) * 68 + sp] = pk2(bflo(v0.w) * r0 * g1.z, bflo(v1.w) * r1 * g1.z); Xs32[(sl1 + 3) * 68 + sp] = pk2(bfhi(v0.w) * r0 * g1.w, bfhi(v1.w) * r1 * g1.w);
        }
      }
#pragma unroll
      for (int i = 0; i < 8; ++i) {
        const int c = tid + 256 * i;
        const int tt = c >> 4, sc = (c & 15) * 8;
        const float* wp = gws + ((long)g * 128 + tt) * 128 + sc;
        float4 a = *(const float4*)wp, b = *(const float4*)(wp + 4);
        a.x = (sc + 0 <= tt) ? a.x : 0.f; a.y = (sc + 1 <= tt) ? a.y : 0.f; a.z = (sc + 2 <= tt) ? a.z : 0.f; a.w = (sc + 3 <= tt) ? a.w : 0.f;
        b.x = (sc + 4 <= tt) ? b.x : 0.f; b.y = (sc + 5 <= tt) ? b.y : 0.f; b.z = (sc + 6 <= tt) ? b.z : 0.f; b.w = (sc + 7 <= tt) ? b.w : 0.f;
        *(uint4*)(Ws + tt * 136 + sc) = pack8(a, b);
      }
      }
      __syncthreads();
      if (isp) {
      f32x16 acc[2][2];
#pragma unroll
      for (int mi = 0; mi < 2; ++mi)
#pragma unroll
        for (int ni = 0; ni < 2; ++ni)
#pragma unroll
          for (int i = 0; i < 16; ++i) acc[mi][ni][i] = 0.f;
      const u16* Ab = Ws + (64 * wm + r) * 136 + 8 * hh;
      const u16* Bb = Xs + (64 * wn + r) * 136 + 8 * hh;
#pragma unroll
      for (int ks = 0; ks < 8; ++ks) {
        bf16x8 a0 = *(const bf16x8*)(Ab + 16 * ks), a1 = *(const bf16x8*)(Ab + 32 * 136 + 16 * ks);
        bf16x8 b0 = *(const bf16x8*)(Bb + 16 * ks), b1 = *(const bf16x8*)(Bb + 32 * 136 + 16 * ks);
        acc[0][0] = MFMA(b0, a0, acc[0][0]); acc[0][1] = MFMA(b1, a0, acc[0][1]);
        acc[1][0] = MFMA(b0, a1, acc[1][0]); acc[1][1] = MFMA(b1, a1, acc[1][1]);
      }
#pragma unroll
      for (int mi = 0; mi < 2; ++mi) {
        const int tl = 64 * wm + 32 * mi + r;
        const long row = t0 + tl;
        const float bias = gbs[g * 128 + tl];
        const u16* zr = p.Z + row * LDZ;
#pragma unroll
        for (int ni = 0; ni < 2; ++ni)
#pragma unroll
          for (int g8 = 0; g8 < 2; ++g8) {
            const int col = c0 + 64 * wn + 32 * ni + 16 * g8 + 8 * hh;
            const uint4 uu = *(const uint4*)(zr + ZU + col), ga = *(const uint4*)(zr + ZGA + col), gb = *(const uint4*)(zr + ZGB + col);
            const uint4 oa = *(const uint4*)(p.OA + row * 1024 + col);
            const unsigned uw[4] = {uu.x, uu.y, uu.z, uu.w}, gaw[4] = {ga.x, ga.y, ga.z, ga.w}, gbw[4] = {gb.x, gb.y, gb.z, gb.w}, oaw[4] = {oa.x, oa.y, oa.z, oa.w};
            unsigned ow[4];
#pragma unroll
            for (int q = 0; q < 4; ++q) {
              const float o0 = sigm(bflo(gaw[q])) * bflo(oaw[q]) + sigm(bflo(gbw[q])) * bflo(uw[q]) * (acc[mi][ni][8 * g8 + 2 * q] + bias);
              const float o1 = sigm(bfhi(gaw[q])) * bfhi(oaw[q]) + sigm(bfhi(gbw[q])) * bfhi(uw[q]) * (acc[mi][ni][8 * g8 + 2 * q + 1] + bias);
              ow[q] = pk2(o0, o1);
            }
            *(uint4*)(p.MIX + row * 1024 + col) = make_uint4(ow[0], ow[1], ow[2], ow[3]);
          }
      }
      }
    }
    if (valid && !isp) {
      const int u = t - NP; const int b = u >> 2, col = (u & 3) * 256 + tid; const int g = col >> 7;
      const long row0 = M_P + 16 * b;
      const float gv = gvn[col];
      float vn[16];
#pragma unroll
      for (int s = 0; s < 16; ++s) vn[s] = bf1(p.Z[(row0 + s) * LDZ + ZV + col]) * p.rsv[row0 + s] * gv;
#pragma unroll
      for (int tt = 0; tt < 16; ++tt) {
        float mx = gbs[g * 128 + tt];
#pragma unroll
        for (int s = 0; s <= tt; ++s) mx += gws[((long)g * 128 + tt) * 128 + s] * vn[s];
        const u16* zr = p.Z + (row0 + tt) * LDZ;
        const float uu = bf1(zr[ZU + col]), ga = bf1(zr[ZGA + col]), gb = bf1(zr[ZGB + col]);
        const float oa = bf1(p.OA[(row0 + tt) * 1024 + col]);
        p.MIX[(row0 + tt) * 1024 + col] = f2bf(sigm(ga) * oa + sigm(gb) * uu * mx);
      }
    }
  }
}

#define XB_TMO      128
#define XB_XCNT(j)  (256  + 64 * (j))
#define XB_XSUB(j)  (1280 + 64 * (j))
#define XB_XGEN(j)  (2304 + 64 * (j))
#define XB_TOP      3328
#define XB_TOPGEN   3392
#define XCD_BAR_WORDS 3456
#define XB_SPIN_CAP (1u << 22)
#define LAS __attribute__((address_space(3)))
DI unsigned xb_ld(unsigned* p) { return __hip_atomic_load(p, __ATOMIC_RELAXED, __HIP_MEMORY_SCOPE_AGENT); }
DI unsigned xb_add(unsigned* p, unsigned v) { return __hip_atomic_fetch_add(p, v, __ATOMIC_RELAXED, __HIP_MEMORY_SCOPE_AGENT); }
DI unsigned xb_xcc_id() { return (unsigned)__builtin_amdgcn_s_getreg((3 << 11) | 20) & 0xFu; }
#define XB_SPIN(cond, bar) do { unsigned _sp = 0; while (cond) { __builtin_amdgcn_s_sleep(1); \
    if ((++_sp & 255u) == 0u) { if (xb_ld(&(bar)[XB_TMO])) break; if (_sp > XB_SPIN_CAP) { atomicAdd(&(bar)[XB_TMO], 1u); break; } } } } while (0)
struct XcdBarrier { unsigned* bar; unsigned x; volatile LAS unsigned* st; };
DI XcdBarrier xcd_barrier_post(unsigned* bar, volatile LAS unsigned* st) {
  XcdBarrier b; b.bar = bar; b.x = xb_xcc_id(); b.st = st;
  if (threadIdx.x == 0) (void)xb_add(&bar[XB_XCNT(b.x)], 1u);
  return b;
}
DI void xcd_barrier_complete(unsigned* bar, unsigned x, unsigned& nloc, unsigned& nx) {
  const unsigned G = gridDim.x * gridDim.y * gridDim.z;
  unsigned sum, cnt, mine, sp = 0u;
  for (;;) {
    sum = 0u; cnt = 0u; mine = 0u;
#pragma unroll
    for (unsigned j = 0; j < 16; ++j) { const unsigned c = xb_ld(&bar[XB_XCNT(j)]); sum += c; cnt += (c > 0u) ? 1u : 0u; mine = (j == x) ? c : mine; }
    if (sum == G) break;
    __builtin_amdgcn_s_sleep(1);
    if ((++sp & 255u) == 0u) { if (xb_ld(&bar[XB_TMO])) break; if (sp > XB_SPIN_CAP) { atomicAdd(&bar[XB_TMO], 1u); break; } }
  }
  nloc = mine > 0u ? mine : 1u; nx = cnt > 0u ? cnt : 1u;
}
DI void xcd_barrier(const XcdBarrier& b) {
  asm volatile("s_waitcnt vmcnt(0)" ::: "memory");
  __syncthreads();
  if (threadIdx.x == 0) {
    unsigned* bar = b.bar;
    __builtin_amdgcn_s_waitcnt(0);
    unsigned nloc = b.st[0], nx = b.st[1];
    if (nloc == 0u) { xcd_barrier_complete(bar, b.x, nloc, nx); b.st[0] = nloc; b.st[1] = nx; }
    const unsigned old = xb_add(&bar[XB_XSUB(b.x)], 1u);
    const unsigned gen = old / nloc;
    if (old + 1u == (gen + 1u) * nloc) {
      __builtin_amdgcn_fence(__ATOMIC_RELEASE, "agent");
      asm volatile("s_waitcnt vmcnt(0)" ::: "memory");
      const unsigned og = xb_add(&bar[XB_TOP], 1u);
      const unsigned tg = og / nx;
      if (og + 1u == (tg + 1u) * nx) xb_add(&bar[XB_TOPGEN], 1u);
      else XB_SPIN(xb_ld(&bar[XB_TOPGEN]) == tg, bar);
      __builtin_amdgcn_fence(__ATOMIC_ACQUIRE, "agent");
      xb_add(&bar[XB_XGEN(b.x)], 1u);
      asm volatile("s_waitcnt vmcnt(0)" ::: "memory");
    } else {
      XB_SPIN(xb_ld(&bar[XB_XGEN(b.x)]) == gen, bar);
      __builtin_amdgcn_fence(__ATOMIC_ACQUIRE, "agent");
      asm volatile("s_waitcnt vmcnt(0)" ::: "memory");
    }
  }
  __syncthreads();
}

__global__ void __launch_bounds__(512, 2) mega_fwd(Params p) {
  const int g_wave_s = __builtin_amdgcn_readfirstlane((int)(threadIdx.x >> 6));
  extern __shared__ __attribute__((aligned(16))) char smem[];
  uint4& xb_words = *(uint4*)(smem + SMEM_BYTES);
  int& s_item = *(int*)(smem + SMEM_BYTES + 16);
  cg::grid_group grid = cg::this_grid();
  if (threadIdx.x == 0) xb_words = make_uint4(0u, 0u, 0u, 0u);
  __syncthreads();
  XcdBarrier xb = xcd_barrier_post(p.bar, (volatile LAS unsigned*)&xb_words);

  prep_phase(p, smem, g_wave_s);
  grid.sync();
#ifdef PROBE_PREP
  prep_phase(p, smem, g_wave_s);
  grid.sync();
#endif
#pragma unroll 1
  for (int l = 0; l < 2; ++l) {
    norm_phase(p.out, p.f1n + l * 1024, p.NB, p.PART, 0, g_wave_s);
    xcd_barrier(xb);
    ffn_up_phase(p, p.Wgu1 + (long)l * 2 * DFF * 1024, smem, g_wave_s);
    xcd_barrier(xb);
#ifdef PROBE_FFN
    ffn_up_phase(p, p.Wgu1 + (long)l * 2 * DFF * 1024, smem, g_wave_s);
    xcd_barrier(xb);
#endif
    resid_gemm_phase(p, p.ACT, DFF, p.Wd1 + (long)l * 1024 * DFF, 0.5f, smem, g_wave_s);
    xcd_barrier(xb);
    norm_phase(p.out, p.mixn + l * 1024, p.NB, p.PART, DFF / 256, g_wave_s);
    xcd_barrier(xb);
    win_phase(p, p.Win + (long)l * LDZ * 1024, smem, g_wave_s);
    xcd_barrier(xb);
    rowpost_phase(p, l, g_wave_s);
    xcd_barrier(xb);
    multi_phase(p, l, smem, g_wave_s);
    xcd_barrier(xb);
    attn_phase(p, l, smem, &s_item, l, g_wave_s);
    xcd_barrier(xb);
#ifdef PROBE_ATTN
    attn_phase(p, l, smem, &s_item, 2 + l, g_wave_s);
    xcd_barrier(xb);
#endif
#ifdef PROBE_MULTI
    multi_phase(p, l, smem, g_wave_s);
    xcd_barrier(xb);
#endif
    gmlp_phase(p, l, smem, g_wave_s);
    xcd_barrier(xb);
#ifdef PROBE_GMLP
    gmlp_phase(p, l, smem, g_wave_s);
    xcd_barrier(xb);
#endif
#ifdef PROBE_ROWPOST
    rowpost_phase(p, l, g_wave_s);
    xcd_barrier(xb);
#endif
    resid_gemm_phase(p, p.MIX, 1024, p.Wo + (long)l * 1024 * 1024, 1.0f, smem, g_wave_s);
    xcd_barrier(xb);
    norm_phase(p.out, p.f2n + l * 1024, p.NB, p.PART, 1024 / 256, g_wave_s);
    xcd_barrier(xb);
    ffn_up_phase(p, p.Wgu2 + (long)l * 2 * DFF * 1024, smem, g_wave_s);
    xcd_barrier(xb);
#ifdef PROBE_FFN
    ffn_up_phase(p, p.Wgu2 + (long)l * 2 * DFF * 1024, smem, g_wave_s);
    xcd_barrier(xb);
#endif
    resid_gemm_phase(p, p.ACT, DFF, p.Wd2 + (long)l * 1024 * DFF, 0.5f, smem, g_wave_s);
    xcd_barrier(xb);
    norm_phase(p.out, p.plen + l * 1024, p.NB, p.PART, DFF / 256, g_wave_s);
    xcd_barrier(xb);
    ple_phase(p, p.Wpg + (long)l * 1024 * 1024, smem, g_wave_s);
    xcd_barrier(xb);
  }
}

extern "C" void kernel_launch(void* const* d_in, const int* in_sizes, int n_in, void* d_out, int out_size, void* d_ws,
                              size_t ws_size, hipStream_t stream) {
  (void)in_sizes; (void)n_in; (void)out_size; (void)ws_size;
  Params p{};
  auto F = [&](int i) { return (const float*)d_in[i]; };
  p.x_prompt = F(0); p.x_sample = F(1); p.cache_c = F(2); p.cache_kr = F(3); p.p_prompt = F(4); p.p_sample = F(5);
  p.f1n = F(6); p.mixn = F(10); p.qan = F(12); p.qnn = F(14); p.qrn = F(15); p.kvan = F(16); p.krn = F(17);
  p.knn = F(20); p.gvn = F(21); p.gws = F(22); p.gbs = F(23); p.f2n = F(25); p.plen = F(29);
  p.out = (float*)d_out;
  char* ws = (char*)d_ws; size_t off = 0;
  auto alloc = [&](size_t bytes) { char* r = ws + off; off += (bytes + 255) & ~(size_t)255; return r; };
  p.Wgu1 = (u16*)alloc(2UL * 2 * DFF * 1024 * 2);
  p.Wd1 = (u16*)alloc(2UL * 1024 * DFF * 2);
  p.Win = (u16*)alloc(2UL * LDZ * 1024 * 2);
  p.Wuq = (u16*)alloc(2UL * 1536 * 384 * 2);
  p.Wkv = (u16*)alloc(2UL * 2048 * 512 * 2);
  p.Wo = (u16*)alloc(2UL * 1024 * 1024 * 2);
  p.Wgu2 = (u16*)alloc(2UL * 2 * DFF * 1024 * 2);
  p.Wd2 = (u16*)alloc(2UL * 1024 * DFF * 2);
  p.Wpg = (u16*)alloc(2UL * 1024 * 1024 * 2);
  p.Wpe = (u16*)alloc(2UL * 1024 * 256 * 2);
  p.NB = (u16*)alloc((size_t)M_ALL * 1024 * 2);
  p.ACT = (u16*)alloc((size_t)M_ALL * DFF * 2);
  p.Z = (u16*)alloc((size_t)M_ALL * LDZ * 2);
  p.QN = (u16*)alloc((size_t)M_ALL * 384 * 2);
  p.C = (u16*)alloc((size_t)M_ALL * 512 * 2);
  p.KRp = (u16*)alloc((size_t)M_P * 64 * 2);
  p.KRs = (u16*)alloc((size_t)32 * LKS * 64 * 2);
  p.Q = (u16*)alloc((size_t)M_ALL * 8 * 192 * 2);
  p.Knp = (u16*)alloc((size_t)M_P * 1024 * 2);
  p.VTp = (u16*)alloc((size_t)M_P * 1024 * 2);
  p.Kns = (u16*)alloc((size_t)32 * LKS * 1024 * 2);
  p.VTs = (u16*)alloc((size_t)32 * LKS * 1024 * 2);
  p.OA = (u16*)alloc((size_t)M_ALL * 1024 * 2);
  p.MIX = (u16*)alloc((size_t)M_ALL * 1024 * 2);
  p.PP = (u16*)alloc((size_t)M_ALL * 1024 * 2);
  p.CB = (u16*)alloc((size_t)32 * PAST * 512 * 2);
  p.PB = (u16*)alloc((size_t)M_ALL * 256 * 2);
  p.rsv = (float*)alloc((size_t)M_ALL * 4);
  p.PART = (float*)alloc((size_t)11 * M_S * 1024 * 4);
  p.rope = (float*)alloc((size_t)16384 * 32 * 2 * 4);
  p.ctr = (unsigned*)alloc(256);
  p.bar = (unsigned*)alloc(XCD_BAR_WORDS * 4);

  int nj = 0, ts = 0;
  auto job = [&](const float* src, u16* dst, int K, int N, int kind) {
    p.jobs[nj].src = src; p.jobs[nj].dst = dst; p.jobs[nj].K = K; p.jobs[nj].N = N; p.jobs[nj].kind = kind; p.jobs[nj].tstart = ts;
    ts += (K / 64) * ((N / 64 + 3) / 4); ++nj;
  };
  for (int l = 0; l < 2; ++l) {
    job(F(7) + (size_t)l * 1024 * DFF, p.Wgu1 + (size_t)l * 2 * DFF * 1024, 1024, DFF, 1);
    job(F(8) + (size_t)l * 1024 * DFF, p.Wgu1 + (size_t)l * 2 * DFF * 1024, 1024, DFF, 2);
    job(F(9) + (size_t)l * DFF * 1024, p.Wd1 + (size_t)l * 1024 * DFF, DFF, 1024, 0);
    job(F(11) + (size_t)l * 1024 * DIN, p.Win + (size_t)l * LDZ * 1024, 1024, DIN, 0);
    job(F(13) + (size_t)l * 384 * 1536, p.Wuq + (size_t)l * 1536 * 384, 384, 1536, 3);
    job(F(18) + (size_t)l * 512 * 1024, p.Wkv + (size_t)l * 2048 * 512, 512, 1024, 0);
    job(F(19) + (size_t)l * 512 * 1024, p.Wkv + (size_t)l * 2048 * 512, 512, 1024, 4);
    job(F(24) + (size_t)l * 1024 * 1024, p.Wo + (size_t)l * 1024 * 1024, 1024, 1024, 0);
    job(F(26) + (size_t)l * 1024 * DFF, p.Wgu2 + (size_t)l * 2 * DFF * 1024, 1024, DFF, 1);
    job(F(27) + (size_t)l * 1024 * DFF, p.Wgu2 + (size_t)l * 2 * DFF * 1024, 1024, DFF, 2);
    job(F(28) + (size_t)l * DFF * 1024, p.Wd2 + (size_t)l * 1024 * DFF, DFF, 1024, 0);
    job(F(30) + (size_t)l * 1024 * 1024, p.Wpg + (size_t)l * 1024 * 1024, 1024, 1024, 0);
    job(F(31) + (size_t)l * 256 * 1024, p.Wpe + (size_t)l * 1024 * 256, 256, 1024, 0);
  }
  p.ntile_prep = ts;

  static int grid_blocks = 0;
  if (!grid_blocks) {
    int dev = 0, cus = 0, per_cu = 0;
    hipGetDevice(&dev);
    hipDeviceGetAttribute(&cus, hipDeviceAttributeMultiprocessorCount, dev);
    hipFuncSetAttribute((const void*)mega_fwd, hipFuncAttributeMaxDynamicSharedMemorySize, LDS_TOTAL);
    hipOccupancyMaxActiveBlocksPerMultiprocessor(&per_cu, (const void*)mega_fwd, 512, LDS_TOTAL);
    if (per_cu > 1) per_cu = 1;
    if (per_cu < 1) per_cu = 1;
    grid_blocks = cus * per_cu;
  }
  (void)hipMemsetAsync(p.bar, 0, XCD_BAR_WORDS * 4, stream);
  void* args[] = {&p};
  hipError_t e = hipLaunchCooperativeKernel((const void*)mega_fwd, dim3(grid_blocks), dim3(512), args, LDS_TOTAL, stream);
  if (e != hipSuccess) fprintf(stderr, "cooperative launch failed: %s (grid %d)\n", hipGetErrorString(e), grid_blocks);
}
```

```cpp
#include <hip/hip_runtime.h>
#include <hip/hip_cooperative_groups.h>
#include <cstdio>
namespace cg = cooperative_groups;

#define DI __device__ __forceinline__
typedef unsigned short u16;
typedef __attribute__((ext_vector_type(8))) short bf16x8;
typedef __attribute__((ext_vector_type(16))) float f32x16;
typedef __attribute__((ext_vector_type(2))) __bf16 bf2_t;
typedef __attribute__((ext_vector_type(2))) float f2_t;

#define M_P 16384
#define M_S 512
#define M_ALL 16896
#define DM 1024
#define DFF 2816
#define DIN 5056
#define LDZ 5120
#define ZQ 0
#define ZKV 384
#define ZKR 896
#define ZU 960
#define ZV 1984
#define ZGA 3008
#define ZGB 4032
#define LKS 4160
#define LKV 4112
#define PAST 4096
#define EPSF 1e-6f
#define QSCALE (0.07216878364870322f * 1.4426950408889634f)

#define NJOBS 26
struct TJob { const float* src; u16* dst; int K, N, kind, tstart; };

struct Params {
  const float *x_prompt, *x_sample, *cache_c, *cache_kr, *p_prompt, *p_sample;
  const float *f1n, *mixn, *qan, *qnn, *qrn, *kvan, *krn, *knn, *gvn, *gws, *gbs, *f2n, *plen;
  float* out;
  u16 *Wgu1, *Wd1, *Win, *Wuq, *Wkv, *Wo, *Wgu2, *Wd2, *Wpg, *Wpe;
  u16 *CB, *PB;
  u16 *NB, *ACT, *Z, *QN, *C, *KRp, *KRs, *Q, *Knp, *VTp, *Kns, *VTs, *OA, *MIX, *PP;
  float *rsv, *rope, *PART;
  unsigned* ctr;
  unsigned* bar;
  TJob jobs[NJOBS];
  int ntile_prep; int pad0;
};

typedef const __attribute__((address_space(4))) Params CParams;

DI int get_tid_impl(int ws) { int t = (ws << 6) | (int)__builtin_amdgcn_mbcnt_hi(~0u, __builtin_amdgcn_mbcnt_lo(~0u, 0u)); asm volatile("" : "+v"(t)); return t; }
#define get_tid() get_tid_impl(g_wave_s)
DI int get_bid() { int t = blockIdx.x; asm volatile("" : "+s"(t)); return t; }
DI unsigned pk2(float a, float b) { f2_t v = {a, b}; bf2_t r = __builtin_convertvector(v, bf2_t); return __builtin_bit_cast(unsigned, r); }
DI float bflo(unsigned v) { return __uint_as_float(v << 16); }
DI float bfhi(unsigned v) { return __uint_as_float(v & 0xffff0000u); }
DI float bf1(u16 v) { return __uint_as_float(((unsigned)v) << 16); }
DI u16 f2bf(float a) { return (u16)(pk2(a, 0.f) & 0xffffu); }
DI float shfl_xor_l(float v, int lane, int o) { return __int_as_float(__builtin_amdgcn_ds_bpermute((lane ^ o) << 2, __float_as_int(v))); }
DI float wave_sum_l(float v, int lane) {
#pragma unroll
  for (int o = 32; o > 0; o >>= 1) v += shfl_xor_l(v, lane, o);
  return v;
}
DI float sigm(float x) { return 1.f / (1.f + __expf(-x)); }
DI uint4 pack8(float4 x, float4 y) { return make_uint4(pk2(x.x, x.y), pk2(x.z, x.w), pk2(y.x, y.y), pk2(y.z, y.w)); }
#define MFMA(a, b, c) __builtin_amdgcn_mfma_f32_32x32x16_bf16((a), (b), (c), 0, 0, 0)

#define HALF_BYTES (73728 + 1024)
#define SMEM_BYTES (2 * HALF_BYTES)
#define LDS_TOTAL (SMEM_BYTES + 32)

DI int job_dst_row(int kind, int n) {
  if (kind == 0) return n;
  if (kind == 1) return 256 * (n >> 7) + (n & 127);
  if (kind == 2) return 256 * (n >> 7) + 128 + (n & 127);
  if (kind == 3) { int h = n / 192, c = n - h * 192; if (c < 128) return h * 128 + c; c -= 128; const int x = c >> 5, cl = c & 31;
                   return 1024 + h * 64 + 32 * (cl >> 4) + 8 * ((cl >> 2) & 3) + 4 * x + (cl & 3); }
  return 1024 + n;
}

DI void prep_phase(CParams& p, char* smem, int g_wave_s) {
  const int tid = get_tid();
  {
    const int vt = tid & 255, half = tid >> 8;
    unsigned* Ts32 = (unsigned*)smem + half * (4 * 64 * 33);
    const int npair = (p.ntile_prep + 1) >> 1;
    for (int t2 = get_bid(); t2 < npair; t2 += gridDim.x) {
      const int t = 2 * t2 + half;
      const bool valid = t < p.ntile_prep;
      int j = 0;
#pragma unroll 1
      for (int q = 1; q < NJOBS; ++q) if (t >= p.jobs[q].tstart) j = q;
      const float* src = p.jobs[j].src; u16* dst = p.jobs[j].dst;
      const int K = p.jobs[j].K, N = p.jobs[j].N, kind = p.jobs[j].kind;
      const int lt = t - p.jobs[j].tstart;
      const int ntn = N >> 6, nst = (ntn + 3) >> 2;
      const int tk = lt / nst, st = lt - tk * nst;
      const int k0 = tk * 64;
      float4 v0[4][2], v1[4][2];
      if (valid) {
#pragma unroll
        for (int q = 0; q < 4; ++q) {
          const int tn = 4 * st + q;
          if (tn < ntn) {
#pragma unroll
            for (int i = 0; i < 2; ++i) {
              const int kp = (vt >> 4) + 16 * i, nc = (vt & 15) * 4;
              v0[q][i] = *(const float4*)(src + (long)(k0 + 2 * kp) * N + tn * 64 + nc);
              v1[q][i] = *(const float4*)(src + (long)(k0 + 2 * kp + 1) * N + tn * 64 + nc);
            }
          }
        }
      }
      __syncthreads();
      if (valid) {
#pragma unroll
        for (int q = 0; q < 4; ++q) {
          if (4 * st + q < ntn) {
#pragma unroll
            for (int i = 0; i < 2; ++i) {
              const int kp = (vt >> 4) + 16 * i, nc = (vt & 15) * 4;
              unsigned* T = Ts32 + q * (64 * 33);
              T[(nc + 0) * 33 + kp] = pk2(v0[q][i].x, v1[q][i].x); T[(nc + 1) * 33 + kp] = pk2(v0[q][i].y, v1[q][i].y);
              T[(nc + 2) * 33 + kp] = pk2(v0[q][i].z, v1[q][i].z); T[(nc + 3) * 33 + kp] = pk2(v0[q][i].w, v1[q][i].w);
            }
          }
        }
      }
      __syncthreads();
      if (valid) {
#pragma unroll
        for (int q = 0; q < 4; ++q) {
          const int tn = 4 * st + q;
          if (tn < ntn) {
            const int n = vt >> 2, kc = (vt & 3) * 16;
            const unsigned* s32 = Ts32 + q * (64 * 33) + n * 33 + (kc >> 1);
            uint4 a = make_uint4(s32[0], s32[1], s32[2], s32[3]);
            uint4 b = make_uint4(s32[4], s32[5], s32[6], s32[7]);
            u16* d = dst + (long)job_dst_row(kind, tn * 64 + n) * K + k0 + kc;
            *(uint4*)d = a; *(uint4*)(d + 8) = b;
          }
        }
      }
    }
  }
  const long gtid = (long)get_bid() * 512 + tid, gstride = (long)gridDim.x * 512;
  for (long e = gtid; e < 2L * 64 * 1024 / 8; e += gstride) {
    const int l = (int)(e / (64 * 1024 / 8)); const long r = e - (long)l * (64 * 1024 / 8);
    *(uint4*)(p.Win + (long)l * LDZ * 1024 + (long)DIN * 1024 + r * 8) = make_uint4(0, 0, 0, 0);
  }
  for (long e = gtid; e < 16384L * 32; e += gstride) {
    const int pos = (int)(e >> 5), i = (int)(e & 31);
    const float inv = powf(10000.0f, -(float)i / 32.0f);
    const float angf = (float)pos * inv;
    const double x = (double)angf;
    const double kq = rint(x * 0.63661977236758134308);
    const double y = (x - kq * 1.5707963267341256e+00) - kq * 6.0771005065061922e-11;
    const double y2 = y * y;
    const double s = y * (1.0 + y2 * (-1.0 / 6 + y2 * (1.0 / 120 + y2 * (-1.0 / 5040 + y2 * (1.0 / 362880 + y2 * (-1.0 / 39916800))))));
    const double c = 1.0 + y2 * (-0.5 + y2 * (1.0 / 24 + y2 * (-1.0 / 720 + y2 * (1.0 / 40320 + y2 * (-1.0 / 3628800 + y2 * (1.0 / 479001600))))));
    const int q = ((int)kq) & 3;
    double cc, ss;
    if (q == 0) { cc = c; ss = s; } else if (q == 1) { cc = -s; ss = c; } else if (q == 2) { cc = -c; ss = -s; } else { cc = s; ss = -c; }
    *(float2*)(p.rope + e * 2) = make_float2((float)cc, (float)ss);
  }
  for (long e = gtid; e < (long)M_ALL * 1024 / 4; e += gstride) {
    const long pe = (long)M_P * 1024 / 4;
    float4 v = e < pe ? ((const float4*)p.x_prompt)[e] : ((const float4*)p.x_sample)[e - pe];
    ((float4*)p.out)[e] = v;
  }
  if (get_bid() == 0 && tid < 16) p.ctr[tid] = 0u;
}

DI void norm_phase(float* __restrict__ h, const float* __restrict__ g, u16* __restrict__ out, const float* __restrict__ part, int nsplit, int g_wave_s) {
  const int tid = get_tid(); const int lane = tid & 63, w = tid >> 6;
  for (int row = get_bid() * 8 + w; row < M_ALL; row += gridDim.x * 8) {
    const float4* hr = (const float4*)(h + (long)row * 1024);
    float4 v[4]; float ss = 0.f;
#pragma unroll
    for (int i = 0; i < 4; ++i) v[i] = hr[lane + 64 * i];
    if (nsplit > 0 && row >= M_P) {
#pragma unroll 1
      for (int s_ = 0; s_ < nsplit; ++s_) {
        const float4* pr = (const float4*)(part + ((long)s_ * M_S + (row - M_P)) * 1024);
#pragma unroll
        for (int i = 0; i < 4; ++i) { const float4 q = pr[lane + 64 * i]; v[i].x += q.x; v[i].y += q.y; v[i].z += q.z; v[i].w += q.w; }
      }
#pragma unroll
      for (int i = 0; i < 4; ++i) ((float4*)(h + (long)row * 1024))[lane + 64 * i] = v[i];
    }
#pragma unroll
    for (int i = 0; i < 4; ++i) ss += v[i].x * v[i].x + v[i].y * v[i].y + v[i].z * v[i].z + v[i].w * v[i].w;
    ss = wave_sum_l(ss, lane);
    const float rs = rsqrtf(ss * (1.f / 1024.f) + EPSF);
#pragma unroll
    for (int i = 0; i < 4; ++i) {
      const float4 gg = ((const float4*)g)[lane + 64 * i];
      uint2 o = make_uint2(pk2(v[i].x * rs * gg.x, v[i].y * rs * gg.y), pk2(v[i].z * rs * gg.z, v[i].w * rs * gg.w));
      ((uint2*)(out + (long)row * 1024))[lane + 64 * i] = o;
    }
  }
}

struct TD { const char* A; const char* B; unsigned sa, sb; int nk; int pb; };
#define RED_OFF 73728

template <class Desc, class Epi>
DI void gemm_stream(int nloc, int nmax, Desc desc, Epi epi, char* smem_all, int g_wave_s) {
  const int tid = get_tid() & 255, lane = tid & 63, w = tid >> 6, wm = w >> 1, wn = w & 1, r = lane & 31, hh = lane >> 5;
  char* smem = smem_all + (get_tid() >> 8) * HALF_BYTES;
  u16* As = (u16*)smem;
  u16* Bs = As + 2 * 128 * 72;
  const int lrow = tid >> 3, lkc = (tid & 7) * 8;
  int ct = 0;
  if (nmax <= 0) return;
  TD ltd = desc(0);
  const int lrot = ((get_bid() >> 3) * 2 + (get_tid() >> 8)) % ltd.nk;
  uint4 S0a0, S0a1, S0a2, S0a3, S0b0, S0b1, S0b2, S0b3, S1a0, S1a1, S1a2, S1a3, S1b0, S1b1, S1b2, S1b3;
#define LD1(dst, base, off) dst = *(const uint4*)((base) + (size_t)(off));
#define GLOADS(S, kk) { \
    int kr_ = (kk) + lrot; kr_ = kr_ >= ltd.nk ? kr_ - ltd.nk : kr_; \
    const unsigned oa_ = lrow * ltd.sa + (unsigned)(kr_ * 64 + lkc) * 2u, ob_ = lrow * ltd.sb + (unsigned)(kr_ * 64 + lkc) * 2u; \
    LD1(S##a0, ltd.A, oa_) LD1(S##a1, ltd.A, oa_ + 32u * ltd.sa) LD1(S##a2, ltd.A, oa_ + 64u * ltd.sa) LD1(S##a3, ltd.A, oa_ + 96u * ltd.sa) \
    LD1(S##b0, ltd.B, ob_) LD1(S##b1, ltd.B, ob_ + 32u * ltd.sb) LD1(S##b2, ltd.B, ob_ + 64u * ltd.sb) LD1(S##b3, ltd.B, ob_ + 96u * ltd.sb) }
#define SST1(arr, src, i, buf) *(uint4*)(arr + ((buf) * 128 + lrow + 32 * (i)) * 72 + lkc) = src;
#define SSTORES(S, buf) { SST1(As, S##a0, 0, buf) SST1(As, S##a1, 1, buf) SST1(As, S##a2, 2, buf) SST1(As, S##a3, 3, buf) \
    SST1(Bs, S##b0, 0, buf) SST1(Bs, S##b1, 1, buf) SST1(Bs, S##b2, 2, buf) SST1(Bs, S##b3, 3, buf) }
#define COMPUTE(buf) { \
    const u16* Ab = As + ((buf) * 128 + 64 * wm + r) * 72 + 8 * hh; \
    const u16* Bb = Bs + ((buf) * 128 + 64 * wn + r) * 72 + 8 * hh; \
    _Pragma("unroll") for (int ks = 0; ks < 4; ++ks) { \
      bf16x8 a0 = *(const bf16x8*)(Ab + 16 * ks), a1 = *(const bf16x8*)(Ab + 32 * 72 + 16 * ks); \
      bf16x8 b0 = *(const bf16x8*)(Bb + 16 * ks), b1 = *(const bf16x8*)(Bb + 32 * 72 + 16 * ks); \
      acc[0][0] = MFMA(b0, a0, acc[0][0]); acc[0][1] = MFMA(b1, a0, acc[0][1]); \
      acc[1][0] = MFMA(b0, a1, acc[1][0]); acc[1][1] = MFMA(b1, a1, acc[1][1]); } }
#define SCHED_STEP() { \
    __builtin_amdgcn_sched_group_barrier(0x020, 8, 0); \
    __builtin_amdgcn_sched_group_barrier(0x100, 4, 0); \
    _Pragma("unroll") for (int q_ = 0; q_ < 4; ++q_) { __builtin_amdgcn_sched_group_barrier(0x008, 1, 0); __builtin_amdgcn_sched_group_barrier(0x100, 1, 0); } \
    _Pragma("unroll") for (int q_ = 0; q_ < 8; ++q_) { __builtin_amdgcn_sched_group_barrier(0x008, 1, 0); __builtin_amdgcn_sched_group_barrier(0x100, 1, 0); __builtin_amdgcn_sched_group_barrier(0x200, 1, 0); } \
    _Pragma("unroll") for (int q_ = 0; q_ < 4; ++q_) { __builtin_amdgcn_sched_group_barrier(0x008, 1, 0); } }

  GLOADS(S0, 0)
  GLOADS(S1, 1)
  SSTORES(S0, 0)
  __syncthreads();
#pragma unroll 1
  for (; ct < nmax; ++ct) {
    const int nk2 = ltd.nk >> 1;
    f32x16 acc[2][2];
#pragma unroll
    for (int mi = 0; mi < 2; ++mi)
#pragma unroll
      for (int ni = 0; ni < 2; ++ni)
#pragma unroll
        for (int i = 0; i < 16; ++i) acc[mi][ni][i] = 0.f;
#pragma unroll 1
    for (int k2 = 0; k2 < nk2; ++k2) {
      int kb = 2 * k2 + 2;
      if (k2 == nk2 - 1) { kb = 0; if (ct + 1 < nloc) ltd = desc(ct + 1); }
      GLOADS(S0, kb)
      COMPUTE(0)
      SSTORES(S1, 1)
      SCHED_STEP()
      __syncthreads();
      GLOADS(S1, kb + 1)
      COMPUTE(1)
      SSTORES(S0, 0)
      SCHED_STEP()
      __syncthreads();
    }
    if (ct < nloc) epi(ct, acc);
  }
#undef LD1
#undef GLOADS
#undef SST1
#undef SSTORES
#undef COMPUTE
#undef SCHED_STEP
}

typedef __attribute__((ext_vector_type(4))) float f32x4;
#define G8_HT (128 * 64)
DI int g8_lds_byte(int r, int c) { const int st = (r >> 4) * 2 + (c >> 5), rr = r & 15, cc = c & 31, ob = rr * 64 + cc * 2; return st * 1024 + (ob ^ (((ob >> 9) & 1) << 5)); }
DI void g8_stage_rc(int b, int& R, int& C) { const int st = b / 1024, sb = b % 1024, swz = sb ^ (((sb >> 9) & 1) << 5); R = (st >> 1) * 16 + swz / 64; C = (st & 1) * 32 + (swz % 64) / 2; }
DI int g8_perm32(int rho) { const int n = rho >> 4, i = rho & 15; return 8 * (i >> 2) + 4 * n + (i & 3); }

DI int g8_permT(int s_) { return 16 * ((s_ >> 3) & 1) + 8 * (s_ >> 4) + 4 * ((s_ >> 2) & 1) + (s_ & 3); }
template <int PERMB>
DI void gemm256_tile(const u16* __restrict__ A, const u16* __restrict__ Bt, int ld, int K, char* smem, f32x4 (&acc)[2][2][4][2], int g_wave_s) {
  u16* shm = (u16*)smem;
  const int tid = get_tid();
  const int wid = tid >> 6, lane = tid & 63, wr = wid >> 2, wc = wid & 3, fr = lane & 15, fq = lane >> 4;
#define G8_SA(b, h) (shm + ((b) * 2 + (h)) * G8_HT)
#define G8_SB(b, h) (shm + (4 + (b) * 2 + (h)) * G8_HT)
  int sr0, sc0;
  g8_stage_rc(tid * 16, sr0, sc0);
  const int br0 = PERMB == 1 ? ((sr0 & ~31) + g8_perm32(sr0 & 31)) : (PERMB == 2 ? ((sr0 & ~31) + g8_permT(sr0 & 31)) : sr0);
  const unsigned aoff0 = (unsigned)(sr0 * ld + sc0) * 2u;
  const unsigned boff0 = (unsigned)(br0 * ld + sc0) * 2u;
#define G8_STAGE_A(P, br, kt) do { const char* g_ = (const char*)(A + (long)(br) * ld + (long)(kt) * 64); \
    __builtin_amdgcn_global_load_lds((const unsigned*)(g_ + (size_t)aoff0), (unsigned*)((char*)(P) + tid * 16), 16, 0, 0); \
    __builtin_amdgcn_global_load_lds((const unsigned*)(g_ + (size_t)ld * 128 + (size_t)aoff0), (unsigned*)((char*)(P) + tid * 16 + 8192), 16, 0, 0); } while (0)
#define G8_STAGE_B(P, br, kt) do { const char* g_ = (const char*)(Bt + (long)(br) * ld + (long)(kt) * 64); \
    __builtin_amdgcn_global_load_lds((const unsigned*)(g_ + (size_t)boff0), (unsigned*)((char*)(P) + tid * 16), 16, 0, 0); \
    __builtin_amdgcn_global_load_lds((const unsigned*)(g_ + (size_t)ld * 128 + (size_t)boff0), (unsigned*)((char*)(P) + tid * 16 + 8192), 16, 0, 0); } while (0)
#define G8_LDA(dst, b, h) _Pragma("unroll") for (int m = 0; m < 4; ++m) _Pragma("unroll") for (int k = 0; k < 2; ++k) \
    dst[m][k] = *reinterpret_cast<const bf16x8*>((char*)G8_SA(b, h) + g8_lds_byte(wr * 64 + m * 16 + fr, k * 32 + fq * 8))
#define G8_LDB(dst, b, h) _Pragma("unroll") for (int n = 0; n < 2; ++n) _Pragma("unroll") for (int k = 0; k < 2; ++k) \
    dst[n][k] = *reinterpret_cast<const bf16x8*>((char*)G8_SB(b, h) + g8_lds_byte(wc * 32 + n * 16 + fr, k * 32 + fq * 8))
#define G8_MMA(ai, bj, At_, Bt_) do { __builtin_amdgcn_s_setprio(1); \
    _Pragma("unroll") for (int m = 0; m < 4; ++m) _Pragma("unroll") for (int n = 0; n < 2; ++n) _Pragma("unroll") for (int k = 0; k < 2; ++k) \
      acc[ai][bj][m][n] = __builtin_amdgcn_mfma_f32_16x16x32_bf16(Bt_[n][k], At_[m][k], acc[ai][bj][m][n], 0, 0, 0); \
    __builtin_amdgcn_s_setprio(0); } while (0)
#define G8_WAIT_V(n) asm volatile("s_waitcnt vmcnt(" #n ")" ::: "memory")
#define G8_WAIT_L(n) asm volatile("s_waitcnt lgkmcnt(" #n ")" ::: "memory")
#define G8_BAR __builtin_amdgcn_s_barrier()
#define G8_SCHED __builtin_amdgcn_sched_barrier(0)
#pragma unroll
  for (int ai = 0; ai < 2; ++ai)
#pragma unroll
    for (int bj = 0; bj < 2; ++bj)
#pragma unroll
      for (int m = 0; m < 4; ++m)
#pragma unroll
        for (int n = 0; n < 2; ++n) acc[ai][bj][m][n] = (f32x4){0.f, 0.f, 0.f, 0.f};
  bf16x8 At[4][2], B0[2][2], B1[2][2];
  const int nt = K >> 6;
  G8_STAGE_B(G8_SB(0, 0), 0, 0); G8_STAGE_A(G8_SA(0, 0), 0, 0);
  G8_STAGE_B(G8_SB(0, 1), 128, 0); G8_STAGE_A(G8_SA(0, 1), 128, 0);
  if (wr == 1) G8_BAR;
  G8_WAIT_V(4); G8_BAR;
  G8_STAGE_B(G8_SB(1, 0), 0, 1); G8_STAGE_A(G8_SA(1, 0), 0, 1); G8_STAGE_B(G8_SB(1, 1), 128, 1);
  G8_WAIT_V(6); G8_BAR;
#pragma unroll 1
  for (int t = 0; t < nt - 2; t += 2) {
    G8_LDB(B0, 0, 0); G8_SCHED; G8_LDA(At, 0, 0); G8_STAGE_A(G8_SA(1, 1), 128, t + 1);
    G8_WAIT_L(8); G8_BAR; G8_WAIT_L(0); G8_MMA(0, 0, At, B0); G8_BAR; G8_SCHED;
    G8_LDB(B1, 0, 1); G8_STAGE_B(G8_SB(0, 0), 0, t + 2);
    G8_BAR; G8_WAIT_L(0); G8_MMA(0, 1, At, B1); G8_BAR;
    G8_LDA(At, 0, 1); G8_STAGE_A(G8_SA(0, 0), 0, t + 2);
    G8_BAR; G8_WAIT_L(0); G8_MMA(1, 0, At, B0); G8_BAR; G8_SCHED;
    G8_STAGE_B(G8_SB(0, 1), 128, t + 2);
    G8_WAIT_V(6); G8_BAR; G8_MMA(1, 1, At, B1); G8_BAR;
    G8_LDB(B0, 1, 0); G8_SCHED; G8_LDA(At, 1, 0); G8_STAGE_A(G8_SA(0, 1), 128, t + 2);
    G8_WAIT_L(8); G8_BAR; G8_WAIT_L(0); G8_MMA(0, 0, At, B0); G8_BAR; G8_SCHED;
    G8_LDB(B1, 1, 1); G8_STAGE_B(G8_SB(1, 0), 0, t + 3);
    G8_BAR; G8_WAIT_L(0); G8_MMA(0, 1, At, B1); G8_BAR;
    G8_LDA(At, 1, 1); G8_STAGE_A(G8_SA(1, 0), 0, t + 3);
    G8_BAR; G8_WAIT_L(0); G8_MMA(1, 0, At, B0); G8_BAR; G8_SCHED;
    G8_STAGE_B(G8_SB(1, 1), 128, t + 3);
    G8_WAIT_V(6); G8_BAR; G8_MMA(1, 1, At, B1); G8_BAR;
  }
  { G8_LDB(B0, 0, 0); G8_LDA(At, 0, 0); G8_STAGE_A(G8_SA(1, 1), 128, nt - 1);
    G8_BAR; G8_WAIT_L(0); G8_MMA(0, 0, At, B0); G8_BAR;
    G8_LDB(B1, 0, 1); G8_BAR; G8_WAIT_L(0); G8_MMA(0, 1, At, B1); G8_BAR;
    G8_LDA(At, 0, 1); G8_WAIT_V(4); G8_BAR; G8_WAIT_L(0); G8_MMA(1, 0, At, B0); G8_MMA(1, 1, At, B1); G8_BAR; }
  { G8_LDB(B0, 1, 0); G8_LDA(At, 1, 0); G8_WAIT_V(2); G8_BAR; G8_WAIT_L(0); G8_MMA(0, 0, At, B0); G8_BAR;
    G8_LDB(B1, 1, 1); G8_WAIT_V(0); G8_BAR; G8_WAIT_L(0); G8_MMA(0, 1, At, B1); G8_BAR;
    G8_LDA(At, 1, 1); G8_BAR; G8_WAIT_L(0); G8_MMA(1, 0, At, B0); G8_MMA(1, 1, At, B1); G8_BAR; }
  if (wr == 0) G8_BAR;
}

#define G8_COORDS const int tid = get_tid(); const int wid = tid >> 6, lane = tid & 63, wr = wid >> 2, wc = wid & 3, fr = lane & 15, fq = lane >> 4; (void)wr; (void)wc; (void)fr; (void)fq;
DI int tok_pos(int m) { return m < M_P ? m : PAST + ((m - M_P) & 15); }
DI int perm_pos(int key) {
  const int g4 = (key >> 2) & 3;
  const int pg = (g4 == 1) ? 2 : ((g4 == 2) ? 1 : g4);
  return (key & ~15) + 4 * pg;
}

DI int nloc_plain(int total) { const int b = get_bid(), G = gridDim.x; return b < total ? (total - b + G - 1) / G : 0; }
DI void grouped_tile(int L, int nM, int nN, int& tm, int& tn) {
  const int nwg = nM * nN;
  const int q = nwg >> 3, rr = nwg & 7, xcd = L & 7, off = L >> 3;
  const int wgid = (xcd < rr ? xcd * (q + 1) : rr * (q + 1) + (xcd - rr) * q) + off;
  const int nig = 8 * nN, gid = wgid / nig, fm = gid * 8;
  const int gsz = (nM - fm) < 8 ? (nM - fm) : 8;
  const int rem = wgid - gid * nig;
  tm = fm + rem % gsz; tn = rem / gsz;
}
#define LANE_COORDS8 const int tid = get_tid(), lane = tid & 63, w = tid >> 6, wm = w >> 1, wn = w & 1, r = lane & 31, hh = lane >> 5; (void)wm; (void)wn; (void)r; (void)hh;

DI void ffn_up_phase(CParams& p, const u16* W, char* smem, int g_wave_s) {
  const int tid = get_tid();
  const int wid = tid >> 6, lane = tid & 63, wr = wid >> 2, wc = wid & 3, fr = lane & 15, fq = lane >> 4;
  const int NT = (2 * DFF) / 256;
  const int G = gridDim.x;
  for (int L = get_bid(); L < 66 * NT; L += G) {
    int tm, tn; grouped_tile(L, 66, NT, tm, tn);
    f32x4 acc[2][2][4][2];
    gemm256_tile<1>(p.NB + (long)tm * 256 * 1024, W + (long)tn * 256 * 1024, 1024, 1024, smem, acc, g_wave_s);
#pragma unroll
    for (int ai = 0; ai < 2; ++ai)
#pragma unroll
      for (int m = 0; m < 4; ++m) {
        const long row = (long)tm * 256 + 128 * ai + 64 * wr + 16 * m + fr;
        const int col = tn * 128 + 32 * wc + 8 * fq;
        float a[8];
#pragma unroll
        for (int n = 0; n < 2; ++n)
#pragma unroll
          for (int j = 0; j < 4; ++j) { const float g = acc[ai][0][m][n][j], u = acc[ai][1][m][n][j]; a[4 * n + j] = g * sigm(g) * u; }
        *(uint4*)(p.ACT + row * DFF + col) = make_uint4(pk2(a[0], a[1]), pk2(a[2], a[3]), pk2(a[4], a[5]), pk2(a[6], a[7]));
      }
  }
}

DI void win_phase(CParams& p, const u16* W, char* smem, int g_wave_s) {
  const int tid = get_tid();
  const int wid = tid >> 6, lane = tid & 63, wr = wid >> 2, wc = wid & 3, fr = lane & 15, fq = lane >> 4;
  const int NT = LDZ / 256;
  const int G = gridDim.x;
  for (int L = get_bid(); L < 66 * NT; L += G) {
    int tm, tn; grouped_tile(L, 66, NT, tm, tn);
    f32x4 acc[2][2][4][2];
    gemm256_tile<1>(p.NB + (long)tm * 256 * 1024, W + (long)tn * 256 * 1024, 1024, 1024, smem, acc, g_wave_s);
#pragma unroll
    for (int ai = 0; ai < 2; ++ai)
#pragma unroll
      for (int m = 0; m < 4; ++m) {
        const long row = (long)tm * 256 + 128 * ai + 64 * wr + 16 * m + fr;
#pragma unroll
        for (int bj = 0; bj < 2; ++bj) {
          const int col = tn * 256 + 128 * bj + 32 * wc + 8 * fq;
          *(uint4*)(p.Z + row * LDZ + col) = make_uint4(pk2(acc[ai][bj][m][0][0], acc[ai][bj][m][0][1]), pk2(acc[ai][bj][m][0][2], acc[ai][bj][m][0][3]),
                                                        pk2(acc[ai][bj][m][1][0], acc[ai][bj][m][1][1]), pk2(acc[ai][bj][m][1][2], acc[ai][bj][m][1][3]));
        }
      }
  }
}

DI void resid_gemm_phase(CParams& p, const u16* A, int K, const u16* W, float alpha, char* smem, int g_wave_s) {
  const int G = gridDim.x;
#pragma unroll 1
  for (int L = get_bid(); L < 64 * 4; L += G) {
    const int tm = L >> 2, tn = L & 3;
    f32x4 acc[2][2][4][2];
    gemm256_tile<1>(A + (long)tm * 256 * K, W + (long)tn * 256 * K, K, K, smem, acc, g_wave_s);
    G8_COORDS
#pragma unroll
    for (int ai = 0; ai < 2; ++ai)
#pragma unroll
      for (int m = 0; m < 4; ++m) {
        const long row = (long)tm * 256 + 128 * ai + 64 * wr + 16 * m + fr;
#pragma unroll
        for (int bj = 0; bj < 2; ++bj) {
          float4* hp = (float4*)(p.out + row * 1024 + tn * 256 + 128 * bj + 32 * wc + 8 * fq);
          float4 v0 = hp[0], v1 = hp[1];
          v0.x += alpha * acc[ai][bj][m][0][0]; v0.y += alpha * acc[ai][bj][m][0][1]; v0.z += alpha * acc[ai][bj][m][0][2]; v0.w += alpha * acc[ai][bj][m][0][3];
          v1.x += alpha * acc[ai][bj][m][1][0]; v1.y += alpha * acc[ai][bj][m][1][1]; v1.z += alpha * acc[ai][bj][m][1][2]; v1.w += alpha * acc[ai][bj][m][1][3];
          hp[0] = v0; hp[1] = v1;
        }
      }
  }
  const int nsplit = K >> 8;
#pragma unroll 1
  for (int it = get_bid(); it < 8 * nsplit; it += G) {
    const int tile = it / nsplit, ks = it - tile * nsplit;
    const int tm = 64 + (tile >> 2), tn = tile & 3;
    f32x4 acc[2][2][4][2];
    gemm256_tile<1>(A + (long)tm * 256 * K + ks * 256, W + (long)tn * 256 * K + ks * 256, K, 256, smem, acc, g_wave_s);
    G8_COORDS
#pragma unroll
    for (int ai = 0; ai < 2; ++ai)
#pragma unroll
      for (int m = 0; m < 4; ++m) {
        const long rs_ = (long)(tm - 64) * 256 + 128 * ai + 64 * wr + 16 * m + fr;
#pragma unroll
        for (int bj = 0; bj < 2; ++bj) {
          float4* pp = (float4*)(p.PART + ((long)ks * M_S + rs_) * 1024 + tn * 256 + 128 * bj + 32 * wc + 8 * fq);
          pp[0] = make_float4(alpha * acc[ai][bj][m][0][0], alpha * acc[ai][bj][m][0][1], alpha * acc[ai][bj][m][0][2], alpha * acc[ai][bj][m][0][3]);
          pp[1] = make_float4(alpha * acc[ai][bj][m][1][0], alpha * acc[ai][bj][m][1][1], alpha * acc[ai][bj][m][1][2], alpha * acc[ai][bj][m][1][3]);
        }
      }
  }
}

DI void ple_phase(CParams& p, const u16* W, char* smem, int g_wave_s) {
  const int G = gridDim.x;
#pragma unroll 1
  for (int L = get_bid(); L < 66 * 4; L += G) {
    const int tm = L >> 2, tn = L & 3;
    f32x4 acc[2][2][4][2];
    gemm256_tile<1>(p.NB + (long)tm * 256 * 1024, W + (long)tn * 256 * 1024, 1024, 1024, smem, acc, g_wave_s);
    G8_COORDS
#pragma unroll
    for (int ai = 0; ai < 2; ++ai)
#pragma unroll
      for (int m = 0; m < 4; ++m) {
        const long row = (long)tm * 256 + 128 * ai + 64 * wr + 16 * m + fr;
#pragma unroll
        for (int bj = 0; bj < 2; ++bj) {
          const int col = tn * 256 + 128 * bj + 32 * wc + 8 * fq;
          float4* hp = (float4*)(p.out + row * 1024 + col);
          const uint4 pp = *(const uint4*)(p.PP + row * 1024 + col);
          float4 v0 = hp[0], v1 = hp[1];
          v0.x += sigm(acc[ai][bj][m][0][0]) * bflo(pp.x); v0.y += sigm(acc[ai][bj][m][0][1]) * bfhi(pp.x);
          v0.z += sigm(acc[ai][bj][m][0][2]) * bflo(pp.y); v0.w += sigm(acc[ai][bj][m][0][3]) * bfhi(pp.y);
          v1.x += sigm(acc[ai][bj][m][1][0]) * bflo(pp.z); v1.y += sigm(acc[ai][bj][m][1][1]) * bfhi(pp.z);
          v1.z += sigm(acc[ai][bj][m][1][2]) * bflo(pp.w); v1.w += sigm(acc[ai][bj][m][1][3]) * bfhi(pp.w);
          hp[0] = v0; hp[1] = v1;
        }
      }
  }
}

DI void rowpost_phase(CParams& p, int l, int g_wave_s) {
  const int tid = get_tid(); const int lane = tid & 63, w = tid >> 6;
  const float* qan = p.qan + l * 384; const float* kvan = p.kvan + l * 512; const float* krn = p.krn + l * 64; const float* gvn = p.gvn + l * 1024;
  float* o_pkv = p.out + 17301504L + (long)l * M_P * 512;
  float* o_pkr = p.out + 34078720L + (long)l * M_P * 64;
  float* o_skv = p.out + 36175872L + (long)l * M_S * 512;
  float* o_skr = p.out + 36700160L + (long)l * M_S * 64;
  float* o_sgv = p.out + 36765696L + (long)l * M_S * 1024;
  for (int row = get_bid() * 8 + w; row < M_ALL; row += gridDim.x * 8) {
    const u16* zr = p.Z + (long)row * LDZ;
    const bool is_s = row >= M_P; const int rs_ = row - M_P;
    {
      unsigned v[3]; float ss = 0.f;
#pragma unroll
      for (int i = 0; i < 3; ++i) { v[i] = *(const unsigned*)(zr + ZQ + 2 * lane + 128 * i); const float a = bflo(v[i]), b = bfhi(v[i]); ss += a * a + b * b; }
      ss = wave_sum_l(ss, lane);
      const float rs = rsqrtf(ss * (1.f / 384.f) + EPSF);
#pragma unroll
      for (int i = 0; i < 3; ++i) {
        const int c = 2 * lane + 128 * i; const float2 g = *(const float2*)(qan + c);
        *(unsigned*)(p.QN + (long)row * 384 + c) = pk2(bflo(v[i]) * rs * g.x, bfhi(v[i]) * rs * g.y);
      }
    }
    {
      const uint4 v = *(const uint4*)(zr + ZKV + 8 * lane);
      float x[8] = {bflo(v.x), bfhi(v.x), bflo(v.y), bfhi(v.y), bflo(v.z), bfhi(v.z), bflo(v.w), bfhi(v.w)};
      float ss = 0.f;
#pragma unroll
      for (int i = 0; i < 8; ++i) ss += x[i] * x[i];
      ss = wave_sum_l(ss, lane);
      const float rs = rsqrtf(ss * (1.f / 512.f) + EPSF);
      const float4 g0 = *(const float4*)(kvan + 8 * lane), g1 = *(const float4*)(kvan + 8 * lane + 4);
      float4 y0 = make_float4(x[0] * rs * g0.x, x[1] * rs * g0.y, x[2] * rs * g0.z, x[3] * rs * g0.w);
      float4 y1 = make_float4(x[4] * rs * g1.x, x[5] * rs * g1.y, x[6] * rs * g1.z, x[7] * rs * g1.w);
      float* od = is_s ? (o_skv + (long)rs_ * 512) : (o_pkv + (long)row * 512);
      *(float4*)(od + 8 * lane) = y0; *(float4*)(od + 8 * lane + 4) = y1;
      *(uint4*)(p.C + (long)row * 512 + 8 * lane) = pack8(y0, y1);
    }
    {
      const float x = bf1(zr[ZKR + lane]);
      const float ss = wave_sum_l(x * x, lane);
      const float rs = rsqrtf(ss * (1.f / 64.f) + EPSF);
      const float y = x * rs * krn[lane];
      const float other = shfl_xor_l(y, lane, 32);
      const int pos = tok_pos(row);
      const float2 cs = *(const float2*)(p.rope + ((long)pos * 32 + (lane & 31)) * 2);
      const float o = lane < 32 ? (y * cs.x - other * cs.y) : (other * cs.y + y * cs.x);
      if (is_s) {
        o_skr[(long)rs_ * 64 + lane] = o;
        p.KRs[((long)(rs_ >> 4) * LKS + PAST + (rs_ & 15)) * 64 + lane] = f2bf(o);
      } else {
        o_pkr[(long)row * 64 + lane] = o;
        p.KRp[(long)row * 64 + lane] = f2bf(o);
      }
    }
    {
      uint4 v[2]; float ss = 0.f;
#pragma unroll
      for (int i = 0; i < 2; ++i) {
        v[i] = *(const uint4*)(zr + ZV + 8 * lane + 512 * i);
        const float x[8] = {bflo(v[i].x), bfhi(v[i].x), bflo(v[i].y), bfhi(v[i].y), bflo(v[i].z), bfhi(v[i].z), bflo(v[i].w), bfhi(v[i].w)};
#pragma unroll
        for (int j = 0; j < 8; ++j) ss += x[j] * x[j];
      }
      ss = wave_sum_l(ss, lane);
      const float rs = rsqrtf(ss * (1.f / 1024.f) + EPSF);
      if (lane == 0) p.rsv[row] = rs;
      if (is_s) {
#pragma unroll
        for (int i = 0; i < 2; ++i) {
          const int c = 8 * lane + 512 * i;
          const float x[8] = {bflo(v[i].x), bfhi(v[i].x), bflo(v[i].y), bfhi(v[i].y), bflo(v[i].z), bfhi(v[i].z), bflo(v[i].w), bfhi(v[i].w)};
          const float4 g0 = *(const float4*)(gvn + c), g1 = *(const float4*)(gvn + c + 4);
          *(float4*)(o_sgv + (long)rs_ * 1024 + c) = make_float4(x[0] * rs * g0.x, x[1] * rs * g0.y, x[2] * rs * g0.z, x[3] * rs * g0.w);
          *(float4*)(o_sgv + (long)rs_ * 1024 + c + 4) = make_float4(x[4] * rs * g1.x, x[5] * rs * g1.y, x[6] * rs * g1.z, x[7] * rs * g1.w);
        }
      }
    }
  }
  {
    const float* cc = p.cache_c + (long)l * 32 * PAST * 512;
    const long gt = (long)get_bid() * 512 + tid, gs = (long)gridDim.x * 512;
    for (long e = gt; e < 32L * PAST * 512 / 8; e += gs) {
      const float4 a = *(const float4*)(cc + e * 8), c = *(const float4*)(cc + e * 8 + 4);
      *(uint4*)(p.CB + e * 8) = pack8(a, c);
    }
    const float* pp = p.p_prompt + (long)l * M_P * 256; const float* ps = p.p_sample + (long)l * M_S * 256;
    for (long e = gt; e < (long)M_ALL * 256 / 8; e += gs) {
      const long pe = (long)M_P * 256 / 8;
      const float* src = e < pe ? (pp + e * 8) : (ps + (e - pe) * 8);
      *(uint4*)(p.PB + e * 8) = pack8(*(const float4*)src, *(const float4*)(src + 4));
    }
  }
  const float* ckr = p.cache_kr + (long)l * 32 * PAST * 64;
  const long gtid = (long)get_bid() * 512 + tid, gstride = (long)gridDim.x * 512;
  for (long e = gtid; e < 32L * PAST * 64 / 8; e += gstride) {
    const long el = e * 8; const int b = (int)(el / (PAST * 64)); const long rem = el - (long)b * PAST * 64;
    const float4 a = *(const float4*)(ckr + el), c = *(const float4*)(ckr + el + 4);
    *(uint4*)(p.KRs + (long)b * LKS * 64 + rem) = pack8(a, c);
  }
}

#define NCKV (512 * 8)
#define NPKV (64 * 8)
#define NSKV (2 * 8)
#define NQT (66 * 6)
#define NPPT (66 * 4)
#define RED8_OFF 131072
template <class RowPtr>
DI void nope_epi256(f32x4 (&acc)[2][2][4][2], const float* __restrict__ gain, float scale, char* smem, RowPtr rowptr, int g_wave_s) {
  const int tid = get_tid();
  const int wid = tid >> 6, lane = tid & 63, wr = wid >> 2, wc = wid & 3, fr = lane & 15, fq = lane >> 4;
  float* red = (float*)(smem + RED8_OFF);
#pragma unroll
  for (int ai = 0; ai < 2; ++ai)
#pragma unroll
    for (int bj = 0; bj < 2; ++bj)
#pragma unroll
      for (int m = 0; m < 4; ++m) {
        float s = 0.f;
#pragma unroll
        for (int n = 0; n < 2; ++n)
#pragma unroll
          for (int j = 0; j < 4; ++j) s += acc[ai][bj][m][n][j] * acc[ai][bj][m][n][j];
        s += shfl_xor_l(s, lane, 16); s += shfl_xor_l(s, lane, 32);
        if (fq == 0) red[((wc * 2 + ai) * 2 + bj) * 128 + 64 * wr + 16 * m + fr] = s;
      }
  __syncthreads();
  const int c = 32 * wc + 8 * fq;
  const float4 ga = *(const float4*)(gain + c), gb = *(const float4*)(gain + c + 4);
#pragma unroll
  for (int ai = 0; ai < 2; ++ai)
#pragma unroll
    for (int bj = 0; bj < 2; ++bj)
#pragma unroll
      for (int m = 0; m < 4; ++m) {
        const int rl = 64 * wr + 16 * m + fr;
        float tot = 0.f;
#pragma unroll
        for (int q = 0; q < 4; ++q) tot += red[((q * 2 + ai) * 2 + bj) * 128 + rl];
        const float rs = rsqrtf(tot * (1.f / 128.f) + EPSF) * scale;
        u16* op = rowptr(128 * ai + rl, bj);
        *(uint4*)(op + c) = make_uint4(pk2(acc[ai][bj][m][0][0] * rs * ga.x, acc[ai][bj][m][0][1] * rs * ga.y), pk2(acc[ai][bj][m][0][2] * rs * ga.z, acc[ai][bj][m][0][3] * rs * ga.w),
                                       pk2(acc[ai][bj][m][1][0] * rs * gb.x, acc[ai][bj][m][1][1] * rs * gb.y), pk2(acc[ai][bj][m][1][2] * rs * gb.z, acc[ai][bj][m][1][3] * rs * gb.w));
      }
}

DI void vt_epi256(CParams& p, f32x4 (&acc)[2][2][4][2], int mode, int m0, int tn, int g_wave_s) {
  G8_COORDS
  const long dstride = (mode == 0) ? (long)M_P : (long)LKS;
#pragma unroll
  for (int bj = 0; bj < 2; ++bj) {
    const int m32 = m0 + 128 * bj + 32 * wc;
#pragma unroll
    for (int ai = 0; ai < 2; ++ai) {
      const int h = 2 * (tn - 4) + ai;
      u16* base;
      if (mode == 0) base = p.VTp + (long)h * 128 * M_P + m32 + 8 * fq;
      else if (mode == 1) base = p.VTs + ((long)(m32 >> 12) * 8 + h) * 128 * LKS + (m32 & 4095) + 8 * fq;
      else base = p.VTs + ((long)((m32 >> 4) + (fq >> 1)) * 8 + h) * 128 * LKS + PAST + 8 * (fq & 1);
#pragma unroll
      for (int m = 0; m < 4; ++m) {
        const int dd = 64 * wr + 16 * m + fr;
        *(uint4*)(base + (long)dd * dstride) = make_uint4(pk2(acc[ai][bj][m][0][0], acc[ai][bj][m][0][1]), pk2(acc[ai][bj][m][0][2], acc[ai][bj][m][0][3]),
                                                          pk2(acc[ai][bj][m][1][0], acc[ai][bj][m][1][1]), pk2(acc[ai][bj][m][1][2], acc[ai][bj][m][1][3]));
      }
    }
  }
}
DI void rope_epi256(CParams& p, int l, f32x4 (&acc)[2][2][4][2], int tm, int tn, char* smem, int g_wave_s) {
  G8_COORDS
  float* red = (float*)(smem + RED8_OFF);
#pragma unroll
  for (int ai = 0; ai < 2; ++ai)
#pragma unroll
    for (int bj = 0; bj < 2; ++bj)
#pragma unroll
      for (int m = 0; m < 4; ++m) {
        float s = 0.f;
#pragma unroll
        for (int n = 0; n < 2; ++n)
#pragma unroll
          for (int j = 0; j < 4; ++j) s += acc[ai][bj][m][n][j] * acc[ai][bj][m][n][j];
        s += shfl_xor_l(s, lane, 16); s += shfl_xor_l(s, lane, 32);
        if (fq == 0) red[((wc * 2 + ai) * 2 + bj) * 128 + 64 * wr + 16 * m + fr] = s;
      }
  __syncthreads();
  const float* g = p.qrn + l * 64;
  const int c0 = 16 * (wc & 1) + 4 * fq;
  const float4 g1 = *(const float4*)(g + c0), g2 = *(const float4*)(g + 32 + c0);
  const float gg1[4] = {g1.x, g1.y, g1.z, g1.w}, gg2[4] = {g2.x, g2.y, g2.z, g2.w};
#pragma unroll
  for (int ai = 0; ai < 2; ++ai)
#pragma unroll
    for (int m = 0; m < 4; ++m) {
      const int rl = 64 * wr + 16 * m + fr;
      const int row = tm * 256 + 128 * ai + rl;
      const int pos = tok_pos(row);
      const float4 t0 = *(const float4*)(p.rope + ((long)pos * 32 + c0) * 2);
      const float4 t1 = *(const float4*)(p.rope + ((long)pos * 32 + c0) * 2 + 4);
      const float cs[4] = {t0.x, t0.z, t1.x, t1.z}, sn[4] = {t0.y, t0.w, t1.y, t1.w};
#pragma unroll
      for (int bj = 0; bj < 2; ++bj) {
        const float tot = red[((wc * 2 + ai) * 2 + bj) * 128 + rl] + red[(((wc ^ 1) * 2 + ai) * 2 + bj) * 128 + rl];
        const float rs = rsqrtf(tot * (1.f / 64.f) + EPSF);
        const int head = 4 * (tn - 4) + 2 * bj + (wc >> 1);
        u16* qp = p.Q + ((long)row * 8 + head) * 192 + 128;
        float o1[4], o2[4];
#pragma unroll
        for (int j = 0; j < 4; ++j) {
          const float y1 = acc[ai][bj][m][0][j] * rs * gg1[j], y2 = acc[ai][bj][m][1][j] * rs * gg2[j];
          o1[j] = (y1 * cs[j] - y2 * sn[j]) * QSCALE; o2[j] = (y1 * sn[j] + y2 * cs[j]) * QSCALE;
        }
        *(uint2*)(qp + c0) = make_uint2(pk2(o1[0], o1[1]), pk2(o1[2], o1[3]));
        *(uint2*)(qp + 32 + c0) = make_uint2(pk2(o2[0], o2[1]), pk2(o2[2], o2[3]));
      }
    }
}
DI void pp_epi256(CParams& p, f32x4 (&acc)[2][2][4][2], int tm, int tn, int g_wave_s) {
  G8_COORDS
#pragma unroll
  for (int ai = 0; ai < 2; ++ai)
#pragma unroll
    for (int m = 0; m < 4; ++m) {
      const long row = (long)tm * 256 + 128 * ai + 64 * wr + 16 * m + fr;
#pragma unroll
      for (int bj = 0; bj < 2; ++bj) {
        const int col = tn * 256 + 128 * bj + 32 * wc + 8 * fq;
        *(uint4*)(p.PP + row * 1024 + col) = make_uint4(pk2(acc[ai][bj][m][0][0], acc[ai][bj][m][0][1]), pk2(acc[ai][bj][m][0][2], acc[ai][bj][m][0][3]),
                                                        pk2(acc[ai][bj][m][1][0], acc[ai][bj][m][1][1]), pk2(acc[ai][bj][m][1][2], acc[ai][bj][m][1][3]));
      }
    }
}

DI void multi_phase(CParams& p, int l, char* smem, int g_wave_s) {
  const u16* Wkv = p.Wkv + (long)l * 2048 * 512;
  const u16* Wuq = p.Wuq + (long)l * 1536 * 384;
  const u16* Wpe = p.Wpe + (long)l * 1024 * 256;
  const int total = NCKV + NPKV + NSKV + NQT + NPPT;
  const int G = gridDim.x;
#pragma unroll 1
  for (int t = get_bid(); t < NCKV + NPKV + NSKV; t += G) {
    f32x4 acc[2][2][4][2];
    {
      const u16* tok; int u = t, mode;
      if (u < NCKV) { tok = p.CB + (long)(u >> 3) * 256 * 512; mode = 1; }
      else if ((u -= NCKV) < NPKV) { tok = p.C + (long)(u >> 3) * 256 * 512; mode = 0; }
      else { u -= NPKV; tok = p.C + ((long)M_P + (u >> 3) * 256) * 512; mode = 2; }
      const int m0 = (u >> 3) * 256, tn = u & 7;
      const u16* wgt = Wkv + (long)tn * 256 * 512;
      if (tn < 4) {
        gemm256_tile<1>(tok, wgt, 512, 512, smem, acc, g_wave_s);
        nope_epi256(acc, p.knn + l * 128, 1.0f, smem, [&](int rloc, int bj) -> u16* {
          const int m = m0 + rloc; const int h = 2 * tn + bj;
          if (mode == 0) return p.Knp + ((long)m * 8 + h) * 128;
          long key;
          if (mode == 1) key = (long)(m >> 12) * LKS + (m & 4095); else key = (long)(m >> 4) * LKS + PAST + (m & 15);
          return p.Kns + (key * 8 + h) * 128;
        }, g_wave_s);
      } else {
        gemm256_tile<2>(wgt, tok, 512, 512, smem, acc, g_wave_s);
        vt_epi256(p, acc, mode, m0, tn, g_wave_s);
      }
    }
  }
#pragma unroll 1
  for (int t = get_bid() + ((NCKV + NPKV + NSKV) / G) * G; t < total; t += G) {
    if (t < NCKV + NPKV + NSKV) continue;
    f32x4 acc[2][2][4][2];
    int u = t - (NCKV + NPKV + NSKV);
    if (u < NQT) {
      const int tm = u / 6, tn = u - tm * 6;
      gemm256_tile<1>(p.QN + (long)tm * 256 * 384, Wuq + (long)tn * 256 * 384, 384, 384, smem, acc, g_wave_s);
      if (tn < 4) nope_epi256(acc, p.qnn + l * 128, QSCALE, smem, [&](int rloc, int bj) -> u16* { return p.Q + ((long)(tm * 256 + rloc) * 8 + 2 * tn + bj) * 192; }, g_wave_s);
      else rope_epi256(p, l, acc, tm, tn, smem, g_wave_s);
      continue;
    }
    u -= NQT;
    {
      const int tm = u >> 2, tn = u & 3;
      gemm256_tile<1>(p.PB + (long)tm * 256 * 256, Wpe + (long)tn * 256 * 256, 256, 256, smem, acc, g_wave_s);
      pp_epi256(p, acc, tm, tn, g_wave_s);
    }
  }
}

#define ASTAGE 40960
DI void attn_item(const u16* __restrict__ Qb, int qclamp, const u16* __restrict__ Kn, const u16* __restrict__ KR,
                  const u16* __restrict__ VT, long vt_stride, int ntiles, int ntw, int Lk, u16* __restrict__ Ob, char* smem, int g_wave_s) {
  const int tid = get_tid(), lane = tid & 63, w = tid >> 6, r = lane & 31, hh = lane >> 5;
  bf16x8 qf[12];
  {
    const int qr = r < qclamp ? r : qclamp;
    const u16* qp = Qb + (long)(32 * w + qr) * (8 * 192) + 8 * hh;
#pragma unroll
    for (int ks = 0; ks < 12; ++ks) qf[ks] = *(const bf16x8*)(qp + 16 * ks);
  }
  f32x16 oacc[4];
#pragma unroll
  for (int dt = 0; dt < 4; ++dt)
#pragma unroll
    for (int i = 0; i < 16; ++i) oacc[dt][i] = 0.f;
  float mrun = 0.f, lrun = 0.f;

  const int lrow = tid >> 3, lq = tid & 7;
  const int sch = lq ^ ((lrow >> 1) & 7);
  unsigned koff = (unsigned)(lrow * 1024 + sch * 8) * 2u;
  unsigned kroff = (unsigned)(lrow * 64 + sch * 8) * 2u;
  const unsigned vstep = (unsigned)(64 * vt_stride * 2);
  unsigned voff = (unsigned)(lrow * vt_stride * 2 + sch * 16);
  const char* KnB = (const char*)Kn; const char* KRB = (const char*)KR; const char* VTB = (const char*)VT;
  char* dstT = smem + tid * 16;
#define ADMA(st_) { char* d_ = dstT + (st_) * ASTAGE; \
    __builtin_amdgcn_global_load_lds((const unsigned*)(KnB + (size_t)koff), (unsigned*)(d_), 16, 0, 0); \
    __builtin_amdgcn_global_load_lds((const unsigned*)(KnB + (size_t)koff + 128), (unsigned*)(d_ + 8192), 16, 0, 0); \
    __builtin_amdgcn_global_load_lds((const unsigned*)(KRB + (size_t)kroff), (unsigned*)(d_ + 16384), 16, 0, 0); \
    __builtin_amdgcn_global_load_lds((const unsigned*)(VTB + (size_t)voff), (unsigned*)(d_ + 24576), 16, 0, 0); \
    __builtin_amdgcn_global_load_lds((const unsigned*)(VTB + (size_t)(voff + vstep)), (unsigned*)(d_ + 32768), 16, 0, 0); \
    koff += 64 * 1024 * 2; kroff += 64 * 64 * 2; voff += 128; }
  const int xr = (r >> 1) & 7;
  const int xo0 = ((0 + hh) ^ xr) << 4, xo1 = ((2 + hh) ^ xr) << 4, xo2 = ((4 + hh) ^ xr) << 4, xo3 = ((6 + hh) ^ xr) << 4;
  const char* rbase = smem + r * 128;

  f32x16 sacc[2];
#define KFRAG(sb_, ks_, kt_) (*(const bf16x8*)((sb_) + ((ks_) >> 2) * 8192 + (kt_) * 4096 + ((((ks_) & 3) == 0) ? xo0 : (((ks_) & 3) == 1) ? xo1 : (((ks_) & 3) == 2) ? xo2 : xo3)))
#define VFRAG(sb_, dt_, q_) (*(const bf16x8*)((sb_) + 24576 + (dt_) * 4096 + (((q_) == 0) ? xo0 : ((q_) == 1) ? xo1 : ((q_) == 2) ? xo2 : xo3)))
#define ATT_S(st_) { \
    { const float ninit = -mrun; _Pragma("unroll") for (int kt = 0; kt < 2; ++kt) _Pragma("unroll") for (int i = 0; i < 16; ++i) sacc[kt][i] = ninit; }     \
    const char* sb = rbase + (st_) * ASTAGE; \
    _Pragma("unroll") for (int ks = 0; ks < 12; ++ks) { \
      bf16x8 k0 = KFRAG(sb, ks, 0); \
      bf16x8 k1 = KFRAG(sb, ks, 1); \
      sacc[0] = MFMA(k0, qf[ks], sacc[0]); \
      sacc[1] = MFMA(k1, qf[ks], sacc[1]); \
      if ((ks & 3) == 3) __builtin_amdgcn_sched_barrier(0); } }
#define ATT_PV(jt_, st_) { \
    if (((jt_) + 1) * 64 > Lk) { \
      _Pragma("unroll") for (int kt = 0; kt < 2; ++kt) _Pragma("unroll") for (int i = 0; i < 16; ++i) { \
          const int key = (jt_) * 64 + 32 * kt + (i & 3) + 8 * (i >> 2) + 4 * hh; \
          if (key >= Lk) sacc[kt][i] = -INFINITY; } } \
    float tmax = -INFINITY; \
    _Pragma("unroll") for (int kt = 0; kt < 2; ++kt) _Pragma("unroll") for (int i = 0; i < 16; ++i) tmax = fmaxf(tmax, sacc[kt][i]); \
    tmax = fmaxf(tmax, shfl_xor_l(tmax, lane, 32)); \
      \
    if (__builtin_amdgcn_ballot_w64(tmax > 8.0f) != 0ull) { \
      const float dlt = fmaxf(tmax, 0.f); \
      const float alpha = __builtin_amdgcn_exp2f(-dlt); \
      mrun += dlt; \
      lrun *= alpha; \
      _Pragma("unroll") for (int kt = 0; kt < 2; ++kt) _Pragma("unroll") for (int i = 0; i < 16; ++i) sacc[kt][i] -= dlt; \
      _Pragma("unroll") for (int dt = 0; dt < 4; ++dt) _Pragma("unroll") for (int i = 0; i < 16; ++i) oacc[dt][i] *= alpha; \
    } \
    float psum = 0.f; \
    _Pragma("unroll") for (int kt = 0; kt < 2; ++kt) _Pragma("unroll") for (int i = 0; i < 16; ++i) { const float pv = __builtin_amdgcn_exp2f(sacc[kt][i]); sacc[kt][i] = pv; psum += pv; } \
    lrun += psum; \
    bf16x8 pf[2][2]; \
    _Pragma("unroll") for (int kt = 0; kt < 2; ++kt) _Pragma("unroll") for (int s = 0; s < 2; ++s) { \
        uint4 pp = make_uint4(pk2(sacc[kt][8 * s + 0], sacc[kt][8 * s + 1]), pk2(sacc[kt][8 * s + 2], sacc[kt][8 * s + 3]), \
                              pk2(sacc[kt][8 * s + 4], sacc[kt][8 * s + 5]), pk2(sacc[kt][8 * s + 6], sacc[kt][8 * s + 7])); \
        pf[kt][s] = __builtin_bit_cast(bf16x8, pp); } \
    const char* sb = rbase + (st_) * ASTAGE; \
    _Pragma("unroll") for (int dt = 0; dt < 4; ++dt) _Pragma("unroll") for (int kt = 0; kt < 2; ++kt) _Pragma("unroll") for (int s = 0; s < 2; ++s) { \
          bf16x8 vf = VFRAG(sb, dt, 2 * kt + s); \
          oacc[dt] = MFMA(vf, pf[kt][s], oacc[dt]); \
          if (kt == 1 && s == 1) __builtin_amdgcn_sched_barrier(0); } }

  ADMA(0)
  int st = 0;
#pragma unroll 1
  for (int jt = 0; jt < ntiles; ++jt) {
    asm volatile("s_waitcnt vmcnt(0)" ::: "memory");
    __syncthreads();
    const int stn = st == 2 ? 0 : st + 1;
    if (jt + 1 < ntiles) ADMA(stn)
    if (jt < ntw) { ATT_S(st) ATT_PV(jt, st) }
    st = stn;
  }
#undef ATT_S
#undef ATT_PV
#undef KFRAG
#undef VFRAG
#undef ADMA
  if (ntw > 0 && r <= qclamp) {
    const float ltot = lrun + shfl_xor_l(lrun, lane, 32);
    const float inv = 1.f / ltot;
    u16* op = Ob + (long)(32 * w + r) * 1024;
#pragma unroll
    for (int dt = 0; dt < 4; ++dt)
#pragma unroll
      for (int i4 = 0; i4 < 4; ++i4) {
        const int d = 32 * dt + 8 * i4 + 4 * hh;
        *(uint2*)(op + d) = make_uint2(pk2(oacc[dt][4 * i4 + 0] * inv, oacc[dt][4 * i4 + 1] * inv), pk2(oacc[dt][4 * i4 + 2] * inv, oacc[dt][4 * i4 + 3] * inv));
      }
  } else if (ntw > 0) {
    (void)shfl_xor_l(lrun, lane, 32);
  }
}

DI void attn_phase(CParams& p, int l, char* smem, int* s_item, int cidx, int g_wave_s) {
  const int tid = get_tid(), w = tid >> 6;
  const int NITEM = 256 + 512;
  for (;;) {
    __syncthreads();
    if (tid == 0) *s_item = (int)atomicAdd(p.ctr + cidx, 1u);
    __syncthreads();
    const int item = *s_item;
    if (item >= NITEM) break;
    if (item < 256) {
      const int b = item >> 3, h = item & 7;
      const u16* Qb = p.Q + ((long)(M_P + 16 * b) * 8 + h) * 192;
      const u16* Kn = p.Kns + ((long)b * LKS * 8 + h) * 128;
      const u16* KR = p.KRs + (long)b * LKS * 64;
      const u16* VT = p.VTs + ((long)b * 8 + h) * 128 * LKS;
      u16* Ob = p.OA + (long)(M_P + 16 * b) * 1024 + h * 128;
      attn_item(Qb, 15, Kn, KR, VT, LKS, 65, w == 0 ? 65 : 0, LKV, Ob, smem, g_wave_s);
    } else {
      const int idx = item - 256;
      const int qb = 63 - (idx >> 3), h = idx & 7;
      const u16* Qb = p.Q + ((long)(256 * qb) * 8 + h) * 192;
      const u16* Kn = p.Knp + (long)h * 128;
      const u16* KR = p.KRp;
      const u16* VT = p.VTp + (long)h * 128 * M_P;
      u16* Ob = p.OA + (long)(256 * qb) * 1024 + h * 128;
      const int ntiles = 4 * qb + 4;
      attn_item(Qb, 31, Kn, KR, VT, M_P, ntiles, 4 * qb + (w >> 1) + 1, 1 << 30, Ob, smem, g_wave_s);
    }
  }
}

DI void gmlp_phase(CParams& p, int l, char* smem_all, int g_wave_s) {
  const int half = get_tid() >> 8; char* smem = smem_all + half * HALF_BYTES;
  const int tid = get_tid() & 255, lane = tid & 63, w = tid >> 6, wm = w >> 1, wn = w & 1, r = lane & 31, hh = lane >> 5;
  const float* gvn = p.gvn + l * 1024;
  const float* gws = p.gws + (long)l * 8 * 128 * 128;
  const float* gbs = p.gbs + (long)l * 8 * 128;
  u16* Xs = (u16*)smem;
  u16* Ws = Xs + 128 * 136;
  const int NP = 128 * 8, NS = 32 * 4;
  for (int t2 = get_bid(); t2 < (NP + NS + 1) / 2; t2 += gridDim.x) {
    const int t = 2 * t2 + half;
    const bool valid = t < NP + NS;
    const bool isp = valid && t < NP;
    {
      const int ci = t >> 3, g = t & 7;
      const int t0 = ci * 128, c0 = g * 128;
      __syncthreads();
      if (isp) {
      {
        unsigned* Xs32 = (unsigned*)Xs;
#pragma unroll
        for (int i = 0; i < 4; ++i) {
          const int sp = (tid & 15) + 16 * i, dq = (tid >> 4) & 15, dc = dq * 8;
          const int sl0 = (dc & ~15) | ((dq & 1) ? 4 : 0), sl1 = (dc & ~15) | ((dq & 1) ? 12 : 8);
          const uint4 v0 = *(const uint4*)(p.Z + (long)(t0 + 2 * sp) * LDZ + ZV + c0 + dc);
          const uint4 v1 = *(const uint4*)(p.Z + (long)(t0 + 2 * sp + 1) * LDZ + ZV + c0 + dc);
          const float r0 = p.rsv[t0 + 2 * sp], r1 = p.rsv[t0 + 2 * sp + 1];
          const float4 g0 = *(const float4*)(gvn + c0 + dc), g1 = *(const float4*)(gvn + c0 + dc + 4);
          Xs32[(sl0 + 0) * 68 + sp] = pk2(bflo(v0.x) * r0 * g0.x, bflo(v1.x) * r1 * g0.x); Xs32[(sl0 + 1) * 68 + sp] = pk2(bfhi(v0.x) * r0 * g0.y, bfhi(v1.x) * r1 * g0.y);
          Xs32[(sl0 + 2) * 68 + sp] = pk2(bflo(v0.y) * r0 * g0.z, bflo(v1.y) * r1 * g0.z); Xs32[(sl0 + 3) * 68 + sp] = pk2(bfhi(v0.y) * r0 * g0.w, bfhi(v1.y) * r1 * g0.w);
          Xs32[(sl1 + 0) * 68 + sp] = pk2(bflo(v0.z) * r0 * g1.x, bflo(v1.z) * r1 * g1.x); Xs32[(sl1 + 1) * 68 + sp] = pk2(bfhi(v0.z) * r0 * g1.y, bfhi(v1.z) * r1 * g1.y);
          Xs32[(sl1 + 2) * 68 + sp] = pk2(bflo(v0.w) * r0 * g1.z, bflo(v1.w) * r1 * g1.z); Xs32[(sl1 + 3) * 68 + sp] = pk2(bfhi(v0.w) * r0 * g1.w, bfhi(v1.w) * r1 * g1.w);
        }
      }
#pragma unroll
      for (int i = 0; i < 8; ++i) {
        const int c = tid + 256 * i;
        const int tt = c >> 4, sc = (c & 15) * 8;
        const float* wp = gws + ((long)g * 128 + tt) * 128 + sc;
        float4 a = *(const float4*)wp, b = *(const float4*)(wp + 4);
        a.x = (sc + 0 <= tt) ? a.x : 0.f; a.y = (sc + 1 <= tt) ? a.y : 0.f; a.z = (sc + 2 <= tt) ? a.z : 0.f; a.w = (sc + 3 <= tt) ? a.w : 0.f;
        b.x = (sc + 4 <= tt) ? b.x : 0.f; b.y = (sc + 5 <= tt) ? b.y : 0.f; b.z = (sc + 6 <= tt) ? b.z : 0.f; b.w = (sc + 7 <= tt) ? b.w : 0.f;
        *(uint4*)(Ws + tt * 136 + sc) = pack8(a, b);
      }
      }
      __syncthreads();
      if (isp) {
      f32x16 acc[2][2];
#pragma unroll
      for (int mi = 0; mi < 2; ++mi)
#pragma unroll
        for (int ni = 0; ni < 2; ++ni)
#pragma unroll
          for (int i = 0; i < 16; ++i) acc[mi][ni][i] = 0.f;
      const u16* Ab = Ws + (64 * wm + r) * 136 + 8 * hh;
      const u16* Bb = Xs + (64 * wn + r) * 136 + 8 * hh;
#pragma unroll
      for (int ks = 0; ks < 8; ++ks) {
        bf16x8 a0 = *(const bf16x8*)(Ab + 16 * ks), a1 = *(const bf16x8*)(Ab + 32 * 136 + 16 * ks);
        bf16x8 b0 = *(const bf16x8*)(Bb + 16 * ks), b1 = *(const bf16x8*)(Bb + 32 * 136 + 16 * ks);
        acc[0][0] = MFMA(b0, a0, acc[0][0]); acc[0][1] = MFMA(b1, a0, acc[0][1]);
        acc[1][0] = MFMA(b0, a1, acc[1][0]); acc[1][1] = MFMA(b1, a1, acc[1][1]);
      }
#pragma unroll
      for (int mi = 0; mi < 2; ++mi) {
        const int tl = 64 * wm + 32 * mi + r;
        const long row = t0 + tl;
        const float bias = gbs[g * 128 + tl];
        const u16* zr = p.Z + row * LDZ;
#pragma unroll
        for (int ni = 0; ni < 2; ++ni)
#pragma unroll
          for (int g8 = 0; g8 < 2; ++g8) {
            const int col = c0 + 64 * wn + 32 * ni + 16 * g8 + 8 * hh;
            const uint4 uu = *(const uint4*)(zr + ZU + col), ga = *(const uint4*)(zr + ZGA + col), gb = *(const uint4*)(zr + ZGB + col);
            const uint4 oa = *(const uint4*)(p.OA + row * 1024 + col);
            const unsigned uw[4] = {uu.x, uu.y, uu.z, uu.w}, gaw[4] = {ga.x, ga.y, ga.z, ga.w}, gbw[4] = {gb.x, gb.y, gb.z, gb.w}, oaw[4] = {oa.x, oa.y, oa.z, oa.w};
            unsigned ow[4];
#pragma unroll
            for (int q = 0; q < 4; ++q) {
              const float o0 = sigm(bflo(gaw[q])) * bflo(oaw[q]) + sigm(bflo(gbw[q])) * bflo(uw[q]) * (acc[mi][ni][8 * g8 + 2 * q] + bias);
              const float o1 = sigm(bfhi(gaw[q])) * bfhi(oaw[q]) + sigm(bfhi(gbw[q])) * bfhi(uw[q]) * (acc[mi][ni][8 * g8 + 2 * q + 1] + bias);
              ow[q] = pk2(o0, o1);
            }
            *(uint4*)(p.MIX + row * 1024 + col) = make_uint4(ow[0], ow[1], ow[2], ow[3]);
          }
      }
      }
    }
    if (valid && !isp) {
      const int u = t - NP; const int b = u >> 2, col = (u & 3) * 256 + tid; const int g = col >> 7;
      const long row0 = M_P + 16 * b;
      const float gv = gvn[col];
      float vn[16];
#pragma unroll
      for (int s = 0; s < 16; ++s) vn[s] = bf1(p.Z[(row0 + s) * LDZ + ZV + col]) * p.rsv[row0 + s] * gv;
#pragma unroll
      for (int tt = 0; tt < 16; ++tt) {
        float mx = gbs[g * 128 + tt];
#pragma unroll
        for (int s = 0; s <= tt; ++s) mx += gws[((long)g * 128 + tt) * 128 + s] * vn[s];
        const u16* zr = p.Z + (row0 + tt) * LDZ;
        const float uu = bf1(zr[ZU + col]), ga = bf1(zr[ZGA + col]), gb = bf1(zr[ZGB + col]);
        const float oa = bf1(p.OA[(row0 + tt) * 1024 + col]);
        p.MIX[(row0 + tt) * 1024 + col] = f2bf(sigm(ga) * oa + sigm(gb) * uu * mx);
      }
    }
  }
}

#define XB_TMO      128
#define XB_XCNT(j)  (256  + 64 * (j))
#define XB_XSUB(j)  (1280 + 64 * (j))
#define XB_XGEN(j)  (2304 + 64 * (j))
#define XB_TOP      3328
#define XB_TOPGEN   3392
#define XCD_BAR_WORDS 3456
#define XB_SPIN_CAP (1u << 22)
#define LAS __attribute__((address_space(3)))
DI unsigned xb_ld(unsigned* p) { return __hip_atomic_load(p, __ATOMIC_RELAXED, __HIP_MEMORY_SCOPE_AGENT); }
DI unsigned xb_add(unsigned* p, unsigned v) { return __hip_atomic_fetch_add(p, v, __ATOMIC_RELAXED, __HIP_MEMORY_SCOPE_AGENT); }
DI unsigned xb_xcc_id() { return (unsigned)__builtin_amdgcn_s_getreg((3 << 11) | 20) & 0xFu; }
#define XB_SPIN(cond, bar) do { unsigned _sp = 0; while (cond) { __builtin_amdgcn_s_sleep(1); \
    if ((++_sp & 255u) == 0u) { if (xb_ld(&(bar)[XB_TMO])) break; if (_sp > XB_SPIN_CAP) { atomicAdd(&(bar)[XB_TMO], 1u); break; } } } } while (0)
struct XcdBarrier { unsigned* bar; unsigned x; volatile LAS unsigned* st; };
DI XcdBarrier xcd_barrier_post(unsigned* bar, volatile LAS unsigned* st) {
  XcdBarrier b; b.bar = bar; b.x = xb_xcc_id(); b.st = st;
  if (threadIdx.x == 0) (void)xb_add(&bar[XB_XCNT(b.x)], 1u);
  return b;
}
DI void xcd_barrier_complete(unsigned* bar, unsigned x, unsigned& nloc, unsigned& nx) {
  const unsigned G = gridDim.x * gridDim.y * gridDim.z;
  unsigned sum, cnt, mine, sp = 0u;
  for (;;) {
    sum = 0u; cnt = 0u; mine = 0u;
#pragma unroll
    for (unsigned j = 0; j < 16; ++j) { const unsigned c = xb_ld(&bar[XB_XCNT(j)]); sum += c; cnt += (c > 0u) ? 1u : 0u; mine = (j == x) ? c : mine; }
    if (sum == G) break;
    __builtin_amdgcn_s_sleep(1);
    if ((++sp & 255u) == 0u) { if (xb_ld(&bar[XB_TMO])) break; if (sp > XB_SPIN_CAP) { atomicAdd(&bar[XB_TMO], 1u); break; } }
  }
  nloc = mine > 0u ? mine : 1u; nx = cnt > 0u ? cnt : 1u;
}
DI void xcd_barrier(const XcdBarrier& b) {
  asm volatile("s_waitcnt vmcnt(0)" ::: "memory");
  __syncthreads();
  if (threadIdx.x == 0) {
    unsigned* bar = b.bar;
    __builtin_amdgcn_s_waitcnt(0);
    unsigned nloc = b.st[0], nx = b.st[1];
    if (nloc == 0u) { xcd_barrier_complete(bar, b.x, nloc, nx); b.st[0] = nloc; b.st[1] = nx; }
    const unsigned old = xb_add(&bar[XB_XSUB(b.x)], 1u);
    const unsigned gen = old / nloc;
    if (old + 1u == (gen + 1u) * nloc) {
      __builtin_amdgcn_fence(__ATOMIC_RELEASE, "agent");
      asm volatile("s_waitcnt vmcnt(0)" ::: "memory");
      const unsigned og = xb_add(&bar[XB_TOP], 1u);
      const unsigned tg = og / nx;
      if (og + 1u == (tg + 1u) * nx) xb_add(&bar[XB_TOPGEN], 1u);
      else XB_SPIN(xb_ld(&bar[XB_TOPGEN]) == tg, bar);
      __builtin_amdgcn_fence(__ATOMIC_ACQUIRE, "agent");
      xb_add(&bar[XB_XGEN(b.x)], 1u);
      asm volatile("s_waitcnt vmcnt(0)" ::: "memory");
    } else {
      XB_SPIN(xb_ld(&bar[XB_XGEN(b.x)]) == gen, bar);
      __builtin_amdgcn_fence(__ATOMIC_ACQUIRE, "agent");
      asm volatile("s_waitcnt vmcnt(0)" ::: "memory");
    }
  }
  __syncthreads();
}

DI CParams& fresh_params() {
  auto kp = __builtin_amdgcn_kernarg_segment_ptr();
  asm volatile("" : "+s"(kp));
  return *(CParams*)kp;
}
#define P_ fresh_params()
__global__ void __launch_bounds__(512, 2) mega_fwd(Params p_unused) {
  const int g_wave_s = __builtin_amdgcn_readfirstlane((int)(threadIdx.x >> 6));
  extern __shared__ __attribute__((aligned(16))) char smem[];
  uint4& xb_words = *(uint4*)(smem + SMEM_BYTES);
  int& s_item = *(int*)(smem + SMEM_BYTES + 16);
  cg::grid_group grid = cg::this_grid();
  if (threadIdx.x == 0) xb_words = make_uint4(0u, 0u, 0u, 0u);
  __syncthreads();
  XcdBarrier xb = xcd_barrier_post(P_.bar, (volatile LAS unsigned*)&xb_words);

  prep_phase(P_, smem, g_wave_s);
  grid.sync();
#pragma unroll 1
  for (int l = 0; l < 2; ++l) {
    norm_phase(P_.out, P_.f1n + l * 1024, P_.NB, P_.PART, 0, g_wave_s);
    xcd_barrier(xb);
    ffn_up_phase(P_, P_.Wgu1 + (long)l * 2 * DFF * 1024, smem, g_wave_s);
    xcd_barrier(xb);
    resid_gemm_phase(P_, P_.ACT, DFF, P_.Wd1 + (long)l * 1024 * DFF, 0.5f, smem, g_wave_s);
    xcd_barrier(xb);
    norm_phase(P_.out, P_.mixn + l * 1024, P_.NB, P_.PART, DFF / 256, g_wave_s);
    xcd_barrier(xb);
    win_phase(P_, P_.Win + (long)l * LDZ * 1024, smem, g_wave_s);
    xcd_barrier(xb);
    rowpost_phase(P_, l, g_wave_s);
    xcd_barrier(xb);
    multi_phase(P_, l, smem, g_wave_s);
    xcd_barrier(xb);
    attn_phase(P_, l, smem, &s_item, l, g_wave_s);
    xcd_barrier(xb);
    gmlp_phase(P_, l, smem, g_wave_s);
    xcd_barrier(xb);
    resid_gemm_phase(P_, P_.MIX, 1024, P_.Wo + (long)l * 1024 * 1024, 1.0f, smem, g_wave_s);
    xcd_barrier(xb);
    norm_phase(P_.out, P_.f2n + l * 1024, P_.NB, P_.PART, 1024 / 256, g_wave_s);
    xcd_barrier(xb);
    ffn_up_phase(P_, P_.Wgu2 + (long)l * 2 * DFF * 1024, smem, g_wave_s);
    xcd_barrier(xb);
    resid_gemm_phase(P_, P_.ACT, DFF, P_.Wd2 + (long)l * 1024 * DFF, 0.5f, smem, g_wave_s);
    xcd_barrier(xb);
    norm_phase(P_.out, P_.plen + l * 1024, P_.NB, P_.PART, DFF / 256, g_wave_s);
    xcd_barrier(xb);
    ple_phase(P_, P_.Wpg + (long)l * 1024 * 1024, smem, g_wave_s);
    xcd_barrier(xb);
  }
}

extern "C" void kernel_launch(void* const* d_in, const int* in_sizes, int n_in, void* d_out, int out_size, void* d_ws,
                              size_t ws_size, hipStream_t stream) {
  (void)in_sizes; (void)n_in; (void)out_size; (void)ws_size;
  Params p{};
  auto F = [&](int i) { return (const float*)d_in[i]; };
  p.x_prompt = F(0); p.x_sample = F(1); p.cache_c = F(2); p.cache_kr = F(3); p.p_prompt = F(4); p.p_sample = F(5);
  p.f1n = F(6); p.mixn = F(10); p.qan = F(12); p.qnn = F(14); p.qrn = F(15); p.kvan = F(16); p.krn = F(17);
  p.knn = F(20); p.gvn = F(21); p.gws = F(22); p.gbs = F(23); p.f2n = F(25); p.plen = F(29);
  p.out = (float*)d_out;
  char* ws = (char*)d_ws; size_t off = 0;
  auto alloc = [&](size_t bytes) { char* r = ws + off; off += (bytes + 255) & ~(size_t)255; return r; };
  p.Wgu1 = (u16*)alloc(2UL * 2 * DFF * 1024 * 2);
  p.Wd1 = (u16*)alloc(2UL * 1024 * DFF * 2);
  p.Win = (u16*)alloc(2UL * LDZ * 1024 * 2);
  p.Wuq = (u16*)alloc(2UL * 1536 * 384 * 2);
  p.Wkv = (u16*)alloc(2UL * 2048 * 512 * 2);
  p.Wo = (u16*)alloc(2UL * 1024 * 1024 * 2);
  p.Wgu2 = (u16*)alloc(2UL * 2 * DFF * 1024 * 2);
  p.Wd2 = (u16*)alloc(2UL * 1024 * DFF * 2);
  p.Wpg = (u16*)alloc(2UL * 1024 * 1024 * 2);
  p.Wpe = (u16*)alloc(2UL * 1024 * 256 * 2);
  p.NB = (u16*)alloc((size_t)M_ALL * 1024 * 2);
  p.ACT = (u16*)alloc((size_t)M_ALL * DFF * 2);
  p.Z = (u16*)alloc((size_t)M_ALL * LDZ * 2);
  p.QN = (u16*)alloc((size_t)M_ALL * 384 * 2);
  p.C = (u16*)alloc((size_t)M_ALL * 512 * 2);
  p.KRp = (u16*)alloc((size_t)M_P * 64 * 2);
  p.KRs = (u16*)alloc((size_t)32 * LKS * 64 * 2);
  p.Q = (u16*)alloc((size_t)M_ALL * 8 * 192 * 2);
  p.Knp = (u16*)alloc((size_t)M_P * 1024 * 2);
  p.VTp = (u16*)alloc((size_t)M_P * 1024 * 2);
  p.Kns = (u16*)alloc((size_t)32 * LKS * 1024 * 2);
  p.VTs = (u16*)alloc((size_t)32 * LKS * 1024 * 2);
  p.OA = (u16*)alloc((size_t)M_ALL * 1024 * 2);
  p.MIX = (u16*)alloc((size_t)M_ALL * 1024 * 2);
  p.PP = (u16*)alloc((size_t)M_ALL * 1024 * 2);
  p.CB = (u16*)alloc((size_t)32 * PAST * 512 * 2);
  p.PB = (u16*)alloc((size_t)M_ALL * 256 * 2);
  p.rsv = (float*)alloc((size_t)M_ALL * 4);
  p.PART = (float*)alloc((size_t)11 * M_S * 1024 * 4);
  p.rope = (float*)alloc((size_t)16384 * 32 * 2 * 4);
  p.ctr = (unsigned*)alloc(256);
  p.bar = (unsigned*)alloc(XCD_BAR_WORDS * 4);

  int nj = 0, ts = 0;
  auto job = [&](const float* src, u16* dst, int K, int N, int kind) {
    p.jobs[nj].src = src; p.jobs[nj].dst = dst; p.jobs[nj].K = K; p.jobs[nj].N = N; p.jobs[nj].kind = kind; p.jobs[nj].tstart = ts;
    ts += (K / 64) * ((N / 64 + 3) / 4); ++nj;
  };
  for (int l = 0; l < 2; ++l) {
    job(F(7) + (size_t)l * 1024 * DFF, p.Wgu1 + (size_t)l * 2 * DFF * 1024, 1024, DFF, 1);
    job(F(8) + (size_t)l * 1024 * DFF, p.Wgu1 + (size_t)l * 2 * DFF * 1024, 1024, DFF, 2);
    job(F(9) + (size_t)l * DFF * 1024, p.Wd1 + (size_t)l * 1024 * DFF, DFF, 1024, 0);
    job(F(11) + (size_t)l * 1024 * DIN, p.Win + (size_t)l * LDZ * 1024, 1024, DIN, 0);
    job(F(13) + (size_t)l * 384 * 1536, p.Wuq + (size_t)l * 1536 * 384, 384, 1536, 3);
    job(F(18) + (size_t)l * 512 * 1024, p.Wkv + (size_t)l * 2048 * 512, 512, 1024, 0);
    job(F(19) + (size_t)l * 512 * 1024, p.Wkv + (size_t)l * 2048 * 512, 512, 1024, 4);
    job(F(24) + (size_t)l * 1024 * 1024, p.Wo + (size_t)l * 1024 * 1024, 1024, 1024, 0);
    job(F(26) + (size_t)l * 1024 * DFF, p.Wgu2 + (size_t)l * 2 * DFF * 1024, 1024, DFF, 1);
    job(F(27) + (size_t)l * 1024 * DFF, p.Wgu2 + (size_t)l * 2 * DFF * 1024, 1024, DFF, 2);
    job(F(28) + (size_t)l * DFF * 1024, p.Wd2 + (size_t)l * 1024 * DFF, DFF, 1024, 0);
    job(F(30) + (size_t)l * 1024 * 1024, p.Wpg + (size_t)l * 1024 * 1024, 1024, 1024, 0);
    job(F(31) + (size_t)l * 256 * 1024, p.Wpe + (size_t)l * 1024 * 256, 256, 1024, 0);
  }
  p.ntile_prep = ts;

  static int grid_blocks = 0;
  if (!grid_blocks) {
    int dev = 0, cus = 0, per_cu = 0;
    hipGetDevice(&dev);
    hipDeviceGetAttribute(&cus, hipDeviceAttributeMultiprocessorCount, dev);
    hipFuncSetAttribute((const void*)mega_fwd, hipFuncAttributeMaxDynamicSharedMemorySize, LDS_TOTAL);
    hipOccupancyMaxActiveBlocksPerMultiprocessor(&per_cu, (const void*)mega_fwd, 512, LDS_TOTAL);
    if (per_cu > 1) per_cu = 1;
    if (per_cu < 1) per_cu = 1;
    grid_blocks = cus * per_cu;
  }
  (void)hipMemsetAsync(p.bar, 0, XCD_BAR_WORDS * 4, stream);
  void* args[] = {&p};
  hipError_t e = hipLaunchCooperativeKernel((const void*)mega_fwd, dim3(grid_blocks), dim3(512), args, LDS_TOTAL, stream);
  if (e != hipSuccess) fprintf(stderr, "cooperative launch failed: %s (grid %d)\n", hipGetErrorString(e), grid_blocks);
}
```

```cpp
#include <hip/hip_runtime.h>
#include <hip/hip_cooperative_groups.h>
#include <cstdio>
namespace cg = cooperative_groups;

#define DI __device__ __forceinline__
typedef unsigned short u16;
typedef __attribute__((ext_vector_type(8))) short bf16x8;
typedef __attribute__((ext_vector_type(16))) float f32x16;
typedef __attribute__((ext_vector_type(2))) __bf16 bf2_t;
typedef __attribute__((ext_vector_type(2))) float f2_t;

#define M_P 16384
#define M_S 512
#define M_ALL 16896
#define DM 1024
#define DFF 2816
#define DIN 5056
#define LDZ 5120
#define ZQ 0
#define ZKV 384
#define ZKR 896
#define ZU 960
#define ZV 1984
#define ZGA 3008
#define ZGB 4032
#define LKS 4160
#define LKV 4112
#define PAST 4096
#define EPSF 1e-6f
#define QSCALE (0.07216878364870322f * 1.4426950408889634f)

#define NJOBS 26
struct TJob { const float* src; u16* dst; int K, N, kind, tstart; };

struct Params {
  const float *x_prompt, *x_sample, *cache_c, *cache_kr, *p_prompt, *p_sample;
  const float *f1n, *mixn, *qan, *qnn, *qrn, *kvan, *krn, *knn, *gvn, *gws, *gbs, *f2n, *plen;
  float* out;
  u16 *Wgu1, *Wd1, *Win, *Wuq, *Wkv, *Wo, *Wgu2, *Wd2, *Wpg, *Wpe;
  u16 *CB, *PB, *WgB;
  u16 *NB, *ACT, *Z, *QN, *C, *KRp, *KRs, *Q, *Knp, *VTp, *Kns, *VTs, *OA, *MIX, *PP;
  float *rsv, *rope, *PART;
  unsigned* ctr;
  unsigned* bar;
  TJob jobs[NJOBS];
  int ntile_prep; int pad0;
};

typedef const __attribute__((address_space(4))) Params CParams;

DI int get_tid_impl(int ws) { int t = (ws << 6) | (int)__builtin_amdgcn_mbcnt_hi(~0u, __builtin_amdgcn_mbcnt_lo(~0u, 0u)); asm volatile("" : "+v"(t)); return t; }
#define get_tid() get_tid_impl(g_wave_s)
DI int get_bid() { int t = blockIdx.x; asm volatile("" : "+s"(t)); return t; }
DI unsigned pk2(float a, float b) { f2_t v = {a, b}; bf2_t r = __builtin_convertvector(v, bf2_t); return __builtin_bit_cast(unsigned, r); }
DI float bflo(unsigned v) { return __uint_as_float(v << 16); }
DI float bfhi(unsigned v) { return __uint_as_float(v & 0xffff0000u); }
DI float bf1(u16 v) { return __uint_as_float(((unsigned)v) << 16); }
DI u16 f2bf(float a) { return (u16)(pk2(a, 0.f) & 0xffffu); }
DI float shfl_xor_l(float v, int lane, int o) { return __int_as_float(__builtin_amdgcn_ds_bpermute((lane ^ o) << 2, __float_as_int(v))); }
DI float wave_sum_l(float v, int lane) {
#pragma unroll
  for (int o = 32; o > 0; o >>= 1) v += shfl_xor_l(v, lane, o);
  return v;
}
typedef __attribute__((ext_vector_type(4))) float f4v_t;
DI float4 ld_nt16(const float* ptr) { const f4v_t v = __builtin_nontemporal_load((const f4v_t*)ptr); return make_float4(v.x, v.y, v.z, v.w); }
DI float sigm(float x) { return __builtin_amdgcn_rcpf(1.f + __builtin_amdgcn_exp2f(-1.4426950408889634f * x)); }
DI uint4 pack8(float4 x, float4 y) { return make_uint4(pk2(x.x, x.y), pk2(x.z, x.w), pk2(y.x, y.y), pk2(y.z, y.w)); }
#define MFMA(a, b, c) __builtin_amdgcn_mfma_f32_32x32x16_bf16((a), (b), (c), 0, 0, 0)

#define HALF_BYTES (73728 + 1024)
#define SMEM_BYTES (2 * HALF_BYTES)
#define LDS_TOTAL (SMEM_BYTES + 32)

DI int job_dst_row(int kind, int n) {
  if (kind == 0) return n;
  if (kind == 1) return 256 * (n >> 7) + (n & 127);
  if (kind == 2) return 256 * (n >> 7) + 128 + (n & 127);
  if (kind == 3) { int h = n / 192, c = n - h * 192; if (c < 128) return h * 128 + c; c -= 128; const int x = c >> 5, cl = c & 31;
                   return 1024 + h * 64 + 32 * (cl >> 4) + 8 * ((cl >> 2) & 3) + 4 * x + (cl & 3); }
  return 1024 + n;
}

DI void prep_phase(CParams& p, char* smem, int g_wave_s) {
  const int tid = get_tid();
  {
    const int vt = tid & 255, half = tid >> 8;
    unsigned* Ts32 = (unsigned*)smem + half * (4 * 64 * 33);
    const int npair = (p.ntile_prep + 1) >> 1;
    for (int t2 = get_bid(); t2 < npair; t2 += gridDim.x) {
      const int t = 2 * t2 + half;
      const bool valid = t < p.ntile_prep;
      int j = 0;
#pragma unroll 1
      for (int q = 1; q < NJOBS; ++q) if (t >= p.jobs[q].tstart) j = q;
      const float* src = p.jobs[j].src; u16* dst = p.jobs[j].dst;
      const int K = p.jobs[j].K, N = p.jobs[j].N, kind = p.jobs[j].kind;
      const int lt = t - p.jobs[j].tstart;
      const int ntn = N >> 6, nst = (ntn + 3) >> 2;
      const int tk = lt / nst, st = lt - tk * nst;
      const int k0 = tk * 64;
      float4 v0[4][2], v1[4][2];
      if (valid) {
#pragma unroll
        for (int q = 0; q < 4; ++q) {
          const int tn = 4 * st + q;
          if (tn < ntn) {
#pragma unroll
            for (int i = 0; i < 2; ++i) {
              const int kp = (vt >> 4) + 16 * i, nc = (vt & 15) * 4;
              v0[q][i] = ld_nt16(src + (long)(k0 + 2 * kp) * N + tn * 64 + nc);
              v1[q][i] = ld_nt16(src + (long)(k0 + 2 * kp + 1) * N + tn * 64 + nc);
            }
          }
        }
      }
      __syncthreads();
      if (valid) {
#pragma unroll
        for (int q = 0; q < 4; ++q) {
          if (4 * st + q < ntn) {
#pragma unroll
            for (int i = 0; i < 2; ++i) {
              const int kp = (vt >> 4) + 16 * i, nc = (vt & 15) * 4;
              unsigned* T = Ts32 + q * (64 * 33);
              T[(nc + 0) * 33 + kp] = pk2(v0[q][i].x, v1[q][i].x); T[(nc + 1) * 33 + kp] = pk2(v0[q][i].y, v1[q][i].y);
              T[(nc + 2) * 33 + kp] = pk2(v0[q][i].z, v1[q][i].z); T[(nc + 3) * 33 + kp] = pk2(v0[q][i].w, v1[q][i].w);
            }
          }
        }
      }
      __syncthreads();
      if (valid) {
#pragma unroll
        for (int q = 0; q < 4; ++q) {
          const int tn = 4 * st + q;
          if (tn < ntn) {
            const int n = vt >> 2, kc = (vt & 3) * 16;
            const unsigned* s32 = Ts32 + q * (64 * 33) + n * 33 + (kc >> 1);
            uint4 a = make_uint4(s32[0], s32[1], s32[2], s32[3]);
            uint4 b = make_uint4(s32[4], s32[5], s32[6], s32[7]);
            u16* d = dst + (long)job_dst_row(kind, tn * 64 + n) * K + k0 + kc;
            *(uint4*)d = a; *(uint4*)(d + 8) = b;
          }
        }
      }
    }
  }
  const long gtid = (long)get_bid() * 512 + tid, gstride = (long)gridDim.x * 512;
  for (long e = gtid; e < 2L * 64 * 1024 / 8; e += gstride) {
    const int l = (int)(e / (64 * 1024 / 8)); const long r = e - (long)l * (64 * 1024 / 8);
    *(uint4*)(p.Win + (long)l * LDZ * 1024 + (long)DIN * 1024 + r * 8) = make_uint4(0, 0, 0, 0);
  }
  for (long e = gtid; e < 16384L * 32; e += gstride) {
    const int pos = (int)(e >> 5), i = (int)(e & 31);
    const float inv = powf(10000.0f, -(float)i / 32.0f);
    const float angf = (float)pos * inv;
    const double x = (double)angf;
    const double kq = rint(x * 0.63661977236758134308);
    const double y = (x - kq * 1.5707963267341256e+00) - kq * 6.0771005065061922e-11;
    const double y2 = y * y;
    const double s = y * (1.0 + y2 * (-1.0 / 6 + y2 * (1.0 / 120 + y2 * (-1.0 / 5040 + y2 * (1.0 / 362880 + y2 * (-1.0 / 39916800))))));
    const double c = 1.0 + y2 * (-0.5 + y2 * (1.0 / 24 + y2 * (-1.0 / 720 + y2 * (1.0 / 40320 + y2 * (-1.0 / 3628800 + y2 * (1.0 / 479001600))))));
    const int q = ((int)kq) & 3;
    double cc, ss;
    if (q == 0) { cc = c; ss = s; } else if (q == 1) { cc = -s; ss = c; } else if (q == 2) { cc = -c; ss = -s; } else { cc = s; ss = -c; }
    *(float2*)(p.rope + e * 2) = make_float2((float)cc, (float)ss);
  }
  for (long e = gtid; e < (long)M_ALL * 1024 / 4; e += gstride) {
    const long pe = (long)M_P * 1024 / 4;
    float4 v = e < pe ? ld_nt16(p.x_prompt + e * 4) : ld_nt16(p.x_sample + (e - pe) * 4);
    ((float4*)p.out)[e] = v;
  }
  for (long e = gtid; e < 2L * 8 * 128 * 128 / 8; e += gstride) {
    const long el = e * 8; const int tt = (int)((el >> 7) & 127), sc = (int)(el & 127);
    float4 a = *(const float4*)(p.gws + el), b = *(const float4*)(p.gws + el + 4);
    a.x = (sc + 0 <= tt) ? a.x : 0.f; a.y = (sc + 1 <= tt) ? a.y : 0.f; a.z = (sc + 2 <= tt) ? a.z : 0.f; a.w = (sc + 3 <= tt) ? a.w : 0.f;
    b.x = (sc + 4 <= tt) ? b.x : 0.f; b.y = (sc + 5 <= tt) ? b.y : 0.f; b.z = (sc + 6 <= tt) ? b.z : 0.f; b.w = (sc + 7 <= tt) ? b.w : 0.f;
    *(uint4*)(p.WgB + el) = pack8(a, b);
  }
  if (get_bid() == 0 && tid < 64) p.ctr[tid] = 0u;
}

DI void norm_phase(float* __restrict__ h, const float* __restrict__ g, u16* __restrict__ out, const float* __restrict__ part, int nsplit, int g_wave_s) {
  const int tid = get_tid(); const int lane = tid & 63, w = tid >> 6;
  for (int row = get_bid() * 8 + w; row < M_ALL; row += gridDim.x * 8) {
    const float4* hr = (const float4*)(h + (long)row * 1024);
    float4 v[4]; float ss = 0.f;
#pragma unroll
    for (int i = 0; i < 4; ++i) v[i] = hr[lane + 64 * i];
    if (nsplit > 0 && row >= M_P) {
#pragma unroll 1
      for (int s_ = 0; s_ < nsplit; ++s_) {
        const float4* pr = (const float4*)(part + ((long)s_ * M_S + (row - M_P)) * 1024);
#pragma unroll
        for (int i = 0; i < 4; ++i) { const float4 q = pr[lane + 64 * i]; v[i].x += q.x; v[i].y += q.y; v[i].z += q.z; v[i].w += q.w; }
      }
#pragma unroll
      for (int i = 0; i < 4; ++i) ((float4*)(h + (long)row * 1024))[lane + 64 * i] = v[i];
    }
#pragma unroll
    for (int i = 0; i < 4; ++i) ss += v[i].x * v[i].x + v[i].y * v[i].y + v[i].z * v[i].z + v[i].w * v[i].w;
    ss = wave_sum_l(ss, lane);
    const float rs = rsqrtf(ss * (1.f / 1024.f) + EPSF);
#pragma unroll
    for (int i = 0; i < 4; ++i) {
      const float4 gg = ((const float4*)g)[lane + 64 * i];
      uint2 o = make_uint2(pk2(v[i].x * rs * gg.x, v[i].y * rs * gg.y), pk2(v[i].z * rs * gg.z, v[i].w * rs * gg.w));
      ((uint2*)(out + (long)row * 1024))[lane + 64 * i] = o;
    }
  }
}

typedef __attribute__((ext_vector_type(4))) float f32x4;
#define G8_HT (128 * 64)
DI int g8_lds_byte(int r, int c) { const int st = (r >> 4) * 2 + (c >> 5), rr = r & 15, cc = c & 31, ob = rr * 64 + cc * 2; return st * 1024 + (ob ^ (((ob >> 9) & 1) << 5)); }
DI void g8_stage_rc(int b, int& R, int& C) { const int st = b / 1024, sb = b % 1024, swz = sb ^ (((sb >> 9) & 1) << 5); R = (st >> 1) * 16 + swz / 64; C = (st & 1) * 32 + (swz % 64) / 2; }
DI int g8_perm32(int rho) { const int n = rho >> 4, i = rho & 15; return 8 * (i >> 2) + 4 * n + (i & 3); }

DI int g8_permT(int s_) { return 16 * ((s_ >> 3) & 1) + 8 * (s_ >> 4) + 4 * ((s_ >> 2) & 1) + (s_ & 3); }
template <int PERMB>
DI void gemm256_tile(const u16* __restrict__ A, const u16* __restrict__ Bt, int ld, int K, char* smem, f32x4 (&acc)[2][2][4][2], int g_wave_s) {
  u16* shm = (u16*)smem;
  const int tid = get_tid();
  const int wid = tid >> 6, lane = tid & 63, wr = wid >> 2, wc = wid & 3, fr = lane & 15, fq = lane >> 4;
#define G8_SA(b, h) (shm + ((b) * 2 + (h)) * G8_HT)
#define G8_SB(b, h) (shm + (4 + (b) * 2 + (h)) * G8_HT)
  int sr0, sc0;
  g8_stage_rc(tid * 16, sr0, sc0);
  const int br0 = PERMB == 1 ? ((sr0 & ~31) + g8_perm32(sr0 & 31)) : (PERMB == 2 ? ((sr0 & ~31) + g8_permT(sr0 & 31)) : sr0);
  const unsigned aoff0 = (unsigned)(sr0 * ld + sc0) * 2u;
  const unsigned boff0 = (unsigned)(br0 * ld + sc0) * 2u;
#define G8_STAGE_A(P, br, kt) do { const char* g_ = (const char*)(A + (long)(br) * ld + (long)(kt) * 64); \
    __builtin_amdgcn_global_load_lds((const unsigned*)(g_ + (size_t)aoff0), (unsigned*)((char*)(P) + tid * 16), 16, 0, 0); \
    __builtin_amdgcn_global_load_lds((const unsigned*)(g_ + (size_t)ld * 128 + (size_t)aoff0), (unsigned*)((char*)(P) + tid * 16 + 8192), 16, 0, 0); } while (0)
#define G8_STAGE_B(P, br, kt) do { const char* g_ = (const char*)(Bt + (long)(br) * ld + (long)(kt) * 64); \
    __builtin_amdgcn_global_load_lds((const unsigned*)(g_ + (size_t)boff0), (unsigned*)((char*)(P) + tid * 16), 16, 0, 0); \
    __builtin_amdgcn_global_load_lds((const unsigned*)(g_ + (size_t)ld * 128 + (size_t)boff0), (unsigned*)((char*)(P) + tid * 16 + 8192), 16, 0, 0); } while (0)
#define G8_LDA(dst, b, h) _Pragma("unroll") for (int m = 0; m < 4; ++m) _Pragma("unroll") for (int k = 0; k < 2; ++k) \
    dst[m][k] = *reinterpret_cast<const bf16x8*>((char*)G8_SA(b, h) + g8_lds_byte(wr * 64 + m * 16 + fr, k * 32 + fq * 8))
#define G8_LDB(dst, b, h) _Pragma("unroll") for (int n = 0; n < 2; ++n) _Pragma("unroll") for (int k = 0; k < 2; ++k) \
    dst[n][k] = *reinterpret_cast<const bf16x8*>((char*)G8_SB(b, h) + g8_lds_byte(wc * 32 + n * 16 + fr, k * 32 + fq * 8))
#define G8_MMA(ai, bj, At_, Bt_) do { __builtin_amdgcn_s_setprio(1); \
    _Pragma("unroll") for (int m = 0; m < 4; ++m) _Pragma("unroll") for (int n = 0; n < 2; ++n) _Pragma("unroll") for (int k = 0; k < 2; ++k) \
      acc[ai][bj][m][n] = __builtin_amdgcn_mfma_f32_16x16x32_bf16(Bt_[n][k], At_[m][k], acc[ai][bj][m][n], 0, 0, 0); \
    __builtin_amdgcn_s_setprio(0); } while (0)
#define G8_WAIT_V(n) asm volatile("s_waitcnt vmcnt(" #n ")" ::: "memory")
#define G8_WAIT_L(n) asm volatile("s_waitcnt lgkmcnt(" #n ")" ::: "memory")
#define G8_BAR __builtin_amdgcn_s_barrier()
#define G8_SCHED __builtin_amdgcn_sched_barrier(0)
#pragma unroll
  for (int ai = 0; ai < 2; ++ai)
#pragma unroll
    for (int bj = 0; bj < 2; ++bj)
#pragma unroll
      for (int m = 0; m < 4; ++m)
#pragma unroll
        for (int n = 0; n < 2; ++n) acc[ai][bj][m][n] = (f32x4){0.f, 0.f, 0.f, 0.f};
  bf16x8 At[4][2], B0[2][2], B1[2][2];
  const int nt = K >> 6;
  G8_STAGE_B(G8_SB(0, 0), 0, 0); G8_STAGE_A(G8_SA(0, 0), 0, 0);
  G8_STAGE_B(G8_SB(0, 1), 128, 0); G8_STAGE_A(G8_SA(0, 1), 128, 0);
  if (wr == 1) G8_BAR;
  G8_WAIT_V(4); G8_BAR;
  G8_STAGE_B(G8_SB(1, 0), 0, 1); G8_STAGE_A(G8_SA(1, 0), 0, 1); G8_STAGE_B(G8_SB(1, 1), 128, 1);
  G8_WAIT_V(6); G8_BAR;
#pragma unroll 1
  for (int t = 0; t < nt - 2; t += 2) {
    G8_LDB(B0, 0, 0); G8_SCHED; G8_LDA(At, 0, 0); G8_STAGE_A(G8_SA(1, 1), 128, t + 1);
    G8_WAIT_L(8); G8_BAR; G8_WAIT_L(0); G8_MMA(0, 0, At, B0); G8_BAR; G8_SCHED;
    G8_LDB(B1, 0, 1); G8_STAGE_B(G8_SB(0, 0), 0, t + 2);
    G8_BAR; G8_WAIT_L(0); G8_MMA(0, 1, At, B1); G8_BAR;
    G8_LDA(At, 0, 1); G8_STAGE_A(G8_SA(0, 0), 0, t + 2);
    G8_BAR; G8_WAIT_L(0); G8_MMA(1, 0, At, B0); G8_BAR; G8_SCHED;
    G8_STAGE_B(G8_SB(0, 1), 128, t + 2);
    G8_WAIT_V(6); G8_BAR; G8_MMA(1, 1, At, B1); G8_BAR;
    G8_LDB(B0, 1, 0); G8_SCHED; G8_LDA(At, 1, 0); G8_STAGE_A(G8_SA(0, 1), 128, t + 2);
    G8_WAIT_L(8); G8_BAR; G8_WAIT_L(0); G8_MMA(0, 0, At, B0); G8_BAR; G8_SCHED;
    G8_LDB(B1, 1, 1); G8_STAGE_B(G8_SB(1, 0), 0, t + 3);
    G8_BAR; G8_WAIT_L(0); G8_MMA(0, 1, At, B1); G8_BAR;
    G8_LDA(At, 1, 1); G8_STAGE_A(G8_SA(1, 0), 0, t + 3);
    G8_BAR; G8_WAIT_L(0); G8_MMA(1, 0, At, B0); G8_BAR; G8_SCHED;
    G8_STAGE_B(G8_SB(1, 1), 128, t + 3);
    G8_WAIT_V(6); G8_BAR; G8_MMA(1, 1, At, B1); G8_BAR;
  }
  { G8_LDB(B0, 0, 0); G8_LDA(At, 0, 0); G8_STAGE_A(G8_SA(1, 1), 128, nt - 1);
    G8_BAR; G8_WAIT_L(0); G8_MMA(0, 0, At, B0); G8_BAR;
    G8_LDB(B1, 0, 1); G8_BAR; G8_WAIT_L(0); G8_MMA(0, 1, At, B1); G8_BAR;
    G8_LDA(At, 0, 1); G8_WAIT_V(4); G8_BAR; G8_WAIT_L(0); G8_MMA(1, 0, At, B0); G8_MMA(1, 1, At, B1); G8_BAR; }
  { G8_LDB(B0, 1, 0); G8_LDA(At, 1, 0); G8_WAIT_V(2); G8_BAR; G8_WAIT_L(0); G8_MMA(0, 0, At, B0); G8_BAR;
    G8_LDB(B1, 1, 1); G8_WAIT_V(0); G8_BAR; G8_WAIT_L(0); G8_MMA(0, 1, At, B1); G8_BAR;
    G8_LDA(At, 1, 1); G8_BAR; G8_WAIT_L(0); G8_MMA(1, 0, At, B0); G8_MMA(1, 1, At, B1); G8_BAR; }
  if (wr == 0) G8_BAR;
}

#define G8_COORDS const int tid = get_tid(); const int wid = tid >> 6, lane = tid & 63, wr = wid >> 2, wc = wid & 3, fr = lane & 15, fq = lane >> 4; (void)wr; (void)wc; (void)fr; (void)fq;
DI int tok_pos(int m) { return m < M_P ? m : PAST + ((m - M_P) & 15); }

DI void grouped_tile(int L, int nM, int nN, int& tm, int& tn) {
  const int nwg = nM * nN;
  const int q = nwg >> 3, rr = nwg & 7, xcd = L & 7, off = L >> 3;
  const int wgid = (xcd < rr ? xcd * (q + 1) : rr * (q + 1) + (xcd - rr) * q) + off;
  const int nig = 8 * nN, gid = wgid / nig, fm = gid * 8;
  const int gsz = (nM - fm) < 8 ? (nM - fm) : 8;
  const int rem = wgid - gid * nig;
  tm = fm + rem % gsz; tn = rem / gsz;
}

DI void ffn_up_phase(CParams& p, const u16* W, char* smem, int g_wave_s) {
  const int tid = get_tid();
  const int wid = tid >> 6, lane = tid & 63, wr = wid >> 2, wc = wid & 3, fr = lane & 15, fq = lane >> 4;
  const int NT = (2 * DFF) / 256;
  const int G = gridDim.x;
  for (int L = get_bid(); L < 66 * NT; L += G) {
    int tm, tn; grouped_tile(L, 66, NT, tm, tn);
    f32x4 acc[2][2][4][2];
    gemm256_tile<1>(p.NB + (long)tm * 256 * 1024, W + (long)tn * 256 * 1024, 1024, 1024, smem, acc, g_wave_s);
#pragma unroll
    for (int ai = 0; ai < 2; ++ai)
#pragma unroll
      for (int m = 0; m < 4; ++m) {
        const long row = (long)tm * 256 + 128 * ai + 64 * wr + 16 * m + fr;
        const int col = tn * 128 + 32 * wc + 8 * fq;
        float a[8];
#pragma unroll
        for (int n = 0; n < 2; ++n)
#pragma unroll
          for (int j = 0; j < 4; ++j) { const float g = acc[ai][0][m][n][j], u = acc[ai][1][m][n][j]; a[4 * n + j] = g * sigm(g) * u; }
        *(uint4*)(p.ACT + row * DFF + col) = make_uint4(pk2(a[0], a[1]), pk2(a[2], a[3]), pk2(a[4], a[5]), pk2(a[6], a[7]));
      }
  }
}

DI void win_phase(CParams& p, const u16* W, char* smem, int g_wave_s) {
  const int tid = get_tid();
  const int wid = tid >> 6, lane = tid & 63, wr = wid >> 2, wc = wid & 3, fr = lane & 15, fq = lane >> 4;
  const int NT = LDZ / 256;
  const int G = gridDim.x;
  for (int L = get_bid(); L < 66 * NT; L += G) {
    int tm, tn; grouped_tile(L, 66, NT, tm, tn);
    f32x4 acc[2][2][4][2];
    gemm256_tile<1>(p.NB + (long)tm * 256 * 1024, W + (long)tn * 256 * 1024, 1024, 1024, smem, acc, g_wave_s);
#pragma unroll
    for (int ai = 0; ai < 2; ++ai)
#pragma unroll
      for (int m = 0; m < 4; ++m) {
        const long row = (long)tm * 256 + 128 * ai + 64 * wr + 16 * m + fr;
#pragma unroll
        for (int bj = 0; bj < 2; ++bj) {
          const int col = tn * 256 + 128 * bj + 32 * wc + 8 * fq;
          *(uint4*)(p.Z + row * LDZ + col) = make_uint4(pk2(acc[ai][bj][m][0][0], acc[ai][bj][m][0][1]), pk2(acc[ai][bj][m][0][2], acc[ai][bj][m][0][3]),
                                                        pk2(acc[ai][bj][m][1][0], acc[ai][bj][m][1][1]), pk2(acc[ai][bj][m][1][2], acc[ai][bj][m][1][3]));
        }
      }
  }
}

DI void resid_gemm_phase(CParams& p, const u16* A, int K, const u16* W, float alpha, char* smem, int g_wave_s) {
  const int G = gridDim.x;
  const int nsplit = K >> 8;
#pragma unroll 1
  for (int it = get_bid(); it < 256 + 8 * nsplit; it += G) {
    int tm, tn, ks = 0, depth = K;
    const bool tail = it >= 256;
    if (!tail) { const int x = it & 7, j = it >> 3; tn = x & 3; tm = 2 * j + (x >> 2); }
    else { const int u = it - 256; const int tile = u / nsplit; ks = u - tile * nsplit; tm = 64 + (tile >> 2); tn = tile & 3; depth = 256; }
    f32x4 acc[2][2][4][2];
    gemm256_tile<1>(A + (long)tm * 256 * K + ks * 256, W + (long)tn * 256 * K + ks * 256, K, depth, smem, acc, g_wave_s);
    G8_COORDS
    float* base = tail ? (p.PART + ((long)ks * M_S + (long)(tm - 64) * 256) * 1024) : (p.out + (long)tm * 256 * 1024);
#pragma unroll
    for (int ai = 0; ai < 2; ++ai)
#pragma unroll
      for (int m = 0; m < 4; ++m) {
        const int rl = 128 * ai + 64 * wr + 16 * m + fr;
#pragma unroll
        for (int bj = 0; bj < 2; ++bj) {
          float4* hp = (float4*)(base + (long)rl * 1024 + tn * 256 + 128 * bj + 32 * wc + 8 * fq);
#pragma unroll
          for (int n = 0; n < 2; ++n) {
            float4 v = make_float4(0.f, 0.f, 0.f, 0.f);
            if (!tail) v = hp[n];
            v.x += alpha * acc[ai][bj][m][n][0]; v.y += alpha * acc[ai][bj][m][n][1]; v.z += alpha * acc[ai][bj][m][n][2]; v.w += alpha * acc[ai][bj][m][n][3];
            hp[n] = v;
          }
        }
      }
  }
}

DI void ple_phase(CParams& p, const u16* W, char* smem, int g_wave_s) {
  const int G = gridDim.x;
#pragma unroll 1
  for (int L = get_bid(); L < 66 * 4; L += G) {
    const int tm = L >> 2, tn = L & 3;
    f32x4 acc[2][2][4][2];
    gemm256_tile<1>(p.NB + (long)tm * 256 * 1024, W + (long)tn * 256 * 1024, 1024, 1024, smem, acc, g_wave_s);
    G8_COORDS
#pragma unroll
    for (int ai = 0; ai < 2; ++ai)
#pragma unroll
      for (int m = 0; m < 4; ++m) {
        const long row = (long)tm * 256 + 128 * ai + 64 * wr + 16 * m + fr;
#pragma unroll
        for (int bj = 0; bj < 2; ++bj) {
          const int col = tn * 256 + 128 * bj + 32 * wc + 8 * fq;
          float4* hp = (float4*)(p.out + row * 1024 + col);
          const uint4 pp = *(const uint4*)(p.PP + row * 1024 + col);
          float4 v0 = hp[0], v1 = hp[1];
          v0.x += sigm(acc[ai][bj][m][0][0]) * bflo(pp.x); v0.y += sigm(acc[ai][bj][m][0][1]) * bfhi(pp.x);
          v0.z += sigm(acc[ai][bj][m][0][2]) * bflo(pp.y); v0.w += sigm(acc[ai][bj][m][0][3]) * bfhi(pp.y);
          v1.x += sigm(acc[ai][bj][m][1][0]) * bflo(pp.z); v1.y += sigm(acc[ai][bj][m][1][1]) * bfhi(pp.z);
          v1.z += sigm(acc[ai][bj][m][1][2]) * bflo(pp.w); v1.w += sigm(acc[ai][bj][m][1][3]) * bfhi(pp.w);
          hp[0] = v0; hp[1] = v1;
        }
      }
  }
}

DI void rowpost_phase(CParams& p, int l, int g_wave_s) {
  const int tid = get_tid(); const int lane = tid & 63, w = tid >> 6;
  const float* qan = p.qan + l * 384; const float* kvan = p.kvan + l * 512; const float* krn = p.krn + l * 64; const float* gvn = p.gvn + l * 1024;
  float* o_pkv = p.out + 17301504L + (long)l * M_P * 512;
  float* o_pkr = p.out + 34078720L + (long)l * M_P * 64;
  float* o_skv = p.out + 36175872L + (long)l * M_S * 512;
  float* o_skr = p.out + 36700160L + (long)l * M_S * 64;
  float* o_sgv = p.out + 36765696L + (long)l * M_S * 1024;
  for (int row = get_bid() * 8 + w; row < M_ALL; row += gridDim.x * 8) {
    const u16* zr = p.Z + (long)row * LDZ;
    const bool is_s = row >= M_P; const int rs_ = row - M_P;
    {
      unsigned v[3]; float ss = 0.f;
#pragma unroll
      for (int i = 0; i < 3; ++i) { v[i] = *(const unsigned*)(zr + ZQ + 2 * lane + 128 * i); const float a = bflo(v[i]), b = bfhi(v[i]); ss += a * a + b * b; }
      ss = wave_sum_l(ss, lane);
      const float rs = rsqrtf(ss * (1.f / 384.f) + EPSF);
#pragma unroll
      for (int i = 0; i < 3; ++i) {
        const int c = 2 * lane + 128 * i; const float2 g = *(const float2*)(qan + c);
        *(unsigned*)(p.QN + (long)row * 384 + c) = pk2(bflo(v[i]) * rs * g.x, bfhi(v[i]) * rs * g.y);
      }
    }
    {
      const uint4 v = *(const uint4*)(zr + ZKV + 8 * lane);
      float x[8] = {bflo(v.x), bfhi(v.x), bflo(v.y), bfhi(v.y), bflo(v.z), bfhi(v.z), bflo(v.w), bfhi(v.w)};
      float ss = 0.f;
#pragma unroll
      for (int i = 0; i < 8; ++i) ss += x[i] * x[i];
      ss = wave_sum_l(ss, lane);
      const float rs = rsqrtf(ss * (1.f / 512.f) + EPSF);
      const float4 g0 = *(const float4*)(kvan + 8 * lane), g1 = *(const float4*)(kvan + 8 * lane + 4);
      float4 y0 = make_float4(x[0] * rs * g0.x, x[1] * rs * g0.y, x[2] * rs * g0.z, x[3] * rs * g0.w);
      float4 y1 = make_float4(x[4] * rs * g1.x, x[5] * rs * g1.y, x[6] * rs * g1.z, x[7] * rs * g1.w);
      float* od = is_s ? (o_skv + (long)rs_ * 512) : (o_pkv + (long)row * 512);
      *(float4*)(od + 8 * lane) = y0; *(float4*)(od + 8 * lane + 4) = y1;
      *(uint4*)(p.C + (long)row * 512 + 8 * lane) = pack8(y0, y1);
    }
    {
      const float x = bf1(zr[ZKR + lane]);
      const float ss = wave_sum_l(x * x, lane);
      const float rs = rsqrtf(ss * (1.f / 64.f) + EPSF);
      const float y = x * rs * krn[lane];
      const float other = shfl_xor_l(y, lane, 32);
      const int pos = tok_pos(row);
      const float2 cs = *(const float2*)(p.rope + ((long)pos * 32 + (lane & 31)) * 2);
      const float o = lane < 32 ? (y * cs.x - other * cs.y) : (other * cs.y + y * cs.x);
      if (is_s) {
        o_skr[(long)rs_ * 64 + lane] = o;
        p.KRs[((long)(rs_ >> 4) * LKS + PAST + (rs_ & 15)) * 64 + lane] = f2bf(o);
      } else {
        o_pkr[(long)row * 64 + lane] = o;
        p.KRp[(long)row * 64 + lane] = f2bf(o);
      }
    }
    {
      uint4 v[2]; float ss = 0.f;
#pragma unroll
      for (int i = 0; i < 2; ++i) {
        v[i] = *(const uint4*)(zr + ZV + 8 * lane + 512 * i);
        const float x[8] = {bflo(v[i].x), bfhi(v[i].x), bflo(v[i].y), bfhi(v[i].y), bflo(v[i].z), bfhi(v[i].z), bflo(v[i].w), bfhi(v[i].w)};
#pragma unroll
        for (int j = 0; j < 8; ++j) ss += x[j] * x[j];
      }
      ss = wave_sum_l(ss, lane);
      const float rs = rsqrtf(ss * (1.f / 1024.f) + EPSF);
      if (lane == 0) p.rsv[row] = rs;
      if (is_s) {
#pragma unroll
        for (int i = 0; i < 2; ++i) {
          const int c = 8 * lane + 512 * i;
          const float x[8] = {bflo(v[i].x), bfhi(v[i].x), bflo(v[i].y), bfhi(v[i].y), bflo(v[i].z), bfhi(v[i].z), bflo(v[i].w), bfhi(v[i].w)};
          const float4 g0 = *(const float4*)(gvn + c), g1 = *(const float4*)(gvn + c + 4);
          *(float4*)(o_sgv + (long)rs_ * 1024 + c) = make_float4(x[0] * rs * g0.x, x[1] * rs * g0.y, x[2] * rs * g0.z, x[3] * rs * g0.w);
          *(float4*)(o_sgv + (long)rs_ * 1024 + c + 4) = make_float4(x[4] * rs * g1.x, x[5] * rs * g1.y, x[6] * rs * g1.z, x[7] * rs * g1.w);
        }
      }
    }
  }
  {
    const float* cc = p.cache_c + (long)l * 32 * PAST * 512;
    const long gt = (long)get_bid() * 512 + tid, gs = (long)gridDim.x * 512;
    for (long e = gt; e < 32L * PAST * 512 / 8; e += gs) {
      typedef __attribute__((ext_vector_type(4))) float f4v;
      const f4v a_ = __builtin_nontemporal_load((const f4v*)(cc + e * 8)), c_ = __builtin_nontemporal_load((const f4v*)(cc + e * 8 + 4));
      const float4 a = make_float4(a_.x, a_.y, a_.z, a_.w), c = make_float4(c_.x, c_.y, c_.z, c_.w);
      *(uint4*)(p.CB + e * 8) = pack8(a, c);
    }
    const float* pp = p.p_prompt + (long)l * M_P * 256; const float* ps = p.p_sample + (long)l * M_S * 256;
    for (long e = gt; e < (long)M_ALL * 256 / 8; e += gs) {
      const long pe = (long)M_P * 256 / 8;
      const float* src = e < pe ? (pp + e * 8) : (ps + (e - pe) * 8);
      *(uint4*)(p.PB + e * 8) = pack8(*(const float4*)src, *(const float4*)(src + 4));
    }
  }
  const float* ckr = p.cache_kr + (long)l * 32 * PAST * 64;
  const long gtid = (long)get_bid() * 512 + tid, gstride = (long)gridDim.x * 512;
  for (long e = gtid; e < 32L * PAST * 64 / 8; e += gstride) {
    const long el = e * 8; const int b = (int)(el / (PAST * 64)); const long rem = el - (long)b * PAST * 64;
    const float4 a = *(const float4*)(ckr + el), c = *(const float4*)(ckr + el + 4);
    *(uint4*)(p.KRs + (long)b * LKS * 64 + rem) = pack8(a, c);
  }
}

#define NCKV (512 * 8)
#define NPKV (64 * 8)
#define NSKV (2 * 8)
#define NQT (66 * 6)
#define NPPT (66 * 4)
#define RED8_OFF 131072
template <class RowPtr>
DI void nope_epi256(f32x4 (&acc)[2][2][4][2], const float* __restrict__ gain, float scale, char* smem, RowPtr rowptr, int g_wave_s) {
  const int tid = get_tid();
  const int wid = tid >> 6, lane = tid & 63, wr = wid >> 2, wc = wid & 3, fr = lane & 15, fq = lane >> 4;
  float* red = (float*)(smem + RED8_OFF);
#pragma unroll
  for (int ai = 0; ai < 2; ++ai)
#pragma unroll
    for (int bj = 0; bj < 2; ++bj)
#pragma unroll
      for (int m = 0; m < 4; ++m) {
        float s = 0.f;
#pragma unroll
        for (int n = 0; n < 2; ++n)
#pragma unroll
          for (int j = 0; j < 4; ++j) s += acc[ai][bj][m][n][j] * acc[ai][bj][m][n][j];
        s += shfl_xor_l(s, lane, 16); s += shfl_xor_l(s, lane, 32);
        if (fq == 0) red[((wc * 2 + ai) * 2 + bj) * 128 + 64 * wr + 16 * m + fr] = s;
      }
  __syncthreads();
  const int c = 32 * wc + 8 * fq;
  const float4 ga = *(const float4*)(gain + c), gb = *(const float4*)(gain + c + 4);
#pragma unroll
  for (int ai = 0; ai < 2; ++ai)
#pragma unroll
    for (int bj = 0; bj < 2; ++bj)
#pragma unroll
      for (int m = 0; m < 4; ++m) {
        const int rl = 64 * wr + 16 * m + fr;
        float tot = 0.f;
#pragma unroll
        for (int q = 0; q < 4; ++q) tot += red[((q * 2 + ai) * 2 + bj) * 128 + rl];
        const float rs = rsqrtf(tot * (1.f / 128.f) + EPSF) * scale;
        u16* op = rowptr(128 * ai + rl, bj);
        *(uint4*)(op + c) = make_uint4(pk2(acc[ai][bj][m][0][0] * rs * ga.x, acc[ai][bj][m][0][1] * rs * ga.y), pk2(acc[ai][bj][m][0][2] * rs * ga.z, acc[ai][bj][m][0][3] * rs * ga.w),
                                       pk2(acc[ai][bj][m][1][0] * rs * gb.x, acc[ai][bj][m][1][1] * rs * gb.y), pk2(acc[ai][bj][m][1][2] * rs * gb.z, acc[ai][bj][m][1][3] * rs * gb.w));
      }
}

DI void vt_epi256(CParams& p, f32x4 (&acc)[2][2][4][2], int mode, int m0, int tn, int g_wave_s) {
  G8_COORDS
  const long dstride = (mode == 0) ? (long)M_P : (long)LKS;
#pragma unroll
  for (int bj = 0; bj < 2; ++bj) {
    const int m32 = m0 + 128 * bj + 32 * wc;
#pragma unroll
    for (int ai = 0; ai < 2; ++ai) {
      const int h = 2 * (tn - 4) + ai;
      u16* base;
      if (mode == 0) base = p.VTp + (long)h * 128 * M_P + m32 + 8 * fq;
      else if (mode == 1) base = p.VTs + ((long)(m32 >> 12) * 8 + h) * 128 * LKS + (m32 & 4095) + 8 * fq;
      else base = p.VTs + ((long)((m32 >> 4) + (fq >> 1)) * 8 + h) * 128 * LKS + PAST + 8 * (fq & 1);
#pragma unroll
      for (int m = 0; m < 4; ++m) {
        const int dd = 64 * wr + 16 * m + fr;
        *(uint4*)(base + (long)dd * dstride) = make_uint4(pk2(acc[ai][bj][m][0][0], acc[ai][bj][m][0][1]), pk2(acc[ai][bj][m][0][2], acc[ai][bj][m][0][3]),
                                                          pk2(acc[ai][bj][m][1][0], acc[ai][bj][m][1][1]), pk2(acc[ai][bj][m][1][2], acc[ai][bj][m][1][3]));
      }
    }
  }
}
DI void rope_epi256(CParams& p, int l, f32x4 (&acc)[2][2][4][2], int tm, int tn, char* smem, int g_wave_s) {
  G8_COORDS
  float* red = (float*)(smem + RED8_OFF);
#pragma unroll
  for (int ai = 0; ai < 2; ++ai)
#pragma unroll
    for (int bj = 0; bj < 2; ++bj)
#pragma unroll
      for (int m = 0; m < 4; ++m) {
        float s = 0.f;
#pragma unroll
        for (int n = 0; n < 2; ++n)
#pragma unroll
          for (int j = 0; j < 4; ++j) s += acc[ai][bj][m][n][j] * acc[ai][bj][m][n][j];
        s += shfl_xor_l(s, lane, 16); s += shfl_xor_l(s, lane, 32);
        if (fq == 0) red[((wc * 2 + ai) * 2 + bj) * 128 + 64 * wr + 16 * m + fr] = s;
      }
  __syncthreads();
  const float* g = p.qrn + l * 64;
  const int c0 = 16 * (wc & 1) + 4 * fq;
  const float4 g1 = *(const float4*)(g + c0), g2 = *(const float4*)(g + 32 + c0);
  const float gg1[4] = {g1.x, g1.y, g1.z, g1.w}, gg2[4] = {g2.x, g2.y, g2.z, g2.w};
#pragma unroll
  for (int ai = 0; ai < 2; ++ai)
#pragma unroll
    for (int m = 0; m < 4; ++m) {
      const int rl = 64 * wr + 16 * m + fr;
      const int row = tm * 256 + 128 * ai + rl;
      const int pos = tok_pos(row);
      const float4 t0 = *(const float4*)(p.rope + ((long)pos * 32 + c0) * 2);
      const float4 t1 = *(const float4*)(p.rope + ((long)pos * 32 + c0) * 2 + 4);
      const float cs[4] = {t0.x, t0.z, t1.x, t1.z}, sn[4] = {t0.y, t0.w, t1.y, t1.w};
#pragma unroll
      for (int bj = 0; bj < 2; ++bj) {
        const float tot = red[((wc * 2 + ai) * 2 + bj) * 128 + rl] + red[(((wc ^ 1) * 2 + ai) * 2 + bj) * 128 + rl];
        const float rs = rsqrtf(tot * (1.f / 64.f) + EPSF);
        const int head = 4 * (tn - 4) + 2 * bj + (wc >> 1);
        u16* qp = p.Q + ((long)row * 8 + head) * 192 + 128;
        float o1[4], o2[4];
#pragma unroll
        for (int j = 0; j < 4; ++j) {
          const float y1 = acc[ai][bj][m][0][j] * rs * gg1[j], y2 = acc[ai][bj][m][1][j] * rs * gg2[j];
          o1[j] = (y1 * cs[j] - y2 * sn[j]) * QSCALE; o2[j] = (y1 * sn[j] + y2 * cs[j]) * QSCALE;
        }
        *(uint2*)(qp + c0) = make_uint2(pk2(o1[0], o1[1]), pk2(o1[2], o1[3]));
        *(uint2*)(qp + 32 + c0) = make_uint2(pk2(o2[0], o2[1]), pk2(o2[2], o2[3]));
      }
    }
}
DI void pp_epi256(CParams& p, f32x4 (&acc)[2][2][4][2], int tm, int tn, int g_wave_s) {
  G8_COORDS
#pragma unroll
  for (int ai = 0; ai < 2; ++ai)
#pragma unroll
    for (int m = 0; m < 4; ++m) {
      const long row = (long)tm * 256 + 128 * ai + 64 * wr + 16 * m + fr;
#pragma unroll
      for (int bj = 0; bj < 2; ++bj) {
        const int col = tn * 256 + 128 * bj + 32 * wc + 8 * fq;
        *(uint4*)(p.PP + row * 1024 + col) = make_uint4(pk2(acc[ai][bj][m][0][0], acc[ai][bj][m][0][1]), pk2(acc[ai][bj][m][0][2], acc[ai][bj][m][0][3]),
                                                        pk2(acc[ai][bj][m][1][0], acc[ai][bj][m][1][1]), pk2(acc[ai][bj][m][1][2], acc[ai][bj][m][1][3]));
      }
    }
}

DI void multi_phase(CParams& p, int l, char* smem, int g_wave_s) {
  const u16* Wkv = p.Wkv + (long)l * 2048 * 512;
  const u16* Wuq = p.Wuq + (long)l * 1536 * 384;
  const u16* Wpe = p.Wpe + (long)l * 1024 * 256;
  const int total = NCKV + NPKV + NSKV + NQT + NPPT;
  const int G = gridDim.x;
  const int per_kv = (NCKV + NPKV + NSKV + G - 1) / G;
  const int t_end = min((get_bid() + 1) * per_kv, NCKV + NPKV + NSKV);
#pragma unroll 1
  for (int t = get_bid() * per_kv; t < t_end; ++t) {
    f32x4 acc[2][2][4][2];
    {
      const u16* tok; int u = t, mode;
      if (u < NCKV) { tok = p.CB + (long)(u >> 3) * 256 * 512; mode = 1; }
      else if ((u -= NCKV) < NPKV) { tok = p.C + (long)(u >> 3) * 256 * 512; mode = 0; }
      else { u -= NPKV; tok = p.C + ((long)M_P + (u >> 3) * 256) * 512; mode = 2; }
      const int m0 = (u >> 3) * 256, tn = u & 7;
      const u16* wgt = Wkv + (long)tn * 256 * 512;
      if (tn < 4) {
        gemm256_tile<1>(tok, wgt, 512, 512, smem, acc, g_wave_s);
        nope_epi256(acc, p.knn + l * 128, 1.0f, smem, [&](int rloc, int bj) -> u16* {
          const int m = m0 + rloc; const int h = 2 * tn + bj;
          if (mode == 0) return p.Knp + ((long)m * 8 + h) * 128;
          long key;
          if (mode == 1) key = (long)(m >> 12) * LKS + (m & 4095); else key = (long)(m >> 4) * LKS + PAST + (m & 15);
          return p.Kns + (key * 8 + h) * 128;
        }, g_wave_s);
      } else {
        gemm256_tile<2>(wgt, tok, 512, 512, smem, acc, g_wave_s);
        vt_epi256(p, acc, mode, m0, tn, g_wave_s);
      }
    }
  }
  int* s_q = (int*)(smem + SMEM_BYTES + 16);
  for (;;) {
    __syncthreads();
    if (get_tid() == 0) *s_q = (int)atomicAdd(p.ctr + 4 + l, 1u);
    __syncthreads();
    const int uu = *s_q;
    if (uu >= NQT + NPPT) break;
    f32x4 acc[2][2][4][2];
    int u = uu;
    if (u < NQT) {
      const int tm = u / 6, tn = u - tm * 6;
      gemm256_tile<1>(p.QN + (long)tm * 256 * 384, Wuq + (long)tn * 256 * 384, 384, 384, smem, acc, g_wave_s);
      if (tn < 4) nope_epi256(acc, p.qnn + l * 128, QSCALE, smem, [&](int rloc, int bj) -> u16* { return p.Q + ((long)(tm * 256 + rloc) * 8 + 2 * tn + bj) * 192; }, g_wave_s);
      else rope_epi256(p, l, acc, tm, tn, smem, g_wave_s);
      continue;
    }
    u -= NQT;
    {
      const int tm = u >> 2, tn = u & 3;
      gemm256_tile<1>(p.PB + (long)tm * 256 * 256, Wpe + (long)tn * 256 * 256, 256, 256, smem, acc, g_wave_s);
      pp_epi256(p, acc, tm, tn, g_wave_s);
    }
  }
}

#define ASTAGE 40960
template <int SPLIT>
DI void attn_item(const u16* __restrict__ Qb, int qclamp, const u16* __restrict__ Kn, const u16* __restrict__ KR,
                  const u16* __restrict__ VT, long vt_stride, int ntiles, int ntw, int Lk, u16* __restrict__ Ob, char* smem, int g_wave_s) {
  const int tid = get_tid(), lane = tid & 63, w = tid >> 6, r = lane & 31, hh = lane >> 5;
  constexpr int KTN = SPLIT ? 1 : 2;
  const int ktb = SPLIT ? (w & 1) : 0;
  const int qrow0 = SPLIT ? 0 : 32 * w;
  bf16x8 qf[12];
  {
    const int qr = r < qclamp ? r : qclamp;
    const u16* qp = Qb + (long)(qrow0 + qr) * (8 * 192) + 8 * hh;
#pragma unroll
    for (int ks = 0; ks < 12; ++ks) qf[ks] = *(const bf16x8*)(qp + 16 * ks);
  }
  f32x16 oacc[4];
#pragma unroll
  for (int dt = 0; dt < 4; ++dt)
#pragma unroll
    for (int i = 0; i < 16; ++i) oacc[dt][i] = 0.f;
  float mrun = 0.f, lrun = 0.f;

  const int lrow = tid >> 3, lq = tid & 7;
  const int sch = lq ^ ((lrow >> 1) & 7);
  unsigned koff = (unsigned)(lrow * 1024 + sch * 8) * 2u;
  unsigned kroff = (unsigned)(lrow * 64 + sch * 8) * 2u;
  const unsigned vstep = (unsigned)(64 * vt_stride * 2);
  unsigned voff = (unsigned)(lrow * vt_stride * 2 + sch * 16);
  const char* KnB = (const char*)Kn; const char* KRB = (const char*)KR; const char* VTB = (const char*)VT;
  char* dstT = smem + tid * 16;
#define ADMA(st_) { char* d_ = dstT + (st_) * ASTAGE; \
    __builtin_amdgcn_global_load_lds((const unsigned*)(KnB + (size_t)koff), (unsigned*)(d_), 16, 0, SPLIT ? 2 : 0); \
    __builtin_amdgcn_global_load_lds((const unsigned*)(KnB + (size_t)koff + 128), (unsigned*)(d_ + 8192), 16, 0, SPLIT ? 2 : 0); \
    __builtin_amdgcn_global_load_lds((const unsigned*)(KRB + (size_t)kroff), (unsigned*)(d_ + 16384), 16, 0, 0); \
    __builtin_amdgcn_global_load_lds((const unsigned*)(VTB + (size_t)voff), (unsigned*)(d_ + 24576), 16, 0, SPLIT ? 2 : 0); \
    __builtin_amdgcn_global_load_lds((const unsigned*)(VTB + (size_t)(voff + vstep)), (unsigned*)(d_ + 32768), 16, 0, SPLIT ? 2 : 0); \
    koff += 64 * 1024 * 2; kroff += 64 * 64 * 2; voff += 128; }
  const int xr = (r >> 1) & 7;
  const int xo0 = ((0 + hh) ^ xr) << 4, xo1 = ((2 + hh) ^ xr) << 4, xo2 = ((4 + hh) ^ xr) << 4, xo3 = ((6 + hh) ^ xr) << 4;
  const char* rbase = smem + r * 128;

  f32x16 sacc[2];
#define KFRAG(sb_, ks_, kt_) (*(const bf16x8*)((sb_) + ((ks_) >> 2) * 8192 + (kt_) * 4096 + ((((ks_) & 3) == 0) ? xo0 : (((ks_) & 3) == 1) ? xo1 : (((ks_) & 3) == 2) ? xo2 : xo3)))
#define VFRAG(sb_, dt_, q_) (*(const bf16x8*)((sb_) + 24576 + (dt_) * 4096 + (((q_) == 0) ? xo0 : ((q_) == 1) ? xo1 : ((q_) == 2) ? xo2 : xo3)))
#define VFRAGX(sb_, dt_, xo_) (*(const bf16x8*)((sb_) + 24576 + (dt_) * 4096 + (xo_)))
  const int vx0 = ktb ? xo2 : xo0, vx1 = ktb ? xo3 : xo1; (void)vx0; (void)vx1;
#define ATT_S(st_) { \
    { const float ninit = -mrun; _Pragma("unroll") for (int kt = 0; kt < KTN; ++kt) _Pragma("unroll") for (int i = 0; i < 16; ++i) sacc[kt][i] = ninit; }     \
    const char* sb = rbase + (st_) * ASTAGE; \
    _Pragma("unroll") for (int ks = 0; ks < 12; ++ks) { \
      bf16x8 k0 = KFRAG(sb, ks, ktb); \
      sacc[0] = MFMA(k0, qf[ks], sacc[0]); \
      if (!SPLIT) { bf16x8 k1 = KFRAG(sb, ks, 1); sacc[1] = MFMA(k1, qf[ks], sacc[1]); } \
      if ((ks & 3) == 3) __builtin_amdgcn_sched_barrier(0); } }
#define ATT_PV(jt_, st_) { \
    if (((jt_) + 1) * 64 > Lk) { \
      _Pragma("unroll") for (int kt = 0; kt < KTN; ++kt) _Pragma("unroll") for (int i = 0; i < 16; ++i) { \
          const int key = (jt_) * 64 + 32 * (kt + ktb) + (i & 3) + 8 * (i >> 2) + 4 * hh; \
          if (key >= Lk) sacc[kt][i] = -INFINITY; } } \
    float tmax = -INFINITY; \
    _Pragma("unroll") for (int kt = 0; kt < KTN; ++kt) _Pragma("unroll") for (int i = 0; i < 16; ++i) tmax = fmaxf(tmax, sacc[kt][i]); \
    tmax = fmaxf(tmax, shfl_xor_l(tmax, lane, 32)); \
      \
    if (__builtin_amdgcn_ballot_w64(tmax > 8.0f) != 0ull) { \
      const float dlt = fmaxf(tmax, 0.f); \
      const float alpha = __builtin_amdgcn_exp2f(-dlt); \
      mrun += dlt; \
      lrun *= alpha; \
      _Pragma("unroll") for (int kt = 0; kt < KTN; ++kt) _Pragma("unroll") for (int i = 0; i < 16; ++i) sacc[kt][i] -= dlt; \
      _Pragma("unroll") for (int dt = 0; dt < 4; ++dt) _Pragma("unroll") for (int i = 0; i < 16; ++i) oacc[dt][i] *= alpha; \
    } \
    float psum = 0.f; \
    _Pragma("unroll") for (int kt = 0; kt < KTN; ++kt) _Pragma("unroll") for (int i = 0; i < 16; ++i) { const float pv = __builtin_amdgcn_exp2f(sacc[kt][i]); sacc[kt][i] = pv; psum += pv; } \
    lrun += psum; \
    bf16x8 pf[2][2]; \
    _Pragma("unroll") for (int kt = 0; kt < KTN; ++kt) _Pragma("unroll") for (int s = 0; s < 2; ++s) { \
        uint4 pp = make_uint4(pk2(sacc[kt][8 * s + 0], sacc[kt][8 * s + 1]), pk2(sacc[kt][8 * s + 2], sacc[kt][8 * s + 3]), \
                              pk2(sacc[kt][8 * s + 4], sacc[kt][8 * s + 5]), pk2(sacc[kt][8 * s + 6], sacc[kt][8 * s + 7])); \
        pf[kt][s] = __builtin_bit_cast(bf16x8, pp); } \
    const char* sb = rbase + (st_) * ASTAGE; \
    _Pragma("unroll") for (int dt = 0; dt < 4; ++dt) _Pragma("unroll") for (int kt = 0; kt < KTN; ++kt) _Pragma("unroll") for (int s = 0; s < 2; ++s) { \
          bf16x8 vf = SPLIT ? VFRAGX(sb, dt, (s == 0 ? vx0 : vx1)) : VFRAG(sb, dt, 2 * kt + s); \
          oacc[dt] = MFMA(vf, pf[kt][s], oacc[dt]); \
          if (kt == 1 && s == 1) __builtin_amdgcn_sched_barrier(0); } }

  ADMA(0)
  if (ntiles > 1) ADMA(1)
  int st = 0;
#pragma unroll 1
  for (int jt = 0; jt < ntiles; ++jt) {
    if (jt + 1 < ntiles) asm volatile("s_waitcnt vmcnt(5)" ::: "memory");
    else asm volatile("s_waitcnt vmcnt(0)" ::: "memory");
    __syncthreads();
    const int stp = st == 0 ? 2 : st - 1;
    if (jt + 2 < ntiles) ADMA(stp)
    if (jt < ntw) { ATT_S(st) ATT_PV(jt, st) }
    st = st == 2 ? 0 : st + 1;
  }
#undef ATT_S
#undef ATT_PV
#undef KFRAG
#undef VFRAG
#undef VFRAGX
#undef ADMA
  if (SPLIT) {
    float* mg = (float*)smem;
    __syncthreads();
    if (w == 1) {
      mg[lane] = mrun; mg[64 + lane] = lrun;
#pragma unroll
      for (int dt = 0; dt < 4; ++dt)
#pragma unroll
        for (int i = 0; i < 16; ++i) mg[(2 + 16 * dt + i) * 64 + lane] = oacc[dt][i];
    }
    __syncthreads();
    if (w == 0) {
      const float m1 = mg[lane], l1 = mg[64 + lane];
      const float mm = fmaxf(mrun, m1);
      const float a0 = __builtin_amdgcn_exp2f(mrun - mm), a1 = __builtin_amdgcn_exp2f(m1 - mm);
      lrun = lrun * a0 + l1 * a1;
#pragma unroll
      for (int dt = 0; dt < 4; ++dt)
#pragma unroll
        for (int i = 0; i < 16; ++i) oacc[dt][i] = oacc[dt][i] * a0 + mg[(2 + 16 * dt + i) * 64 + lane] * a1;
    }
    if (w != 0) ntw = 0;
  }
  if (ntw > 0 && r <= qclamp) {
    const float ltot = lrun + shfl_xor_l(lrun, lane, 32);
    const float inv = 1.f / ltot;
    u16* op = Ob + (long)(qrow0 + r) * 1024;
#pragma unroll
    for (int dt = 0; dt < 4; ++dt)
#pragma unroll
      for (int i4 = 0; i4 < 4; ++i4) {
        const int d = 32 * dt + 8 * i4 + 4 * hh;
        *(uint2*)(op + d) = make_uint2(pk2(oacc[dt][4 * i4 + 0] * inv, oacc[dt][4 * i4 + 1] * inv), pk2(oacc[dt][4 * i4 + 2] * inv, oacc[dt][4 * i4 + 3] * inv));
      }
  } else if (ntw > 0) {
    (void)shfl_xor_l(lrun, lane, 32);
  }
}

DI void attn_phase(CParams& p, int l, char* smem, int* s_item, int cidx, int g_wave_s) {
  const int tid = get_tid(), w = tid >> 6;
  (void)cidx;
  const int xq = (int)((unsigned)__builtin_amdgcn_s_getreg((3 << 11) | 20) & 7u);
  unsigned* qctr = p.ctr + 16 + l * 8;
  int qoff = 0;
  for (;;) {
    __syncthreads();
    if (tid == 0) {
      int code = -1;
      for (int a = qoff; a < 8; ++a) {
        const int q = (xq + a) & 7;
        const int it = (int)atomicAdd(qctr + q, 1u);
        if (it < 96) { code = (a << 16) | (q << 8) | it; break; }
      }
      *s_item = code;
    }
    __syncthreads();
    const int code = *s_item;
    if (code < 0) break;
    qoff = code >> 16;
    const int h = (code >> 8) & 7, item = code & 255;
    const int i3 = item / 3, r3 = item - 3 * i3;
    if (r3 == 2) {
      const int b = i3;
      const u16* Qb = p.Q + ((long)(M_P + 16 * b) * 8 + h) * 192;
      const u16* Kn = p.Kns + ((long)b * LKS * 8 + h) * 128;
      const u16* KR = p.KRs + (long)b * LKS * 64;
      const u16* VT = p.VTs + ((long)b * 8 + h) * 128 * LKS;
      u16* Ob = p.OA + (long)(M_P + 16 * b) * 1024 + h * 128;
      attn_item<1>(Qb, 15, Kn, KR, VT, LKS, 65, w < 2 ? 65 : 0, LKV, Ob, smem, g_wave_s);
    } else {
      const int qb = 63 - (2 * i3 + r3);
      const u16* Qb = p.Q + ((long)(256 * qb) * 8 + h) * 192;
      const u16* Kn = p.Knp + (long)h * 128;
      const u16* KR = p.KRp;
      const u16* VT = p.VTp + (long)h * 128 * M_P;
      u16* Ob = p.OA + (long)(256 * qb) * 1024 + h * 128;
      const int ntiles = 4 * qb + 4;
      attn_item<0>(Qb, 31, Kn, KR, VT, M_P, ntiles, 4 * qb + (w >> 1) + 1, 1 << 30, Ob, smem, g_wave_s);
    }
  }
}

DI void gmlp_phase(CParams& p, int l, char* smem_all, int g_wave_s) {
  const int half = get_tid() >> 8; char* smem = smem_all + half * HALF_BYTES;
  const int tid = get_tid() & 255, lane = tid & 63, w = tid >> 6, wm = w >> 1, wn = w & 1, r = lane & 31, hh = lane >> 5;
  const float* gvn = p.gvn + l * 1024;
  const float* gws = p.gws + (long)l * 8 * 128 * 128;
  const float* gbs = p.gbs + (long)l * 8 * 128;
  u16* Xs = (u16*)smem;
  u16* Ws = Xs + 128 * 136;
  const int NP = 128 * 8, NS = 32 * 4;
  for (int t2 = get_bid(); t2 < (NP + NS + 1) / 2; t2 += gridDim.x) {
    const int t = 2 * t2 + half;
    const bool valid = t < NP + NS;
    const bool isp = valid && t < NP;
    {
      const int ci = t >> 3, g = t & 7;
      const int t0 = ci * 128, c0 = g * 128;
      __syncthreads();
      if (isp) {
      {
        unsigned* Xs32 = (unsigned*)Xs;
#pragma unroll
        for (int i = 0; i < 4; ++i) {
          const int sp = (tid & 15) + 16 * i, dq = (tid >> 4) & 15, dc = dq * 8;
          const int sl0 = (dc & ~15) | ((dq & 1) ? 4 : 0), sl1 = (dc & ~15) | ((dq & 1) ? 12 : 8);
          const uint4 v0 = *(const uint4*)(p.Z + (long)(t0 + 2 * sp) * LDZ + ZV + c0 + dc);
          const uint4 v1 = *(const uint4*)(p.Z + (long)(t0 + 2 * sp + 1) * LDZ + ZV + c0 + dc);
          const float r0 = p.rsv[t0 + 2 * sp], r1 = p.rsv[t0 + 2 * sp + 1];
          const float4 g0 = *(const float4*)(gvn + c0 + dc), g1 = *(const float4*)(gvn + c0 + dc + 4);
          Xs32[(sl0 + 0) * 68 + sp] = pk2(bflo(v0.x) * r0 * g0.x, bflo(v1.x) * r1 * g0.x); Xs32[(sl0 + 1) * 68 + sp] = pk2(bfhi(v0.x) * r0 * g0.y, bfhi(v1.x) * r1 * g0.y);
          Xs32[(sl0 + 2) * 68 + sp] = pk2(bflo(v0.y) * r0 * g0.z, bflo(v1.y) * r1 * g0.z); Xs32[(sl0 + 3) * 68 + sp] = pk2(bfhi(v0.y) * r0 * g0.w, bfhi(v1.y) * r1 * g0.w);
          Xs32[(sl1 + 0) * 68 + sp] = pk2(bflo(v0.z) * r0 * g1.x, bflo(v1.z) * r1 * g1.x); Xs32[(sl1 + 1) * 68 + sp] = pk2(bfhi(v0.z) * r0 * g1.y, bfhi(v1.z) * r1 * g1.y);
          Xs32[(sl1 + 2) * 68 + sp] = pk2(bflo(v0.w) * r0 * g1.z, bflo(v1.w) * r1 * g1.z); Xs32[(sl1 + 3) * 68 + sp] = pk2(bfhi(v0.w) * r0 * g1.w, bfhi(v1.w) * r1 * g1.w);
        }
      }
#pragma unroll
      for (int i = 0; i < 8; ++i) {
        const int c = tid + 256 * i;
        const int tt = c >> 4, sc = (c & 15) * 8;
        *(uint4*)(Ws + tt * 136 + sc) = *(const uint4*)(p.WgB + (((long)l * 8 + g) * 128 + tt) * 128 + sc);
      }
      }
      __syncthreads();
      if (isp) {
      f32x16 acc[2][2];
#pragma unroll
      for (int mi = 0; mi < 2; ++mi)
#pragma unroll
        for (int ni = 0; ni < 2; ++ni)
#pragma unroll
          for (int i = 0; i < 16; ++i) acc[mi][ni][i] = 0.f;
      const u16* Ab = Ws + (64 * wm + r) * 136 + 8 * hh;
      const u16* Bb = Xs + (64 * wn + r) * 136 + 8 * hh;
#pragma unroll
      for (int ks = 0; ks < 8; ++ks) {
        bf16x8 a0 = *(const bf16x8*)(Ab + 16 * ks), a1 = *(const bf16x8*)(Ab + 32 * 136 + 16 * ks);
        bf16x8 b0 = *(const bf16x8*)(Bb + 16 * ks), b1 = *(const bf16x8*)(Bb + 32 * 136 + 16 * ks);
        acc[0][0] = MFMA(b0, a0, acc[0][0]); acc[0][1] = MFMA(b1, a0, acc[0][1]);
        acc[1][0] = MFMA(b0, a1, acc[1][0]); acc[1][1] = MFMA(b1, a1, acc[1][1]);
      }
#pragma unroll
      for (int mi = 0; mi < 2; ++mi) {
        const int tl = 64 * wm + 32 * mi + r;
        const long row = t0 + tl;
        const float bias = gbs[g * 128 + tl];
        const u16* zr = p.Z + row * LDZ;
#pragma unroll
        for (int ni = 0; ni < 2; ++ni)
#pragma unroll
          for (int g8 = 0; g8 < 2; ++g8) {
            const int col = c0 + 64 * wn + 32 * ni + 16 * g8 + 8 * hh;
            const uint4 uu = *(const uint4*)(zr + ZU + col), ga = *(const uint4*)(zr + ZGA + col), gb = *(const uint4*)(zr + ZGB + col);
            const uint4 oa = *(const uint4*)(p.OA + row * 1024 + col);
            const unsigned uw[4] = {uu.x, uu.y, uu.z, uu.w}, gaw[4] = {ga.x, ga.y, ga.z, ga.w}, gbw[4] = {gb.x, gb.y, gb.z, gb.w}, oaw[4] = {oa.x, oa.y, oa.z, oa.w};
            unsigned ow[4];
#pragma unroll
            for (int q = 0; q < 4; ++q) {
              const float o0 = sigm(bflo(gaw[q])) * bflo(oaw[q]) + sigm(bflo(gbw[q])) * bflo(uw[q]) * (acc[mi][ni][8 * g8 + 2 * q] + bias);
              const float o1 = sigm(bfhi(gaw[q])) * bfhi(oaw[q]) + sigm(bfhi(gbw[q])) * bfhi(uw[q]) * (acc[mi][ni][8 * g8 + 2 * q + 1] + bias);
              ow[q] = pk2(o0, o1);
            }
            *(uint4*)(p.MIX + row * 1024 + col) = make_uint4(ow[0], ow[1], ow[2], ow[3]);
          }
      }
      }
    }
    if (valid && !isp) {
      const int u = t - NP; const int b = u >> 2, col = (u & 3) * 256 + tid; const int g = col >> 7;
      const long row0 = M_P + 16 * b;
      const float gv = gvn[col];
      float vn[16];
#pragma unroll
      for (int s = 0; s < 16; ++s) vn[s] = bf1(p.Z[(row0 + s) * LDZ + ZV + col]) * p.rsv[row0 + s] * gv;
#pragma unroll
      for (int tt = 0; tt < 16; ++tt) {
        float mx = gbs[g * 128 + tt];
#pragma unroll
        for (int s = 0; s <= tt; ++s) mx += gws[((long)g * 128 + tt) * 128 + s] * vn[s];
        const u16* zr = p.Z + (row0 + tt) * LDZ;
        const float uu = bf1(zr[ZU + col]), ga = bf1(zr[ZGA + col]), gb = bf1(zr[ZGB + col]);
        const float oa = bf1(p.OA[(row0 + tt) * 1024 + col]);
        p.MIX[(row0 + tt) * 1024 + col] = f2bf(sigm(ga) * oa + sigm(gb) * uu * mx);
      }
    }
  }
}

#define XB_TMO      128
#define XB_XCNT(j)  (256  + 64 * (j))
#define XB_XSUB(j)  (1280 + 64 * (j))
#define XB_XGEN(j)  (2304 + 64 * (j))
#define XB_TOP      3328
#define XB_TOPGEN   3392
#define XCD_BAR_WORDS 3456
#define XB_SPIN_CAP (1u << 22)
#define LAS __attribute__((address_space(3)))
DI unsigned xb_ld(unsigned* p) { return __hip_atomic_load(p, __ATOMIC_RELAXED, __HIP_MEMORY_SCOPE_AGENT); }
DI unsigned xb_add(unsigned* p, unsigned v) { return __hip_atomic_fetch_add(p, v, __ATOMIC_RELAXED, __HIP_MEMORY_SCOPE_AGENT); }
DI unsigned xb_xcc_id() { return (unsigned)__builtin_amdgcn_s_getreg((3 << 11) | 20) & 0xFu; }
#define XB_SPIN(cond, bar) do { unsigned _sp = 0; while (cond) { __builtin_amdgcn_s_sleep(1); \
    if ((++_sp & 255u) == 0u) { if (xb_ld(&(bar)[XB_TMO])) break; if (_sp > XB_SPIN_CAP) { atomicAdd(&(bar)[XB_TMO], 1u); break; } } } } while (0)
struct XcdBarrier { unsigned* bar; unsigned x; volatile LAS unsigned* st; };
DI XcdBarrier xcd_barrier_post(unsigned* bar, volatile LAS unsigned* st) {
  XcdBarrier b; b.bar = bar; b.x = xb_xcc_id(); b.st = st;
  if (threadIdx.x == 0) (void)xb_add(&bar[XB_XCNT(b.x)], 1u);
  return b;
}
DI void xcd_barrier_complete(unsigned* bar, unsigned x, unsigned& nloc, unsigned& nx) {
  const unsigned G = gridDim.x * gridDim.y * gridDim.z;
  unsigned sum, cnt, mine, sp = 0u;
  for (;;) {
    sum = 0u; cnt = 0u; mine = 0u;
#pragma unroll
    for (unsigned j = 0; j < 16; ++j) { const unsigned c = xb_ld(&bar[XB_XCNT(j)]); sum += c; cnt += (c > 0u) ? 1u : 0u; mine = (j == x) ? c : mine; }
    if (sum == G) break;
    __builtin_amdgcn_s_sleep(1);
    if ((++sp & 255u) == 0u) { if (xb_ld(&bar[XB_TMO])) break; if (sp > XB_SPIN_CAP) { atomicAdd(&bar[XB_TMO], 1u); break; } }
  }
  nloc = mine > 0u ? mine : 1u; nx = cnt > 0u ? cnt : 1u;
}
DI void xcd_barrier(const XcdBarrier& b) {
  asm volatile("s_waitcnt vmcnt(0)" ::: "memory");
  __syncthreads();
  if (threadIdx.x == 0) {
    unsigned* bar = b.bar;
    unsigned bx_ = b.x; asm volatile("" : "+s"(bx_));
    asm volatile("" : "+s"(bar));
    __builtin_amdgcn_s_waitcnt(0);
    unsigned nloc = b.st[0], nx = b.st[1];
    if (nloc == 0u) { xcd_barrier_complete(bar, bx_, nloc, nx); b.st[0] = nloc; b.st[1] = nx; }
    const unsigned old = xb_add(&bar[XB_XSUB(bx_)], 1u);
    const unsigned gen = old / nloc;
    if (old + 1u == (gen + 1u) * nloc) {
      __builtin_amdgcn_fence(__ATOMIC_RELEASE, "agent");
      asm volatile("s_waitcnt vmcnt(0)" ::: "memory");
      const unsigned og = xb_add(&bar[XB_TOP], 1u);
      const unsigned tg = og / nx;
      if (og + 1u == (tg + 1u) * nx) xb_add(&bar[XB_TOPGEN], 1u);
      else XB_SPIN(xb_ld(&bar[XB_TOPGEN]) == tg, bar);
      __builtin_amdgcn_fence(__ATOMIC_ACQUIRE, "agent");
      xb_add(&bar[XB_XGEN(bx_)], 1u);
      asm volatile("s_waitcnt vmcnt(0)" ::: "memory");
    } else {
      XB_SPIN(xb_ld(&bar[XB_XGEN(bx_)]) == gen, bar);
      __builtin_amdgcn_fence(__ATOMIC_ACQUIRE, "agent");
      asm volatile("s_waitcnt vmcnt(0)" ::: "memory");
    }
  }
  __syncthreads();
}

DI CParams& fresh_params() {
  auto kp = __builtin_amdgcn_kernarg_segment_ptr();
  asm volatile("" : "+s"(kp));
  return *(CParams*)kp;
}
#define P_ fresh_params()
__global__ void __launch_bounds__(512, 2) mega_fwd(Params p_unused) {
  const int g_wave_s = __builtin_amdgcn_readfirstlane((int)(threadIdx.x >> 6));
  extern __shared__ __attribute__((aligned(16))) char smem[];
  uint4& xb_words = *(uint4*)(smem + SMEM_BYTES);
  int& s_item = *(int*)(smem + SMEM_BYTES + 16);
  cg::grid_group grid = cg::this_grid();
  if (threadIdx.x == 0) xb_words = make_uint4(0u, 0u, 0u, 0u);
  __syncthreads();
  XcdBarrier xb = xcd_barrier_post(P_.bar, (volatile LAS unsigned*)&xb_words);

  prep_phase(P_, smem, g_wave_s);
  if (P_.out == nullptr) grid.sync();
  xcd_barrier(xb);
#pragma unroll 1
  for (int l = 0; l < 2; ++l) {
    norm_phase(P_.out, P_.f1n + l * 1024, P_.NB, P_.PART, 0, g_wave_s);
    xcd_barrier(xb);
    ffn_up_phase(P_, P_.Wgu1 + (long)l * 2 * DFF * 1024, smem, g_wave_s);
    xcd_barrier(xb);
    resid_gemm_phase(P_, P_.ACT, DFF, P_.Wd1 + (long)l * 1024 * DFF, 0.5f, smem, g_wave_s);
    xcd_barrier(xb);
    norm_phase(P_.out, P_.mixn + l * 1024, P_.NB, P_.PART, DFF / 256, g_wave_s);
    xcd_barrier(xb);
    win_phase(P_, P_.Win + (long)l * LDZ * 1024, smem, g_wave_s);
    xcd_barrier(xb);
    rowpost_phase(P_, l, g_wave_s);
    xcd_barrier(xb);
    multi_phase(P_, l, smem, g_wave_s);
    xcd_barrier(xb);
    attn_phase(P_, l, smem, &s_item, l, g_wave_s);
    xcd_barrier(xb);
    gmlp_phase(P_, l, smem, g_wave_s);
    xcd_barrier(xb);
    resid_gemm_phase(P_, P_.MIX, 1024, P_.Wo + (long)l * 1024 * 1024, 1.0f, smem, g_wave_s);
    xcd_barrier(xb);
    norm_phase(P_.out, P_.f2n + l * 1024, P_.NB, P_.PART, 1024 / 256, g_wave_s);
    xcd_barrier(xb);
    ffn_up_phase(P_, P_.Wgu2 + (long)l * 2 * DFF * 1024, smem, g_wave_s);
    xcd_barrier(xb);
    resid_gemm_phase(P_, P_.ACT, DFF, P_.Wd2 + (long)l * 1024 * DFF, 0.5f, smem, g_wave_s);
    xcd_barrier(xb);
    norm_phase(P_.out, P_.plen + l * 1024, P_.NB, P_.PART, DFF / 256, g_wave_s);
    xcd_barrier(xb);
    ple_phase(P_, P_.Wpg + (long)l * 1024 * 1024, smem, g_wave_s);
    xcd_barrier(xb);
  }
}

extern "C" void kernel_launch(void* const* d_in, const int* in_sizes, int n_in, void* d_out, int out_size, void* d_ws,
                              size_t ws_size, hipStream_t stream) {
  (void)in_sizes; (void)n_in; (void)out_size; (void)ws_size;
  Params p{};
  auto F = [&](int i) { return (const float*)d_in[i]; };
  p.x_prompt = F(0); p.x_sample = F(1); p.cache_c = F(2); p.cache_kr = F(3); p.p_prompt = F(4); p.p_sample = F(5);
  p.f1n = F(6); p.mixn = F(10); p.qan = F(12); p.qnn = F(14); p.qrn = F(15); p.kvan = F(16); p.krn = F(17);
  p.knn = F(20); p.gvn = F(21); p.gws = F(22); p.gbs = F(23); p.f2n = F(25); p.plen = F(29);
  p.out = (float*)d_out;
  char* ws = (char*)d_ws; size_t off = 0;
  auto alloc = [&](size_t bytes) { char* r = ws + off; off += (bytes + 255) & ~(size_t)255; return r; };
  p.Wgu1 = (u16*)alloc(2UL * 2 * DFF * 1024 * 2);
  p.Wd1 = (u16*)alloc(2UL * 1024 * DFF * 2);
  p.Win = (u16*)alloc(2UL * LDZ * 1024 * 2);
  p.Wuq = (u16*)alloc(2UL * 1536 * 384 * 2);
  p.Wkv = (u16*)alloc(2UL * 2048 * 512 * 2);
  p.Wo = (u16*)alloc(2UL * 1024 * 1024 * 2);
  p.Wgu2 = (u16*)alloc(2UL * 2 * DFF * 1024 * 2);
  p.Wd2 = (u16*)alloc(2UL * 1024 * DFF * 2);
  p.Wpg = (u16*)alloc(2UL * 1024 * 1024 * 2);
  p.Wpe = (u16*)alloc(2UL * 1024 * 256 * 2);
  p.NB = (u16*)alloc((size_t)M_ALL * 1024 * 2);
  p.ACT = (u16*)alloc((size_t)M_ALL * DFF * 2);
  p.Z = (u16*)alloc((size_t)M_ALL * LDZ * 2);
  p.QN = (u16*)alloc((size_t)M_ALL * 384 * 2);
  p.C = (u16*)alloc((size_t)M_ALL * 512 * 2);
  p.KRp = (u16*)alloc((size_t)M_P * 64 * 2);
  p.KRs = (u16*)alloc((size_t)32 * LKS * 64 * 2);
  p.Q = (u16*)alloc((size_t)M_ALL * 8 * 192 * 2);
  p.Knp = (u16*)alloc((size_t)M_P * 1024 * 2);
  p.VTp = (u16*)alloc((size_t)M_P * 1024 * 2);
  p.Kns = (u16*)alloc((size_t)32 * LKS * 1024 * 2);
  p.VTs = (u16*)alloc((size_t)32 * LKS * 1024 * 2);
  p.OA = (u16*)alloc((size_t)M_ALL * 1024 * 2);
  p.MIX = (u16*)alloc((size_t)M_ALL * 1024 * 2);
  p.PP = (u16*)alloc((size_t)M_ALL * 1024 * 2);
  p.CB = (u16*)alloc((size_t)32 * PAST * 512 * 2);
  p.PB = (u16*)alloc((size_t)M_ALL * 256 * 2);
  p.WgB = (u16*)alloc((size_t)2 * 8 * 128 * 128 * 2);
  p.rsv = (float*)alloc((size_t)M_ALL * 4);
  p.PART = (float*)alloc((size_t)11 * M_S * 1024 * 4);
  p.rope = (float*)alloc((size_t)16384 * 32 * 2 * 4);
  p.ctr = (unsigned*)alloc(256);
  p.bar = (unsigned*)alloc(XCD_BAR_WORDS * 4);

  int nj = 0, ts = 0;
  auto job = [&](const float* src, u16* dst, int K, int N, int kind) {
    p.jobs[nj].src = src; p.jobs[nj].dst = dst; p.jobs[nj].K = K; p.jobs[nj].N = N; p.jobs[nj].kind = kind; p.jobs[nj].tstart = ts;
    ts += (K / 64) * ((N / 64 + 3) / 4); ++nj;
  };
  for (int l = 0; l < 2; ++l) {
    job(F(7) + (size_t)l * 1024 * DFF, p.Wgu1 + (size_t)l * 2 * DFF * 1024, 1024, DFF, 1);
    job(F(8) + (size_t)l * 1024 * DFF, p.Wgu1 + (size_t)l * 2 * DFF * 1024, 1024, DFF, 2);
    job(F(9) + (size_t)l * DFF * 1024, p.Wd1 + (size_t)l * 1024 * DFF, DFF, 1024, 0);
    job(F(11) + (size_t)l * 1024 * DIN, p.Win + (size_t)l * LDZ * 1024, 1024, DIN, 0);
    job(F(13) + (size_t)l * 384 * 1536, p.Wuq + (size_t)l * 1536 * 384, 384, 1536, 3);
    job(F(18) + (size_t)l * 512 * 1024, p.Wkv + (size_t)l * 2048 * 512, 512, 1024, 0);
    job(F(19) + (size_t)l * 512 * 1024, p.Wkv + (size_t)l * 2048 * 512, 512, 1024, 4);
    job(F(24) + (size_t)l * 1024 * 1024, p.Wo + (size_t)l * 1024 * 1024, 1024, 1024, 0);
    job(F(26) + (size_t)l * 1024 * DFF, p.Wgu2 + (size_t)l * 2 * DFF * 1024, 1024, DFF, 1);
    job(F(27) + (size_t)l * 1024 * DFF, p.Wgu2 + (size_t)l * 2 * DFF * 1024, 1024, DFF, 2);
    job(F(28) + (size_t)l * DFF * 1024, p.Wd2 + (size_t)l * 1024 * DFF, DFF, 1024, 0);
    job(F(30) + (size_t)l * 1024 * 1024, p.Wpg + (size_t)l * 1024 * 1024, 1024, 1024, 0);
    job(F(31) + (size_t)l * 256 * 1024, p.Wpe + (size_t)l * 1024 * 256, 256, 1024, 0);
  }
  p.ntile_prep = ts;

  static int grid_blocks = 0;
  if (!grid_blocks) {
    int dev = 0, cus = 0, per_cu = 0;
    hipGetDevice(&dev);
    hipDeviceGetAttribute(&cus, hipDeviceAttributeMultiprocessorCount, dev);
    hipFuncSetAttribute((const void*)mega_fwd, hipFuncAttributeMaxDynamicSharedMemorySize, LDS_TOTAL);
    hipOccupancyMaxActiveBlocksPerMultiprocessor(&per_cu, (const void*)mega_fwd, 512, LDS_TOTAL);
    if (per_cu > 1) per_cu = 1;
    if (per_cu < 1) per_cu = 1;
    grid_blocks = cus * per_cu;
  }
  (void)hipMemsetAsync(p.bar, 0, XCD_BAR_WORDS * 4, stream);
  void* args[] = {&p};
  hipError_t e = hipLaunchCooperativeKernel((const void*)mega_fwd, dim3(grid_blocks), dim3(512), args, LDS_TOTAL, stream);
  if (e != hipSuccess) fprintf(stderr, "cooperative launch failed: %s (grid %d)\n", hipGetErrorString(e), grid_blocks);
}
```

```cpp
#include <hip/hip_runtime.h>
#include <hip/hip_cooperative_groups.h>
#include <cstdio>
namespace cg = cooperative_groups;

#define DI __device__ __forceinline__
typedef unsigned short u16;
typedef __attribute__((ext_vector_type(8))) short bf16x8;
typedef __attribute__((ext_vector_type(16))) float f32x16;
typedef __attribute__((ext_vector_type(2))) __bf16 bf2_t;
typedef __attribute__((ext_vector_type(2))) float f2_t;

#define M_P 16384
#define M_S 512
#define M_ALL 16896
#define DM 1024
#define DFF 2816
#define DIN 5056
#define LDZ 5120
#define ZQ 0
#define ZKV 384
#define ZKR 896
#define ZU 960
#define ZV 1984
#define ZGA 3008
#define ZGB 4032
#define LKS 4160
#define LKV 4112
#define PAST 4096
#define EPSF 1e-6f
#define QSCALE (0.07216878364870322f * 1.4426950408889634f)

#define NJOBS 26
struct TJob { const float* src; u16* dst; int K, N, kind, tstart; };

struct Params {
  const float *x_prompt, *x_sample, *cache_c, *cache_kr, *p_prompt, *p_sample;
  const float *f1n, *mixn, *qan, *qnn, *qrn, *kvan, *krn, *knn, *gvn, *gws, *gbs, *f2n, *plen;
  float* out;
  u16 *Wgu1, *Wd1, *Win, *Wuq, *Wkv, *Wo, *Wgu2, *Wd2, *Wpg, *Wpe;
  u16 *CB, *PB, *WgB;
  u16 *NB, *ACT, *Z, *QN, *C, *KRp, *KRs, *Q, *Knp, *VTp, *Kns, *VTs, *OA, *MIX, *PP;
  float *rsv, *rope, *PART;
  unsigned* ctr;
  unsigned* bar;
  TJob jobs[NJOBS];
  int ntile_prep; int pad0;
};

typedef const __attribute__((address_space(4))) Params CParams;

DI int get_tid_impl(int ws) { int t = (ws << 6) | (int)__builtin_amdgcn_mbcnt_hi(~0u, __builtin_amdgcn_mbcnt_lo(~0u, 0u)); asm volatile("" : "+v"(t)); return t; }
#define get_tid() get_tid_impl(g_wave_s)
DI int get_bid() { int t = blockIdx.x; asm volatile("" : "+s"(t)); return t; }
DI unsigned pk2(float a, float b) { f2_t v = {a, b}; bf2_t r = __builtin_convertvector(v, bf2_t); return __builtin_bit_cast(unsigned, r); }
DI float bflo(unsigned v) { return __uint_as_float(v << 16); }
DI float bfhi(unsigned v) { return __uint_as_float(v & 0xffff0000u); }
DI float bf1(u16 v) { return __uint_as_float(((unsigned)v) << 16); }
DI u16 f2bf(float a) { return (u16)(pk2(a, 0.f) & 0xffffu); }
DI float shfl_xor_l(float v, int lane, int o) { return __int_as_float(__builtin_amdgcn_ds_bpermute((lane ^ o) << 2, __float_as_int(v))); }
DI float wave_sum_l(float v, int lane) {
#pragma unroll
  for (int o = 32; o > 0; o >>= 1) v += shfl_xor_l(v, lane, o);
  return v;
}
typedef __attribute__((ext_vector_type(4))) float f4v_t;
DI float4 ld_nt16(const float* ptr) { const f4v_t v = __builtin_nontemporal_load((const f4v_t*)ptr); return make_float4(v.x, v.y, v.z, v.w); }
DI float sigm(float x) { return __builtin_amdgcn_rcpf(1.f + __builtin_amdgcn_exp2f(-1.4426950408889634f * x)); }
DI uint4 pack8(float4 x, float4 y) { return make_uint4(pk2(x.x, x.y), pk2(x.z, x.w), pk2(y.x, y.y), pk2(y.z, y.w)); }
#define MFMA(a, b, c) __builtin_amdgcn_mfma_f32_32x32x16_bf16((a), (b), (c), 0, 0, 0)

#define HALF_BYTES (73728 + 1024)
#define SMEM_BYTES (2 * HALF_BYTES)
#define LDS_TOTAL (SMEM_BYTES + 32)

DI int job_dst_row(int kind, int n) {
  if (kind == 0) return n;
  if (kind == 1) return 256 * (n >> 7) + (n & 127);
  if (kind == 2) return 256 * (n >> 7) + 128 + (n & 127);
  if (kind == 3) { int h = n / 192, c = n - h * 192; if (c < 128) return h * 128 + c; c -= 128; const int x = c >> 5, cl = c & 31;
                   return 1024 + h * 64 + 32 * (cl >> 4) + 8 * ((cl >> 2) & 3) + 4 * x + (cl & 3); }
  return 1024 + n;
}

DI void prep_phase(CParams& p, char* smem, int g_wave_s) {
  const int tid = get_tid();
  {
    const int vt = tid & 255, half = tid >> 8;
    unsigned* Ts32 = (unsigned*)smem + half * (4 * 64 * 33);
    const int npair = (p.ntile_prep + 1) >> 1;
    for (int t2 = get_bid(); t2 < npair; t2 += gridDim.x) {
      const int t = 2 * t2 + half;
      const bool valid = t < p.ntile_prep;
      int j = 0;
#pragma unroll 1
      for (int q = 1; q < NJOBS; ++q) if (t >= p.jobs[q].tstart) j = q;
      const float* src = p.jobs[j].src; u16* dst = p.jobs[j].dst;
      const int K = p.jobs[j].K, N = p.jobs[j].N, kind = p.jobs[j].kind;
      const int lt = t - p.jobs[j].tstart;
      const int ntn = N >> 6, nst = (ntn + 3) >> 2;
      const int tk = lt / nst, st = lt - tk * nst;
      const int k0 = tk * 64;
      float4 v0[4][2], v1[4][2];
      if (valid) {
#pragma unroll
        for (int q = 0; q < 4; ++q) {
          const int tn = 4 * st + q;
          if (tn < ntn) {
#pragma unroll
            for (int i = 0; i < 2; ++i) {
              const int kp = (vt >> 4) + 16 * i, nc = (vt & 15) * 4;
              v0[q][i] = ld_nt16(src + (long)(k0 + 2 * kp) * N + tn * 64 + nc);
              v1[q][i] = ld_nt16(src + (long)(k0 + 2 * kp + 1) * N + tn * 64 + nc);
            }
          }
        }
      }
      __syncthreads();
      if (valid) {
#pragma unroll
        for (int q = 0; q < 4; ++q) {
          if (4 * st + q < ntn) {
#pragma unroll
            for (int i = 0; i < 2; ++i) {
              const int kp = (vt >> 4) + 16 * i, nc = (vt & 15) * 4;
              unsigned* T = Ts32 + q * (64 * 33);
              T[(nc + 0) * 33 + kp] = pk2(v0[q][i].x, v1[q][i].x); T[(nc + 1) * 33 + kp] = pk2(v0[q][i].y, v1[q][i].y);
              T[(nc + 2) * 33 + kp] = pk2(v0[q][i].z, v1[q][i].z); T[(nc + 3) * 33 + kp] = pk2(v0[q][i].w, v1[q][i].w);
            }
          }
        }
      }
      __syncthreads();
      if (valid) {
#pragma unroll
        for (int q = 0; q < 4; ++q) {
          const int tn = 4 * st + q;
          if (tn < ntn) {
            const int n = vt >> 2, kc = (vt & 3) * 16;
            const unsigned* s32 = Ts32 + q * (64 * 33) + n * 33 + (kc >> 1);
            uint4 a = make_uint4(s32[0], s32[1], s32[2], s32[3]);
            uint4 b = make_uint4(s32[4], s32[5], s32[6], s32[7]);
            u16* d = dst + (long)job_dst_row(kind, tn * 64 + n) * K + k0 + kc;
            *(uint4*)d = a; *(uint4*)(d + 8) = b;
          }
        }
      }
    }
  }
  const long gtid = (long)get_bid() * 512 + tid, gstride = (long)gridDim.x * 512;
  for (long e = gtid; e < 2L * 64 * 1024 / 8; e += gstride) {
    const int l = (int)(e / (64 * 1024 / 8)); const long r = e - (long)l * (64 * 1024 / 8);
    *(uint4*)(p.Win + (long)l * LDZ * 1024 + (long)DIN * 1024 + r * 8) = make_uint4(0, 0, 0, 0);
  }
  for (long e = gtid; e < 16384L * 32; e += gstride) {
    const int pos = (int)(e >> 5), i = (int)(e & 31);
    const float inv = powf(10000.0f, -(float)i / 32.0f);
    const float angf = (float)pos * inv;
    const double x = (double)angf;
    const double kq = rint(x * 0.63661977236758134308);
    const double y = (x - kq * 1.5707963267341256e+00) - kq * 6.0771005065061922e-11;
    const double y2 = y * y;
    const double s = y * (1.0 + y2 * (-1.0 / 6 + y2 * (1.0 / 120 + y2 * (-1.0 / 5040 + y2 * (1.0 / 362880 + y2 * (-1.0 / 39916800))))));
    const double c = 1.0 + y2 * (-0.5 + y2 * (1.0 / 24 + y2 * (-1.0 / 720 + y2 * (1.0 / 40320 + y2 * (-1.0 / 3628800 + y2 * (1.0 / 479001600))))));
    const int q = ((int)kq) & 3;
    double cc, ss;
    if (q == 0) { cc = c; ss = s; } else if (q == 1) { cc = -s; ss = c; } else if (q == 2) { cc = -c; ss = -s; } else { cc = s; ss = -c; }
    *(float2*)(p.rope + e * 2) = make_float2((float)cc, (float)ss);
  }
  for (long e = gtid; e < (long)M_ALL * 1024 / 4; e += gstride) {
    const long pe = (long)M_P * 1024 / 4;
    float4 v = e < pe ? ld_nt16(p.x_prompt + e * 4) : ld_nt16(p.x_sample + (e - pe) * 4);
    ((float4*)p.out)[e] = v;
  }
  for (long e = gtid; e < 2L * 8 * 128 * 128 / 8; e += gstride) {
    const long el = e * 8; const int tt = (int)((el >> 7) & 127), sc = (int)(el & 127);
    float4 a = *(const float4*)(p.gws + el), b = *(const float4*)(p.gws + el + 4);
    a.x = (sc + 0 <= tt) ? a.x : 0.f; a.y = (sc + 1 <= tt) ? a.y : 0.f; a.z = (sc + 2 <= tt) ? a.z : 0.f; a.w = (sc + 3 <= tt) ? a.w : 0.f;
    b.x = (sc + 4 <= tt) ? b.x : 0.f; b.y = (sc + 5 <= tt) ? b.y : 0.f; b.z = (sc + 6 <= tt) ? b.z : 0.f; b.w = (sc + 7 <= tt) ? b.w : 0.f;
    *(uint4*)(p.WgB + el) = pack8(a, b);
  }
  if (get_bid() == 0 && tid < 64) p.ctr[tid] = 0u;
}

DI void norm_phase(float* __restrict__ h, const float* __restrict__ g, u16* __restrict__ out, const float* __restrict__ part, int nsplit, int g_wave_s) {
  const int tid = get_tid(); const int lane = tid & 63, w = tid >> 6;
  for (int row = get_bid() * 8 + w; row < M_ALL; row += gridDim.x * 8) {
    const float4* hr = (const float4*)(h + (long)row * 1024);
    float4 v[4]; float ss = 0.f;
#pragma unroll
    for (int i = 0; i < 4; ++i) v[i] = hr[lane + 64 * i];
    if (nsplit > 0 && row >= M_P) {
#pragma unroll 1
      for (int s_ = 0; s_ < nsplit; ++s_) {
        const float4* pr = (const float4*)(part + ((long)s_ * M_S + (row - M_P)) * 1024);
#pragma unroll
        for (int i = 0; i < 4; ++i) { const float4 q = pr[lane + 64 * i]; v[i].x += q.x; v[i].y += q.y; v[i].z += q.z; v[i].w += q.w; }
      }
#pragma unroll
      for (int i = 0; i < 4; ++i) ((float4*)(h + (long)row * 1024))[lane + 64 * i] = v[i];
    }
#pragma unroll
    for (int i = 0; i < 4; ++i) ss += v[i].x * v[i].x + v[i].y * v[i].y + v[i].z * v[i].z + v[i].w * v[i].w;
    ss = wave_sum_l(ss, lane);
    const float rs = rsqrtf(ss * (1.f / 1024.f) + EPSF);
#pragma unroll
    for (int i = 0; i < 4; ++i) {
      const float4 gg = ((const float4*)g)[lane + 64 * i];
      uint2 o = make_uint2(pk2(v[i].x * rs * gg.x, v[i].y * rs * gg.y), pk2(v[i].z * rs * gg.z, v[i].w * rs * gg.w));
      ((uint2*)(out + (long)row * 1024))[lane + 64 * i] = o;
    }
  }
}

typedef __attribute__((ext_vector_type(4))) float f32x4;
#define G8_HT (128 * 64)
DI int g8_lds_byte(int r, int c) { const int st = (r >> 4) * 2 + (c >> 5), rr = r & 15, cc = c & 31, ob = rr * 64 + cc * 2; return st * 1024 + (ob ^ (((ob >> 9) & 1) << 5)); }
DI void g8_stage_rc(int b, int& R, int& C) { const int st = b / 1024, sb = b % 1024, swz = sb ^ (((sb >> 9) & 1) << 5); R = (st >> 1) * 16 + swz / 64; C = (st & 1) * 32 + (swz % 64) / 2; }
DI int g8_perm32(int rho) { const int n = rho >> 4, i = rho & 15; return 8 * (i >> 2) + 4 * n + (i & 3); }

DI int g8_permT(int s_) { return 16 * ((s_ >> 3) & 1) + 8 * (s_ >> 4) + 4 * ((s_ >> 2) & 1) + (s_ & 3); }
template <int PERMB>
DI void gemm256_tile(const u16* __restrict__ A, const u16* __restrict__ Bt, int ld, int K, char* smem, f32x4 (&acc)[2][2][4][2], int g_wave_s) {
  u16* shm = (u16*)smem;
  const int tid = get_tid();
  const int wid = tid >> 6, lane = tid & 63, wr = wid >> 2, wc = wid & 3, fr = lane & 15, fq = lane >> 4;
#define G8_SA(b, h) (shm + ((b) * 2 + (h)) * G8_HT)
#define G8_SB(b, h) (shm + (4 + (b) * 2 + (h)) * G8_HT)
  int sr0, sc0;
  g8_stage_rc(tid * 16, sr0, sc0);
  const int br0 = PERMB == 1 ? ((sr0 & ~31) + g8_perm32(sr0 & 31)) : (PERMB == 2 ? ((sr0 & ~31) + g8_permT(sr0 & 31)) : sr0);
  const unsigned aoff0 = (unsigned)(sr0 * ld + sc0) * 2u;
  const unsigned boff0 = (unsigned)(br0 * ld + sc0) * 2u;
#define G8_STAGE_A(P, br, kt) do { const char* g_ = (const char*)(A + (long)(br) * ld + (long)(kt) * 64); \
    __builtin_amdgcn_global_load_lds((const unsigned*)(g_ + (size_t)aoff0), (unsigned*)((char*)(P) + tid * 16), 16, 0, 0); \
    __builtin_amdgcn_global_load_lds((const unsigned*)(g_ + (size_t)ld * 128 + (size_t)aoff0), (unsigned*)((char*)(P) + tid * 16 + 8192), 16, 0, 0); } while (0)
#define G8_STAGE_B(P, br, kt) do { const char* g_ = (const char*)(Bt + (long)(br) * ld + (long)(kt) * 64); \
    __builtin_amdgcn_global_load_lds((const unsigned*)(g_ + (size_t)boff0), (unsigned*)((char*)(P) + tid * 16), 16, 0, 0); \
    __builtin_amdgcn_global_load_lds((const unsigned*)(g_ + (size_t)ld * 128 + (size_t)boff0), (unsigned*)((char*)(P) + tid * 16 + 8192), 16, 0, 0); } while (0)
#define G8_LDA(dst, b, h) _Pragma("unroll") for (int m = 0; m < 4; ++m) _Pragma("unroll") for (int k = 0; k < 2; ++k) \
    dst[m][k] = *reinterpret_cast<const bf16x8*>((char*)G8_SA(b, h) + g8_lds_byte(wr * 64 + m * 16 + fr, k * 32 + fq * 8))
#define G8_LDB(dst, b, h) _Pragma("unroll") for (int n = 0; n < 2; ++n) _Pragma("unroll") for (int k = 0; k < 2; ++k) \
    dst[n][k] = *reinterpret_cast<const bf16x8*>((char*)G8_SB(b, h) + g8_lds_byte(wc * 32 + n * 16 + fr, k * 32 + fq * 8))
#define G8_MMA(ai, bj, At_, Bt_) do { __builtin_amdgcn_s_setprio(1); \
    _Pragma("unroll") for (int m = 0; m < 4; ++m) _Pragma("unroll") for (int n = 0; n < 2; ++n) _Pragma("unroll") for (int k = 0; k < 2; ++k) \
      acc[ai][bj][m][n] = __builtin_amdgcn_mfma_f32_16x16x32_bf16(Bt_[n][k], At_[m][k], acc[ai][bj][m][n], 0, 0, 0); \
    __builtin_amdgcn_s_setprio(0); } while (0)
#define G8_WAIT_V(n) asm volatile("s_waitcnt vmcnt(" #n ")" ::: "memory")
#define G8_WAIT_L(n) asm volatile("s_waitcnt lgkmcnt(" #n ")" ::: "memory")
#define G8_BAR __builtin_amdgcn_s_barrier()
#define G8_SCHED __builtin_amdgcn_sched_barrier(0)
#pragma unroll
  for (int ai = 0; ai < 2; ++ai)
#pragma unroll
    for (int bj = 0; bj < 2; ++bj)
#pragma unroll
      for (int m = 0; m < 4; ++m)
#pragma unroll
        for (int n = 0; n < 2; ++n) acc[ai][bj][m][n] = (f32x4){0.f, 0.f, 0.f, 0.f};
  bf16x8 At[4][2], B0[2][2], B1[2][2];
  const int nt = K >> 6;
  G8_STAGE_B(G8_SB(0, 0), 0, 0); G8_STAGE_A(G8_SA(0, 0), 0, 0);
  G8_STAGE_B(G8_SB(0, 1), 128, 0); G8_STAGE_A(G8_SA(0, 1), 128, 0);
  if (wr == 1) G8_BAR;
  G8_WAIT_V(4); G8_BAR;
  G8_STAGE_B(G8_SB(1, 0), 0, 1); G8_STAGE_A(G8_SA(1, 0), 0, 1); G8_STAGE_B(G8_SB(1, 1), 128, 1);
  G8_WAIT_V(6); G8_BAR;
#pragma unroll 1
  for (int t = 0; t < nt - 2; t += 2) {
    G8_LDB(B0, 0, 0); G8_SCHED; G8_LDA(At, 0, 0); G8_STAGE_A(G8_SA(1, 1), 128, t + 1);
    G8_WAIT_L(8); G8_BAR; G8_WAIT_L(0); G8_MMA(0, 0, At, B0); G8_BAR; G8_SCHED;
    G8_LDB(B1, 0, 1); G8_STAGE_B(G8_SB(0, 0), 0, t + 2);
    G8_BAR; G8_WAIT_L(0); G8_MMA(0, 1, At, B1); G8_BAR;
    G8_LDA(At, 0, 1); G8_STAGE_A(G8_SA(0, 0), 0, t + 2);
    G8_BAR; G8_WAIT_L(0); G8_MMA(1, 0, At, B0); G8_BAR; G8_SCHED;
    G8_STAGE_B(G8_SB(0, 1), 128, t + 2);
    G8_WAIT_V(6); G8_BAR; G8_MMA(1, 1, At, B1); G8_BAR;
    G8_LDB(B0, 1, 0); G8_SCHED; G8_LDA(At, 1, 0); G8_STAGE_A(G8_SA(0, 1), 128, t + 2);
    G8_WAIT_L(8); G8_BAR; G8_WAIT_L(0); G8_MMA(0, 0, At, B0); G8_BAR; G8_SCHED;
    G8_LDB(B1, 1, 1); G8_STAGE_B(G8_SB(1, 0), 0, t + 3);
    G8_BAR; G8_WAIT_L(0); G8_MMA(0, 1, At, B1); G8_BAR;
    G8_LDA(At, 1, 1); G8_STAGE_A(G8_SA(1, 0), 0, t + 3);
    G8_BAR; G8_WAIT_L(0); G8_MMA(1, 0, At, B0); G8_BAR; G8_SCHED;
    G8_STAGE_B(G8_SB(1, 1), 128, t + 3);
    G8_WAIT_V(6); G8_BAR; G8_MMA(1, 1, At, B1); G8_BAR;
  }
  { G8_LDB(B0, 0, 0); G8_LDA(At, 0, 0); G8_STAGE_A(G8_SA(1, 1), 128, nt - 1);
    G8_BAR; G8_WAIT_L(0); G8_MMA(0, 0, At, B0); G8_BAR;
    G8_LDB(B1, 0, 1); G8_BAR; G8_WAIT_L(0); G8_MMA(0, 1, At, B1); G8_BAR;
    G8_LDA(At, 0, 1); G8_WAIT_V(4); G8_BAR; G8_WAIT_L(0); G8_MMA(1, 0, At, B0); G8_MMA(1, 1, At, B1); G8_BAR; }
  { G8_LDB(B0, 1, 0); G8_LDA(At, 1, 0); G8_WAIT_V(2); G8_BAR; G8_WAIT_L(0); G8_MMA(0, 0, At, B0); G8_BAR;
    G8_LDB(B1, 1, 1); G8_WAIT_V(0); G8_BAR; G8_WAIT_L(0); G8_MMA(0, 1, At, B1); G8_BAR;
    G8_LDA(At, 1, 1); G8_BAR; G8_WAIT_L(0); G8_MMA(1, 0, At, B0); G8_MMA(1, 1, At, B1); G8_BAR; }
  if (wr == 0) G8_BAR;
}

#define G8_COORDS const int tid = get_tid(); const int wid = tid >> 6, lane = tid & 63, wr = wid >> 2, wc = wid & 3, fr = lane & 15, fq = lane >> 4; (void)wr; (void)wc; (void)fr; (void)fq;
DI int tok_pos(int m) { return m < M_P ? m : PAST + ((m - M_P) & 15); }

DI void grouped_tile(int L, int nM, int nN, int& tm, int& tn) {
  const int nwg = nM * nN;
  const int q = nwg >> 3, rr = nwg & 7, xcd = L & 7, off = L >> 3;
  const int wgid = (xcd < rr ? xcd * (q + 1) : rr * (q + 1) + (xcd - rr) * q) + off;
  const int nig = 8 * nN, gid = wgid / nig, fm = gid * 8;
  const int gsz = (nM - fm) < 8 ? (nM - fm) : 8;
  const int rem = wgid - gid * nig;
  tm = fm + rem % gsz; tn = rem / gsz;
}

DI void ffn_up_phase(CParams& p, const u16* W, char* smem, int g_wave_s) {
  const int tid = get_tid();
  const int wid = tid >> 6, lane = tid & 63, wr = wid >> 2, wc = wid & 3, fr = lane & 15, fq = lane >> 4;
  const int NT = (2 * DFF) / 256;
  const int G = gridDim.x;
  for (int L = get_bid(); L < 66 * NT; L += G) {
    int tm, tn; grouped_tile(L, 66, NT, tm, tn);
    f32x4 acc[2][2][4][2];
    gemm256_tile<1>(p.NB + (long)tm * 256 * 1024, W + (long)tn * 256 * 1024, 1024, 1024, smem, acc, g_wave_s);
#pragma unroll
    for (int ai = 0; ai < 2; ++ai)
#pragma unroll
      for (int m = 0; m < 4; ++m) {
        const long row = (long)tm * 256 + 128 * ai + 64 * wr + 16 * m + fr;
        const int col = tn * 128 + 32 * wc + 8 * fq;
        float a[8];
#pragma unroll
        for (int n = 0; n < 2; ++n)
#pragma unroll
          for (int j = 0; j < 4; ++j) { const float g = acc[ai][0][m][n][j], u = acc[ai][1][m][n][j]; a[4 * n + j] = g * sigm(g) * u; }
        *(uint4*)(p.ACT + row * DFF + col) = make_uint4(pk2(a[0], a[1]), pk2(a[2], a[3]), pk2(a[4], a[5]), pk2(a[6], a[7]));
      }
  }
}

DI void win_phase(CParams& p, const u16* W, char* smem, int g_wave_s) {
  const int tid = get_tid();
  const int wid = tid >> 6, lane = tid & 63, wr = wid >> 2, wc = wid & 3, fr = lane & 15, fq = lane >> 4;
  const int NT = LDZ / 256;
  const int G = gridDim.x;
  for (int L = get_bid(); L < 66 * NT; L += G) {
    int tm, tn; grouped_tile(L, 66, NT, tm, tn);
    f32x4 acc[2][2][4][2];
    gemm256_tile<1>(p.NB + (long)tm * 256 * 1024, W + (long)tn * 256 * 1024, 1024, 1024, smem, acc, g_wave_s);
#pragma unroll
    for (int ai = 0; ai < 2; ++ai)
#pragma unroll
      for (int m = 0; m < 4; ++m) {
        const long row = (long)tm * 256 + 128 * ai + 64 * wr + 16 * m + fr;
#pragma unroll
        for (int bj = 0; bj < 2; ++bj) {
          const int col = tn * 256 + 128 * bj + 32 * wc + 8 * fq;
          *(uint4*)(p.Z + row * LDZ + col) = make_uint4(pk2(acc[ai][bj][m][0][0], acc[ai][bj][m][0][1]), pk2(acc[ai][bj][m][0][2], acc[ai][bj][m][0][3]),
                                                        pk2(acc[ai][bj][m][1][0], acc[ai][bj][m][1][1]), pk2(acc[ai][bj][m][1][2], acc[ai][bj][m][1][3]));
        }
      }
  }
}

DI void resid_gemm_phase(CParams& p, const u16* A, int K, const u16* W, float alpha, char* smem, int g_wave_s) {
  const int G = gridDim.x;
  const int nsplit = K >> 8;
#pragma unroll 1
  for (int it = get_bid(); it < 256 + 8 * nsplit; it += G) {
    int tm, tn, ks = 0, depth = K;
    const bool tail = it >= 256;
    if (!tail) { const int x = it & 7, j = it >> 3; tn = x & 3; tm = 2 * j + (x >> 2); }
    else { const int u = it - 256; const int tile = u / nsplit; ks = u - tile * nsplit; tm = 64 + (tile >> 2); tn = tile & 3; depth = 256; }
    f32x4 acc[2][2][4][2];
    gemm256_tile<1>(A + (long)tm * 256 * K + ks * 256, W + (long)tn * 256 * K + ks * 256, K, depth, smem, acc, g_wave_s);
    G8_COORDS
    float* base = tail ? (p.PART + ((long)ks * M_S + (long)(tm - 64) * 256) * 1024) : (p.out + (long)tm * 256 * 1024);
#pragma unroll
    for (int ai = 0; ai < 2; ++ai)
#pragma unroll
      for (int m = 0; m < 4; ++m) {
        const int rl = 128 * ai + 64 * wr + 16 * m + fr;
#pragma unroll
        for (int bj = 0; bj < 2; ++bj) {
          float4* hp = (float4*)(base + (long)rl * 1024 + tn * 256 + 128 * bj + 32 * wc + 8 * fq);
#pragma unroll
          for (int n = 0; n < 2; ++n) {
            float4 v = make_float4(0.f, 0.f, 0.f, 0.f);
            if (!tail) v = hp[n];
            v.x += alpha * acc[ai][bj][m][n][0]; v.y += alpha * acc[ai][bj][m][n][1]; v.z += alpha * acc[ai][bj][m][n][2]; v.w += alpha * acc[ai][bj][m][n][3];
            hp[n] = v;
          }
        }
      }
  }
}

DI void ple_phase(CParams& p, const u16* W, char* smem, int g_wave_s) {
  const int G = gridDim.x;
#pragma unroll 1
  for (int L = get_bid(); L < 66 * 4; L += G) {
    int tm = L >> 2, tn = L & 3;
    if (L < 256) { const int x = L & 7, j = L >> 3; tn = x & 3; tm = 2 * j + (x >> 2); }
    f32x4 acc[2][2][4][2];
    gemm256_tile<1>(p.NB + (long)tm * 256 * 1024, W + (long)tn * 256 * 1024, 1024, 1024, smem, acc, g_wave_s);
    G8_COORDS
#pragma unroll
    for (int ai = 0; ai < 2; ++ai)
#pragma unroll
      for (int m = 0; m < 4; ++m) {
        const long row = (long)tm * 256 + 128 * ai + 64 * wr + 16 * m + fr;
#pragma unroll
        for (int bj = 0; bj < 2; ++bj) {
          const int col = tn * 256 + 128 * bj + 32 * wc + 8 * fq;
          float4* hp = (float4*)(p.out + row * 1024 + col);
          const uint4 pp = *(const uint4*)(p.PP + row * 1024 + col);
          float4 v0 = hp[0], v1 = hp[1];
          v0.x += sigm(acc[ai][bj][m][0][0]) * bflo(pp.x); v0.y += sigm(acc[ai][bj][m][0][1]) * bfhi(pp.x);
          v0.z += sigm(acc[ai][bj][m][0][2]) * bflo(pp.y); v0.w += sigm(acc[ai][bj][m][0][3]) * bfhi(pp.y);
          v1.x += sigm(acc[ai][bj][m][1][0]) * bflo(pp.z); v1.y += sigm(acc[ai][bj][m][1][1]) * bfhi(pp.z);
          v1.z += sigm(acc[ai][bj][m][1][2]) * bflo(pp.w); v1.w += sigm(acc[ai][bj][m][1][3]) * bfhi(pp.w);
          hp[0] = v0; hp[1] = v1;
        }
      }
  }
}

DI void rowpost_phase(CParams& p, int l, int g_wave_s) {
  const int tid = get_tid(); const int lane = tid & 63, w = tid >> 6;
  const float* qan = p.qan + l * 384; const float* kvan = p.kvan + l * 512; const float* krn = p.krn + l * 64; const float* gvn = p.gvn + l * 1024;
  float* o_pkv = p.out + 17301504L + (long)l * M_P * 512;
  float* o_pkr = p.out + 34078720L + (long)l * M_P * 64;
  float* o_skv = p.out + 36175872L + (long)l * M_S * 512;
  float* o_skr = p.out + 36700160L + (long)l * M_S * 64;
  float* o_sgv = p.out + 36765696L + (long)l * M_S * 1024;
  for (int row = get_bid() * 8 + w; row < M_ALL; row += gridDim.x * 8) {
    const u16* zr = p.Z + (long)row * LDZ;
    const bool is_s = row >= M_P; const int rs_ = row - M_P;
    {
      unsigned v[3]; float ss = 0.f;
#pragma unroll
      for (int i = 0; i < 3; ++i) { v[i] = *(const unsigned*)(zr + ZQ + 2 * lane + 128 * i); const float a = bflo(v[i]), b = bfhi(v[i]); ss += a * a + b * b; }
      ss = wave_sum_l(ss, lane);
      const float rs = rsqrtf(ss * (1.f / 384.f) + EPSF);
#pragma unroll
      for (int i = 0; i < 3; ++i) {
        const int c = 2 * lane + 128 * i; const float2 g = *(const float2*)(qan + c);
        *(unsigned*)(p.QN + (long)row * 384 + c) = pk2(bflo(v[i]) * rs * g.x, bfhi(v[i]) * rs * g.y);
      }
    }
    {
      const uint4 v = *(const uint4*)(zr + ZKV + 8 * lane);
      float x[8] = {bflo(v.x), bfhi(v.x), bflo(v.y), bfhi(v.y), bflo(v.z), bfhi(v.z), bflo(v.w), bfhi(v.w)};
      float ss = 0.f;
#pragma unroll
      for (int i = 0; i < 8; ++i) ss += x[i] * x[i];
      ss = wave_sum_l(ss, lane);
      const float rs = rsqrtf(ss * (1.f / 512.f) + EPSF);
      const float4 g0 = *(const float4*)(kvan + 8 * lane), g1 = *(const float4*)(kvan + 8 * lane + 4);
      float4 y0 = make_float4(x[0] * rs * g0.x, x[1] * rs * g0.y, x[2] * rs * g0.z, x[3] * rs * g0.w);
      float4 y1 = make_float4(x[4] * rs * g1.x, x[5] * rs * g1.y, x[6] * rs * g1.z, x[7] * rs * g1.w);
      float* od = is_s ? (o_skv + (long)rs_ * 512) : (o_pkv + (long)row * 512);
      *(float4*)(od + 8 * lane) = y0; *(float4*)(od + 8 * lane + 4) = y1;
      *(uint4*)(p.C + (long)row * 512 + 8 * lane) = pack8(y0, y1);
    }
    {
      const float x = bf1(zr[ZKR + lane]);
      const float ss = wave_sum_l(x * x, lane);
      const float rs = rsqrtf(ss * (1.f / 64.f) + EPSF);
      const float y = x * rs * krn[lane];
      const float other = shfl_xor_l(y, lane, 32);
      const int pos = tok_pos(row);
      const float2 cs = *(const float2*)(p.rope + ((long)pos * 32 + (lane & 31)) * 2);
      const float o = lane < 32 ? (y * cs.x - other * cs.y) : (other * cs.y + y * cs.x);
      if (is_s) {
        o_skr[(long)rs_ * 64 + lane] = o;
        p.KRs[((long)(rs_ >> 4) * LKS + PAST + (rs_ & 15)) * 64 + lane] = f2bf(o);
      } else {
        o_pkr[(long)row * 64 + lane] = o;
        p.KRp[(long)row * 64 + lane] = f2bf(o);
      }
    }
    {
      uint4 v[2]; float ss = 0.f;
#pragma unroll
      for (int i = 0; i < 2; ++i) {
        v[i] = *(const uint4*)(zr + ZV + 8 * lane + 512 * i);
        const float x[8] = {bflo(v[i].x), bfhi(v[i].x), bflo(v[i].y), bfhi(v[i].y), bflo(v[i].z), bfhi(v[i].z), bflo(v[i].w), bfhi(v[i].w)};
#pragma unroll
        for (int j = 0; j < 8; ++j) ss += x[j] * x[j];
      }
      ss = wave_sum_l(ss, lane);
      const float rs = rsqrtf(ss * (1.f / 1024.f) + EPSF);
      if (lane == 0) p.rsv[row] = rs;
      if (is_s) {
#pragma unroll
        for (int i = 0; i < 2; ++i) {
          const int c = 8 * lane + 512 * i;
          const float x[8] = {bflo(v[i].x), bfhi(v[i].x), bflo(v[i].y), bfhi(v[i].y), bflo(v[i].z), bfhi(v[i].z), bflo(v[i].w), bfhi(v[i].w)};
          const float4 g0 = *(const float4*)(gvn + c), g1 = *(const float4*)(gvn + c + 4);
          *(float4*)(o_sgv + (long)rs_ * 1024 + c) = make_float4(x[0] * rs * g0.x, x[1] * rs * g0.y, x[2] * rs * g0.z, x[3] * rs * g0.w);
          *(float4*)(o_sgv + (long)rs_ * 1024 + c + 4) = make_float4(x[4] * rs * g1.x, x[5] * rs * g1.y, x[6] * rs * g1.z, x[7] * rs * g1.w);
        }
      }
    }
  }
  {
    const float* cc = p.cache_c + (long)l * 32 * PAST * 512;
    const long gt = (long)get_bid() * 512 + tid, gs = (long)gridDim.x * 512;
    for (long e = gt; e < 32L * PAST * 512 / 8; e += gs) {
      typedef __attribute__((ext_vector_type(4))) float f4v;
      const f4v a_ = __builtin_nontemporal_load((const f4v*)(cc + e * 8)), c_ = __builtin_nontemporal_load((const f4v*)(cc + e * 8 + 4));
      const float4 a = make_float4(a_.x, a_.y, a_.z, a_.w), c = make_float4(c_.x, c_.y, c_.z, c_.w);
      *(uint4*)(p.CB + e * 8) = pack8(a, c);
    }
    const float* pp = p.p_prompt + (long)l * M_P * 256; const float* ps = p.p_sample + (long)l * M_S * 256;
    for (long e = gt; e < (long)M_ALL * 256 / 8; e += gs) {
      const long pe = (long)M_P * 256 / 8;
      const float* src = e < pe ? (pp + e * 8) : (ps + (e - pe) * 8);
      *(uint4*)(p.PB + e * 8) = pack8(*(const float4*)src, *(const float4*)(src + 4));
    }
  }
  const float* ckr = p.cache_kr + (long)l * 32 * PAST * 64;
  const long gtid = (long)get_bid() * 512 + tid, gstride = (long)gridDim.x * 512;
  for (long e = gtid; e < 32L * PAST * 64 / 8; e += gstride) {
    const long el = e * 8; const int b = (int)(el / (PAST * 64)); const long rem = el - (long)b * PAST * 64;
    const float4 a = *(const float4*)(ckr + el), c = *(const float4*)(ckr + el + 4);
    *(uint4*)(p.KRs + (long)b * LKS * 64 + rem) = pack8(a, c);
  }
}

#define NCKV (512 * 8)
#define NPKV (64 * 8)
#define NSKV (2 * 8)
#define NQT (66 * 6)
#define NPPT (66 * 4)
#define RED8_OFF 131072
template <class RowPtr>
DI void nope_epi256(f32x4 (&acc)[2][2][4][2], const float* __restrict__ gain, float scale, char* smem, RowPtr rowptr, int g_wave_s) {
  const int tid = get_tid();
  const int wid = tid >> 6, lane = tid & 63, wr = wid >> 2, wc = wid & 3, fr = lane & 15, fq = lane >> 4;
  float* red = (float*)(smem + RED8_OFF);
#pragma unroll
  for (int ai = 0; ai < 2; ++ai)
#pragma unroll
    for (int bj = 0; bj < 2; ++bj)
#pragma unroll
      for (int m = 0; m < 4; ++m) {
        float s = 0.f;
#pragma unroll
        for (int n = 0; n < 2; ++n)
#pragma unroll
          for (int j = 0; j < 4; ++j) s += acc[ai][bj][m][n][j] * acc[ai][bj][m][n][j];
        s += shfl_xor_l(s, lane, 16); s += shfl_xor_l(s, lane, 32);
        if (fq == 0) red[((wc * 2 + ai) * 2 + bj) * 128 + 64 * wr + 16 * m + fr] = s;
      }
  __syncthreads();
  const int c = 32 * wc + 8 * fq;
  const float4 ga = *(const float4*)(gain + c), gb = *(const float4*)(gain + c + 4);
#pragma unroll
  for (int ai = 0; ai < 2; ++ai)
#pragma unroll
    for (int bj = 0; bj < 2; ++bj)
#pragma unroll
      for (int m = 0; m < 4; ++m) {
        const int rl = 64 * wr + 16 * m + fr;
        float tot = 0.f;
#pragma unroll
        for (int q = 0; q < 4; ++q) tot += red[((q * 2 + ai) * 2 + bj) * 128 + rl];
        const float rs = rsqrtf(tot * (1.f / 128.f) + EPSF) * scale;
        u16* op = rowptr(128 * ai + rl, bj);
        *(uint4*)(op + c) = make_uint4(pk2(acc[ai][bj][m][0][0] * rs * ga.x, acc[ai][bj][m][0][1] * rs * ga.y), pk2(acc[ai][bj][m][0][2] * rs * ga.z, acc[ai][bj][m][0][3] * rs * ga.w),
                                       pk2(acc[ai][bj][m][1][0] * rs * gb.x, acc[ai][bj][m][1][1] * rs * gb.y), pk2(acc[ai][bj][m][1][2] * rs * gb.z, acc[ai][bj][m][1][3] * rs * gb.w));
      }
}

DI void vt_epi256(CParams& p, f32x4 (&acc)[2][2][4][2], int mode, int m0, int tn, int g_wave_s) {
  G8_COORDS
  const long dstride = (mode == 0) ? (long)M_P : (long)LKS;
#pragma unroll
  for (int bj = 0; bj < 2; ++bj) {
    const int m32 = m0 + 128 * bj + 32 * wc;
#pragma unroll
    for (int ai = 0; ai < 2; ++ai) {
      const int h = 2 * (tn - 4) + ai;
      u16* base;
      if (mode == 0) base = p.VTp + (long)h * 128 * M_P + m32 + 8 * fq;
      else if (mode == 1) base = p.VTs + ((long)(m32 >> 12) * 8 + h) * 128 * LKS + (m32 & 4095) + 8 * fq;
      else base = p.VTs + ((long)((m32 >> 4) + (fq >> 1)) * 8 + h) * 128 * LKS + PAST + 8 * (fq & 1);
#pragma unroll
      for (int m = 0; m < 4; ++m) {
        const int dd = 64 * wr + 16 * m + fr;
        *(uint4*)(base + (long)dd * dstride) = make_uint4(pk2(acc[ai][bj][m][0][0], acc[ai][bj][m][0][1]), pk2(acc[ai][bj][m][0][2], acc[ai][bj][m][0][3]),
                                                          pk2(acc[ai][bj][m][1][0], acc[ai][bj][m][1][1]), pk2(acc[ai][bj][m][1][2], acc[ai][bj][m][1][3]));
      }
    }
  }
}
DI void rope_epi256(CParams& p, int l, f32x4 (&acc)[2][2][4][2], int tm, int tn, char* smem, int g_wave_s) {
  G8_COORDS
  float* red = (float*)(smem + RED8_OFF);
#pragma unroll
  for (int ai = 0; ai < 2; ++ai)
#pragma unroll
    for (int bj = 0; bj < 2; ++bj)
#pragma unroll
      for (int m = 0; m < 4; ++m) {
        float s = 0.f;
#pragma unroll
        for (int n = 0; n < 2; ++n)
#pragma unroll
          for (int j = 0; j < 4; ++j) s += acc[ai][bj][m][n][j] * acc[ai][bj][m][n][j];
        s += shfl_xor_l(s, lane, 16); s += shfl_xor_l(s, lane, 32);
        if (fq == 0) red[((wc * 2 + ai) * 2 + bj) * 128 + 64 * wr + 16 * m + fr] = s;
      }
  __syncthreads();
  const float* g = p.qrn + l * 64;
  const int c0 = 16 * (wc & 1) + 4 * fq;
  const float4 g1 = *(const float4*)(g + c0), g2 = *(const float4*)(g + 32 + c0);
  const float gg1[4] = {g1.x, g1.y, g1.z, g1.w}, gg2[4] = {g2.x, g2.y, g2.z, g2.w};
#pragma unroll
  for (int ai = 0; ai < 2; ++ai)
#pragma unroll
    for (int m = 0; m < 4; ++m) {
      const int rl = 64 * wr + 16 * m + fr;
      const int row = tm * 256 + 128 * ai + rl;
      const int pos = tok_pos(row);
      const float4 t0 = *(const float4*)(p.rope + ((long)pos * 32 + c0) * 2);
      const float4 t1 = *(const float4*)(p.rope + ((long)pos * 32 + c0) * 2 + 4);
      const float cs[4] = {t0.x, t0.z, t1.x, t1.z}, sn[4] = {t0.y, t0.w, t1.y, t1.w};
#pragma unroll
      for (int bj = 0; bj < 2; ++bj) {
        const float tot = red[((wc * 2 + ai) * 2 + bj) * 128 + rl] + red[(((wc ^ 1) * 2 + ai) * 2 + bj) * 128 + rl];
        const float rs = rsqrtf(tot * (1.f / 64.f) + EPSF);
        const int head = 4 * (tn - 4) + 2 * bj + (wc >> 1);
        u16* qp = p.Q + ((long)row * 8 + head) * 192 + 128;
        float o1[4], o2[4];
#pragma unroll
        for (int j = 0; j < 4; ++j) {
          const float y1 = acc[ai][bj][m][0][j] * rs * gg1[j], y2 = acc[ai][bj][m][1][j] * rs * gg2[j];
          o1[j] = (y1 * cs[j] - y2 * sn[j]) * QSCALE; o2[j] = (y1 * sn[j] + y2 * cs[j]) * QSCALE;
        }
        *(uint2*)(qp + c0) = make_uint2(pk2(o1[0], o1[1]), pk2(o1[2], o1[3]));
        *(uint2*)(qp + 32 + c0) = make_uint2(pk2(o2[0], o2[1]), pk2(o2[2], o2[3]));
      }
    }
}
DI void pp_epi256(CParams& p, f32x4 (&acc)[2][2][4][2], int tm, int tn, int g_wave_s) {
  G8_COORDS
#pragma unroll
  for (int ai = 0; ai < 2; ++ai)
#pragma unroll
    for (int m = 0; m < 4; ++m) {
      const long row = (long)tm * 256 + 128 * ai + 64 * wr + 16 * m + fr;
#pragma unroll
      for (int bj = 0; bj < 2; ++bj) {
        const int col = tn * 256 + 128 * bj + 32 * wc + 8 * fq;
        *(uint4*)(p.PP + row * 1024 + col) = make_uint4(pk2(acc[ai][bj][m][0][0], acc[ai][bj][m][0][1]), pk2(acc[ai][bj][m][0][2], acc[ai][bj][m][0][3]),
                                                        pk2(acc[ai][bj][m][1][0], acc[ai][bj][m][1][1]), pk2(acc[ai][bj][m][1][2], acc[ai][bj][m][1][3]));
      }
    }
}

DI void multi_phase(CParams& p, int l, char* smem, int g_wave_s) {
  const u16* Wkv = p.Wkv + (long)l * 2048 * 512;
  const u16* Wuq = p.Wuq + (long)l * 1536 * 384;
  const u16* Wpe = p.Wpe + (long)l * 1024 * 256;
  const int total = NCKV + NPKV + NSKV + NQT + NPPT;
  const int G = gridDim.x;
  const int per_kv = (NCKV + NPKV + NSKV + G - 1) / G;
  const int t_end = min((get_bid() + 1) * per_kv, NCKV + NPKV + NSKV);
#pragma unroll 1
  for (int t = get_bid() * per_kv; t < t_end; ++t) {
    f32x4 acc[2][2][4][2];
    {
      const u16* tok; int u = t, mode;
      if (u < NCKV) { tok = p.CB + (long)(u >> 3) * 256 * 512; mode = 1; }
      else if ((u -= NCKV) < NPKV) { tok = p.C + (long)(u >> 3) * 256 * 512; mode = 0; }
      else { u -= NPKV; tok = p.C + ((long)M_P + (u >> 3) * 256) * 512; mode = 2; }
      const int m0 = (u >> 3) * 256, tn = u & 7;
      const u16* wgt = Wkv + (long)tn * 256 * 512;
      if (tn < 4) {
        gemm256_tile<1>(tok, wgt, 512, 512, smem, acc, g_wave_s);
        nope_epi256(acc, p.knn + l * 128, 1.0f, smem, [&](int rloc, int bj) -> u16* {
          const int m = m0 + rloc; const int h = 2 * tn + bj;
          if (mode == 0) return p.Knp + ((long)m * 8 + h) * 128;
          long key;
          if (mode == 1) key = (long)(m >> 12) * LKS + (m & 4095); else key = (long)(m >> 4) * LKS + PAST + (m & 15);
          return p.Kns + (key * 8 + h) * 128;
        }, g_wave_s);
      } else {
        gemm256_tile<2>(wgt, tok, 512, 512, smem, acc, g_wave_s);
        vt_epi256(p, acc, mode, m0, tn, g_wave_s);
      }
    }
  }
  int* s_q = (int*)(smem + SMEM_BYTES + 16);
  for (;;) {
    __syncthreads();
    if (get_tid() == 0) *s_q = (int)atomicAdd(p.ctr + 4 + l, 1u);
    __syncthreads();
    const int uu = *s_q;
    if (uu >= NQT + NPPT) break;
    f32x4 acc[2][2][4][2];
    int u = uu;
    if (u < NQT) {
      const int tm = u / 6, tn = u - tm * 6;
      gemm256_tile<1>(p.QN + (long)tm * 256 * 384, Wuq + (long)tn * 256 * 384, 384, 384, smem, acc, g_wave_s);
      if (tn < 4) nope_epi256(acc, p.qnn + l * 128, QSCALE, smem, [&](int rloc, int bj) -> u16* { return p.Q + ((long)(tm * 256 + rloc) * 8 + 2 * tn + bj) * 192; }, g_wave_s);
      else rope_epi256(p, l, acc, tm, tn, smem, g_wave_s);
      continue;
    }
    u -= NQT;
    {
      const int tm = u >> 2, tn = u & 3;
      gemm256_tile<1>(p.PB + (long)tm * 256 * 256, Wpe + (long)tn * 256 * 256, 256, 256, smem, acc, g_wave_s);
      pp_epi256(p, acc, tm, tn, g_wave_s);
    }
  }
}

#define ASTAGE 40960
template <int SPLIT>
DI void attn_item(const u16* __restrict__ Qb, int qclamp, const u16* __restrict__ Kn, const u16* __restrict__ KR,
                  const u16* __restrict__ VT, long vt_stride, int ntiles, int ntw, int Lk, u16* __restrict__ Ob, char* smem, int g_wave_s) {
  const int tid = get_tid(), lane = tid & 63, w = tid >> 6, r = lane & 31, hh = lane >> 5;
  constexpr int KTN = SPLIT ? 1 : 2;
  const int ktb = SPLIT ? (w & 1) : 0;
  const int qrow0 = SPLIT ? 0 : 32 * w;
  bf16x8 qf[12];
  {
    const int qr = r < qclamp ? r : qclamp;
    const u16* qp = Qb + (long)(qrow0 + qr) * (8 * 192) + 8 * hh;
#pragma unroll
    for (int ks = 0; ks < 12; ++ks) qf[ks] = *(const bf16x8*)(qp + 16 * ks);
  }
  f32x16 oacc[4];
#pragma unroll
  for (int dt = 0; dt < 4; ++dt)
#pragma unroll
    for (int i = 0; i < 16; ++i) oacc[dt][i] = 0.f;
  float mrun = 0.f, lrun = 0.f;

  const int lrow = tid >> 3, lq = tid & 7;
  const int sch = lq ^ ((lrow >> 1) & 7);
  unsigned koff = (unsigned)(lrow * 1024 + sch * 8) * 2u;
  unsigned kroff = (unsigned)(lrow * 64 + sch * 8) * 2u;
  const unsigned vstep = (unsigned)(64 * vt_stride * 2);
  unsigned voff = (unsigned)(lrow * vt_stride * 2 + sch * 16);
  const char* KnB = (const char*)Kn; const char* KRB = (const char*)KR; const char* VTB = (const char*)VT;
  char* dstT = smem + tid * 16;
#define ADMA(st_) { char* d_ = dstT + (st_) * ASTAGE; \
    __builtin_amdgcn_global_load_lds((const unsigned*)(KnB + (size_t)koff), (unsigned*)(d_), 16, 0, 0); \
    __builtin_amdgcn_global_load_lds((const unsigned*)(KnB + (size_t)koff + 128), (unsigned*)(d_ + 8192), 16, 0, 0); \
    __builtin_amdgcn_global_load_lds((const unsigned*)(KRB + (size_t)kroff), (unsigned*)(d_ + 16384), 16, 0, 0); \
    __builtin_amdgcn_global_load_lds((const unsigned*)(VTB + (size_t)voff), (unsigned*)(d_ + 24576), 16, 0, 0); \
    __builtin_amdgcn_global_load_lds((const unsigned*)(VTB + (size_t)(voff + vstep)), (unsigned*)(d_ + 32768), 16, 0, 0); \
    koff += 64 * 1024 * 2; kroff += 64 * 64 * 2; voff += 128; }
  const int xr = (r >> 1) & 7;
  const int xo0 = ((0 + hh) ^ xr) << 4, xo1 = ((2 + hh) ^ xr) << 4, xo2 = ((4 + hh) ^ xr) << 4, xo3 = ((6 + hh) ^ xr) << 4;
  const char* rbase = smem + r * 128;

  f32x16 sacc[2];
#define KFRAG(sb_, ks_, kt_) (*(const bf16x8*)((sb_) + ((ks_) >> 2) * 8192 + (kt_) * 4096 + ((((ks_) & 3) == 0) ? xo0 : (((ks_) & 3) == 1) ? xo1 : (((ks_) & 3) == 2) ? xo2 : xo3)))
#define VFRAG(sb_, dt_, q_) (*(const bf16x8*)((sb_) + 24576 + (dt_) * 4096 + (((q_) == 0) ? xo0 : ((q_) == 1) ? xo1 : ((q_) == 2) ? xo2 : xo3)))
#define VFRAGX(sb_, dt_, xo_) (*(const bf16x8*)((sb_) + 24576 + (dt_) * 4096 + (xo_)))
  const int vx0 = ktb ? xo2 : xo0, vx1 = ktb ? xo3 : xo1; (void)vx0; (void)vx1;
#define ATT_S(st_) { \
    { const float ninit = -mrun; _Pragma("unroll") for (int kt = 0; kt < KTN; ++kt) _Pragma("unroll") for (int i = 0; i < 16; ++i) sacc[kt][i] = ninit; }     \
    const char* sb = rbase + (st_) * ASTAGE; \
    _Pragma("unroll") for (int ks = 0; ks < 12; ++ks) { \
      bf16x8 k0 = KFRAG(sb, ks, ktb); \
      sacc[0] = MFMA(k0, qf[ks], sacc[0]); \
      if (!SPLIT) { bf16x8 k1 = KFRAG(sb, ks, 1); sacc[1] = MFMA(k1, qf[ks], sacc[1]); } \
      if ((ks & 3) == 3) __builtin_amdgcn_sched_barrier(0); } }
#define ATT_PV(jt_, st_) { \
    if (((jt_) + 1) * 64 > Lk) { \
      _Pragma("unroll") for (int kt = 0; kt < KTN; ++kt) _Pragma("unroll") for (int i = 0; i < 16; ++i) { \
          const int key = (jt_) * 64 + 32 * (kt + ktb) + (i & 3) + 8 * (i >> 2) + 4 * hh; \
          if (key >= Lk) sacc[kt][i] = -INFINITY; } } \
    float tmax = -INFINITY; \
    _Pragma("unroll") for (int kt = 0; kt < KTN; ++kt) _Pragma("unroll") for (int i = 0; i < 16; ++i) tmax = fmaxf(tmax, sacc[kt][i]); \
    tmax = fmaxf(tmax, shfl_xor_l(tmax, lane, 32)); \
      \
    if (__builtin_amdgcn_ballot_w64(tmax > 8.0f) != 0ull) { \
      const float dlt = fmaxf(tmax, 0.f); \
      const float alpha = __builtin_amdgcn_exp2f(-dlt); \
      mrun += dlt; \
      lrun *= alpha; \
      _Pragma("unroll") for (int kt = 0; kt < KTN; ++kt) _Pragma("unroll") for (int i = 0; i < 16; ++i) sacc[kt][i] -= dlt; \
      _Pragma("unroll") for (int dt = 0; dt < 4; ++dt) _Pragma("unroll") for (int i = 0; i < 16; ++i) oacc[dt][i] *= alpha; \
    } \
    float psum = 0.f; \
    _Pragma("unroll") for (int kt = 0; kt < KTN; ++kt) _Pragma("unroll") for (int i = 0; i < 16; ++i) { const float pv = __builtin_amdgcn_exp2f(sacc[kt][i]); sacc[kt][i] = pv; psum += pv; } \
    lrun += psum; \
    bf16x8 pf[2][2]; \
    _Pragma("unroll") for (int kt = 0; kt < KTN; ++kt) _Pragma("unroll") for (int s = 0; s < 2; ++s) { \
        uint4 pp = make_uint4(pk2(sacc[kt][8 * s + 0], sacc[kt][8 * s + 1]), pk2(sacc[kt][8 * s + 2], sacc[kt][8 * s + 3]), \
                              pk2(sacc[kt][8 * s + 4], sacc[kt][8 * s + 5]), pk2(sacc[kt][8 * s + 6], sacc[kt][8 * s + 7])); \
        pf[kt][s] = __builtin_bit_cast(bf16x8, pp); } \
    const char* sb = rbase + (st_) * ASTAGE; \
    _Pragma("unroll") for (int dt = 0; dt < 4; ++dt) _Pragma("unroll") for (int kt = 0; kt < KTN; ++kt) _Pragma("unroll") for (int s = 0; s < 2; ++s) { \
          bf16x8 vf = SPLIT ? VFRAGX(sb, dt, (s == 0 ? vx0 : vx1)) : VFRAG(sb, dt, 2 * kt + s); \
          oacc[dt] = MFMA(vf, pf[kt][s], oacc[dt]); \
          if (kt == 1 && s == 1) __builtin_amdgcn_sched_barrier(0); } }

  ADMA(0)
  if (ntiles > 1) ADMA(1)
  int st = 0;
#pragma unroll 1
  for (int jt = 0; jt < ntiles; ++jt) {
    if (jt + 1 < ntiles) asm volatile("s_waitcnt vmcnt(5)" ::: "memory");
    else asm volatile("s_waitcnt vmcnt(0)" ::: "memory");
    __syncthreads();
    const int stp = st == 0 ? 2 : st - 1;
    if (jt + 2 < ntiles) ADMA(stp)
    if (jt < ntw) { ATT_S(st) ATT_PV(jt, st) }
    st = st == 2 ? 0 : st + 1;
  }
#undef ATT_S
#undef ATT_PV
#undef KFRAG
#undef VFRAG
#undef VFRAGX
#undef ADMA
  if (SPLIT) {
    float* mg = (float*)smem;
    __syncthreads();
    if (w == 1) {
      mg[lane] = mrun; mg[64 + lane] = lrun;
#pragma unroll
      for (int dt = 0; dt < 4; ++dt)
#pragma unroll
        for (int i = 0; i < 16; ++i) mg[(2 + 16 * dt + i) * 64 + lane] = oacc[dt][i];
    }
    __syncthreads();
    if (w == 0) {
      const float m1 = mg[lane], l1 = mg[64 + lane];
      const float mm = fmaxf(mrun, m1);
      const float a0 = __builtin_amdgcn_exp2f(mrun - mm), a1 = __builtin_amdgcn_exp2f(m1 - mm);
      lrun = lrun * a0 + l1 * a1;
#pragma unroll
      for (int dt = 0; dt < 4; ++dt)
#pragma unroll
        for (int i = 0; i < 16; ++i) oacc[dt][i] = oacc[dt][i] * a0 + mg[(2 + 16 * dt + i) * 64 + lane] * a1;
    }
    if (w != 0) ntw = 0;
  }
  if (ntw > 0 && r <= qclamp) {
    const float ltot = lrun + shfl_xor_l(lrun, lane, 32);
    const float inv = 1.f / ltot;
    u16* op = Ob + (long)(qrow0 + r) * 1024;
#pragma unroll
    for (int dt = 0; dt < 4; ++dt)
#pragma unroll
      for (int i4 = 0; i4 < 4; ++i4) {
        const int d = 32 * dt + 8 * i4 + 4 * hh;
        *(uint2*)(op + d) = make_uint2(pk2(oacc[dt][4 * i4 + 0] * inv, oacc[dt][4 * i4 + 1] * inv), pk2(oacc[dt][4 * i4 + 2] * inv, oacc[dt][4 * i4 + 3] * inv));
      }
  } else if (ntw > 0) {
    (void)shfl_xor_l(lrun, lane, 32);
  }
}

DI void attn_phase(CParams& p, int l, char* smem, int* s_item, int cidx, int g_wave_s) {
  const int tid = get_tid(), w = tid >> 6;
  (void)cidx;
  const int xq = (int)((unsigned)__builtin_amdgcn_s_getreg((3 << 11) | 20) & 7u);
  unsigned* qctr = p.ctr + 16 + l * 8;
  int qoff = 0;
  for (;;) {
    __syncthreads();
    if (tid == 0) {
      int code = -1;
      for (int a = qoff; a < 8; ++a) {
        const int q = (xq + a) & 7;
        const int it = (int)atomicAdd(qctr + q, 1u);
        if (it < 96) { code = (a << 16) | (q << 8) | it; break; }
      }
      *s_item = code;
    }
    __syncthreads();
    const int code = *s_item;
    if (code < 0) break;
    qoff = code >> 16;
    const int h = (code >> 8) & 7, item = code & 255;
    const int i3 = item / 3, r3 = item - 3 * i3;
    if (r3 == 2) {
      const int b = i3;
      const u16* Qb = p.Q + ((long)(M_P + 16 * b) * 8 + h) * 192;
      const u16* Kn = p.Kns + ((long)b * LKS * 8 + h) * 128;
      const u16* KR = p.KRs + (long)b * LKS * 64;
      const u16* VT = p.VTs + ((long)b * 8 + h) * 128 * LKS;
      u16* Ob = p.OA + (long)(M_P + 16 * b) * 1024 + h * 128;
      attn_item<1>(Qb, 15, Kn, KR, VT, LKS, 65, w < 2 ? 65 : 0, LKV, Ob, smem, g_wave_s);
    } else {
      const int qb = 63 - (2 * i3 + r3);
      const u16* Qb = p.Q + ((long)(256 * qb) * 8 + h) * 192;
      const u16* Kn = p.Knp + (long)h * 128;
      const u16* KR = p.KRp;
      const u16* VT = p.VTp + (long)h * 128 * M_P;
      u16* Ob = p.OA + (long)(256 * qb) * 1024 + h * 128;
      const int ntiles = 4 * qb + 4;
      attn_item<0>(Qb, 31, Kn, KR, VT, M_P, ntiles, 4 * qb + (w >> 1) + 1, 1 << 30, Ob, smem, g_wave_s);
    }
  }
}

DI void gmlp_phase(CParams& p, int l, char* smem_all, int g_wave_s) {
  const int half = get_tid() >> 8; char* smem = smem_all + half * HALF_BYTES;
  const int tid = get_tid() & 255, lane = tid & 63, w = tid >> 6, wm = w >> 1, wn = w & 1, r = lane & 31, hh = lane >> 5;
  const float* gvn = p.gvn + l * 1024;
  const float* gws = p.gws + (long)l * 8 * 128 * 128;
  const float* gbs = p.gbs + (long)l * 8 * 128;
  u16* Xs = (u16*)smem;
  u16* Ws = Xs + 128 * 136;
  const int NP = 128 * 8, NS = 32 * 4;
  for (int t2 = get_bid(); t2 < (NP + NS + 1) / 2; t2 += gridDim.x) {
    const int t = 2 * t2 + half;
    const bool valid = t < NP + NS;
    const bool isp = valid && t < NP;
    {
      const int ci = t >> 3, g = t & 7;
      const int t0 = ci * 128, c0 = g * 128;
      __syncthreads();
      if (isp) {
      {
        unsigned* Xs32 = (unsigned*)Xs;
#pragma unroll
        for (int i = 0; i < 4; ++i) {
          const int sp = (tid & 15) + 16 * i, dq = (tid >> 4) & 15, dc = dq * 8;
          const int sl0 = (dc & ~15) | ((dq & 1) ? 4 : 0), sl1 = (dc & ~15) | ((dq & 1) ? 12 : 8);
          const uint4 v0 = *(const uint4*)(p.Z + (long)(t0 + 2 * sp) * LDZ + ZV + c0 + dc);
          const uint4 v1 = *(const uint4*)(p.Z + (long)(t0 + 2 * sp + 1) * LDZ + ZV + c0 + dc);
          const float r0 = p.rsv[t0 + 2 * sp], r1 = p.rsv[t0 + 2 * sp + 1];
          const float4 g0 = *(const float4*)(gvn + c0 + dc), g1 = *(const float4*)(gvn + c0 + dc + 4);
          Xs32[(sl0 + 0) * 68 + sp] = pk2(bflo(v0.x) * r0 * g0.x, bflo(v1.x) * r1 * g0.x); Xs32[(sl0 + 1) * 68 + sp] = pk2(bfhi(v0.x) * r0 * g0.y, bfhi(v1.x) * r1 * g0.y);
          Xs32[(sl0 + 2) * 68 + sp] = pk2(bflo(v0.y) * r0 * g0.z, bflo(v1.y) * r1 * g0.z); Xs32[(sl0 + 3) * 68 + sp] = pk2(bfhi(v0.y) * r0 * g0.w, bfhi(v1.y) * r1 * g0.w);
          Xs32[(sl1 + 0) * 68 + sp] = pk2(bflo(v0.z) * r0 * g1.x, bflo(v1.z) * r1 * g1.x); Xs32[(sl1 + 1) * 68 + sp] = pk2(bfhi(v0.z) * r0 * g1.y, bfhi(v1.z) * r1 * g1.y);
          Xs32[(sl1 + 2) * 68 + sp] = pk2(bflo(v0.w) * r0 * g1.z, bflo(v1.w) * r1 * g1.z); Xs32[(sl1 + 3) * 68 + sp] = pk2(bfhi(v0.w) * r0 * g1.w, bfhi(v1.w) * r1 * g1.w);
        }
      }
#pragma unroll
      for (int i = 0; i < 8; ++i) {
        const int c = tid + 256 * i;
        const int tt = c >> 4, sc = (c & 15) * 8;
        *(uint4*)(Ws + tt * 136 + sc) = *(const uint4*)(p.WgB + (((long)l * 8 + g) * 128 + tt) * 128 + sc);
      }
      }
      __syncthreads();
      if (isp) {
      f32x16 acc[2][2];
#pragma unroll
      for (int mi = 0; mi < 2; ++mi)
#pragma unroll
        for (int ni = 0; ni < 2; ++ni)
#pragma unroll
          for (int i = 0; i < 16; ++i) acc[mi][ni][i] = 0.f;
      const u16* Ab = Ws + (64 * wm + r) * 136 + 8 * hh;
      const u16* Bb = Xs + (64 * wn + r) * 136 + 8 * hh;
#pragma unroll
      for (int ks = 0; ks < 8; ++ks) {
        bf16x8 a0 = *(const bf16x8*)(Ab + 16 * ks), a1 = *(const bf16x8*)(Ab + 32 * 136 + 16 * ks);
        bf16x8 b0 = *(const bf16x8*)(Bb + 16 * ks), b1 = *(const bf16x8*)(Bb + 32 * 136 + 16 * ks);
        acc[0][0] = MFMA(b0, a0, acc[0][0]); acc[0][1] = MFMA(b1, a0, acc[0][1]);
        acc[1][0] = MFMA(b0, a1, acc[1][0]); acc[1][1] = MFMA(b1, a1, acc[1][1]);
      }
#pragma unroll
      for (int mi = 0; mi < 2; ++mi) {
        const int tl = 64 * wm + 32 * mi + r;
        const long row = t0 + tl;
        const float bias = gbs[g * 128 + tl];
        const u16* zr = p.Z + row * LDZ;
#pragma unroll
        for (int ni = 0; ni < 2; ++ni)
#pragma unroll
          for (int g8 = 0; g8 < 2; ++g8) {
            const int col = c0 + 64 * wn + 32 * ni + 16 * g8 + 8 * hh;
            const uint4 uu = *(const uint4*)(zr + ZU + col), ga = *(const uint4*)(zr + ZGA + col), gb = *(const uint4*)(zr + ZGB + col);
            const uint4 oa = *(const uint4*)(p.OA + row * 1024 + col);
            const unsigned uw[4] = {uu.x, uu.y, uu.z, uu.w}, gaw[4] = {ga.x, ga.y, ga.z, ga.w}, gbw[4] = {gb.x, gb.y, gb.z, gb.w}, oaw[4] = {oa.x, oa.y, oa.z, oa.w};
            unsigned ow[4];
#pragma unroll
            for (int q = 0; q < 4; ++q) {
              const float o0 = sigm(bflo(gaw[q])) * bflo(oaw[q]) + sigm(bflo(gbw[q])) * bflo(uw[q]) * (acc[mi][ni][8 * g8 + 2 * q] + bias);
              const float o1 = sigm(bfhi(gaw[q])) * bfhi(oaw[q]) + sigm(bfhi(gbw[q])) * bfhi(uw[q]) * (acc[mi][ni][8 * g8 + 2 * q + 1] + bias);
              ow[q] = pk2(o0, o1);
            }
            *(uint4*)(p.MIX + row * 1024 + col) = make_uint4(ow[0], ow[1], ow[2], ow[3]);
          }
      }
      }
    }
    if (valid && !isp) {
      const int u = t - NP; const int b = u >> 2, col = (u & 3) * 256 + tid; const int g = col >> 7;
      const long row0 = M_P + 16 * b;
      const float gv = gvn[col];
      float vn[16];
#pragma unroll
      for (int s = 0; s < 16; ++s) vn[s] = bf1(p.Z[(row0 + s) * LDZ + ZV + col]) * p.rsv[row0 + s] * gv;
#pragma unroll
      for (int tt = 0; tt < 16; ++tt) {
        float mx = gbs[g * 128 + tt];
#pragma unroll
        for (int s = 0; s <= tt; ++s) mx += gws[((long)g * 128 + tt) * 128 + s] * vn[s];
        const u16* zr = p.Z + (row0 + tt) * LDZ;
        const float uu = bf1(zr[ZU + col]), ga = bf1(zr[ZGA + col]), gb = bf1(zr[ZGB + col]);
        const float oa = bf1(p.OA[(row0 + tt) * 1024 + col]);
        p.MIX[(row0 + tt) * 1024 + col] = f2bf(sigm(ga) * oa + sigm(gb) * uu * mx);
      }
    }
  }
}

#define XB_TMO      128
#define XB_XCNT(j)  (256  + 64 * (j))
#define XB_XSUB(j)  (1280 + 64 * (j))
#define XB_XGEN(j)  (2304 + 64 * (j))
#define XB_TOP      3328
#define XB_TOPGEN   3392
#define XCD_BAR_WORDS 3456
#define XB_SPIN_CAP (1u << 22)
#define LAS __attribute__((address_space(3)))
DI unsigned xb_ld(unsigned* p) { return __hip_atomic_load(p, __ATOMIC_RELAXED, __HIP_MEMORY_SCOPE_AGENT); }
DI unsigned xb_add(unsigned* p, unsigned v) { return __hip_atomic_fetch_add(p, v, __ATOMIC_RELAXED, __HIP_MEMORY_SCOPE_AGENT); }
DI unsigned xb_xcc_id() { return (unsigned)__builtin_amdgcn_s_getreg((3 << 11) | 20) & 0xFu; }
#define XB_SPIN(cond, bar) do { unsigned _sp = 0; while (cond) { __builtin_amdgcn_s_sleep(1); \
    if ((++_sp & 255u) == 0u) { if (xb_ld(&(bar)[XB_TMO])) break; if (_sp > XB_SPIN_CAP) { atomicAdd(&(bar)[XB_TMO], 1u); break; } } } } while (0)
struct XcdBarrier { unsigned* bar; unsigned x; volatile LAS unsigned* st; };
DI XcdBarrier xcd_barrier_post(unsigned* bar, volatile LAS unsigned* st) {
  XcdBarrier b; b.bar = bar; b.x = xb_xcc_id(); b.st = st;
  if (threadIdx.x == 0) (void)xb_add(&bar[XB_XCNT(b.x)], 1u);
  return b;
}
DI void xcd_barrier_complete(unsigned* bar, unsigned x, unsigned& nloc, unsigned& nx) {
  const unsigned G = gridDim.x * gridDim.y * gridDim.z;
  unsigned sum, cnt, mine, sp = 0u;
  for (;;) {
    sum = 0u; cnt = 0u; mine = 0u;
#pragma unroll
    for (unsigned j = 0; j < 16; ++j) { const unsigned c = xb_ld(&bar[XB_XCNT(j)]); sum += c; cnt += (c > 0u) ? 1u : 0u; mine = (j == x) ? c : mine; }
    if (sum == G) break;
    __builtin_amdgcn_s_sleep(1);
    if ((++sp & 255u) == 0u) { if (xb_ld(&bar[XB_TMO])) break; if (sp > XB_SPIN_CAP) { atomicAdd(&bar[XB_TMO], 1u); break; } }
  }
  nloc = mine > 0u ? mine : 1u; nx = cnt > 0u ? cnt : 1u;
}
DI void xcd_barrier(const XcdBarrier& b) {
  asm volatile("s_waitcnt vmcnt(0)" ::: "memory");
  __syncthreads();
  if (threadIdx.x == 0) {
    unsigned* bar = b.bar;
    unsigned bx_ = b.x; asm volatile("" : "+s"(bx_));
    asm volatile("" : "+s"(bar));
    __builtin_amdgcn_s_waitcnt(0);
    unsigned nloc = b.st[0], nx = b.st[1];
    if (nloc == 0u) { xcd_barrier_complete(bar, bx_, nloc, nx); b.st[0] = nloc; b.st[1] = nx; }
    const unsigned old = xb_add(&bar[XB_XSUB(bx_)], 1u);
    const unsigned gen = old / nloc;
    if (old + 1u == (gen + 1u) * nloc) {
      __builtin_amdgcn_fence(__ATOMIC_RELEASE, "agent");
      asm volatile("s_waitcnt vmcnt(0)" ::: "memory");
      const unsigned og = xb_add(&bar[XB_TOP], 1u);
      const unsigned tg = og / nx;
      if (og + 1u == (tg + 1u) * nx) xb_add(&bar[XB_TOPGEN], 1u);
      else XB_SPIN(xb_ld(&bar[XB_TOPGEN]) == tg, bar);
      __builtin_amdgcn_fence(__ATOMIC_ACQUIRE, "agent");
      xb_add(&bar[XB_XGEN(bx_)], 1u);
      asm volatile("s_waitcnt vmcnt(0)" ::: "memory");
    } else {
      XB_SPIN(xb_ld(&bar[XB_XGEN(bx_)]) == gen, bar);
      __builtin_amdgcn_fence(__ATOMIC_ACQUIRE, "agent");
      asm volatile("s_waitcnt vmcnt(0)" ::: "memory");
    }
  }
  __syncthreads();
}

DI CParams& fresh_params() {
  auto kp = __builtin_amdgcn_kernarg_segment_ptr();
  asm volatile("" : "+s"(kp));
  return *(CParams*)kp;
}
#define P_ fresh_params()
__global__ void __launch_bounds__(512, 2) mega_fwd(Params p_unused) {
  const int g_wave_s = __builtin_amdgcn_readfirstlane((int)(threadIdx.x >> 6));
  extern __shared__ __attribute__((aligned(16))) char smem[];
  uint4& xb_words = *(uint4*)(smem + SMEM_BYTES);
  int& s_item = *(int*)(smem + SMEM_BYTES + 16);
  cg::grid_group grid = cg::this_grid();
  if (threadIdx.x == 0) xb_words = make_uint4(0u, 0u, 0u, 0u);
  __syncthreads();
  XcdBarrier xb = xcd_barrier_post(P_.bar, (volatile LAS unsigned*)&xb_words);

  prep_phase(P_, smem, g_wave_s);
  if (P_.out == nullptr) grid.sync();
  xcd_barrier(xb);
#pragma unroll 1
  for (int l = 0; l < 2; ++l) {
    norm_phase(P_.out, P_.f1n + l * 1024, P_.NB, P_.PART, 0, g_wave_s);
    xcd_barrier(xb);
    ffn_up_phase(P_, P_.Wgu1 + (long)l * 2 * DFF * 1024, smem, g_wave_s);
    xcd_barrier(xb);
    resid_gemm_phase(P_, P_.ACT, DFF, P_.Wd1 + (long)l * 1024 * DFF, 0.5f, smem, g_wave_s);
    xcd_barrier(xb);
    norm_phase(P_.out, P_.mixn + l * 1024, P_.NB, P_.PART, DFF / 256, g_wave_s);
    xcd_barrier(xb);
    win_phase(P_, P_.Win + (long)l * LDZ * 1024, smem, g_wave_s);
    xcd_barrier(xb);
    rowpost_phase(P_, l, g_wave_s);
    xcd_barrier(xb);
    multi_phase(P_, l, smem, g_wave_s);
    xcd_barrier(xb);
    attn_phase(P_, l, smem, &s_item, l, g_wave_s);
    xcd_barrier(xb);
    gmlp_phase(P_, l, smem, g_wave_s);
    xcd_barrier(xb);
    resid_gemm_phase(P_, P_.MIX, 1024, P_.Wo + (long)l * 1024 * 1024, 1.0f, smem, g_wave_s);
    xcd_barrier(xb);
    norm_phase(P_.out, P_.f2n + l * 1024, P_.NB, P_.PART, 1024 / 256, g_wave_s);
    xcd_barrier(xb);
    ffn_up_phase(P_, P_.Wgu2 + (long)l * 2 * DFF * 1024, smem, g_wave_s);
    xcd_barrier(xb);
    resid_gemm_phase(P_, P_.ACT, DFF, P_.Wd2 + (long)l * 1024 * DFF, 0.5f, smem, g_wave_s);
    xcd_barrier(xb);
    norm_phase(P_.out, P_.plen + l * 1024, P_.NB, P_.PART, DFF / 256, g_wave_s);
    xcd_barrier(xb);
    ple_phase(P_, P_.Wpg + (long)l * 1024 * 1024, smem, g_wave_s);
    xcd_barrier(xb);
  }
}

extern "C" void kernel_launch(void* const* d_in, const int* in_sizes, int n_in, void* d_out, int out_size, void* d_ws,
                              size_t ws_size, hipStream_t stream) {
  (void)in_sizes; (void)n_in; (void)out_size; (void)ws_size;
  Params p{};
  auto F = [&](int i) { return (const float*)d_in[i]; };
  p.x_prompt = F(0); p.x_sample = F(1); p.cache_c = F(2); p.cache_kr = F(3); p.p_prompt = F(4); p.p_sample = F(5);
  p.f1n = F(6); p.mixn = F(10); p.qan = F(12); p.qnn = F(14); p.qrn = F(15); p.kvan = F(16); p.krn = F(17);
  p.knn = F(20); p.gvn = F(21); p.gws = F(22); p.gbs = F(23); p.f2n = F(25); p.plen = F(29);
  p.out = (float*)d_out;
  char* ws = (char*)d_ws; size_t off = 0;
  auto alloc = [&](size_t bytes) { char* r = ws + off; off += (bytes + 255) & ~(size_t)255; return r; };
  p.Wgu1 = (u16*)alloc(2UL * 2 * DFF * 1024 * 2);
  p.Wd1 = (u16*)alloc(2UL * 1024 * DFF * 2);
  p.Win = (u16*)alloc(2UL * LDZ * 1024 * 2);
  p.Wuq = (u16*)alloc(2UL * 1536 * 384 * 2);
  p.Wkv = (u16*)alloc(2UL * 2048 * 512 * 2);
  p.Wo = (u16*)alloc(2UL * 1024 * 1024 * 2);
  p.Wgu2 = (u16*)alloc(2UL * 2 * DFF * 1024 * 2);
  p.Wd2 = (u16*)alloc(2UL * 1024 * DFF * 2);
  p.Wpg = (u16*)alloc(2UL * 1024 * 1024 * 2);
  p.Wpe = (u16*)alloc(2UL * 1024 * 256 * 2);
  p.NB = (u16*)alloc((size_t)M_ALL * 1024 * 2);
  p.ACT = (u16*)alloc((size_t)M_ALL * DFF * 2);
  p.Z = (u16*)alloc((size_t)M_ALL * LDZ * 2);
  p.QN = (u16*)alloc((size_t)M_ALL * 384 * 2);
  p.C = (u16*)alloc((size_t)M_ALL * 512 * 2);
  p.KRp = (u16*)alloc((size_t)M_P * 64 * 2);
  p.KRs = (u16*)alloc((size_t)32 * LKS * 64 * 2);
  p.Q = (u16*)alloc((size_t)M_ALL * 8 * 192 * 2);
  p.Knp = (u16*)alloc((size_t)M_P * 1024 * 2);
  p.VTp = (u16*)alloc((size_t)M_P * 1024 * 2);
  p.Kns = (u16*)alloc((size_t)32 * LKS * 1024 * 2);
  p.VTs = (u16*)alloc((size_t)32 * LKS * 1024 * 2);
  p.OA = (u16*)alloc((size_t)M_ALL * 1024 * 2);
  p.MIX = (u16*)alloc((size_t)M_ALL * 1024 * 2);
  p.PP = (u16*)alloc((size_t)M_ALL * 1024 * 2);
  p.CB = (u16*)alloc((size_t)32 * PAST * 512 * 2);
  p.PB = (u16*)alloc((size_t)M_ALL * 256 * 2);
  p.WgB = (u16*)alloc((size_t)2 * 8 * 128 * 128 * 2);
  p.rsv = (float*)alloc((size_t)M_ALL * 4);
  p.PART = (float*)alloc((size_t)11 * M_S * 1024 * 4);
  p.rope = (float*)alloc((size_t)16384 * 32 * 2 * 4);
  p.ctr = (unsigned*)alloc(256);
  p.bar = (unsigned*)alloc(XCD_BAR_WORDS * 4);

  int nj = 0, ts = 0;
  auto job = [&](const float* src, u16* dst, int K, int N, int kind) {
    p.jobs[nj].src = src; p.jobs[nj].dst = dst; p.jobs[nj].K = K; p.jobs[nj].N = N; p.jobs[nj].kind = kind; p.jobs[nj].tstart = ts;
    ts += (K / 64) * ((N / 64 + 3) / 4); ++nj;
  };
  for (int l = 0; l < 2; ++l) {
    job(F(7) + (size_t)l * 1024 * DFF, p.Wgu1 + (size_t)l * 2 * DFF * 1024, 1024, DFF, 1);
    job(F(8) + (size_t)l * 1024 * DFF, p.Wgu1 + (size_t)l * 2 * DFF * 1024, 1024, DFF, 2);
    job(F(9) + (size_t)l * DFF * 1024, p.Wd1 + (size_t)l * 1024 * DFF, DFF, 1024, 0);
    job(F(11) + (size_t)l * 1024 * DIN, p.Win + (size_t)l * LDZ * 1024, 1024, DIN, 0);
    job(F(13) + (size_t)l * 384 * 1536, p.Wuq + (size_t)l * 1536 * 384, 384, 1536, 3);
    job(F(18) + (size_t)l * 512 * 1024, p.Wkv + (size_t)l * 2048 * 512, 512, 1024, 0);
    job(F(19) + (size_t)l * 512 * 1024, p.Wkv + (size_t)l * 2048 * 512, 512, 1024, 4);
    job(F(24) + (size_t)l * 1024 * 1024, p.Wo + (size_t)l * 1024 * 1024, 1024, 1024, 0);
    job(F(26) + (size_t)l * 1024 * DFF, p.Wgu2 + (size_t)l * 2 * DFF * 1024, 1024, DFF, 1);
    job(F(27) + (size_t)l * 1024 * DFF, p.Wgu2 + (size_t)l * 2 * DFF * 1024, 1024, DFF, 2);
    job(F(28) + (size_t)l * DFF * 1024, p.Wd2 + (size_t)l * 1024 * DFF, DFF, 1024, 0);
    job(F(30) + (size_t)l * 1024 * 1024, p.Wpg + (size_t)l * 1024 * 1024, 1024, 1024, 0);
    job(F(31) + (size_t)l * 256 * 1024, p.Wpe + (size_t)l * 1024 * 256, 256, 1024, 0);
  }
  p.ntile_prep = ts;

  static int grid_blocks = 0;
  if (!grid_blocks) {
    int dev = 0, cus = 0, per_cu = 0;
    hipGetDevice(&dev);
    hipDeviceGetAttribute(&cus, hipDeviceAttributeMultiprocessorCount, dev);
    hipFuncSetAttribute((const void*)mega_fwd, hipFuncAttributeMaxDynamicSharedMemorySize, LDS_TOTAL);
    hipOccupancyMaxActiveBlocksPerMultiprocessor(&per_cu, (const void*)mega_fwd, 512, LDS_TOTAL);
    if (per_cu > 1) per_cu = 1;
    if (per_cu < 1) per_cu = 1;
    grid_blocks = cus * per_cu;
  }
  (void)hipMemsetAsync(p.bar, 0, XCD_BAR_WORDS * 4, stream);
  void* args[] = {&p};
  hipError_t e = hipLaunchCooperativeKernel((const void*)mega_fwd, dim3(grid_blocks), dim3(512), args, LDS_TOTAL, stream);
  if (e != hipSuccess) fprintf(stderr, "cooperative launch failed: %s (grid %d)\n", hipGetErrorString(e), grid_blocks);
}
```
